# Optimizing an MI355X kernel written in HIP

```python
import math
import jax, jax.numpy as jnp
from jax import lax
import numpy as np

D_MODEL = 1024
BATCH = 8
SEQ = 2048
DEPTH = 1
DEC_BATCH = 128
DEC_SEQ = 4
PAST_LEN = 16384
PAGE_SIZE = 128

H_A = 4
DK = 256
DV = 512
RET_CHUNK = 128
ROPE_BASE = 10000.0
GM_WIDTH = 1024
GM_GROUPS = 8
GM_GC = GM_WIDTH // GM_GROUPS
GM_CHUNK = 128
D_FF = 4 * D_MODEL
PLE_DIM = 256
EPS = 1e-6

Q_W = H_A * DK
V_W = H_A * DV
IN_SPLITS = (Q_W, Q_W, V_W, V_W, GM_WIDTH, GM_WIDTH, D_MODEL, D_MODEL)
IN_W = sum(IN_SPLITS)

kernel_name = "retnet_gmlp_gated_hybrid_step"


def rmsnorm(x, g):
    xf = x.astype(jnp.float32)
    y = xf * lax.rsqrt(jnp.mean(xf * xf, axis=-1, keepdims=True) + EPS)
    return (y * g.astype(jnp.float32)).astype(x.dtype)


def layernorm(x, g):
    xf = x.astype(jnp.float32)
    mu = jnp.mean(xf, axis=-1, keepdims=True)
    xc = xf - mu
    y = xc * lax.rsqrt(jnp.mean(xc * xc, axis=-1, keepdims=True) + EPS)
    return (y * g.astype(jnp.float32)).astype(x.dtype)


def rotary(x, pos):
    half = DK // 2
    inv = ROPE_BASE ** (-jnp.arange(half, dtype=jnp.float32) / half)
    ang = pos[:, None] * inv[None, :]
    cos = jnp.cos(ang)[None, :, None, :]
    sin = jnp.sin(ang)[None, :, None, :]
    xf = x.astype(jnp.float32)
    x1, x2 = xf[..., :half], xf[..., half:]
    return jnp.concatenate([x1 * cos - x2 * sin, x2 * cos + x1 * sin], axis=-1)


def log_decays():
    return jnp.log(1.0 - 2.0 ** (-5.0 - jnp.arange(H_A, dtype=jnp.float32)))


def retention_chunked(q, k, v, s0):
    b, L = q.shape[0], q.shape[1]
    c = min(RET_CHUNK, L)
    nc = L // c
    lg = log_decays()
    idx = jnp.arange(c, dtype=jnp.float32)
    diff = idx[:, None] - idx[None, :]
    dmat = jnp.where(diff[None] >= 0, jnp.exp(jnp.maximum(diff, 0.0)[None] * lg[:, None, None]), 0.0)
    in_decay = jnp.exp((idx[:, None] + 1.0) * lg[None, :])
    st_decay = jnp.exp((c - 1.0 - idx[None, :]) * lg[:, None])
    ch_decay = jnp.exp(c * lg)

    def to_chunks(a):
        return jnp.moveaxis(a.reshape(b, nc, c, *a.shape[2:]), 1, 0)

    qc, kc, vc = to_chunks(q), to_chunks(k), to_chunks(v)

    def step(s, inp):
        qi, ki, vi = inp
        sc = jnp.einsum('bqhd,bkhd->bhqk', qi, ki) * dmat[None]
        inner = jnp.einsum('bhqk,bkhv->bqhv', sc, vi)
        cross = jnp.einsum('bqhd,bhdv->bqhv', qi, s) * in_decay[None, :, :, None]
        s_new = s * ch_decay[None, :, None, None] + jnp.einsum('bkhd,bkhv,hk->bhdv', ki, vi, st_decay)
        return s_new, inner + cross

    s_fin, o = lax.scan(step, s0, (qc, kc, vc))
    o = jnp.moveaxis(o, 0, 1).reshape(b, L, H_A, DV)
    return o, s_fin


def spatial_gating(v, w_s, b_s):
    b, L = v.shape[0], v.shape[1]
    c = min(GM_CHUNK, L)
    nc = L // c
    mask = jnp.tril(jnp.ones((c, c), dtype=bool))
    w = jnp.where(mask[None], w_s[:, :c, :c], 0.0).astype(v.dtype)
    vr = v.reshape(b, nc, c, GM_GROUPS, GM_GC)
    out = jnp.einsum('gnm,bcmgd->bcngd', w, vr) + jnp.transpose(b_s[:, :c])[None, None, :, :, None].astype(v.dtype)
    return out.reshape(b, L, GM_WIDTH)


def layer(h, p_i, s0, pos, g_mix, w_in, g_ret, w_s, b_s, g_gm, w_br_a, w_br_b, w_o,
          g_mlp, w_up, w_down, g_ple, w_pg, w_pp):
    b, L = h.shape[0], h.shape[1]
    n = rmsnorm(h, g_mix)
    z = n @ w_in
    offs = np.cumsum((0,) + IN_SPLITS)
    zq, zk, zv, zg, zu, zgv, zga, zgb = [z[..., offs[j]:offs[j + 1]] for j in range(len(IN_SPLITS))]
    q = rotary(zq.reshape(b, L, H_A, DK), pos)
    k = rotary(zk.reshape(b, L, H_A, DK), pos) * (DK ** -0.5)
    vv = zv.reshape(b, L, H_A, DV).astype(jnp.float32)
    o, s_new = retention_chunked(q, k, vv, s0.astype(jnp.float32))
    o = rmsnorm(o, g_ret.reshape(H_A, DV)).reshape(b, L, V_W).astype(h.dtype)
    y_a = jax.nn.silu(zg) * o
    u = jax.nn.gelu(zu, approximate=False)
    gv = layernorm(jax.nn.gelu(zgv, approximate=False), g_gm)
    y_b = u * spatial_gating(gv, w_s, b_s)
    merged = jax.nn.sigmoid(zga) * (y_a @ w_br_a) + jax.nn.sigmoid(zgb) * (y_b @ w_br_b)
    h = h + merged @ w_o
    n2 = rmsnorm(h, g_mlp)
    h = h + jnp.square(jax.nn.relu(n2 @ w_up)) @ w_down
    n3 = rmsnorm(h, g_ple)
    h = h + jax.nn.sigmoid(n3 @ w_pg) * (p_i @ w_pp)
    return h, s_new.astype(s0.dtype), gv


def setup_inputs(seed: int = 0) -> dict:
    key = jax.random.key(seed)
    ks = jax.random.split(key, 24)
    f = jnp.float32

    def nrm(k, shape, scale):
        return jax.random.normal(k, shape, f) * scale

    def gain(k, shape):
        return 1.0 + 0.05 * jax.random.normal(k, shape, f)

    return {
        "x_prompt": nrm(ks[0], (BATCH, SEQ, D_MODEL), 1.0),
        "x_sample": nrm(ks[1], (DEC_BATCH, DEC_SEQ, D_MODEL), 1.0),
        "p_prompt": nrm(ks[2], (DEPTH, BATCH, SEQ, PLE_DIM), 1.0),
        "p_sample": nrm(ks[3], (DEPTH, DEC_BATCH, DEC_SEQ, PLE_DIM), 1.0),
        "state_ret": nrm(ks[4], (DEPTH, DEC_BATCH, H_A, DK, DV), 0.1),
        "g_mix": gain(ks[5], (DEPTH, D_MODEL)),
        "w_in": nrm(ks[6], (DEPTH, D_MODEL, IN_W), D_MODEL ** -0.5),
        "g_ret": gain(ks[7], (DEPTH, V_W)),
        "w_s": nrm(ks[8], (DEPTH, GM_GROUPS, GM_CHUNK, GM_CHUNK), 0.5 * GM_CHUNK ** -0.5),
        "b_s": 1.0 + 0.01 * jax.random.normal(ks[9], (DEPTH, GM_GROUPS, GM_CHUNK), f),
        "g_gm": gain(ks[10], (DEPTH, GM_WIDTH)),
        "w_br_a": nrm(ks[11], (DEPTH, V_W, D_MODEL), V_W ** -0.5),
        "w_br_b": nrm(ks[12], (DEPTH, GM_WIDTH, D_MODEL), GM_WIDTH ** -0.5),
        "w_o": nrm(ks[13], (DEPTH, D_MODEL, D_MODEL), D_MODEL ** -0.5),
        "g_mlp": gain(ks[14], (DEPTH, D_MODEL)),
        "w_up": nrm(ks[15], (DEPTH, D_MODEL, D_FF), D_MODEL ** -0.5),
        "w_down": nrm(ks[16], (DEPTH, D_FF, D_MODEL), D_FF ** -0.5),
        "g_ple": gain(ks[17], (DEPTH, D_MODEL)),
        "w_pg": nrm(ks[18], (DEPTH, D_MODEL, D_MODEL), D_MODEL ** -0.5),
        "w_pp": nrm(ks[19], (DEPTH, PLE_DIM, D_MODEL), PLE_DIM ** -0.5),
        "g_final": gain(ks[20], (D_MODEL,)),
    }


def reference(x_prompt, x_sample, p_prompt, p_sample, state_ret, g_mix, w_in, g_ret, w_s, b_s,
              g_gm, w_br_a, w_br_b, w_o, g_mlp, w_up, w_down, g_ple, w_pg, w_pp, g_final):
    pos_p = jnp.arange(SEQ, dtype=jnp.float32)
    pos_s = PAST_LEN + jnp.arange(DEC_SEQ, dtype=jnp.float32)
    hp, hs = x_prompt, x_sample
    sp_list, ss_list, gv_list = [], [], []
    for i in range(DEPTH):
        params = (g_mix[i], w_in[i], g_ret[i], w_s[i], b_s[i], g_gm[i], w_br_a[i], w_br_b[i], w_o[i],
                  g_mlp[i], w_up[i], w_down[i], g_ple[i], w_pg[i], w_pp[i])
        s0_p = jnp.zeros((BATCH, H_A, DK, DV), state_ret.dtype)
        hp, sp, _ = layer(hp, p_prompt[i], s0_p, pos_p, *params)
        hs, ss, gv_s = layer(hs, p_sample[i], state_ret[i], pos_s, *params)
        sp_list.append(sp)
        ss_list.append(ss)
        gv_list.append(gv_s)
    y_prompt = rmsnorm(hp, g_final)
    y_sample = rmsnorm(hs, g_final)
    state_ret_prompt = jnp.stack(sp_list, axis=0)
    state_ret_sample = jnp.stack(ss_list, axis=0)
    state_gm_v_sample = jnp.stack(gv_list, axis=0)
    return (y_prompt, y_sample, state_ret_prompt, state_ret_sample, state_gm_v_sample)
```

```cpp
#include <hip/hip_runtime.h>
#include <cstdio>
#include <cstdint>
namespace pg8 {
#define PG8_LAS __attribute__((address_space(3)))
typedef unsigned short bf16_t;
typedef short bf16x8 __attribute__((ext_vector_type(8)));
typedef float f32x4 __attribute__((ext_vector_type(4)));
typedef unsigned u32x4 __attribute__((ext_vector_type(4)));
constexpr int BM = 256, BK = 64, HALF = 128, HTB = HALF * BK * 2  , STAGE_BYTES = 8 * HTB, NXCD = 8, WGM = 8;

__host__ __device__ __forceinline__ int lds_byte(int r, int c) { const int st = (r >> 4) * 2 + (c >> 5), rr = r & 15, cc = c & 31, ob = rr * 64 + cc * 2; return st * 1024 + (ob ^ (((ob >> 9) & 1) << 5)); }
__host__ __device__ __forceinline__ void stage_rc(int b, int& R, int& C) { const int st = b / 1024, sb = b % 1024, swz = sb ^ (((sb >> 9) & 1) << 5); R = (st >> 1) * 16 + swz / 64; C = (st & 1) * 32 + (swz % 64) / 2; }
__host__ __device__ __forceinline__ int perm32(int rho) { const int n = rho >> 4, i = rho & 15; return 8 * (i >> 2) + 4 * n + (i & 3); }

struct Unit { int pm, pn; };
struct Gemm { const bf16_t* A; const bf16_t* Bt; int M, N, K; };

struct StaticOrder {
    int nM, nN, nwg, G, c;
    __host__ __device__ void init(int M, int N, int G_, int c_) { nM = M / BM; nN = N / BM; nwg = nM * nN; G = G_; c = c_; }
    __host__ __device__ bool next(int i, Unit& u) const {
        const long L = (long)i * G + c; if (L >= nwg) return false;
        int wgid = (int)L; { const int q = nwg / NXCD, r = nwg % NXCD, xcd = wgid % NXCD, off = wgid / NXCD; wgid = (xcd < r ? xcd * (q + 1) : r * (q + 1) + (xcd - r) * q) + off; }
        const int nig = WGM * nN, gid = wgid / nig, fm = gid * WGM, gsz = (nM - fm) < WGM ? (nM - fm) : WGM;
        u.pm = fm + ((wgid % nig) % gsz); u.pn = (wgid % nig) / gsz; return true;
    }
    __device__ __forceinline__ void a_ready(const Unit&) const {}
    __device__ __forceinline__ void done(const Unit&) const {}
};

__device__ __forceinline__ unsigned cvt_pk_bf16(float lo, float hi) { unsigned r; asm volatile("v_cvt_pk_bf16_f32 %0, %1, %2" : "=v"(r) : "v"(lo), "v"(hi)); return r; }
typedef float f32x2 __attribute__((ext_vector_type(2)));
__device__ __forceinline__ f32x2 gelu_pk(f32x2 v) {
    const f32x2 av = __builtin_elementwise_abs(v), d = av * 0.2316418882f + 1.0f;
    f32x2 t; t.x = __builtin_amdgcn_rcpf(d.x); t.y = __builtin_amdgcn_rcpf(d.y);
    f32x2 q = t * 0.5307027145f + (-0.7265760135f); q = q * t + 0.7107068705f; q = q * t + (-0.142248368f); q = q * t + 0.127414796f; q = q * t;
    const f32x2 s = (v * v) * (-0.72134752044f);
    f32x2 e; e.x = __builtin_amdgcn_exp2f(s.x); e.y = __builtin_amdgcn_exp2f(s.y);
    const f32x2 m = v * (q * e), r = v - m;
    f32x2 o; o.x = v.x < 0.f ? m.x : r.x; o.y = v.y < 0.f ? m.y : r.y; return o;
}
template <class Epi, class Sched, bool ALIGN_EPI = false, bool SP2 = false>
__device__ __forceinline__ void gemm_phase(PG8_LAS unsigned char* lds, const Gemm g, const Sched& S, const Epi& E) {
    const int tid = threadIdx.x, wid = __builtin_amdgcn_readfirstlane(tid >> 6), lane = tid & 63, wr = wid >> 2, wc = wid & 3, fr = lane & 15, fq = lane >> 4;
    const int K = g.K, nt = K / BK;
    unsigned voffA[2], voffB[2];
#pragma unroll
    for (int i = 0; i < 2; ++i) { int R, C; stage_rc(tid * 16 + i * 8192, R, C); const int Rb = Epi::PERM ? ((R & ~31) + perm32(R & 31)) : R;
        voffA[i] = (unsigned)(R * K + C) * 2u; voffB[i] = (unsigned)(Rb * K + C) * 2u; }
    const size_t kstep = (size_t)(BK * 2);
    const size_t hstep = (size_t)HALF * K * 2;
    const size_t tstep = 2 * hstep;
    const unsigned ldsw = (unsigned)wid * 1024u;
    const int aoff = lds_byte(wr * 64 + fr, fq * 8), boff = lds_byte(wc * 32 + fr, fq * 8);
#define PG8_SA(b, h) (((b) * 2 + (h)) * HTB)
#define PG8_SB(b, h) ((4 + (b) * 2 + (h)) * HTB)
#define PG8_STAGE(bufoff, gbase, voff) do { _Pragma("unroll") for (int _i = 0; _i < 2; ++_i) \
        __builtin_amdgcn_global_load_lds((const unsigned*)((const char*)(gbase) + (voff)[_i]), (PG8_LAS unsigned*)(lds + (bufoff) + ldsw + _i * 8192), 16, 0, 0); } while (0)
#define PG8_LDA(dst, b, h) do { _Pragma("unroll") for (int m = 0; m < 4; ++m) _Pragma("unroll") for (int k = 0; k < 2; ++k) dst[m][k] = *(const PG8_LAS bf16x8*)(lds + PG8_SA(b, h) + aoff + m * 2048 + k * 1024); } while (0)
#define PG8_LDB(dst, b, h) do { _Pragma("unroll") for (int n = 0; n < 2; ++n) _Pragma("unroll") for (int k = 0; k < 2; ++k) dst[n][k] = *(const PG8_LAS bf16x8*)(lds + PG8_SB(b, h) + boff + n * 2048 + k * 1024); } while (0)
#define PG8_MMA(ai, bj, At, Bt) do { __builtin_amdgcn_s_setprio(1); _Pragma("unroll") for (int m = 0; m < 4; ++m) _Pragma("unroll") for (int n = 0; n < 2; ++n) _Pragma("unroll") for (int k = 0; k < 2; ++k) \
        acc[ai][bj][m][n] = __builtin_amdgcn_mfma_f32_16x16x32_bf16(Bt[n][k], At[m][k], acc[ai][bj][m][n], 0, 0, 0); __builtin_amdgcn_s_setprio(0); } while (0)
#define PG8_WAIT_V(n) asm volatile("s_waitcnt vmcnt(" #n ")" ::: "memory")
#define PG8_WAIT_L(n) asm volatile("s_waitcnt lgkmcnt(" #n ")" ::: "memory")
#define PG8_BAR __builtin_amdgcn_s_barrier()
#define PG8_SCHED __builtin_amdgcn_sched_barrier(0)
    Unit cur, nxt; int ui = 0;
    if (!S.next(0, cur)) return;
    f32x4 acc[2][2][4][2];
#pragma unroll
    for (int a = 0; a < 2; ++a)
#pragma unroll
        for (int b = 0; b < 2; ++b)
#pragma unroll
            for (int m = 0; m < 4; ++m)
#pragma unroll
                for (int n = 0; n < 2; ++n) acc[a][b][m][n] = (f32x4){0.f, 0.f, 0.f, 0.f};
    bf16x8 At[4][2], B0[2][2], B1[2][2];
    const char* cA = (const char*)g.A + (size_t)cur.pm * tstep; const char* cB = (const char*)g.Bt + (size_t)cur.pn * tstep;
    S.a_ready(cur);
    if constexpr (SP2) {
        PG8_STAGE(PG8_SB(0, 0), cB, voffB); PG8_STAGE(PG8_SB(0, 1), cB + hstep, voffB); PG8_STAGE(PG8_SA(0, 0), cA, voffA); PG8_STAGE(PG8_SA(0, 1), cA + hstep, voffA);
        if (wr == 1) PG8_BAR;
        PG8_WAIT_V(2); PG8_BAR;
        PG8_STAGE(PG8_SB(1, 0), cB + kstep, voffB); PG8_STAGE(PG8_SA(1, 0), cA + kstep, voffA); PG8_STAGE(PG8_SB(1, 1), cB + hstep + kstep, voffB);
        PG8_WAIT_V(6); PG8_BAR;
    } else {
        PG8_STAGE(PG8_SB(0, 0), cB, voffB); PG8_STAGE(PG8_SA(0, 0), cA, voffA); PG8_STAGE(PG8_SB(0, 1), cB + hstep, voffB); PG8_STAGE(PG8_SA(0, 1), cA + hstep, voffA);
        if (wr == 1) PG8_BAR;
        PG8_WAIT_V(4); PG8_BAR;
        PG8_STAGE(PG8_SB(1, 0), cB + kstep, voffB); PG8_STAGE(PG8_SA(1, 0), cA + kstep, voffA); PG8_STAGE(PG8_SB(1, 1), cB + hstep + kstep, voffB);
        PG8_WAIT_V(6); PG8_BAR;
    }
    for (;;) {
        const bool has_next = S.next(ui + 1, nxt);
        const char* nA = has_next ? (const char*)g.A + (size_t)nxt.pm * tstep : cA; const char* nB = has_next ? (const char*)g.Bt + (size_t)nxt.pn * tstep : cB;
        for (int t = 0; t < nt; t += 2) {
            const bool last = (t == nt - 2);
            const char* a1 = cA + (size_t)(t + 1) * kstep;
            const char* a2 = last ? nA : cA + (size_t)(t + 2) * kstep; const char* b2 = last ? nB : cB + (size_t)(t + 2) * kstep;
            const char* a3 = a2 + kstep; const char* b3 = b2 + kstep;
            if (last && has_next) S.a_ready(nxt);
            if constexpr (SP2) {
            PG8_LDB(B0, 0, 0); PG8_LDB(B1, 0, 1); PG8_SCHED; PG8_LDA(At, 0, 0); PG8_STAGE(PG8_SA(1, 1), a1 + hstep, voffA);
            PG8_WAIT_V(8); PG8_WAIT_L(0); PG8_BAR; PG8_MMA(0, 0, At, B0); PG8_MMA(0, 1, At, B1); PG8_BAR; PG8_SCHED;
            PG8_LDA(At, 0, 1); PG8_STAGE(PG8_SB(0, 0), b2, voffB); PG8_STAGE(PG8_SB(0, 1), b2 + hstep, voffB); PG8_STAGE(PG8_SA(0, 0), a2, voffA);
            PG8_WAIT_V(8); PG8_WAIT_L(0); PG8_BAR; PG8_MMA(1, 0, At, B0); PG8_MMA(1, 1, At, B1); PG8_BAR; PG8_SCHED;
            PG8_LDB(B0, 1, 0); PG8_LDB(B1, 1, 1); PG8_SCHED; PG8_LDA(At, 1, 0); PG8_STAGE(PG8_SA(0, 1), a2 + hstep, voffA);
            PG8_WAIT_V(8); PG8_WAIT_L(0); PG8_BAR; PG8_MMA(0, 0, At, B0); PG8_MMA(0, 1, At, B1); PG8_BAR; PG8_SCHED;
            PG8_LDA(At, 1, 1); PG8_STAGE(PG8_SB(1, 0), b3, voffB); PG8_STAGE(PG8_SB(1, 1), b3 + hstep, voffB); PG8_STAGE(PG8_SA(1, 0), a3, voffA);
            PG8_WAIT_V(8); PG8_WAIT_L(0); PG8_BAR; PG8_MMA(1, 0, At, B0); PG8_MMA(1, 1, At, B1); PG8_BAR; PG8_SCHED;
            } else {
            PG8_LDB(B0, 0, 0); PG8_SCHED; PG8_LDA(At, 0, 0); PG8_STAGE(PG8_SA(1, 1), a1 + hstep, voffA);
            PG8_WAIT_L(8); PG8_BAR; PG8_WAIT_L(0); PG8_MMA(0, 0, At, B0); PG8_BAR; PG8_SCHED;
            PG8_LDB(B1, 0, 1); PG8_STAGE(PG8_SB(0, 0), b2, voffB);
            PG8_BAR; PG8_WAIT_L(0); PG8_MMA(0, 1, At, B1); PG8_BAR;
            PG8_LDA(At, 0, 1); PG8_STAGE(PG8_SA(0, 0), a2, voffA);
            PG8_BAR; PG8_WAIT_L(0); PG8_MMA(1, 0, At, B0); PG8_BAR; PG8_SCHED;
            PG8_STAGE(PG8_SB(0, 1), b2 + hstep, voffB);
            PG8_WAIT_V(6); PG8_BAR; PG8_MMA(1, 1, At, B1); PG8_BAR;
            PG8_LDB(B0, 1, 0); PG8_SCHED; PG8_LDA(At, 1, 0); PG8_STAGE(PG8_SA(0, 1), a2 + hstep, voffA);
            PG8_WAIT_L(8); PG8_BAR; PG8_WAIT_L(0); PG8_MMA(0, 0, At, B0); PG8_BAR; PG8_SCHED;
            PG8_LDB(B1, 1, 1); PG8_STAGE(PG8_SB(1, 0), b3, voffB);
            PG8_BAR; PG8_WAIT_L(0); PG8_MMA(0, 1, At, B1); PG8_BAR;
            PG8_LDA(At, 1, 1); PG8_STAGE(PG8_SA(1, 0), a3, voffA);
            PG8_BAR; PG8_WAIT_L(0); PG8_MMA(1, 0, At, B0); PG8_BAR; PG8_SCHED;
            PG8_STAGE(PG8_SB(1, 1), b3 + hstep, voffB);
            PG8_WAIT_V(6); PG8_BAR; PG8_MMA(1, 1, At, B1); PG8_BAR;
            }
        }
        if constexpr (ALIGN_EPI) { if (wr == 0) PG8_BAR; }
        if constexpr (!Epi::AFTER_DRAIN) { E(acc, cur, wr, wc, fr, fq); S.done(cur); }
        if (!has_next) break;
#pragma unroll
        for (int a = 0; a < 2; ++a)
#pragma unroll
            for (int b = 0; b < 2; ++b)
#pragma unroll
                for (int m = 0; m < 4; ++m)
#pragma unroll
                    for (int n = 0; n < 2; ++n) acc[a][b][m][n] = (f32x4){0.f, 0.f, 0.f, 0.f};
        cur = nxt; cA = nA; cB = nB; ++ui;
        if constexpr (ALIGN_EPI) { if (wr == 1) PG8_BAR; }
    }
    PG8_WAIT_V(0);
    if constexpr (!ALIGN_EPI) { if (wr == 0) PG8_BAR; }
    PG8_BAR;
    if constexpr (Epi::AFTER_DRAIN) { E.fused(acc, cur, wr, wc, fr, fq, lds, wid, lane); S.done(cur); }
#undef PG8_SA
#undef PG8_SB
#undef PG8_STAGE
#undef PG8_LDA
#undef PG8_LDB
#undef PG8_MMA
#undef PG8_WAIT_V
#undef PG8_WAIT_L
#undef PG8_BAR
#undef PG8_SCHED
}
}

namespace mk {
using pg8::bf16_t; using pg8::f32x4; using pg8::f32x2; using pg8::Unit; using pg8::cvt_pk_bf16; using pg8::gelu_pk;
typedef unsigned u32x2 __attribute__((ext_vector_type(2)));
typedef unsigned u32x4 __attribute__((ext_vector_type(4)));
#define LAS __attribute__((address_space(3)))

constexpr int MP = 16384, MS = 512, MT = MP + MS, DM = 1024, INW = 10240, FF = 4096, PLE = 256;
constexpr int CQ = 0, CK = 1024, CV = 2048, CG = 4096, CU = 6144, CGV = 7168, CGA = 8192, CGB = 9216;
constexpr int NTAB = 2048 + 4;
constexpr float EPS = 1e-6f;
constexpr int NWAVES = 8, NTHR = 512;

constexpr size_t O_Y = 0;
constexpr size_t O_SRP = (size_t)MT * DM;
constexpr size_t O_SRS = O_SRP + (size_t)8 * 4 * 256 * 512;
constexpr size_t O_GMV = O_SRS + (size_t)128 * 4 * 256 * 512;
constexpr size_t O_END = O_GMV + (size_t)128 * 4 * 1024;

constexpr size_t al256(size_t x) { return (x + 255) & ~(size_t)255; }
constexpr size_t WS_CTL = 0, CTL_BYTES = 1u << 20;
constexpr size_t WS_LNS = WS_CTL + CTL_BYTES;
constexpr size_t WS_SSQO = WS_LNS + al256((size_t)MT * 2 * 4);
constexpr size_t WS_SSQ2 = WS_SSQO + al256((size_t)MT * 4 * 4);
constexpr size_t WS_SSQ3 = WS_SSQ2 + al256((size_t)MT * 4);
constexpr size_t WS_SSQ4 = WS_SSQ3 + al256((size_t)MT * 4);
constexpr size_t WS_ZERO_END = WS_SSQ4 + al256((size_t)MT * 4);
constexpr size_t WS_COS = al256(WS_ZERO_END);
constexpr size_t WS_SIN = WS_COS + al256((size_t)NTAB * 128 * 4);
constexpr size_t WS_WIN = WS_SIN + al256((size_t)NTAB * 128 * 4);
constexpr size_t WS_WBRA = WS_WIN + (size_t)INW * DM * 2;
constexpr size_t WS_WBRB = WS_WBRA + (size_t)DM * 2048 * 2;
constexpr size_t WS_WO = WS_WBRB + (size_t)DM * DM * 2;
constexpr size_t WS_WUP = WS_WO + (size_t)DM * DM * 2;
constexpr size_t WS_WDN = WS_WUP + (size_t)FF * DM * 2;
constexpr size_t WS_WPG = WS_WDN + (size_t)DM * FF * 2;
constexpr size_t WS_WPP = WS_WPG + (size_t)DM * DM * 2;
constexpr size_t WS_XN = WS_WPP + (size_t)DM * PLE * 2;
constexpr size_t WS_PB = WS_XN + (size_t)MT * DM * 2;
constexpr size_t WS_A = WS_PB + (size_t)MT * PLE * 2;
constexpr size_t WS_Z = WS_A;
constexpr size_t WS_U = WS_A;
constexpr size_t WS_H2 = WS_U + (size_t)MT * FF * 2;
constexpr size_t WS_H2B = WS_H2 + (size_t)MT * DM * 4;
constexpr size_t WS_PE = WS_H2B + (size_t)MT * DM * 2;
constexpr size_t WS_A_END = WS_A + (size_t)MT * INW * 2;
static_assert(WS_PE + (size_t)MT * DM * 4 <= WS_A_END, "region A overlay");
constexpr size_t WS_ORAW = WS_A_END;
constexpr size_t WS_H3 = WS_ORAW;
constexpr size_t WS_YA = WS_ORAW + (size_t)MT * 2048 * 2;
constexpr size_t WS_YB = WS_YA + (size_t)MT * 2048 * 2;
constexpr size_t WS_T = WS_YB + (size_t)MT * DM * 2;
constexpr size_t WS_MG = WS_T + (size_t)MT * DM * 4;
constexpr size_t WS_H1 = WS_MG + (size_t)MT * DM * 2;
constexpr size_t WS_H1B = WS_H1 + (size_t)MT * DM * 4;
constexpr size_t WS_END = WS_H1B + (size_t)MT * DM * 2;

constexpr int LDS_RING = 131072, LDS_MISC = LDS_RING, LDS_BYTES = LDS_RING + 1024;

struct Args {
    const float* in[21]; float* out; unsigned char* ws; int ph_lo, ph_hi;
};

__device__ __forceinline__ float bf2f(unsigned short u) { return __uint_as_float((unsigned)u << 16); }
__device__ __forceinline__ unsigned f2bf(float f) { unsigned u = __float_as_uint(f); return (u + 0x7fffu + ((u >> 16) & 1u)) >> 16; }
__device__ __forceinline__ unsigned pk2(float lo, float hi) { return f2bf(lo) | (f2bf(hi) << 16); }
__device__ __forceinline__ f32x4 ld_bf4(const bf16_t* p) { const u32x2 w = *(const u32x2*)p; return (f32x4){__uint_as_float(w.x << 16), __uint_as_float(w.x & 0xffff0000u), __uint_as_float(w.y << 16), __uint_as_float(w.y & 0xffff0000u)}; }
typedef float f32x2_t __attribute__((ext_vector_type(2))); typedef __bf16 bf16x2_t __attribute__((ext_vector_type(2)));
__device__ __forceinline__ unsigned cvtpk(float lo, float hi) { const f32x2_t v = {lo, hi}; const bf16x2_t b = __builtin_convertvector(v, bf16x2_t); return __builtin_bit_cast(unsigned, b); }
__device__ __forceinline__ void st_bf4(bf16_t* p, f32x4 v) { u32x2 w; w.x = cvtpk(v[0], v[1]); w.y = cvtpk(v[2], v[3]); *(u32x2*)p = w; }
__device__ __forceinline__ float sigmoidf_(float x) { return __builtin_amdgcn_rcpf(1.0f + __builtin_amdgcn_exp2f(-1.4426950408889634f * x)); }
__device__ __forceinline__ f32x4 sigmoid4(f32x4 v) { return (f32x4){sigmoidf_(v[0]), sigmoidf_(v[1]), sigmoidf_(v[2]), sigmoidf_(v[3])}; }
__device__ __forceinline__ f32x4 silu4(f32x4 v) { return v * sigmoid4(v); }
__device__ __forceinline__ f32x4 gelu4(f32x4 v) { const f32x2 a = gelu_pk((f32x2){v[0], v[1]}), b = gelu_pk((f32x2){v[2], v[3]}); return (f32x4){a.x, a.y, b.x, b.y}; }
__device__ __forceinline__ float sum4(f32x4 v) { return (v[0] + v[1]) + (v[2] + v[3]); }
__device__ __forceinline__ float wave_sum(float v) {
#pragma unroll
    for (int o = 1; o < 64; o <<= 1) v += __shfl_xor(v, o);
    return v;
}
__device__ __forceinline__ int tab_index(int row) { return row < MP ? (row & 2047) : 2048 + (row & 3); }

template <class F> struct EpiGen {
    static constexpr bool PERM = false, AFTER_DRAIN = false;
    F f;
    template <int KIND> __device__ __forceinline__ void run(const f32x4 (&acc)[2][2][4][2], int row0, int col0, int fq) const {
#pragma unroll
        for (int ai = 0; ai < 2; ++ai)
#pragma unroll
            for (int m = 0; m < 4; ++m) {
                const int row = row0 + ai * 128 + m * 16;
                float red[2] = {0.f, 0.f};
                const typename F::RowCtx rc = f.template row_begin<KIND>(row);
#pragma unroll
                for (int n = 0; n < 2; ++n) f.template pair<KIND>(rc, row, col0 + n * 16, acc[ai][0][m][n], col0 + 128 + n * 16, acc[ai][1][m][n], red);
                if (F::template nred<KIND>() > 0) {
                    red[0] += __shfl_xor(red[0], 16); red[0] += __shfl_xor(red[0], 32);
                    if (F::template nred<KIND>() > 1) { red[1] += __shfl_xor(red[1], 16); red[1] += __shfl_xor(red[1], 32); }
                    if (fq == 0) f.template row_add<KIND>(row, red);
                }
                asm volatile("" ::: "memory");
            }
    }
    __device__ __forceinline__ void operator()(const f32x4 (&acc)[2][2][4][2], const Unit& u, int wr, int wc, int fr, int fq) const {
        const int row0 = u.pm * 256 + wr * 64 + fr, col0 = u.pn * 256 + wc * 32 + 4 * fq;
        const int kind = f.kind(u.pn * 256);
        if (F::NK == 1) { run<0>(acc, row0, col0, fq); return; }
        switch (kind) {
            case 0: run<0>(acc, row0, col0, fq); break;
            case 1: run<(F::NK > 1 ? 1 : 0)>(acc, row0, col0, fq); break;
            case 2: run<(F::NK > 2 ? 2 : 0)>(acc, row0, col0, fq); break;
            case 3: run<(F::NK > 3 ? 3 : 0)>(acc, row0, col0, fq); break;
            case 4: run<(F::NK > 4 ? 4 : 0)>(acc, row0, col0, fq); break;
            default: run<(F::NK > 5 ? 5 : 0)>(acc, row0, col0, fq); break;
        }
    }
};

struct F1 {
    static constexpr int NK = 6; typedef int RowCtx;
    bf16_t* Z; const float* cosT; const float* sinT; float* LNS;
    __device__ __forceinline__ int kind(int cb) const { return cb < CV ? 0 : cb < CG ? 1 : cb < CU ? 2 : cb < CGV ? 3 : cb < CGA ? 4 : 5; }
    template <int K> static __device__ __forceinline__ constexpr int nred() { return K == 4 ? 2 : 0; }
    template <int K> __device__ __forceinline__ RowCtx row_begin(int row) const { return K == 0 ? tab_index(row) * 128 : 0; }
    template <int K> __device__ __forceinline__ void pair(RowCtx rc, int row, int c0, f32x4 v0, int c1, f32x4 v1, float (&red)[2]) const {
        bf16_t* zr = Z + (size_t)row * INW;
        if (K == 0) { const int i0 = c0 & 255; const f32x4 cs = *(const f32x4*)(cosT + rc + i0), sn = *(const f32x4*)(sinT + rc + i0);
            const f32x4 o0 = v0 * cs - v1 * sn, o1 = v1 * cs + v0 * sn; st_bf4(zr + c0, o0); st_bf4(zr + c1, o1); }
        else if (K == 1) { st_bf4(zr + c0, v0); st_bf4(zr + c1, v1); }
        else if (K == 2) { st_bf4(zr + c0, silu4(v0)); st_bf4(zr + c1, silu4(v1)); }
        else if (K == 3) { st_bf4(zr + c0, gelu4(v0)); st_bf4(zr + c1, gelu4(v1)); }
        else if (K == 4) { const f32x4 g0 = gelu4(v0), g1 = gelu4(v1); st_bf4(zr + c0, g0); st_bf4(zr + c1, g1);
            red[0] += sum4(g0) + sum4(g1); red[1] += sum4(g0 * g0) + sum4(g1 * g1); }
        else { st_bf4(zr + c0, sigmoid4(v0)); st_bf4(zr + c1, sigmoid4(v1)); }
    }
    template <int K> __device__ __forceinline__ void row_add(int row, const float (&red)[2]) const { atomicAdd(LNS + 2 * row, red[0]); atomicAdd(LNS + 2 * row + 1, red[1]); }
};
struct F2a {
    static constexpr int NK = 1; typedef int RowCtx;
    const bf16_t* Z; float* T;
    __device__ __forceinline__ int kind(int) const { return 0; }
    template <int K> static __device__ __forceinline__ constexpr int nred() { return 0; }
    template <int K> __device__ __forceinline__ RowCtx row_begin(int) const { return 0; }
    template <int K> __device__ __forceinline__ void pair(RowCtx, int row, int c0, f32x4 v0, int c1, f32x4 v1, float (&)[2]) const {
        const bf16_t* g = Z + (size_t)row * INW + CGA; float* t = T + (size_t)row * DM;
        *(f32x4*)(t + c0) = ld_bf4(g + c0) * v0; *(f32x4*)(t + c1) = ld_bf4(g + c1) * v1;
    }
    template <int K> __device__ __forceinline__ void row_add(int, const float (&)[2]) const {}
};
struct F2b {
    static constexpr int NK = 1; typedef int RowCtx;
    const bf16_t* Z; const float* T; bf16_t* MG;
    __device__ __forceinline__ int kind(int) const { return 0; }
    template <int K> static __device__ __forceinline__ constexpr int nred() { return 0; }
    template <int K> __device__ __forceinline__ RowCtx row_begin(int) const { return 0; }
    template <int K> __device__ __forceinline__ void pair(RowCtx, int row, int c0, f32x4 v0, int c1, f32x4 v1, float (&)[2]) const {
        const bf16_t* g = Z + (size_t)row * INW + CGB; const float* t = T + (size_t)row * DM; bf16_t* o = MG + (size_t)row * DM;
        st_bf4(o + c0, *(const f32x4*)(t + c0) + ld_bf4(g + c0) * v0); st_bf4(o + c1, *(const f32x4*)(t + c1) + ld_bf4(g + c1) * v1);
    }
    template <int K> __device__ __forceinline__ void row_add(int, const float (&)[2]) const {}
};
struct FRes {
    static constexpr int NK = 1; typedef const float* RowCtx;
    const float* baseP; const float* baseS; float* H; bf16_t* HB; float* SSQ;
    __device__ __forceinline__ int kind(int) const { return 0; }
    template <int K> static __device__ __forceinline__ constexpr int nred() { return 1; }
    template <int K> __device__ __forceinline__ RowCtx row_begin(int row) const { return row < MP ? baseP + (size_t)row * DM : baseS + (size_t)(row - MP) * DM; }
    template <int K> __device__ __forceinline__ void pair(RowCtx rc, int row, int c0, f32x4 v0, int c1, f32x4 v1, float (&red)[2]) const {
        const f32x4 h0 = *(const f32x4*)(rc + c0) + v0, h1 = *(const f32x4*)(rc + c1) + v1;
        float* h = H + (size_t)row * DM; bf16_t* hb = HB + (size_t)row * DM;
        *(f32x4*)(h + c0) = h0; *(f32x4*)(h + c1) = h1; st_bf4(hb + c0, h0); st_bf4(hb + c1, h1);
        red[0] += sum4(h0 * h0) + sum4(h1 * h1);
    }
    template <int K> __device__ __forceinline__ void row_add(int row, const float (&red)[2]) const { atomicAdd(SSQ + row, red[0]); }
};
struct F4 {
    static constexpr int NK = 1; typedef float RowCtx;
    const float* SSQ; bf16_t* U;
    __device__ __forceinline__ int kind(int) const { return 0; }
    template <int K> static __device__ __forceinline__ constexpr int nred() { return 0; }
    template <int K> __device__ __forceinline__ RowCtx row_begin(int row) const { return rsqrtf(SSQ[row] * (1.0f / DM) + EPS); }
    template <int K> __device__ __forceinline__ void pair(RowCtx rs, int row, int c0, f32x4 v0, int c1, f32x4 v1, float (&)[2]) const {
        bf16_t* u = U + (size_t)row * FF; const f32x4 z = (f32x4){0.f, 0.f, 0.f, 0.f};
        f32x4 a = __builtin_elementwise_max(v0 * rs, z), b = __builtin_elementwise_max(v1 * rs, z);
        st_bf4(u + c0, a * a); st_bf4(u + c1, b * b);
    }
    template <int K> __device__ __forceinline__ void row_add(int, const float (&)[2]) const {}
};
struct F6a {
    static constexpr int NK = 1; typedef int RowCtx;
    float* PE;
    __device__ __forceinline__ int kind(int) const { return 0; }
    template <int K> static __device__ __forceinline__ constexpr int nred() { return 0; }
    template <int K> __device__ __forceinline__ RowCtx row_begin(int) const { return 0; }
    template <int K> __device__ __forceinline__ void pair(RowCtx, int row, int c0, f32x4 v0, int c1, f32x4 v1, float (&)[2]) const {
        float* p = PE + (size_t)row * DM; *(f32x4*)(p + c0) = v0; *(f32x4*)(p + c1) = v1;
    }
    template <int K> __device__ __forceinline__ void row_add(int, const float (&)[2]) const {}
};
struct F6b {
    static constexpr int NK = 1; typedef float RowCtx;
    const float* SSQ3; const float* H2; const float* PE; float* H3; float* SSQ4;
    __device__ __forceinline__ int kind(int) const { return 0; }
    template <int K> static __device__ __forceinline__ constexpr int nred() { return 1; }
    template <int K> __device__ __forceinline__ RowCtx row_begin(int row) const { return rsqrtf(SSQ3[row] * (1.0f / DM) + EPS); }
    template <int K> __device__ __forceinline__ void pair(RowCtx rs, int row, int c0, f32x4 v0, int c1, f32x4 v1, float (&red)[2]) const {
        const size_t o = (size_t)row * DM;
        const f32x4 h0 = *(const f32x4*)(H2 + o + c0) + sigmoid4(v0 * rs) * *(const f32x4*)(PE + o + c0);
        const f32x4 h1 = *(const f32x4*)(H2 + o + c1) + sigmoid4(v1 * rs) * *(const f32x4*)(PE + o + c1);
        *(f32x4*)(H3 + o + c0) = h0; *(f32x4*)(H3 + o + c1) = h1;
        red[0] += sum4(h0 * h0) + sum4(h1 * h1);
    }
    template <int K> __device__ __forceinline__ void row_add(int row, const float (&red)[2]) const { atomicAdd(SSQ4 + row, red[0]); }
};

struct Ctx {
    LAS unsigned char* lds; int tid, lane, wave, vcu, G;
    const float* const* in; float* out; unsigned char* ws;
    template <class T> __device__ __forceinline__ T* w(size_t off) const { return (T*)(ws + off); }
};
enum { I_XP = 0, I_XS, I_PP, I_PS, I_ST, I_GMIX, I_WIN, I_GRET, I_WS, I_BS, I_GGM, I_WBRA, I_WBRB, I_WO, I_GMLP, I_WUP, I_WDN, I_GPLE, I_WPG, I_WPP, I_GFIN };

__device__ __forceinline__ void p0_transpose_item(const float* W, int K, int N, bf16_t* WT, LAS float* scr, int item, int lane, const float* rowg, int cs_lo, int cs_hi, float cs) {
    const int nblk = N / 32, kb = item / nblk, nb = item % nblk, k0 = 64 * kb, n0 = 32 * nb;
#pragma unroll 8
    for (int i = 0; i < 32; ++i) { const int kk = 2 * i + (lane >> 5); float wv = W[(size_t)(k0 + kk) * N + n0 + (lane & 31)]; if (rowg) wv *= rowg[k0 + kk]; scr[kk * 33 + (lane & 31)] = wv; }
    asm volatile("s_waitcnt lgkmcnt(0)" ::: "memory");
    const int c = lane & 7;
#pragma unroll
    for (int j = 0; j < 4; ++j) { const int n = (lane >> 3) + 8 * j; const LAS float* s = scr + (8 * c) * 33 + n; const float sc = (n0 + n >= cs_lo && n0 + n < cs_hi) ? cs : 1.0f;
        u32x4 o; o.x = pk2(s[0 * 33] * sc, s[1 * 33] * sc); o.y = pk2(s[2 * 33] * sc, s[3 * 33] * sc); o.z = pk2(s[4 * 33] * sc, s[5 * 33] * sc); o.w = pk2(s[6 * 33] * sc, s[7 * 33] * sc);
        *(u32x4*)(WT + (size_t)(n0 + n) * K + k0 + 8 * c) = o; }
    asm volatile("s_waitcnt lgkmcnt(0)" ::: "memory");
}
__device__ __forceinline__ double sin_poly(double x) {
    const double x2 = x * x; double r = -1.0 / 8841761993739701954543616000000.0;
    r = r * x2 + 1.0 / 10888869450418352160768000000.0;
    r = r * x2 - 1.0 / 15511210043330985984000000.0;
    r = r * x2 + 1.0 / 25852016738884976640000.0;
    r = r * x2 - 1.0 / 51090942171709440000.0;
    r = r * x2 + 1.0 / 121645100408832000.0;
    r = r * x2 - 1.0 / 355687428096000.0;
    r = r * x2 + 1.0 / 1307674368000.0;
    r = r * x2 - 1.0 / 6227020800.0;
    r = r * x2 + 1.0 / 39916800.0;
    r = r * x2 - 1.0 / 362880.0;
    r = r * x2 + 1.0 / 5040.0;
    r = r * x2 - 1.0 / 120.0;
    r = r * x2 + 1.0 / 6.0;
    r = r * x2 - 1.0;
    return -r * x;
}
__device__ __forceinline__ double cos_poly(double x) {
    const double x2 = x * x; double r = -1.0 / 265252859812191058636308480000000.0;
    r = r * x2 + 1.0 / 304888344611713860501504000000.0;
    r = r * x2 - 1.0 / 403291461126605635584000000.0;
    r = r * x2 + 1.0 / 620448401733239439360000.0;
    r = r * x2 - 1.0 / 1124000727777607680000.0;
    r = r * x2 + 1.0 / 2432902008176640000.0;
    r = r * x2 - 1.0 / 6402373705728000.0;
    r = r * x2 + 1.0 / 20922789888000.0;
    r = r * x2 - 1.0 / 87178291200.0;
    r = r * x2 + 1.0 / 479001600.0;
    r = r * x2 - 1.0 / 3628800.0;
    r = r * x2 + 1.0 / 40320.0;
    r = r * x2 - 1.0 / 720.0;
    r = r * x2 + 1.0 / 24.0;
    r = r * x2 - 0.5;
    r = r * x2 + 1.0;
    return r;
}
__device__ __forceinline__ void p0_prologue(const Ctx& C) {
    LAS float* scr = (LAS float*)(C.lds + C.wave * 16384);
    const int gw = C.vcu * NWAVES + C.wave, NGW = C.G * NWAVES, lane = C.lane;
    constexpr int I_IN = (DM / 64) * (INW / 32), I_BRA = (2048 / 64) * (DM / 32), I_SQ = (DM / 64) * (DM / 32), I_UP = (DM / 64) * (FF / 32), I_DN = (FF / 64) * (DM / 32), I_PPI = (PLE / 64) * (DM / 32);
    constexpr int NITEMS = I_IN + I_BRA + 3 * I_SQ + I_UP + I_DN + I_PPI;
    for (int it = gw; it < NITEMS; it += NGW) {
        int r = it;
        if (r < I_IN) { p0_transpose_item(C.in[I_WIN], DM, INW, C.w<bf16_t>(WS_WIN), scr, r, lane, nullptr, CK, CV, 0.0625f); continue; } r -= I_IN;
        if (r < I_BRA) { p0_transpose_item(C.in[I_WBRA], 2048, DM, C.w<bf16_t>(WS_WBRA), scr, r, lane, nullptr, 0, 0, 1.f); continue; } r -= I_BRA;
        if (r < I_SQ) { p0_transpose_item(C.in[I_WBRB], DM, DM, C.w<bf16_t>(WS_WBRB), scr, r, lane, nullptr, 0, 0, 1.f); continue; } r -= I_SQ;
        if (r < I_SQ) { p0_transpose_item(C.in[I_WO], DM, DM, C.w<bf16_t>(WS_WO), scr, r, lane, nullptr, 0, 0, 1.f); continue; } r -= I_SQ;
        if (r < I_SQ) { p0_transpose_item(C.in[I_WPG], DM, DM, C.w<bf16_t>(WS_WPG), scr, r, lane, C.in[I_GPLE], 0, 0, 1.f); continue; } r -= I_SQ;
        if (r < I_UP) { p0_transpose_item(C.in[I_WUP], DM, FF, C.w<bf16_t>(WS_WUP), scr, r, lane, C.in[I_GMLP], 0, 0, 1.f); continue; } r -= I_UP;
        if (r < I_DN) { p0_transpose_item(C.in[I_WDN], FF, DM, C.w<bf16_t>(WS_WDN), scr, r, lane, nullptr, 0, 0, 1.f); continue; } r -= I_DN;
        p0_transpose_item(C.in[I_WPP], PLE, DM, C.w<bf16_t>(WS_WPP), scr, r, lane, nullptr, 0, 0, 1.f);
    }
    const float* gm = C.in[I_GMIX];
    f32x4 gv[4];
#pragma unroll
    for (int j = 0; j < 4; ++j) gv[j] = ((const f32x4*)gm)[lane + 64 * j];
    bf16_t* XN = C.w<bf16_t>(WS_XN); bf16_t* PB = C.w<bf16_t>(WS_PB);
    for (int m = gw; m < MT; m += NGW) {
        const float* xrow = m < MP ? C.in[I_XP] + (size_t)m * DM : C.in[I_XS] + (size_t)(m - MP) * DM;
        const f32x4* xr = (const f32x4*)xrow + lane;
        f32x4 v[4]; float s = 0.f;
#pragma unroll
        for (int j = 0; j < 4; ++j) { v[j] = xr[64 * j]; s += sum4(v[j] * v[j]); }
        const float rstd = rsqrtf(wave_sum(s) * (1.f / DM) + EPS);
        u32x2* o8 = (u32x2*)(XN + (size_t)m * DM) + lane;
#pragma unroll
        for (int j = 0; j < 4; ++j) { const f32x4 y = v[j] * rstd * gv[j]; u32x2 w; w.x = pk2(y[0], y[1]); w.y = pk2(y[2], y[3]); o8[64 * j] = w; }
        const float* prow = m < MP ? C.in[I_PP] + (size_t)m * PLE : C.in[I_PS] + (size_t)(m - MP) * PLE;
        const f32x4 pv = ((const f32x4*)prow)[lane]; u32x2 pw; pw.x = pk2(pv[0], pv[1]); pw.y = pk2(pv[2], pv[3]);
        ((u32x2*)(PB + (size_t)m * PLE))[lane] = pw;
    }
    float* cosT = C.w<float>(WS_COS); float* sinT = C.w<float>(WS_SIN);
    for (int e = (C.vcu * NTHR + C.tid); e < NTAB * 128; e += C.G * NTHR) {
        const int ti = e >> 7, i = e & 127; const float pos = ti < 2048 ? (float)ti : (float)(16384 + ti - 2048);
        const float inv = (float)exp2(-(double)i * (13.287712379549449 / 128.0));
        const float ang = pos * inv;
        const double x = (double)ang; const double k = __builtin_rint(x * 0.15915494309189535);
        double r = __builtin_fma(-k, 6.283185307179586, x); r = __builtin_fma(-k, 2.4492935982947064e-16, r);
        cosT[e] = (float)cos_poly(r); sinT[e] = (float)sin_poly(r);
    }
}

template <class F> __device__ __forceinline__ void run_gemm(const Ctx& C, const bf16_t* A, const bf16_t* Bt, int M, int N, int K, const F& f) {
    asm volatile("" : "+s"(K));
    pg8::Gemm g{A, Bt, M, N, K}; pg8::StaticOrder S; S.init(M, N, C.G, (int)blockIdx.x);
    EpiGen<F> E{f};
    pg8::gemm_phase<EpiGen<F>, pg8::StaticOrder, true, true>((PG8_LAS unsigned char*)C.lds, g, S, E);
}

__device__ __forceinline__ void ret_simple_item(const Ctx& C, bool sample, int b, int h, int vs) {
    const int v = C.tid & 63, dg = C.wave, d0 = 32 * dg;
    const int L = sample ? 4 : 2048, row0 = sample ? MP + 4 * b : 2048 * b;
    const float gamma = 1.0f - exp2f(-5.0f - (float)h);
    float S[32];
    const size_t sbase = ((size_t)(b * 4 + h) * 256 + d0) * 512 + vs * 64 + v;
    if (sample) { const float* st = C.in[I_ST] + sbase;
#pragma unroll
        for (int j = 0; j < 32; ++j) S[j] = st[(size_t)j * 512]; }
    else {
#pragma unroll
        for (int j = 0; j < 32; ++j) S[j] = 0.f; }
    const bf16_t* Z = C.w<bf16_t>(WS_Z); bf16_t* OR = C.w<bf16_t>(WS_ORAW); float* SSQO = C.w<float>(WS_SSQO);
    LAS float* part = (LAS float*)C.lds;
    for (int t = 0; t < L; ++t) {
        const int row = row0 + t; const bf16_t* zr = Z + (size_t)row * INW;
        const float vv = bf2f(zr[CV + h * 512 + vs * 64 + v]);
        const u32x4* qp = (const u32x4*)(zr + CQ + h * 256 + d0); const u32x4* kp = (const u32x4*)(zr + CK + h * 256 + d0);
        float o = 0.f;
#pragma unroll
        for (int c = 0; c < 4; ++c) { const u32x4 qw = qp[c], kw = kp[c];
#pragma unroll
            for (int e = 0; e < 4; ++e) { const unsigned q2 = qw[e], k2 = kw[e]; const int j = c * 8 + e * 2;
                S[j] = gamma * S[j] + __uint_as_float(k2 << 16) * vv; o += __uint_as_float(q2 << 16) * S[j];
                S[j + 1] = gamma * S[j + 1] + __uint_as_float(k2 & 0xffff0000u) * vv; o += __uint_as_float(q2 & 0xffff0000u) * S[j + 1]; } }
        part[((t & 1) * 8 + dg) * 64 + v] = o;
        __syncthreads();
        if (dg == 0) { float ot = 0.f;
#pragma unroll
            for (int g = 0; g < 8; ++g) ot += part[((t & 1) * 8 + g) * 64 + v];
            OR[(size_t)row * 2048 + h * 512 + vs * 64 + v] = (bf16_t)f2bf(ot);
            const float ss = wave_sum(ot * ot); if (v == 0) atomicAdd(SSQO + row * 4 + h, ss); }
    }
    float* so = C.out + (sample ? O_SRS : O_SRP) + sbase;
#pragma unroll
    for (int j = 0; j < 32; ++j) so[(size_t)j * 512] = S[j];
    __syncthreads();
}
__device__ __forceinline__ void p2_retention_simple(const Ctx& C) {
    for (int it = C.vcu; it < 256; it += C.G) ret_simple_item(C, false, it >> 5, (it >> 3) & 3, it & 7);
    for (int it = C.vcu; it < 4096; it += C.G) ret_simple_item(C, true, it >> 5, (it >> 3) & 3, it & 7);
}
template <int CH> __device__ __forceinline__ void gate_simple_item(const Ctx& C, int row0, float* gmv_out) {
    LAS float* gvl = (LAS float*)C.lds;
    LAS float* wl = (LAS float*)(C.lds + 65536);
    const bf16_t* Z = C.w<bf16_t>(WS_Z); const float* LNS = C.w<float>(WS_LNS); bf16_t* YB = C.w<bf16_t>(WS_YB);
    const float* w_s = C.in[I_WS]; const float* b_s = C.in[I_BS]; const float* g_gm = C.in[I_GGM];
    for (int g = 0; g < 8; ++g) {
        for (int e = C.tid; e < CH * 128; e += NTHR) { const int m = e >> 7, ch = e & 127; const int row = row0 + m;
            const float mu = LNS[2 * row] * (1.f / 1024.f), var = LNS[2 * row + 1] * (1.f / 1024.f) - mu * mu, rstd = rsqrtf(var + EPS);
            const float x = bf2f(Z[(size_t)row * INW + CGV + g * 128 + ch]); const float y = (x - mu) * rstd * g_gm[g * 128 + ch];
            gvl[e] = y; if (gmv_out) gmv_out[(size_t)m * 1024 + g * 128 + ch] = y;
            wl[e] = (ch < CH) ? w_s[((size_t)g * 128 + m) * 128 + ch] : 0.f; }
        __syncthreads();
        const int ch = C.tid & 127;
        for (int n = C.tid >> 7; n < CH; n += 4) { float acc = b_s[g * 128 + n];
            for (int m = 0; m <= n; ++m) acc += wl[n * 128 + m] * gvl[m * 128 + ch];
            const int row = row0 + n; const float u = bf2f(Z[(size_t)row * INW + CU + g * 128 + ch]);
            YB[(size_t)row * DM + g * 128 + ch] = (bf16_t)f2bf(u * acc); }
        __syncthreads();
    }
}
__device__ __forceinline__ void p2_gating_simple(const Ctx& C) {
    for (int it = C.vcu; it < 128; it += C.G) gate_simple_item<128>(C, (it >> 4) * 2048 + (it & 15) * 128, nullptr);
    for (int it = C.vcu; it < 128; it += C.G) gate_simple_item<4>(C, MP + 4 * it, C.out + O_GMV + (size_t)it * 4 * 1024);
}
__device__ __forceinline__ void p3_finalize_ya(const Ctx& C) {
    const bf16_t* Z = C.w<bf16_t>(WS_Z); const bf16_t* OR = C.w<bf16_t>(WS_ORAW); const float* SSQO = C.w<float>(WS_SSQO); bf16_t* YA = C.w<bf16_t>(WS_YA);
    const float* g_ret = C.in[I_GRET];
    const int gw = C.vcu * NWAVES + C.wave, NGW = C.G * NWAVES, lane = C.lane;
    for (int row = gw; row < MT; row += NGW) {
#pragma unroll
        for (int j = 0; j < 8; ++j) { const int c = 4 * lane + 256 * j, h = c >> 9;
            const float rs = rsqrtf(SSQO[row * 4 + h] * (1.f / 512.f) + EPS);
            const f32x4 o = ld_bf4(OR + (size_t)row * 2048 + c), gz = ld_bf4(Z + (size_t)row * INW + CG + c), gr = *(const f32x4*)(g_ret + c);
            st_bf4(YA + (size_t)row * 2048 + c, gz * o * rs * gr); }
    }
}
__device__ __forceinline__ void p9_final_norm(const Ctx& C) {
    const float* H3 = C.w<float>(WS_H3); const float* SSQ4 = C.w<float>(WS_SSQ4); const float* gf = C.in[I_GFIN];
    const int gw = C.vcu * NWAVES + C.wave, NGW = C.G * NWAVES, lane = C.lane;
    f32x4 gv[4];
#pragma unroll
    for (int j = 0; j < 4; ++j) gv[j] = ((const f32x4*)gf)[lane + 64 * j];
    for (int row = gw; row < MT; row += NGW) {
        const float rs = rsqrtf(SSQ4[row] * (1.f / DM) + EPS);
        const f32x4* hr = (const f32x4*)(H3 + (size_t)row * DM) + lane; f32x4* o = (f32x4*)(C.out + O_Y + (size_t)row * DM) + lane;
#pragma unroll
        for (int j = 0; j < 4; ++j) o[64 * j] = hr[64 * j] * rs * gv[j];
    }
}

#ifdef DBG_EXPORT
__device__ __forceinline__ void dbg_export(const Ctx& C) {
    const bf16_t* Z = C.w<bf16_t>(WS_Z); const bf16_t* YA = C.w<bf16_t>(WS_YA); const bf16_t* YB = C.w<bf16_t>(WS_YB);
    const int gw = C.vcu * NWAVES + C.wave, NGW = C.G * NWAVES, lane = C.lane;
    for (int row = gw; row < MT; row += NGW)
        for (int j = 0; j < 4; ++j) { const int c = 4 * lane + 256 * j;
            f32x4 v = (f32x4){0.f, 0.f, 0.f, 0.f};
#if DBG_EXPORT == 1
            v = ld_bf4(YB + (size_t)row * DM + c);
#elif DBG_EXPORT == 4
            v = ld_bf4(YA + (size_t)row * 2048 + c) + ld_bf4(YA + (size_t)row * 2048 + 1024 + c);
#elif DBG_EXPORT == 5
            v = ld_bf4(Z + (size_t)row * INW + CGA + c) + ld_bf4(Z + (size_t)row * INW + CGB + c);
#elif DBG_EXPORT == 6
            v = ld_bf4(C.w<bf16_t>(WS_ORAW) + (size_t)row * 2048 + c) + ld_bf4(C.w<bf16_t>(WS_ORAW) + (size_t)row * 2048 + 1024 + c);
#elif DBG_EXPORT == 7
            v = ld_bf4(Z + (size_t)row * INW + CG + c) + ld_bf4(Z + (size_t)row * INW + CG + 1024 + c);
#elif DBG_EXPORT == 8
            v = ld_bf4(Z + (size_t)row * INW + CQ + c);
#endif
            *(f32x4*)(C.out + O_Y + (size_t)row * DM + c) = v; }
}
#endif
constexpr int NPHASE = 10;
__global__ void __launch_bounds__(NTHR, 2) mk_fwd(Args args) {
    extern __shared__ __attribute__((aligned(16))) unsigned char lds_raw[];
    Ctx C;
    C.lds = (LAS unsigned char*)lds_raw; C.tid = threadIdx.x; C.lane = C.tid & 63; C.wave = __builtin_amdgcn_readfirstlane(C.tid >> 6);
    C.G = gridDim.x; { const int bx = blockIdx.x; C.vcu = (C.G % 8 == 0) ? (bx % 8) * (C.G / 8) + bx / 8 : bx; }
    C.in = args.in; C.out = args.out; C.ws = args.ws;
    const int lo = args.ph_lo, hi = args.ph_hi;
#define IN(k) (lo <= (k) && (k) < hi)
#define SEAM(k) do { if (IN(k) && IN((k) + 1)) { GRID_BAR(); } } while (0)
#define GRID_BAR() do { } while (0)
    if (IN(0)) { p0_prologue(C); } SEAM(0);
    if (IN(1)) { F1 f{C.w<bf16_t>(WS_Z), C.w<float>(WS_COS), C.w<float>(WS_SIN), C.w<float>(WS_LNS)}; run_gemm(C, C.w<bf16_t>(WS_XN), C.w<bf16_t>(WS_WIN), MT, INW, DM, f); } SEAM(1);
    if (IN(2)) { p2_retention_simple(C); p2_gating_simple(C); } SEAM(2);
    if (IN(3)) { p3_finalize_ya(C); } SEAM(3);
    if (IN(4)) { { F2a f{C.w<bf16_t>(WS_Z), C.w<float>(WS_T)}; run_gemm(C, C.w<bf16_t>(WS_YA), C.w<bf16_t>(WS_WBRA), MT, DM, 2048, f); }
                 { F2b f{C.w<bf16_t>(WS_Z), C.w<float>(WS_T), C.w<bf16_t>(WS_MG)}; run_gemm(C, C.w<bf16_t>(WS_YB), C.w<bf16_t>(WS_WBRB), MT, DM, DM, f); } } SEAM(4);
    if (IN(5)) { FRes f{C.in[I_XP], C.in[I_XS], C.w<float>(WS_H1), C.w<bf16_t>(WS_H1B), C.w<float>(WS_SSQ2)}; run_gemm(C, C.w<bf16_t>(WS_MG), C.w<bf16_t>(WS_WO), MT, DM, DM, f); } SEAM(5);
    if (IN(6)) { F4 f{C.w<float>(WS_SSQ2), C.w<bf16_t>(WS_U)}; run_gemm(C, C.w<bf16_t>(WS_H1B), C.w<bf16_t>(WS_WUP), MT, FF, DM, f); } SEAM(6);
    if (IN(7)) { FRes f{C.w<float>(WS_H1), C.w<float>(WS_H1) + (size_t)MP * DM, C.w<float>(WS_H2), C.w<bf16_t>(WS_H2B), C.w<float>(WS_SSQ3)}; run_gemm(C, C.w<bf16_t>(WS_U), C.w<bf16_t>(WS_WDN), MT, DM, FF, f); } SEAM(7);
    if (IN(8)) { { F6a f{C.w<float>(WS_PE)}; run_gemm(C, C.w<bf16_t>(WS_PB), C.w<bf16_t>(WS_WPP), MT, DM, PLE, f); }
                 { F6b f{C.w<float>(WS_SSQ3), C.w<float>(WS_H2), C.w<float>(WS_PE), C.w<float>(WS_H3), C.w<float>(WS_SSQ4)}; run_gemm(C, C.w<bf16_t>(WS_H2B), C.w<bf16_t>(WS_WPG), MT, DM, DM, f); } } SEAM(8);
    if (IN(9)) { p9_final_norm(C); }
#ifdef DBG_EXPORT
    if (IN(10)) { dbg_export(C); }
#endif
#undef IN
#undef SEAM
#undef GRID_BAR
}
}

extern "C" void kernel_launch(void* const* d_in, const int* in_sizes, int n_in, void* d_out, int out_size, void* d_ws, size_t ws_size, hipStream_t stream) {
    using namespace mk;
    static int grid = 0;
    if (grid == 0) {
        if (n_in != 21 || (size_t)out_size != O_END || ws_size < WS_END) { fprintf(stderr, "kernel_launch: unexpected shapes: n_in %d out %d ws %zu (need %zu)\n", n_in, out_size, ws_size, (size_t)WS_END); grid = -1; return; }
        int dev = 0, cus = 0;
        if (hipGetDevice(&dev) != hipSuccess || hipDeviceGetAttribute(&cus, hipDeviceAttributeMultiprocessorCount, dev) != hipSuccess) { grid = -1; return; }
        if (hipFuncSetAttribute((const void*)mk_fwd, hipFuncAttributeMaxDynamicSharedMemorySize, LDS_BYTES) != hipSuccess) { fprintf(stderr, "kernel_launch: hipFuncSetAttribute failed\n"); grid = -1; return; }
        grid = cus;
    }
    if (grid < 0) return;
    (void)hipMemsetAsync((char*)d_ws, 0, WS_ZERO_END, stream);
    Args a{};
    for (int i = 0; i < 21; ++i) a.in[i] = (const float*)d_in[i];
    a.out = (float*)d_out; a.ws = (unsigned char*)d_ws;
#ifdef DBG_EXPORT
    for (int p = 0; p <= DBG_LAST; ++p) { a.ph_lo = p; a.ph_hi = p + 1; hipLaunchKernelGGL(mk_fwd, dim3(grid), dim3(NTHR), LDS_BYTES, stream, a); }
    a.ph_lo = 10; a.ph_hi = 11; hipLaunchKernelGGL(mk_fwd, dim3(grid), dim3(NTHR), LDS_BYTES, stream, a);
#else
    for (int p = 0; p < NPHASE; ++p) { a.ph_lo = p; a.ph_hi = p + 1; hipLaunchKernelGGL(mk_fwd, dim3(grid), dim3(NTHR), LDS_BYTES, stream, a); }
#endif
}
```

```cpp
#include <hip/hip_runtime.h>
#include <hip/hip_cooperative_groups.h>
#include <cstdio>
#include <cstdint>
namespace pg8 {
#define PG8_LAS __attribute__((address_space(3)))
typedef unsigned short bf16_t;
typedef short bf16x8 __attribute__((ext_vector_type(8)));
typedef float f32x4 __attribute__((ext_vector_type(4)));
typedef unsigned u32x4 __attribute__((ext_vector_type(4)));
constexpr int BM = 256, BK = 64, HALF = 128, HTB = HALF * BK * 2  , STAGE_BYTES = 8 * HTB, NXCD = 8, WGM = 8;

__host__ __device__ __forceinline__ int lds_byte(int r, int c) { const int st = (r >> 4) * 2 + (c >> 5), rr = r & 15, cc = c & 31, ob = rr * 64 + cc * 2; return st * 1024 + (ob ^ (((ob >> 9) & 1) << 5)); }
__host__ __device__ __forceinline__ void stage_rc(int b, int& R, int& C) { const int st = b / 1024, sb = b % 1024, swz = sb ^ (((sb >> 9) & 1) << 5); R = (st >> 1) * 16 + swz / 64; C = (st & 1) * 32 + (swz % 64) / 2; }
__host__ __device__ __forceinline__ int perm32(int rho) { const int n = rho >> 4, i = rho & 15; return 8 * (i >> 2) + 4 * n + (i & 3); }

struct Unit { int pm, pn; };
struct Gemm { const bf16_t* A; const bf16_t* Bt; int M, N, K; };

struct StaticOrder {
    int nM, nN, nwg, G, c;
    __host__ __device__ void init(int M, int N, int G_, int c_) { nM = M / BM; nN = N / BM; nwg = nM * nN; G = G_; c = c_; }
    __host__ __device__ bool next(int i, Unit& u) const {
        const long L = (long)i * G + c; if (L >= nwg) return false;
        int wgid = (int)L; { const int q = nwg / NXCD, r = nwg % NXCD, xcd = wgid % NXCD, off = wgid / NXCD; wgid = (xcd < r ? xcd * (q + 1) : r * (q + 1) + (xcd - r) * q) + off; }
        const int nig = WGM * nN, gid = wgid / nig, fm = gid * WGM, gsz = (nM - fm) < WGM ? (nM - fm) : WGM;
        u.pm = fm + ((wgid % nig) % gsz); u.pn = (wgid % nig) / gsz; return true;
    }
    __device__ __forceinline__ void a_ready(const Unit&) const {}
    __device__ __forceinline__ void done(const Unit&) const {}
};

__device__ __forceinline__ unsigned cvt_pk_bf16(float lo, float hi) { unsigned r; asm volatile("v_cvt_pk_bf16_f32 %0, %1, %2" : "=v"(r) : "v"(lo), "v"(hi)); return r; }
typedef float f32x2 __attribute__((ext_vector_type(2)));
__device__ __forceinline__ f32x2 gelu_pk(f32x2 v) {
    const f32x2 av = __builtin_elementwise_abs(v), d = av * 0.2316418882f + 1.0f;
    f32x2 t; t.x = __builtin_amdgcn_rcpf(d.x); t.y = __builtin_amdgcn_rcpf(d.y);
    f32x2 q = t * 0.5307027145f + (-0.7265760135f); q = q * t + 0.7107068705f; q = q * t + (-0.142248368f); q = q * t + 0.127414796f; q = q * t;
    const f32x2 s = (v * v) * (-0.72134752044f);
    f32x2 e; e.x = __builtin_amdgcn_exp2f(s.x); e.y = __builtin_amdgcn_exp2f(s.y);
    const f32x2 m = v * (q * e), r = v - m;
    f32x2 o; o.x = v.x < 0.f ? m.x : r.x; o.y = v.y < 0.f ? m.y : r.y; return o;
}
template <class Epi, class Sched, bool ALIGN_EPI = false, bool SP2 = false>
__device__ __forceinline__ void gemm_phase(PG8_LAS unsigned char* lds, const Gemm g, const Sched& S, const Epi& E) {
    const int tid = threadIdx.x, wid = __builtin_amdgcn_readfirstlane(tid >> 6), lane = tid & 63, wr = wid >> 2, wc = wid & 3, fr = lane & 15, fq = lane >> 4;
    const int K = g.K, nt = K / BK;
    unsigned voffA[2], voffB[2];
#pragma unroll
    for (int i = 0; i < 2; ++i) { int R, C; stage_rc(tid * 16 + i * 8192, R, C); const int Rb = Epi::PERM ? ((R & ~31) + perm32(R & 31)) : R;
        voffA[i] = (unsigned)(R * K + C) * 2u; voffB[i] = (unsigned)(Rb * K + C) * 2u; }
    const size_t kstep = (size_t)(BK * 2);
    const size_t hstep = (size_t)HALF * K * 2;
    const size_t tstep = 2 * hstep;
    const unsigned ldsw = (unsigned)wid * 1024u;
    const int aoff = lds_byte(wr * 64 + fr, fq * 8), boff = lds_byte(wc * 32 + fr, fq * 8);
#define PG8_SA(b, h) (((b) * 2 + (h)) * HTB)
#define PG8_SB(b, h) ((4 + (b) * 2 + (h)) * HTB)
#define PG8_STAGE(bufoff, gbase, voff) do { _Pragma("unroll") for (int _i = 0; _i < 2; ++_i) \
        __builtin_amdgcn_global_load_lds((const unsigned*)((const char*)(gbase) + (voff)[_i]), (PG8_LAS unsigned*)(lds + (bufoff) + ldsw + _i * 8192), 16, 0, 0); } while (0)
#define PG8_LDA(dst, b, h) do { _Pragma("unroll") for (int m = 0; m < 4; ++m) _Pragma("unroll") for (int k = 0; k < 2; ++k) dst[m][k] = *(const PG8_LAS bf16x8*)(lds + PG8_SA(b, h) + aoff + m * 2048 + k * 1024); } while (0)
#define PG8_LDB(dst, b, h) do { _Pragma("unroll") for (int n = 0; n < 2; ++n) _Pragma("unroll") for (int k = 0; k < 2; ++k) dst[n][k] = *(const PG8_LAS bf16x8*)(lds + PG8_SB(b, h) + boff + n * 2048 + k * 1024); } while (0)
#define PG8_MMA(ai, bj, At, Bt) do { __builtin_amdgcn_s_setprio(1); _Pragma("unroll") for (int m = 0; m < 4; ++m) _Pragma("unroll") for (int n = 0; n < 2; ++n) _Pragma("unroll") for (int k = 0; k < 2; ++k) \
        acc[ai][bj][m][n] = __builtin_amdgcn_mfma_f32_16x16x32_bf16(Bt[n][k], At[m][k], acc[ai][bj][m][n], 0, 0, 0); __builtin_amdgcn_s_setprio(0); } while (0)
#define PG8_WAIT_V(n) asm volatile("s_waitcnt vmcnt(" #n ")" ::: "memory")
#define PG8_WAIT_L(n) asm volatile("s_waitcnt lgkmcnt(" #n ")" ::: "memory")
#define PG8_BAR __builtin_amdgcn_s_barrier()
#define PG8_SCHED __builtin_amdgcn_sched_barrier(0)
    Unit cur, nxt; int ui = 0;
    if (!S.next(0, cur)) return;
    f32x4 acc[2][2][4][2];
#pragma unroll
    for (int a = 0; a < 2; ++a)
#pragma unroll
        for (int b = 0; b < 2; ++b)
#pragma unroll
            for (int m = 0; m < 4; ++m)
#pragma unroll
                for (int n = 0; n < 2; ++n) acc[a][b][m][n] = (f32x4){0.f, 0.f, 0.f, 0.f};
    bf16x8 At[4][2], B0[2][2], B1[2][2];
    const char* cA = (const char*)g.A + (size_t)cur.pm * tstep; const char* cB = (const char*)g.Bt + (size_t)cur.pn * tstep;
    S.a_ready(cur);
    if constexpr (SP2) {
        PG8_STAGE(PG8_SB(0, 0), cB, voffB); PG8_STAGE(PG8_SB(0, 1), cB + hstep, voffB); PG8_STAGE(PG8_SA(0, 0), cA, voffA); PG8_STAGE(PG8_SA(0, 1), cA + hstep, voffA);
        if (wr == 1) PG8_BAR;
        PG8_WAIT_V(2); PG8_BAR;
        PG8_STAGE(PG8_SB(1, 0), cB + kstep, voffB); PG8_STAGE(PG8_SA(1, 0), cA + kstep, voffA); PG8_STAGE(PG8_SB(1, 1), cB + hstep + kstep, voffB);
        PG8_WAIT_V(6); PG8_BAR;
    } else {
        PG8_STAGE(PG8_SB(0, 0), cB, voffB); PG8_STAGE(PG8_SA(0, 0), cA, voffA); PG8_STAGE(PG8_SB(0, 1), cB + hstep, voffB); PG8_STAGE(PG8_SA(0, 1), cA + hstep, voffA);
        if (wr == 1) PG8_BAR;
        PG8_WAIT_V(4); PG8_BAR;
        PG8_STAGE(PG8_SB(1, 0), cB + kstep, voffB); PG8_STAGE(PG8_SA(1, 0), cA + kstep, voffA); PG8_STAGE(PG8_SB(1, 1), cB + hstep + kstep, voffB);
        PG8_WAIT_V(6); PG8_BAR;
    }
    for (;;) {
        const bool has_next = S.next(ui + 1, nxt);
        const char* nA = has_next ? (const char*)g.A + (size_t)nxt.pm * tstep : cA; const char* nB = has_next ? (const char*)g.Bt + (size_t)nxt.pn * tstep : cB;
        for (int t = 0; t < nt; t += 2) {
            const bool last = (t == nt - 2);
            const char* a1 = cA + (size_t)(t + 1) * kstep;
            const char* a2 = last ? nA : cA + (size_t)(t + 2) * kstep; const char* b2 = last ? nB : cB + (size_t)(t + 2) * kstep;
            const char* a3 = a2 + kstep; const char* b3 = b2 + kstep;
            if (last && has_next) S.a_ready(nxt);
            if constexpr (SP2) {
            PG8_LDB(B0, 0, 0); PG8_LDB(B1, 0, 1); PG8_SCHED; PG8_LDA(At, 0, 0); PG8_STAGE(PG8_SA(1, 1), a1 + hstep, voffA);
            PG8_WAIT_V(8); PG8_WAIT_L(0); PG8_BAR; PG8_MMA(0, 0, At, B0); PG8_MMA(0, 1, At, B1); PG8_BAR; PG8_SCHED;
            PG8_LDA(At, 0, 1); PG8_STAGE(PG8_SB(0, 0), b2, voffB); PG8_STAGE(PG8_SB(0, 1), b2 + hstep, voffB); PG8_STAGE(PG8_SA(0, 0), a2, voffA);
            PG8_WAIT_V(8); PG8_WAIT_L(0); PG8_BAR; PG8_MMA(1, 0, At, B0); PG8_MMA(1, 1, At, B1); PG8_BAR; PG8_SCHED;
            PG8_LDB(B0, 1, 0); PG8_LDB(B1, 1, 1); PG8_SCHED; PG8_LDA(At, 1, 0); PG8_STAGE(PG8_SA(0, 1), a2 + hstep, voffA);
            PG8_WAIT_V(8); PG8_WAIT_L(0); PG8_BAR; PG8_MMA(0, 0, At, B0); PG8_MMA(0, 1, At, B1); PG8_BAR; PG8_SCHED;
            PG8_LDA(At, 1, 1); PG8_STAGE(PG8_SB(1, 0), b3, voffB); PG8_STAGE(PG8_SB(1, 1), b3 + hstep, voffB); PG8_STAGE(PG8_SA(1, 0), a3, voffA);
            PG8_WAIT_V(8); PG8_WAIT_L(0); PG8_BAR; PG8_MMA(1, 0, At, B0); PG8_MMA(1, 1, At, B1); PG8_BAR; PG8_SCHED;
            } else {
            PG8_LDB(B0, 0, 0); PG8_SCHED; PG8_LDA(At, 0, 0); PG8_STAGE(PG8_SA(1, 1), a1 + hstep, voffA);
            PG8_WAIT_L(8); PG8_BAR; PG8_WAIT_L(0); PG8_MMA(0, 0, At, B0); PG8_BAR; PG8_SCHED;
            PG8_LDB(B1, 0, 1); PG8_STAGE(PG8_SB(0, 0), b2, voffB);
            PG8_BAR; PG8_WAIT_L(0); PG8_MMA(0, 1, At, B1); PG8_BAR;
            PG8_LDA(At, 0, 1); PG8_STAGE(PG8_SA(0, 0), a2, voffA);
            PG8_BAR; PG8_WAIT_L(0); PG8_MMA(1, 0, At, B0); PG8_BAR; PG8_SCHED;
            PG8_STAGE(PG8_SB(0, 1), b2 + hstep, voffB);
            PG8_WAIT_V(6); PG8_BAR; PG8_MMA(1, 1, At, B1); PG8_BAR;
            PG8_LDB(B0, 1, 0); PG8_SCHED; PG8_LDA(At, 1, 0); PG8_STAGE(PG8_SA(0, 1), a2 + hstep, voffA);
            PG8_WAIT_L(8); PG8_BAR; PG8_WAIT_L(0); PG8_MMA(0, 0, At, B0); PG8_BAR; PG8_SCHED;
            PG8_LDB(B1, 1, 1); PG8_STAGE(PG8_SB(1, 0), b3, voffB);
            PG8_BAR; PG8_WAIT_L(0); PG8_MMA(0, 1, At, B1); PG8_BAR;
            PG8_LDA(At, 1, 1); PG8_STAGE(PG8_SA(1, 0), a3, voffA);
            PG8_BAR; PG8_WAIT_L(0); PG8_MMA(1, 0, At, B0); PG8_BAR; PG8_SCHED;
            PG8_STAGE(PG8_SB(1, 1), b3 + hstep, voffB);
            PG8_WAIT_V(6); PG8_BAR; PG8_MMA(1, 1, At, B1); PG8_BAR;
            }
        }
        if constexpr (ALIGN_EPI) { if (wr == 0) PG8_BAR; }
        if constexpr (!Epi::AFTER_DRAIN) { E(acc, cur, wr, wc, fr, fq); S.done(cur); }
        if (!has_next) break;
#pragma unroll
        for (int a = 0; a < 2; ++a)
#pragma unroll
            for (int b = 0; b < 2; ++b)
#pragma unroll
                for (int m = 0; m < 4; ++m)
#pragma unroll
                    for (int n = 0; n < 2; ++n) acc[a][b][m][n] = (f32x4){0.f, 0.f, 0.f, 0.f};
        cur = nxt; cA = nA; cB = nB; ++ui;
        if constexpr (ALIGN_EPI) { if (wr == 1) PG8_BAR; }
    }
    PG8_WAIT_V(0);
    if constexpr (!ALIGN_EPI) { if (wr == 0) PG8_BAR; }
    PG8_BAR;
    if constexpr (Epi::AFTER_DRAIN) { E.fused(acc, cur, wr, wc, fr, fq, lds, wid, lane); S.done(cur); }
#undef PG8_SA
#undef PG8_SB
#undef PG8_STAGE
#undef PG8_LDA
#undef PG8_LDB
#undef PG8_MMA
#undef PG8_WAIT_V
#undef PG8_WAIT_L
#undef PG8_BAR
#undef PG8_SCHED
}
}

namespace mk {
using pg8::bf16_t; using pg8::f32x4; using pg8::f32x2; using pg8::Unit; using pg8::cvt_pk_bf16; using pg8::gelu_pk;
typedef unsigned u32x2 __attribute__((ext_vector_type(2)));
typedef unsigned u32x4 __attribute__((ext_vector_type(4)));
#define LAS __attribute__((address_space(3)))

constexpr int MP = 16384, MS = 512, MT = MP + MS, DM = 1024, INW = 10240, FF = 4096, PLE = 256;
constexpr int CQ = 0, CK = 1024, CV = 2048, CG = 4096, CU = 6144, CGV = 7168, CGA = 8192, CGB = 9216;
constexpr int NTAB = 2048 + 4;
constexpr float EPS = 1e-6f;
constexpr int NWAVES = 8, NTHR = 512;

constexpr size_t O_Y = 0;
constexpr size_t O_SRP = (size_t)MT * DM;
constexpr size_t O_SRS = O_SRP + (size_t)8 * 4 * 256 * 512;
constexpr size_t O_GMV = O_SRS + (size_t)128 * 4 * 256 * 512;
constexpr size_t O_END = O_GMV + (size_t)128 * 4 * 1024;

constexpr size_t al256(size_t x) { return (x + 255) & ~(size_t)255; }
constexpr size_t WS_CTL = 0, CTL_BYTES = 1u << 20;
constexpr size_t WS_LNS = WS_CTL + CTL_BYTES;
constexpr size_t WS_SSQO = WS_LNS + al256((size_t)MT * 2 * 4);
constexpr size_t WS_SSQ2 = WS_SSQO + al256((size_t)MT * 4 * 4);
constexpr size_t WS_SSQ3 = WS_SSQ2 + al256((size_t)MT * 4);
constexpr size_t WS_SSQ4 = WS_SSQ3 + al256((size_t)MT * 4);
constexpr size_t WS_ZERO_END = WS_SSQ4 + al256((size_t)MT * 4);
constexpr size_t WS_COS = al256(WS_ZERO_END);
constexpr size_t WS_SIN = WS_COS + al256((size_t)NTAB * 128 * 4);
constexpr size_t WS_WIN = WS_SIN + al256((size_t)NTAB * 128 * 4);
constexpr size_t WS_WBRA = WS_WIN + (size_t)INW * DM * 2;
constexpr size_t WS_WBRB = WS_WBRA + (size_t)DM * 2048 * 2;
constexpr size_t WS_WO = WS_WBRB + (size_t)DM * DM * 2;
constexpr size_t WS_WUP = WS_WO + (size_t)DM * DM * 2;
constexpr size_t WS_WDN = WS_WUP + (size_t)FF * DM * 2;
constexpr size_t WS_WPG = WS_WDN + (size_t)DM * FF * 2;
constexpr size_t WS_WPP = WS_WPG + (size_t)DM * DM * 2;
constexpr size_t WS_XN = WS_WPP + (size_t)DM * PLE * 2;
constexpr size_t WS_PB = WS_XN + (size_t)MT * DM * 2;
constexpr size_t WS_A = WS_PB + (size_t)MT * PLE * 2;
constexpr size_t WS_Z = WS_A;
constexpr size_t WS_U = WS_A;
constexpr size_t WS_H2 = WS_U + (size_t)MT * FF * 2;
constexpr size_t WS_H2B = WS_H2 + (size_t)MT * DM * 4;
constexpr size_t WS_PE = WS_H2B + (size_t)MT * DM * 2;
constexpr size_t WS_A_END = WS_A + (size_t)MT * INW * 2;
static_assert(WS_PE + (size_t)MT * DM * 4 <= WS_A_END, "region A overlay");
constexpr size_t WS_ORAW = WS_A_END;
constexpr size_t WS_H3 = WS_ORAW;
constexpr size_t WS_YA = WS_ORAW + (size_t)MT * 2048 * 2;
constexpr size_t WS_YB = WS_YA + (size_t)MT * 2048 * 2;
constexpr size_t WS_T = WS_YB + (size_t)MT * DM * 2;
constexpr size_t WS_MG = WS_T + (size_t)MT * DM * 4;
constexpr size_t WS_H1 = WS_MG + (size_t)MT * DM * 2;
constexpr size_t WS_H1B = WS_H1 + (size_t)MT * DM * 4;
constexpr size_t WS_END = WS_H1B + (size_t)MT * DM * 2;

constexpr int LDS_RING = 131072, LDS_MISC = LDS_RING, LDS_BYTES = LDS_RING + 1024;

struct Args {
    const float* in[21]; float* out; unsigned char* ws; int ph_lo, ph_hi;
};

__device__ __forceinline__ float bf2f(unsigned short u) { return __uint_as_float((unsigned)u << 16); }
__device__ __forceinline__ unsigned f2bf(float f) { unsigned u = __float_as_uint(f); return (u + 0x7fffu + ((u >> 16) & 1u)) >> 16; }
__device__ __forceinline__ unsigned pk2(float lo, float hi) { return f2bf(lo) | (f2bf(hi) << 16); }
__device__ __forceinline__ f32x4 ld_bf4(const bf16_t* p) { const u32x2 w = *(const u32x2*)p; return (f32x4){__uint_as_float(w.x << 16), __uint_as_float(w.x & 0xffff0000u), __uint_as_float(w.y << 16), __uint_as_float(w.y & 0xffff0000u)}; }
typedef float f32x2_t __attribute__((ext_vector_type(2))); typedef __bf16 bf16x2_t __attribute__((ext_vector_type(2)));
__device__ __forceinline__ unsigned cvtpk(float lo, float hi) { const f32x2_t v = {lo, hi}; const bf16x2_t b = __builtin_convertvector(v, bf16x2_t); return __builtin_bit_cast(unsigned, b); }
__device__ __forceinline__ void st_bf4(bf16_t* p, f32x4 v) { u32x2 w; w.x = cvtpk(v[0], v[1]); w.y = cvtpk(v[2], v[3]); *(u32x2*)p = w; }
__device__ __forceinline__ float sigmoidf_(float x) { return __builtin_amdgcn_rcpf(1.0f + __builtin_amdgcn_exp2f(-1.4426950408889634f * x)); }
__device__ __forceinline__ f32x4 sigmoid4(f32x4 v) { return (f32x4){sigmoidf_(v[0]), sigmoidf_(v[1]), sigmoidf_(v[2]), sigmoidf_(v[3])}; }
__device__ __forceinline__ f32x4 silu4(f32x4 v) { return v * sigmoid4(v); }
__device__ __forceinline__ f32x4 gelu4(f32x4 v) { const f32x2 a = gelu_pk((f32x2){v[0], v[1]}), b = gelu_pk((f32x2){v[2], v[3]}); return (f32x4){a.x, a.y, b.x, b.y}; }
__device__ __forceinline__ float sum4(f32x4 v) { return (v[0] + v[1]) + (v[2] + v[3]); }
__device__ __forceinline__ float wave_sum(float v) {
#pragma unroll
    for (int o = 1; o < 64; o <<= 1) v += __shfl_xor(v, o);
    return v;
}
__device__ __forceinline__ int tab_index(int row) { return row < MP ? (row & 2047) : 2048 + (row & 3); }

template <class F> struct EpiGen {
    static constexpr bool PERM = false, AFTER_DRAIN = false;
    F f;
    template <int KIND> __device__ __forceinline__ void run(const f32x4 (&acc)[2][2][4][2], int row0, int col0, int fq) const {
#pragma unroll
        for (int ai = 0; ai < 2; ++ai)
#pragma unroll
            for (int m = 0; m < 4; ++m) {
                const int row = row0 + ai * 128 + m * 16;
                float red[2] = {0.f, 0.f};
                const typename F::RowCtx rc = f.template row_begin<KIND>(row);
#pragma unroll
                for (int n = 0; n < 2; ++n) f.template pair<KIND>(rc, row, col0 + n * 16, acc[ai][0][m][n], col0 + 128 + n * 16, acc[ai][1][m][n], red);
                if (F::template nred<KIND>() > 0) {
                    red[0] += __shfl_xor(red[0], 16); red[0] += __shfl_xor(red[0], 32);
                    if (F::template nred<KIND>() > 1) { red[1] += __shfl_xor(red[1], 16); red[1] += __shfl_xor(red[1], 32); }
                    if (fq == 0) f.template row_add<KIND>(row, red);
                }
                asm volatile("" ::: "memory");
            }
    }
    __device__ __forceinline__ void operator()(const f32x4 (&acc)[2][2][4][2], const Unit& u, int wr, int wc, int fr, int fq) const {
        const int row0 = u.pm * 256 + wr * 64 + fr, col0 = u.pn * 256 + wc * 32 + 4 * fq;
        const int kind = f.kind(u.pn * 256);
        if (F::NK == 1) { run<0>(acc, row0, col0, fq); return; }
        switch (kind) {
            case 0: run<0>(acc, row0, col0, fq); break;
            case 1: run<(F::NK > 1 ? 1 : 0)>(acc, row0, col0, fq); break;
            case 2: run<(F::NK > 2 ? 2 : 0)>(acc, row0, col0, fq); break;
            case 3: run<(F::NK > 3 ? 3 : 0)>(acc, row0, col0, fq); break;
            case 4: run<(F::NK > 4 ? 4 : 0)>(acc, row0, col0, fq); break;
            default: run<(F::NK > 5 ? 5 : 0)>(acc, row0, col0, fq); break;
        }
    }
};

struct F1 {
    static constexpr int NK = 6; typedef int RowCtx;
    bf16_t* Z; const float* cosT; const float* sinT; float* LNS;
    __device__ __forceinline__ int kind(int cb) const { return cb < CV ? 0 : cb < CG ? 1 : cb < CU ? 2 : cb < CGV ? 3 : cb < CGA ? 4 : 5; }
    template <int K> static __device__ __forceinline__ constexpr int nred() { return K == 4 ? 2 : 0; }
    template <int K> __device__ __forceinline__ RowCtx row_begin(int row) const { return K == 0 ? tab_index(row) * 128 : 0; }
    template <int K> __device__ __forceinline__ void pair(RowCtx rc, int row, int c0, f32x4 v0, int c1, f32x4 v1, float (&red)[2]) const {
        bf16_t* zr = Z + (size_t)row * INW;
        if (K == 0) { const int i0 = c0 & 255; const f32x4 cs = *(const f32x4*)(cosT + rc + i0), sn = *(const f32x4*)(sinT + rc + i0);
            const f32x4 o0 = v0 * cs - v1 * sn, o1 = v1 * cs + v0 * sn; st_bf4(zr + c0, o0); st_bf4(zr + c1, o1); }
        else if (K == 1) { st_bf4(zr + c0, v0); st_bf4(zr + c1, v1); }
        else if (K == 2) { st_bf4(zr + c0, silu4(v0)); st_bf4(zr + c1, silu4(v1)); }
        else if (K == 3) { st_bf4(zr + c0, gelu4(v0)); st_bf4(zr + c1, gelu4(v1)); }
        else if (K == 4) { const f32x4 g0 = gelu4(v0), g1 = gelu4(v1); st_bf4(zr + c0, g0); st_bf4(zr + c1, g1);
            red[0] += sum4(g0) + sum4(g1); red[1] += sum4(g0 * g0) + sum4(g1 * g1); }
        else { st_bf4(zr + c0, sigmoid4(v0)); st_bf4(zr + c1, sigmoid4(v1)); }
    }
    template <int K> __device__ __forceinline__ void row_add(int row, const float (&red)[2]) const { atomicAdd(LNS + 2 * row, red[0]); atomicAdd(LNS + 2 * row + 1, red[1]); }
};
struct F2a {
    static constexpr int NK = 1; typedef int RowCtx;
    const bf16_t* Z; float* T;
    __device__ __forceinline__ int kind(int) const { return 0; }
    template <int K> static __device__ __forceinline__ constexpr int nred() { return 0; }
    template <int K> __device__ __forceinline__ RowCtx row_begin(int) const { return 0; }
    template <int K> __device__ __forceinline__ void pair(RowCtx, int row, int c0, f32x4 v0, int c1, f32x4 v1, float (&)[2]) const {
        const bf16_t* g = Z + (size_t)row * INW + CGA; float* t = T + (size_t)row * DM;
        *(f32x4*)(t + c0) = ld_bf4(g + c0) * v0; *(f32x4*)(t + c1) = ld_bf4(g + c1) * v1;
    }
    template <int K> __device__ __forceinline__ void row_add(int, const float (&)[2]) const {}
};
struct F2b {
    static constexpr int NK = 1; typedef int RowCtx;
    const bf16_t* Z; const float* T; bf16_t* MG;
    __device__ __forceinline__ int kind(int) const { return 0; }
    template <int K> static __device__ __forceinline__ constexpr int nred() { return 0; }
    template <int K> __device__ __forceinline__ RowCtx row_begin(int) const { return 0; }
    template <int K> __device__ __forceinline__ void pair(RowCtx, int row, int c0, f32x4 v0, int c1, f32x4 v1, float (&)[2]) const {
        const bf16_t* g = Z + (size_t)row * INW + CGB; const float* t = T + (size_t)row * DM; bf16_t* o = MG + (size_t)row * DM;
        st_bf4(o + c0, *(const f32x4*)(t + c0) + ld_bf4(g + c0) * v0); st_bf4(o + c1, *(const f32x4*)(t + c1) + ld_bf4(g + c1) * v1);
    }
    template <int K> __device__ __forceinline__ void row_add(int, const float (&)[2]) const {}
};
struct FRes {
    static constexpr int NK = 1; typedef const float* RowCtx;
    const float* baseP; const float* baseS; float* H; bf16_t* HB; float* SSQ;
    __device__ __forceinline__ int kind(int) const { return 0; }
    template <int K> static __device__ __forceinline__ constexpr int nred() { return 1; }
    template <int K> __device__ __forceinline__ RowCtx row_begin(int row) const { return row < MP ? baseP + (size_t)row * DM : baseS + (size_t)(row - MP) * DM; }
    template <int K> __device__ __forceinline__ void pair(RowCtx rc, int row, int c0, f32x4 v0, int c1, f32x4 v1, float (&red)[2]) const {
        const f32x4 h0 = *(const f32x4*)(rc + c0) + v0, h1 = *(const f32x4*)(rc + c1) + v1;
        float* h = H + (size_t)row * DM; bf16_t* hb = HB + (size_t)row * DM;
        *(f32x4*)(h + c0) = h0; *(f32x4*)(h + c1) = h1; st_bf4(hb + c0, h0); st_bf4(hb + c1, h1);
        red[0] += sum4(h0 * h0) + sum4(h1 * h1);
    }
    template <int K> __device__ __forceinline__ void row_add(int row, const float (&red)[2]) const { atomicAdd(SSQ + row, red[0]); }
};
struct F4 {
    static constexpr int NK = 1; typedef float RowCtx;
    const float* SSQ; bf16_t* U;
    __device__ __forceinline__ int kind(int) const { return 0; }
    template <int K> static __device__ __forceinline__ constexpr int nred() { return 0; }
    template <int K> __device__ __forceinline__ RowCtx row_begin(int row) const { return rsqrtf(SSQ[row] * (1.0f / DM) + EPS); }
    template <int K> __device__ __forceinline__ void pair(RowCtx rs, int row, int c0, f32x4 v0, int c1, f32x4 v1, float (&)[2]) const {
        bf16_t* u = U + (size_t)row * FF; const f32x4 z = (f32x4){0.f, 0.f, 0.f, 0.f};
        f32x4 a = __builtin_elementwise_max(v0 * rs, z), b = __builtin_elementwise_max(v1 * rs, z);
        st_bf4(u + c0, a * a); st_bf4(u + c1, b * b);
    }
    template <int K> __device__ __forceinline__ void row_add(int, const float (&)[2]) const {}
};
struct F6a {
    static constexpr int NK = 1; typedef int RowCtx;
    float* PE;
    __device__ __forceinline__ int kind(int) const { return 0; }
    template <int K> static __device__ __forceinline__ constexpr int nred() { return 0; }
    template <int K> __device__ __forceinline__ RowCtx row_begin(int) const { return 0; }
    template <int K> __device__ __forceinline__ void pair(RowCtx, int row, int c0, f32x4 v0, int c1, f32x4 v1, float (&)[2]) const {
        float* p = PE + (size_t)row * DM; *(f32x4*)(p + c0) = v0; *(f32x4*)(p + c1) = v1;
    }
    template <int K> __device__ __forceinline__ void row_add(int, const float (&)[2]) const {}
};
struct F6b {
    static constexpr int NK = 1; typedef float RowCtx;
    const float* SSQ3; const float* H2; const float* PE; float* H3; float* SSQ4;
    __device__ __forceinline__ int kind(int) const { return 0; }
    template <int K> static __device__ __forceinline__ constexpr int nred() { return 1; }
    template <int K> __device__ __forceinline__ RowCtx row_begin(int row) const { return rsqrtf(SSQ3[row] * (1.0f / DM) + EPS); }
    template <int K> __device__ __forceinline__ void pair(RowCtx rs, int row, int c0, f32x4 v0, int c1, f32x4 v1, float (&red)[2]) const {
        const size_t o = (size_t)row * DM;
        const f32x4 h0 = *(const f32x4*)(H2 + o + c0) + sigmoid4(v0 * rs) * *(const f32x4*)(PE + o + c0);
        const f32x4 h1 = *(const f32x4*)(H2 + o + c1) + sigmoid4(v1 * rs) * *(const f32x4*)(PE + o + c1);
        *(f32x4*)(H3 + o + c0) = h0; *(f32x4*)(H3 + o + c1) = h1;
        red[0] += sum4(h0 * h0) + sum4(h1 * h1);
    }
    template <int K> __device__ __forceinline__ void row_add(int row, const float (&red)[2]) const { atomicAdd(SSQ4 + row, red[0]); }
};

struct Ctx {
    LAS unsigned char* lds; int tid, lane, wave, vcu, G;
    const float* const* in; float* out; unsigned char* ws;
    template <class T> __device__ __forceinline__ T* w(size_t off) const { return (T*)(ws + off); }
};
enum { I_XP = 0, I_XS, I_PP, I_PS, I_ST, I_GMIX, I_WIN, I_GRET, I_WS, I_BS, I_GGM, I_WBRA, I_WBRB, I_WO, I_GMLP, I_WUP, I_WDN, I_GPLE, I_WPG, I_WPP, I_GFIN };

__device__ __forceinline__ void p0_transpose_item(const float* W, int K, int N, bf16_t* WT, LAS float* scr, int item, int lane, const float* rowg, int cs_lo, int cs_hi, float cs) {
    const int nblk = N / 32, kb = item / nblk, nb = item % nblk, k0 = 64 * kb, n0 = 32 * nb;
#pragma unroll 8
    for (int i = 0; i < 32; ++i) { const int kk = 2 * i + (lane >> 5); float wv = W[(size_t)(k0 + kk) * N + n0 + (lane & 31)]; if (rowg) wv *= rowg[k0 + kk]; scr[kk * 33 + (lane & 31)] = wv; }
    asm volatile("s_waitcnt lgkmcnt(0)" ::: "memory");
    const int c = lane & 7;
#pragma unroll
    for (int j = 0; j < 4; ++j) { const int n = (lane >> 3) + 8 * j; const LAS float* s = scr + (8 * c) * 33 + n; const float sc = (n0 + n >= cs_lo && n0 + n < cs_hi) ? cs : 1.0f;
        u32x4 o; o.x = pk2(s[0 * 33] * sc, s[1 * 33] * sc); o.y = pk2(s[2 * 33] * sc, s[3 * 33] * sc); o.z = pk2(s[4 * 33] * sc, s[5 * 33] * sc); o.w = pk2(s[6 * 33] * sc, s[7 * 33] * sc);
        *(u32x4*)(WT + (size_t)(n0 + n) * K + k0 + 8 * c) = o; }
    asm volatile("s_waitcnt lgkmcnt(0)" ::: "memory");
}
__device__ __forceinline__ double sin_poly(double x) {
    const double x2 = x * x; double r = -1.0 / 8841761993739701954543616000000.0;
    r = r * x2 + 1.0 / 10888869450418352160768000000.0;
    r = r * x2 - 1.0 / 15511210043330985984000000.0;
    r = r * x2 + 1.0 / 25852016738884976640000.0;
    r = r * x2 - 1.0 / 51090942171709440000.0;
    r = r * x2 + 1.0 / 121645100408832000.0;
    r = r * x2 - 1.0 / 355687428096000.0;
    r = r * x2 + 1.0 / 1307674368000.0;
    r = r * x2 - 1.0 / 6227020800.0;
    r = r * x2 + 1.0 / 39916800.0;
    r = r * x2 - 1.0 / 362880.0;
    r = r * x2 + 1.0 / 5040.0;
    r = r * x2 - 1.0 / 120.0;
    r = r * x2 + 1.0 / 6.0;
    r = r * x2 - 1.0;
    return -r * x;
}
__device__ __forceinline__ double cos_poly(double x) {
    const double x2 = x * x; double r = -1.0 / 265252859812191058636308480000000.0;
    r = r * x2 + 1.0 / 304888344611713860501504000000.0;
    r = r * x2 - 1.0 / 403291461126605635584000000.0;
    r = r * x2 + 1.0 / 620448401733239439360000.0;
    r = r * x2 - 1.0 / 1124000727777607680000.0;
    r = r * x2 + 1.0 / 2432902008176640000.0;
    r = r * x2 - 1.0 / 6402373705728000.0;
    r = r * x2 + 1.0 / 20922789888000.0;
    r = r * x2 - 1.0 / 87178291200.0;
    r = r * x2 + 1.0 / 479001600.0;
    r = r * x2 - 1.0 / 3628800.0;
    r = r * x2 + 1.0 / 40320.0;
    r = r * x2 - 1.0 / 720.0;
    r = r * x2 + 1.0 / 24.0;
    r = r * x2 - 0.5;
    r = r * x2 + 1.0;
    return r;
}
__device__ __forceinline__ void p0_prologue(const Ctx& C) {
    LAS float* scr = (LAS float*)(C.lds + C.wave * 16384);
    const int gw = C.vcu * NWAVES + C.wave, NGW = C.G * NWAVES, lane = C.lane;
    constexpr int I_IN = (DM / 64) * (INW / 32), I_BRA = (2048 / 64) * (DM / 32), I_SQ = (DM / 64) * (DM / 32), I_UP = (DM / 64) * (FF / 32), I_DN = (FF / 64) * (DM / 32), I_PPI = (PLE / 64) * (DM / 32);
    constexpr int NITEMS = I_IN + I_BRA + 3 * I_SQ + I_UP + I_DN + I_PPI;
    for (int it = gw; it < NITEMS; it += NGW) {
        int r = it;
        if (r < I_IN) { p0_transpose_item(C.in[I_WIN], DM, INW, C.w<bf16_t>(WS_WIN), scr, r, lane, nullptr, CK, CV, 0.0625f); continue; } r -= I_IN;
        if (r < I_BRA) { p0_transpose_item(C.in[I_WBRA], 2048, DM, C.w<bf16_t>(WS_WBRA), scr, r, lane, nullptr, 0, 0, 1.f); continue; } r -= I_BRA;
        if (r < I_SQ) { p0_transpose_item(C.in[I_WBRB], DM, DM, C.w<bf16_t>(WS_WBRB), scr, r, lane, nullptr, 0, 0, 1.f); continue; } r -= I_SQ;
        if (r < I_SQ) { p0_transpose_item(C.in[I_WO], DM, DM, C.w<bf16_t>(WS_WO), scr, r, lane, nullptr, 0, 0, 1.f); continue; } r -= I_SQ;
        if (r < I_SQ) { p0_transpose_item(C.in[I_WPG], DM, DM, C.w<bf16_t>(WS_WPG), scr, r, lane, C.in[I_GPLE], 0, 0, 1.f); continue; } r -= I_SQ;
        if (r < I_UP) { p0_transpose_item(C.in[I_WUP], DM, FF, C.w<bf16_t>(WS_WUP), scr, r, lane, C.in[I_GMLP], 0, 0, 1.f); continue; } r -= I_UP;
        if (r < I_DN) { p0_transpose_item(C.in[I_WDN], FF, DM, C.w<bf16_t>(WS_WDN), scr, r, lane, nullptr, 0, 0, 1.f); continue; } r -= I_DN;
        p0_transpose_item(C.in[I_WPP], PLE, DM, C.w<bf16_t>(WS_WPP), scr, r, lane, nullptr, 0, 0, 1.f);
    }
    const float* gm = C.in[I_GMIX];
    f32x4 gv[4];
#pragma unroll
    for (int j = 0; j < 4; ++j) gv[j] = ((const f32x4*)gm)[lane + 64 * j];
    bf16_t* XN = C.w<bf16_t>(WS_XN); bf16_t* PB = C.w<bf16_t>(WS_PB);
    for (int m = gw; m < MT; m += NGW) {
        const float* xrow = m < MP ? C.in[I_XP] + (size_t)m * DM : C.in[I_XS] + (size_t)(m - MP) * DM;
        const f32x4* xr = (const f32x4*)xrow + lane;
        f32x4 v[4]; float s = 0.f;
#pragma unroll
        for (int j = 0; j < 4; ++j) { v[j] = xr[64 * j]; s += sum4(v[j] * v[j]); }
        const float rstd = rsqrtf(wave_sum(s) * (1.f / DM) + EPS);
        u32x2* o8 = (u32x2*)(XN + (size_t)m * DM) + lane;
#pragma unroll
        for (int j = 0; j < 4; ++j) { const f32x4 y = v[j] * rstd * gv[j]; u32x2 w; w.x = pk2(y[0], y[1]); w.y = pk2(y[2], y[3]); o8[64 * j] = w; }
        const float* prow = m < MP ? C.in[I_PP] + (size_t)m * PLE : C.in[I_PS] + (size_t)(m - MP) * PLE;
        const f32x4 pv = ((const f32x4*)prow)[lane]; u32x2 pw; pw.x = pk2(pv[0], pv[1]); pw.y = pk2(pv[2], pv[3]);
        ((u32x2*)(PB + (size_t)m * PLE))[lane] = pw;
    }
    float* cosT = C.w<float>(WS_COS); float* sinT = C.w<float>(WS_SIN);
    for (int e = (C.vcu * NTHR + C.tid); e < NTAB * 128; e += C.G * NTHR) {
        const int ti = e >> 7, i = e & 127; const float pos = ti < 2048 ? (float)ti : (float)(16384 + ti - 2048);
        const float inv = (float)exp2(-(double)i * (13.287712379549449 / 128.0));
        const float ang = pos * inv;
        const double x = (double)ang; const double k = __builtin_rint(x * 0.15915494309189535);
        double r = __builtin_fma(-k, 6.283185307179586, x); r = __builtin_fma(-k, 2.4492935982947064e-16, r);
        cosT[e] = (float)cos_poly(r); sinT[e] = (float)sin_poly(r);
    }
}

template <class F> __device__ __forceinline__ void run_gemm(const Ctx& C, const bf16_t* A, const bf16_t* Bt, int M, int N, int K, const F& f) {
    asm volatile("" : "+s"(K));
    pg8::Gemm g{A, Bt, M, N, K}; pg8::StaticOrder S; S.init(M, N, C.G, (int)blockIdx.x);
    EpiGen<F> E{f};
    pg8::gemm_phase<EpiGen<F>, pg8::StaticOrder, true, true>((PG8_LAS unsigned char*)C.lds, g, S, E);
}

__device__ __forceinline__ void ret_simple_item(const Ctx& C, bool sample, int b, int h, int vs) {
    const int v = C.tid & 63, dg = C.wave, d0 = 32 * dg;
    const int L = sample ? 4 : 2048, row0 = sample ? MP + 4 * b : 2048 * b;
    const float gamma = 1.0f - exp2f(-5.0f - (float)h);
    float S[32];
    const size_t sbase = ((size_t)(b * 4 + h) * 256 + d0) * 512 + vs * 64 + v;
    if (sample) { const float* st = C.in[I_ST] + sbase;
#pragma unroll
        for (int j = 0; j < 32; ++j) S[j] = st[(size_t)j * 512]; }
    else {
#pragma unroll
        for (int j = 0; j < 32; ++j) S[j] = 0.f; }
    const bf16_t* Z = C.w<bf16_t>(WS_Z); bf16_t* OR = C.w<bf16_t>(WS_ORAW); float* SSQO = C.w<float>(WS_SSQO);
    LAS float* part = (LAS float*)C.lds;
    for (int t = 0; t < L; ++t) {
        const int row = row0 + t; const bf16_t* zr = Z + (size_t)row * INW;
        const float vv = bf2f(zr[CV + h * 512 + vs * 64 + v]);
        const u32x4* qp = (const u32x4*)(zr + CQ + h * 256 + d0); const u32x4* kp = (const u32x4*)(zr + CK + h * 256 + d0);
        float o = 0.f;
#pragma unroll
        for (int c = 0; c < 4; ++c) { const u32x4 qw = qp[c], kw = kp[c];
#pragma unroll
            for (int e = 0; e < 4; ++e) { const unsigned q2 = qw[e], k2 = kw[e]; const int j = c * 8 + e * 2;
                S[j] = gamma * S[j] + __uint_as_float(k2 << 16) * vv; o += __uint_as_float(q2 << 16) * S[j];
                S[j + 1] = gamma * S[j + 1] + __uint_as_float(k2 & 0xffff0000u) * vv; o += __uint_as_float(q2 & 0xffff0000u) * S[j + 1]; } }
        part[((t & 1) * 8 + dg) * 64 + v] = o;
        __syncthreads();
        if (dg == 0) { float ot = 0.f;
#pragma unroll
            for (int g = 0; g < 8; ++g) ot += part[((t & 1) * 8 + g) * 64 + v];
            OR[(size_t)row * 2048 + h * 512 + vs * 64 + v] = (bf16_t)f2bf(ot);
            const float ss = wave_sum(ot * ot); if (v == 0) atomicAdd(SSQO + row * 4 + h, ss); }
    }
    float* so = C.out + (sample ? O_SRS : O_SRP) + sbase;
#pragma unroll
    for (int j = 0; j < 32; ++j) so[(size_t)j * 512] = S[j];
    __syncthreads();
}
__device__ __forceinline__ void p2_retention_simple(const Ctx& C) {
    for (int it = C.vcu; it < 256; it += C.G) ret_simple_item(C, false, it >> 5, (it >> 3) & 3, it & 7);
    for (int it = C.vcu; it < 4096; it += C.G) ret_simple_item(C, true, it >> 5, (it >> 3) & 3, it & 7);
}
template <int CH> __device__ __forceinline__ void gate_simple_item(const Ctx& C, int row0, float* gmv_out) {
    LAS float* gvl = (LAS float*)C.lds;
    LAS float* wl = (LAS float*)(C.lds + 65536);
    const bf16_t* Z = C.w<bf16_t>(WS_Z); const float* LNS = C.w<float>(WS_LNS); bf16_t* YB = C.w<bf16_t>(WS_YB);
    const float* w_s = C.in[I_WS]; const float* b_s = C.in[I_BS]; const float* g_gm = C.in[I_GGM];
    for (int g = 0; g < 8; ++g) {
        for (int e = C.tid; e < CH * 128; e += NTHR) { const int m = e >> 7, ch = e & 127; const int row = row0 + m;
            const float mu = LNS[2 * row] * (1.f / 1024.f), var = LNS[2 * row + 1] * (1.f / 1024.f) - mu * mu, rstd = rsqrtf(var + EPS);
            const float x = bf2f(Z[(size_t)row * INW + CGV + g * 128 + ch]); const float y = (x - mu) * rstd * g_gm[g * 128 + ch];
            gvl[e] = y; if (gmv_out) gmv_out[(size_t)m * 1024 + g * 128 + ch] = y;
            wl[e] = (ch < CH) ? w_s[((size_t)g * 128 + m) * 128 + ch] : 0.f; }
        __syncthreads();
        const int ch = C.tid & 127;
        for (int n = C.tid >> 7; n < CH; n += 4) { float acc = b_s[g * 128 + n];
            for (int m = 0; m <= n; ++m) acc += wl[n * 128 + m] * gvl[m * 128 + ch];
            const int row = row0 + n; const float u = bf2f(Z[(size_t)row * INW + CU + g * 128 + ch]);
            YB[(size_t)row * DM + g * 128 + ch] = (bf16_t)f2bf(u * acc); }
        __syncthreads();
    }
}
__device__ __forceinline__ void p2_gating_simple(const Ctx& C) {
    for (int it = C.vcu; it < 128; it += C.G) gate_simple_item<128>(C, (it >> 4) * 2048 + (it & 15) * 128, nullptr);
    for (int it = C.vcu; it < 128; it += C.G) gate_simple_item<4>(C, MP + 4 * it, C.out + O_GMV + (size_t)it * 4 * 1024);
}
__device__ __forceinline__ void p3_finalize_ya(const Ctx& C) {
    const bf16_t* Z = C.w<bf16_t>(WS_Z); const bf16_t* OR = C.w<bf16_t>(WS_ORAW); const float* SSQO = C.w<float>(WS_SSQO); bf16_t* YA = C.w<bf16_t>(WS_YA);
    const float* g_ret = C.in[I_GRET];
    const int gw = C.vcu * NWAVES + C.wave, NGW = C.G * NWAVES, lane = C.lane;
    for (int row = gw; row < MT; row += NGW) {
#pragma unroll
        for (int j = 0; j < 8; ++j) { const int c = 4 * lane + 256 * j, h = c >> 9;
            const float rs = rsqrtf(SSQO[row * 4 + h] * (1.f / 512.f) + EPS);
            const f32x4 o = ld_bf4(OR + (size_t)row * 2048 + c), gz = ld_bf4(Z + (size_t)row * INW + CG + c), gr = *(const f32x4*)(g_ret + c);
            st_bf4(YA + (size_t)row * 2048 + c, gz * o * rs * gr); }
    }
}
__device__ __forceinline__ void p9_final_norm(const Ctx& C) {
    const float* H3 = C.w<float>(WS_H3); const float* SSQ4 = C.w<float>(WS_SSQ4); const float* gf = C.in[I_GFIN];
    const int gw = C.vcu * NWAVES + C.wave, NGW = C.G * NWAVES, lane = C.lane;
    f32x4 gv[4];
#pragma unroll
    for (int j = 0; j < 4; ++j) gv[j] = ((const f32x4*)gf)[lane + 64 * j];
    for (int row = gw; row < MT; row += NGW) {
        const float rs = rsqrtf(SSQ4[row] * (1.f / DM) + EPS);
        const f32x4* hr = (const f32x4*)(H3 + (size_t)row * DM) + lane; f32x4* o = (f32x4*)(C.out + O_Y + (size_t)row * DM) + lane;
#pragma unroll
        for (int j = 0; j < 4; ++j) o[64 * j] = hr[64 * j] * rs * gv[j];
    }
}

#ifdef DBG_EXPORT
__device__ __forceinline__ void dbg_export(const Ctx& C) {
    const bf16_t* Z = C.w<bf16_t>(WS_Z); const bf16_t* YA = C.w<bf16_t>(WS_YA); const bf16_t* YB = C.w<bf16_t>(WS_YB);
    const int gw = C.vcu * NWAVES + C.wave, NGW = C.G * NWAVES, lane = C.lane;
    for (int row = gw; row < MT; row += NGW)
        for (int j = 0; j < 4; ++j) { const int c = 4 * lane + 256 * j;
            f32x4 v = (f32x4){0.f, 0.f, 0.f, 0.f};
#if DBG_EXPORT == 1
            v = ld_bf4(YB + (size_t)row * DM + c);
#elif DBG_EXPORT == 4
            v = ld_bf4(YA + (size_t)row * 2048 + c) + ld_bf4(YA + (size_t)row * 2048 + 1024 + c);
#elif DBG_EXPORT == 5
            v = ld_bf4(Z + (size_t)row * INW + CGA + c) + ld_bf4(Z + (size_t)row * INW + CGB + c);
#elif DBG_EXPORT == 6
            v = ld_bf4(C.w<bf16_t>(WS_ORAW) + (size_t)row * 2048 + c) + ld_bf4(C.w<bf16_t>(WS_ORAW) + (size_t)row * 2048 + 1024 + c);
#elif DBG_EXPORT == 7
            v = ld_bf4(Z + (size_t)row * INW + CG + c) + ld_bf4(Z + (size_t)row * INW + CG + 1024 + c);
#elif DBG_EXPORT == 8
            v = ld_bf4(Z + (size_t)row * INW + CQ + c);
#endif
            *(f32x4*)(C.out + O_Y + (size_t)row * DM + c) = v; }
}
#endif
constexpr int NPHASE = 10;
__global__ void __launch_bounds__(NTHR, 2) mk_fwd(Args args) {
    extern __shared__ __attribute__((aligned(16))) unsigned char lds_raw[];
    Ctx C;
    C.lds = (LAS unsigned char*)lds_raw; C.tid = threadIdx.x; C.lane = C.tid & 63; C.wave = __builtin_amdgcn_readfirstlane(C.tid >> 6);
    C.G = gridDim.x; { const int bx = blockIdx.x; C.vcu = (C.G % 8 == 0) ? (bx % 8) * (C.G / 8) + bx / 8 : bx; }
    C.in = args.in; C.out = args.out; C.ws = args.ws;
    const int lo = args.ph_lo, hi = args.ph_hi;
#define IN(k) (lo <= (k) && (k) < hi)
#define SEAM(k) do { if (IN(k) && IN((k) + 1)) { GRID_BAR(); } } while (0)
#define GRID_BAR() do { cooperative_groups::this_grid().sync(); } while (0)
    if (IN(0)) { p0_prologue(C); } SEAM(0);
    if (IN(1)) { F1 f{C.w<bf16_t>(WS_Z), C.w<float>(WS_COS), C.w<float>(WS_SIN), C.w<float>(WS_LNS)}; run_gemm(C, C.w<bf16_t>(WS_XN), C.w<bf16_t>(WS_WIN), MT, INW, DM, f); } SEAM(1);
    if (IN(2)) { p2_retention_simple(C); p2_gating_simple(C); } SEAM(2);
    if (IN(3)) { p3_finalize_ya(C); } SEAM(3);
    if (IN(4)) { { F2a f{C.w<bf16_t>(WS_Z), C.w<float>(WS_T)}; run_gemm(C, C.w<bf16_t>(WS_YA), C.w<bf16_t>(WS_WBRA), MT, DM, 2048, f); }
                 { F2b f{C.w<bf16_t>(WS_Z), C.w<float>(WS_T), C.w<bf16_t>(WS_MG)}; run_gemm(C, C.w<bf16_t>(WS_YB), C.w<bf16_t>(WS_WBRB), MT, DM, DM, f); } } SEAM(4);
    if (IN(5)) { FRes f{C.in[I_XP], C.in[I_XS], C.w<float>(WS_H1), C.w<bf16_t>(WS_H1B), C.w<float>(WS_SSQ2)}; run_gemm(C, C.w<bf16_t>(WS_MG), C.w<bf16_t>(WS_WO), MT, DM, DM, f); } SEAM(5);
    if (IN(6)) { F4 f{C.w<float>(WS_SSQ2), C.w<bf16_t>(WS_U)}; run_gemm(C, C.w<bf16_t>(WS_H1B), C.w<bf16_t>(WS_WUP), MT, FF, DM, f); } SEAM(6);
    if (IN(7)) { FRes f{C.w<float>(WS_H1), C.w<float>(WS_H1) + (size_t)MP * DM, C.w<float>(WS_H2), C.w<bf16_t>(WS_H2B), C.w<float>(WS_SSQ3)}; run_gemm(C, C.w<bf16_t>(WS_U), C.w<bf16_t>(WS_WDN), MT, DM, FF, f); } SEAM(7);
    if (IN(8)) { { F6a f{C.w<float>(WS_PE)}; run_gemm(C, C.w<bf16_t>(WS_PB), C.w<bf16_t>(WS_WPP), MT, DM, PLE, f); }
                 { F6b f{C.w<float>(WS_SSQ3), C.w<float>(WS_H2), C.w<float>(WS_PE), C.w<float>(WS_H3), C.w<float>(WS_SSQ4)}; run_gemm(C, C.w<bf16_t>(WS_H2B), C.w<bf16_t>(WS_WPG), MT, DM, DM, f); } } SEAM(8);
    if (IN(9)) { p9_final_norm(C); }
#ifdef DBG_EXPORT
    if (IN(10)) { dbg_export(C); }
#endif
#undef IN
#undef SEAM
#undef GRID_BAR
}
}

extern "C" void kernel_launch(void* const* d_in, const int* in_sizes, int n_in, void* d_out, int out_size, void* d_ws, size_t ws_size, hipStream_t stream) {
    using namespace mk;
    static int grid = 0;
    if (grid == 0) {
        if (n_in != 21 || (size_t)out_size != O_END || ws_size < WS_END) { fprintf(stderr, "kernel_launch: unexpected shapes: n_in %d out %d ws %zu (need %zu)\n", n_in, out_size, ws_size, (size_t)WS_END); grid = -1; return; }
        int dev = 0, cus = 0;
        if (hipGetDevice(&dev) != hipSuccess || hipDeviceGetAttribute(&cus, hipDeviceAttributeMultiprocessorCount, dev) != hipSuccess) { grid = -1; return; }
        if (hipFuncSetAttribute((const void*)mk_fwd, hipFuncAttributeMaxDynamicSharedMemorySize, LDS_BYTES) != hipSuccess) { fprintf(stderr, "kernel_launch: hipFuncSetAttribute failed\n"); grid = -1; return; }
        int per_cu = 0;
        if (hipOccupancyMaxActiveBlocksPerMultiprocessor(&per_cu, (const void*)mk_fwd, NTHR, LDS_BYTES) != hipSuccess || per_cu < 1) { fprintf(stderr, "kernel_launch: occupancy query says %d blocks/CU\n", per_cu); (void)hipGetLastError(); grid = -1; return; }
        grid = cus;
    }
    if (grid < 0) return;
    (void)hipMemsetAsync((char*)d_ws, 0, WS_ZERO_END, stream);
    Args a{};
    for (int i = 0; i < 21; ++i) a.in[i] = (const float*)d_in[i];
    a.out = (float*)d_out; a.ws = (unsigned char*)d_ws;
#ifdef MK_MULTI
    for (int p = 0; p < NPHASE; ++p) { a.ph_lo = p; a.ph_hi = p + 1; hipLaunchKernelGGL(mk_fwd, dim3(grid), dim3(NTHR), LDS_BYTES, stream, a); }
#else
    a.ph_lo = 0; a.ph_hi = NPHASE;
    void* kargs[] = {&a};
    const hipError_t le = hipLaunchCooperativeKernel((const void*)mk_fwd, dim3(grid), dim3(NTHR), kargs, LDS_BYTES, stream);
    if (le != hipSuccess) fprintf(stderr, "kernel_launch: cooperative launch failed: %s (grid %d)\n", hipGetErrorString(le), grid);
#endif
}
```

```cpp
#include <hip/hip_runtime.h>
#include <hip/hip_cooperative_groups.h>
#include <cstdio>
#include <cstdint>
namespace pg8 {
#define PG8_LAS __attribute__((address_space(3)))
typedef unsigned short bf16_t;
typedef short bf16x8 __attribute__((ext_vector_type(8)));
typedef float f32x4 __attribute__((ext_vector_type(4)));
typedef unsigned u32x4 __attribute__((ext_vector_type(4)));
constexpr int BM = 256, BK = 64, HALF = 128, HTB = HALF * BK * 2  , STAGE_BYTES = 8 * HTB, NXCD = 8, WGM = 8;

__host__ __device__ __forceinline__ int lds_byte(int r, int c) { const int st = (r >> 4) * 2 + (c >> 5), rr = r & 15, cc = c & 31, ob = rr * 64 + cc * 2; return st * 1024 + (ob ^ (((ob >> 9) & 1) << 5)); }
__host__ __device__ __forceinline__ void stage_rc(int b, int& R, int& C) { const int st = b / 1024, sb = b % 1024, swz = sb ^ (((sb >> 9) & 1) << 5); R = (st >> 1) * 16 + swz / 64; C = (st & 1) * 32 + (swz % 64) / 2; }
__host__ __device__ __forceinline__ int perm32(int rho) { const int n = rho >> 4, i = rho & 15; return 8 * (i >> 2) + 4 * n + (i & 3); }

struct Unit { int pm, pn; };
struct Gemm { const bf16_t* A; const bf16_t* Bt; int M, N, K; };

struct StaticOrder {
    int nM, nN, nwg, G, c;
    __host__ __device__ void init(int M, int N, int G_, int c_) { nM = M / BM; nN = N / BM; nwg = nM * nN; G = G_; c = c_; }
    __host__ __device__ bool next(int i, Unit& u) const {
        const long L = (long)i * G + c; if (L >= nwg) return false;
        int wgid = (int)L; { const int q = nwg / NXCD, r = nwg % NXCD, xcd = wgid % NXCD, off = wgid / NXCD; wgid = (xcd < r ? xcd * (q + 1) : r * (q + 1) + (xcd - r) * q) + off; }
        const int nig = WGM * nN, gid = wgid / nig, fm = gid * WGM, gsz = (nM - fm) < WGM ? (nM - fm) : WGM;
        u.pm = fm + ((wgid % nig) % gsz); u.pn = (wgid % nig) / gsz; return true;
    }
    __device__ __forceinline__ void a_ready(const Unit&) const {}
    __device__ __forceinline__ void done(const Unit&) const {}
};

__device__ __forceinline__ unsigned cvt_pk_bf16(float lo, float hi) { unsigned r; asm volatile("v_cvt_pk_bf16_f32 %0, %1, %2" : "=v"(r) : "v"(lo), "v"(hi)); return r; }
typedef float f32x2 __attribute__((ext_vector_type(2)));
__device__ __forceinline__ f32x2 gelu_pk(f32x2 v) {
    const f32x2 av = __builtin_elementwise_abs(v), d = av * 0.2316418882f + 1.0f;
    f32x2 t; t.x = __builtin_amdgcn_rcpf(d.x); t.y = __builtin_amdgcn_rcpf(d.y);
    f32x2 q = t * 0.5307027145f + (-0.7265760135f); q = q * t + 0.7107068705f; q = q * t + (-0.142248368f); q = q * t + 0.127414796f; q = q * t;
    const f32x2 s = (v * v) * (-0.72134752044f);
    f32x2 e; e.x = __builtin_amdgcn_exp2f(s.x); e.y = __builtin_amdgcn_exp2f(s.y);
    const f32x2 m = v * (q * e), r = v - m;
    f32x2 o; o.x = v.x < 0.f ? m.x : r.x; o.y = v.y < 0.f ? m.y : r.y; return o;
}
template <class Epi, class Sched, bool ALIGN_EPI = false, bool SP2 = false>
__device__ __forceinline__ void gemm_phase(PG8_LAS unsigned char* lds, const Gemm g, const Sched& S, const Epi& E) {
    const int tid = threadIdx.x, wid = __builtin_amdgcn_readfirstlane(tid >> 6), lane = tid & 63, wr = wid >> 2, wc = wid & 3, fr = lane & 15, fq = lane >> 4;
    const int K = g.K, nt = K / BK;
    unsigned voffA[2], voffB[2];
#pragma unroll
    for (int i = 0; i < 2; ++i) { int R, C; stage_rc(tid * 16 + i * 8192, R, C); const int Rb = Epi::PERM ? ((R & ~31) + perm32(R & 31)) : R;
        voffA[i] = (unsigned)(R * K + C) * 2u; voffB[i] = (unsigned)(Rb * K + C) * 2u; }
    const size_t kstep = (size_t)(BK * 2);
    const size_t hstep = (size_t)HALF * K * 2;
    const size_t tstep = 2 * hstep;
    const unsigned ldsw = (unsigned)wid * 1024u;
    const int aoff = lds_byte(wr * 64 + fr, fq * 8), boff = lds_byte(wc * 32 + fr, fq * 8);
#define PG8_SA(b, h) (((b) * 2 + (h)) * HTB)
#define PG8_SB(b, h) ((4 + (b) * 2 + (h)) * HTB)
#define PG8_STAGE(bufoff, gbase, voff) do { _Pragma("unroll") for (int _i = 0; _i < 2; ++_i) \
        __builtin_amdgcn_global_load_lds((const unsigned*)((const char*)(gbase) + (voff)[_i]), (PG8_LAS unsigned*)(lds + (bufoff) + ldsw + _i * 8192), 16, 0, 0); } while (0)
#define PG8_LDA(dst, b, h) do { _Pragma("unroll") for (int m = 0; m < 4; ++m) _Pragma("unroll") for (int k = 0; k < 2; ++k) dst[m][k] = *(const PG8_LAS bf16x8*)(lds + PG8_SA(b, h) + aoff + m * 2048 + k * 1024); } while (0)
#define PG8_LDB(dst, b, h) do { _Pragma("unroll") for (int n = 0; n < 2; ++n) _Pragma("unroll") for (int k = 0; k < 2; ++k) dst[n][k] = *(const PG8_LAS bf16x8*)(lds + PG8_SB(b, h) + boff + n * 2048 + k * 1024); } while (0)
#define PG8_MMA(ai, bj, At, Bt) do { __builtin_amdgcn_s_setprio(1); _Pragma("unroll") for (int m = 0; m < 4; ++m) _Pragma("unroll") for (int n = 0; n < 2; ++n) _Pragma("unroll") for (int k = 0; k < 2; ++k) \
        acc[ai][bj][m][n] = __builtin_amdgcn_mfma_f32_16x16x32_bf16(Bt[n][k], At[m][k], acc[ai][bj][m][n], 0, 0, 0); __builtin_amdgcn_s_setprio(0); } while (0)
#define PG8_WAIT_V(n) asm volatile("s_waitcnt vmcnt(" #n ")" ::: "memory")
#define PG8_WAIT_L(n) asm volatile("s_waitcnt lgkmcnt(" #n ")" ::: "memory")
#define PG8_BAR __builtin_amdgcn_s_barrier()
#define PG8_SCHED __builtin_amdgcn_sched_barrier(0)
    Unit cur, nxt; int ui = 0;
    if (!S.next(0, cur)) return;
    f32x4 acc[2][2][4][2];
#pragma unroll
    for (int a = 0; a < 2; ++a)
#pragma unroll
        for (int b = 0; b < 2; ++b)
#pragma unroll
            for (int m = 0; m < 4; ++m)
#pragma unroll
                for (int n = 0; n < 2; ++n) acc[a][b][m][n] = (f32x4){0.f, 0.f, 0.f, 0.f};
    bf16x8 At[4][2], B0[2][2], B1[2][2];
    const char* cA = (const char*)g.A + (size_t)cur.pm * tstep; const char* cB = (const char*)g.Bt + (size_t)cur.pn * tstep;
    S.a_ready(cur);
    if constexpr (SP2) {
        PG8_STAGE(PG8_SB(0, 0), cB, voffB); PG8_STAGE(PG8_SB(0, 1), cB + hstep, voffB); PG8_STAGE(PG8_SA(0, 0), cA, voffA); PG8_STAGE(PG8_SA(0, 1), cA + hstep, voffA);
        if (wr == 1) PG8_BAR;
        PG8_WAIT_V(2); PG8_BAR;
        PG8_STAGE(PG8_SB(1, 0), cB + kstep, voffB); PG8_STAGE(PG8_SA(1, 0), cA + kstep, voffA); PG8_STAGE(PG8_SB(1, 1), cB + hstep + kstep, voffB);
        PG8_WAIT_V(6); PG8_BAR;
    } else {
        PG8_STAGE(PG8_SB(0, 0), cB, voffB); PG8_STAGE(PG8_SA(0, 0), cA, voffA); PG8_STAGE(PG8_SB(0, 1), cB + hstep, voffB); PG8_STAGE(PG8_SA(0, 1), cA + hstep, voffA);
        if (wr == 1) PG8_BAR;
        PG8_WAIT_V(4); PG8_BAR;
        PG8_STAGE(PG8_SB(1, 0), cB + kstep, voffB); PG8_STAGE(PG8_SA(1, 0), cA + kstep, voffA); PG8_STAGE(PG8_SB(1, 1), cB + hstep + kstep, voffB);
        PG8_WAIT_V(6); PG8_BAR;
    }
    for (;;) {
        const bool has_next = S.next(ui + 1, nxt);
        const char* nA = has_next ? (const char*)g.A + (size_t)nxt.pm * tstep : cA; const char* nB = has_next ? (const char*)g.Bt + (size_t)nxt.pn * tstep : cB;
        for (int t = 0; t < nt; t += 2) {
            const bool last = (t == nt - 2);
            const char* a1 = cA + (size_t)(t + 1) * kstep;
            const char* a2 = last ? nA : cA + (size_t)(t + 2) * kstep; const char* b2 = last ? nB : cB + (size_t)(t + 2) * kstep;
            const char* a3 = a2 + kstep; const char* b3 = b2 + kstep;
            if (last && has_next) S.a_ready(nxt);
            if constexpr (SP2) {
            PG8_LDB(B0, 0, 0); PG8_LDB(B1, 0, 1); PG8_SCHED; PG8_LDA(At, 0, 0); PG8_STAGE(PG8_SA(1, 1), a1 + hstep, voffA);
            PG8_WAIT_V(8); PG8_WAIT_L(0); PG8_BAR; PG8_MMA(0, 0, At, B0); PG8_MMA(0, 1, At, B1); PG8_BAR; PG8_SCHED;
            PG8_LDA(At, 0, 1); PG8_STAGE(PG8_SB(0, 0), b2, voffB); PG8_STAGE(PG8_SB(0, 1), b2 + hstep, voffB); PG8_STAGE(PG8_SA(0, 0), a2, voffA);
            PG8_WAIT_V(8); PG8_WAIT_L(0); PG8_BAR; PG8_MMA(1, 0, At, B0); PG8_MMA(1, 1, At, B1); PG8_BAR; PG8_SCHED;
            PG8_LDB(B0, 1, 0); PG8_LDB(B1, 1, 1); PG8_SCHED; PG8_LDA(At, 1, 0); PG8_STAGE(PG8_SA(0, 1), a2 + hstep, voffA);
            PG8_WAIT_V(8); PG8_WAIT_L(0); PG8_BAR; PG8_MMA(0, 0, At, B0); PG8_MMA(0, 1, At, B1); PG8_BAR; PG8_SCHED;
            PG8_LDA(At, 1, 1); PG8_STAGE(PG8_SB(1, 0), b3, voffB); PG8_STAGE(PG8_SB(1, 1), b3 + hstep, voffB); PG8_STAGE(PG8_SA(1, 0), a3, voffA);
            PG8_WAIT_V(8); PG8_WAIT_L(0); PG8_BAR; PG8_MMA(1, 0, At, B0); PG8_MMA(1, 1, At, B1); PG8_BAR; PG8_SCHED;
            } else {
            PG8_LDB(B0, 0, 0); PG8_SCHED; PG8_LDA(At, 0, 0); PG8_STAGE(PG8_SA(1, 1), a1 + hstep, voffA);
            PG8_WAIT_L(8); PG8_BAR; PG8_WAIT_L(0); PG8_MMA(0, 0, At, B0); PG8_BAR; PG8_SCHED;
            PG8_LDB(B1, 0, 1); PG8_STAGE(PG8_SB(0, 0), b2, voffB);
            PG8_BAR; PG8_WAIT_L(0); PG8_MMA(0, 1, At, B1); PG8_BAR;
            PG8_LDA(At, 0, 1); PG8_STAGE(PG8_SA(0, 0), a2, voffA);
            PG8_BAR; PG8_WAIT_L(0); PG8_MMA(1, 0, At, B0); PG8_BAR; PG8_SCHED;
            PG8_STAGE(PG8_SB(0, 1), b2 + hstep, voffB);
            PG8_WAIT_V(6); PG8_BAR; PG8_MMA(1, 1, At, B1); PG8_BAR;
            PG8_LDB(B0, 1, 0); PG8_SCHED; PG8_LDA(At, 1, 0); PG8_STAGE(PG8_SA(0, 1), a2 + hstep, voffA);
            PG8_WAIT_L(8); PG8_BAR; PG8_WAIT_L(0); PG8_MMA(0, 0, At, B0); PG8_BAR; PG8_SCHED;
            PG8_LDB(B1, 1, 1); PG8_STAGE(PG8_SB(1, 0), b3, voffB);
            PG8_BAR; PG8_WAIT_L(0); PG8_MMA(0, 1, At, B1); PG8_BAR;
            PG8_LDA(At, 1, 1); PG8_STAGE(PG8_SA(1, 0), a3, voffA);
            PG8_BAR; PG8_WAIT_L(0); PG8_MMA(1, 0, At, B0); PG8_BAR; PG8_SCHED;
            PG8_STAGE(PG8_SB(1, 1), b3 + hstep, voffB);
            PG8_WAIT_V(6); PG8_BAR; PG8_MMA(1, 1, At, B1); PG8_BAR;
            }
        }
        if constexpr (ALIGN_EPI) { if (wr == 0) PG8_BAR; }
        if constexpr (!Epi::AFTER_DRAIN) { E(acc, cur, wr, wc, fr, fq); S.done(cur); }
        if (!has_next) break;
#pragma unroll
        for (int a = 0; a < 2; ++a)
#pragma unroll
            for (int b = 0; b < 2; ++b)
#pragma unroll
                for (int m = 0; m < 4; ++m)
#pragma unroll
                    for (int n = 0; n < 2; ++n) acc[a][b][m][n] = (f32x4){0.f, 0.f, 0.f, 0.f};
        cur = nxt; cA = nA; cB = nB; ++ui;
        if constexpr (ALIGN_EPI) { if (wr == 1) PG8_BAR; }
    }
    PG8_WAIT_V(0);
    if constexpr (!ALIGN_EPI) { if (wr == 0) PG8_BAR; }
    PG8_BAR;
    if constexpr (Epi::AFTER_DRAIN) { E.fused(acc, cur, wr, wc, fr, fq, lds, wid, lane); S.done(cur); }
#undef PG8_SA
#undef PG8_SB
#undef PG8_STAGE
#undef PG8_LDA
#undef PG8_LDB
#undef PG8_MMA
#undef PG8_WAIT_V
#undef PG8_WAIT_L
#undef PG8_BAR
#undef PG8_SCHED
}
}

namespace mk {
using pg8::bf16_t; using pg8::f32x4; using pg8::f32x2; using pg8::Unit; using pg8::cvt_pk_bf16; using pg8::gelu_pk;
typedef unsigned u32x2 __attribute__((ext_vector_type(2)));
typedef unsigned u32x4 __attribute__((ext_vector_type(4)));
#define LAS __attribute__((address_space(3)))

constexpr int MP = 16384, MS = 512, MT = MP + MS, DM = 1024, INW = 10240, FF = 4096, PLE = 256;
constexpr int CQ = 0, CK = 1024, CV = 2048, CG = 4096, CU = 6144, CGV = 7168, CGA = 8192, CGB = 9216;
constexpr int NTAB = 2048 + 4;
constexpr float EPS = 1e-6f;
constexpr int NWAVES = 8, NTHR = 512;

constexpr size_t O_Y = 0;
constexpr size_t O_SRP = (size_t)MT * DM;
constexpr size_t O_SRS = O_SRP + (size_t)8 * 4 * 256 * 512;
constexpr size_t O_GMV = O_SRS + (size_t)128 * 4 * 256 * 512;
constexpr size_t O_END = O_GMV + (size_t)128 * 4 * 1024;

constexpr size_t al256(size_t x) { return (x + 255) & ~(size_t)255; }
constexpr size_t WS_CTL = 0, CTL_BYTES = 1u << 20;
constexpr size_t WS_LNS = WS_CTL + CTL_BYTES;
constexpr size_t WS_SSQO = WS_LNS + al256((size_t)MT * 2 * 4);
constexpr size_t WS_SSQ2 = WS_SSQO + al256((size_t)MT * 4 * 4);
constexpr size_t WS_SSQ3 = WS_SSQ2 + al256((size_t)MT * 4);
constexpr size_t WS_SSQ4 = WS_SSQ3 + al256((size_t)MT * 4);
constexpr size_t WS_ZERO_END = WS_SSQ4 + al256((size_t)MT * 4);
constexpr size_t WS_COS = al256(WS_ZERO_END);
constexpr size_t WS_SIN = WS_COS + al256((size_t)NTAB * 128 * 4);
constexpr size_t WS_WIN = WS_SIN + al256((size_t)NTAB * 128 * 4);
constexpr size_t WS_WBRA = WS_WIN + (size_t)INW * DM * 2;
constexpr size_t WS_WBRB = WS_WBRA + (size_t)DM * 2048 * 2;
constexpr size_t WS_WO = WS_WBRB + (size_t)DM * DM * 2;
constexpr size_t WS_WUP = WS_WO + (size_t)DM * DM * 2;
constexpr size_t WS_WDN = WS_WUP + (size_t)FF * DM * 2;
constexpr size_t WS_WPG = WS_WDN + (size_t)DM * FF * 2;
constexpr size_t WS_WPP = WS_WPG + (size_t)DM * DM * 2;
constexpr size_t WS_XN = WS_WPP + (size_t)DM * PLE * 2;
constexpr size_t WS_PB = WS_XN + (size_t)MT * DM * 2;
constexpr size_t WS_A = WS_PB + (size_t)MT * PLE * 2;
constexpr size_t WS_Z = WS_A;
constexpr size_t WS_U = WS_A;
constexpr size_t WS_H2 = WS_U + (size_t)MT * FF * 2;
constexpr size_t WS_H2B = WS_H2 + (size_t)MT * DM * 4;
constexpr size_t WS_PE = WS_H2B + (size_t)MT * DM * 2;
constexpr size_t WS_A_END = WS_A + (size_t)MT * INW * 2;
static_assert(WS_PE + (size_t)MT * DM * 4 <= WS_A_END, "region A overlay");
constexpr size_t WS_ORAW = WS_A_END;
constexpr size_t WS_H3 = WS_ORAW;
constexpr size_t WS_YA = WS_ORAW + (size_t)MT * 2048 * 2;
constexpr size_t WS_YB = WS_YA + (size_t)MT * 2048 * 2;
constexpr size_t WS_T = WS_YB + (size_t)MT * DM * 2;
constexpr size_t WS_MG = WS_T + (size_t)MT * DM * 4;
constexpr size_t WS_H1 = WS_MG + (size_t)MT * DM * 2;
constexpr size_t WS_H1B = WS_H1 + (size_t)MT * DM * 4;
constexpr size_t WS_END = WS_H1B + (size_t)MT * DM * 2;

constexpr int LDS_RING = 131072, LDS_BYTES = 139264;

struct Args {
    const float* in[21]; float* out; unsigned char* ws; int ph_lo, ph_hi;
};

__device__ __forceinline__ float bf2f(unsigned short u) { return __uint_as_float((unsigned)u << 16); }
__device__ __forceinline__ unsigned f2bf(float f) { unsigned u = __float_as_uint(f); return (u + 0x7fffu + ((u >> 16) & 1u)) >> 16; }
__device__ __forceinline__ unsigned pk2(float lo, float hi) { return f2bf(lo) | (f2bf(hi) << 16); }
__device__ __forceinline__ f32x4 ld_bf4(const bf16_t* p) { const u32x2 w = *(const u32x2*)p; return (f32x4){__uint_as_float(w.x << 16), __uint_as_float(w.x & 0xffff0000u), __uint_as_float(w.y << 16), __uint_as_float(w.y & 0xffff0000u)}; }
typedef float f32x2_t __attribute__((ext_vector_type(2))); typedef __bf16 bf16x2_t __attribute__((ext_vector_type(2)));
__device__ __forceinline__ unsigned cvtpk(float lo, float hi) { const f32x2_t v = {lo, hi}; const bf16x2_t b = __builtin_convertvector(v, bf16x2_t); return __builtin_bit_cast(unsigned, b); }
__device__ __forceinline__ void st_bf4(bf16_t* p, f32x4 v) { u32x2 w; w.x = cvtpk(v[0], v[1]); w.y = cvtpk(v[2], v[3]); *(u32x2*)p = w; }
__device__ __forceinline__ float sigmoidf_(float x) { return __builtin_amdgcn_rcpf(1.0f + __builtin_amdgcn_exp2f(-1.4426950408889634f * x)); }
__device__ __forceinline__ f32x4 sigmoid4(f32x4 v) { return (f32x4){sigmoidf_(v[0]), sigmoidf_(v[1]), sigmoidf_(v[2]), sigmoidf_(v[3])}; }
__device__ __forceinline__ f32x4 silu4(f32x4 v) { return v * sigmoid4(v); }
__device__ __forceinline__ f32x4 gelu4(f32x4 v) { const f32x2 a = gelu_pk((f32x2){v[0], v[1]}), b = gelu_pk((f32x2){v[2], v[3]}); return (f32x4){a.x, a.y, b.x, b.y}; }
__device__ __forceinline__ float sum4(f32x4 v) { return (v[0] + v[1]) + (v[2] + v[3]); }
__device__ __forceinline__ float wave_sum(float v) {
#pragma unroll
    for (int o = 1; o < 64; o <<= 1) v += __shfl_xor(v, o);
    return v;
}
__device__ __forceinline__ int tab_index(int row) { return row < MP ? (row & 2047) : 2048 + (row & 3); }

template <class F> struct EpiGen {
    static constexpr bool PERM = false, AFTER_DRAIN = false;
    F f;
    template <int KIND> __device__ __forceinline__ void run(const f32x4 (&acc)[2][2][4][2], int row0, int col0, int fq) const {
#pragma unroll
        for (int ai = 0; ai < 2; ++ai)
#pragma unroll
            for (int m = 0; m < 4; ++m) {
                const int row = row0 + ai * 128 + m * 16;
                float red[2] = {0.f, 0.f};
                const typename F::RowCtx rc = f.template row_begin<KIND>(row);
#pragma unroll
                for (int n = 0; n < 2; ++n) f.template pair<KIND>(rc, row, col0 + n * 16, acc[ai][0][m][n], col0 + 128 + n * 16, acc[ai][1][m][n], red);
                if (F::template nred<KIND>() > 0) {
                    red[0] += __shfl_xor(red[0], 16); red[0] += __shfl_xor(red[0], 32);
                    if (F::template nred<KIND>() > 1) { red[1] += __shfl_xor(red[1], 16); red[1] += __shfl_xor(red[1], 32); }
                    if (fq == 0) f.template row_add<KIND>(row, red);
                }
                asm volatile("" ::: "memory");
            }
    }
    __device__ __forceinline__ void operator()(const f32x4 (&acc)[2][2][4][2], const Unit& u, int wr, int wc, int fr, int fq) const {
        const int row0 = u.pm * 256 + wr * 64 + fr, col0 = u.pn * 256 + wc * 32 + 4 * fq;
        const int kind = f.kind(u.pn * 256);
        if (F::NK == 1) { run<0>(acc, row0, col0, fq); return; }
        switch (kind) {
            case 0: run<0>(acc, row0, col0, fq); break;
            case 1: run<(F::NK > 1 ? 1 : 0)>(acc, row0, col0, fq); break;
            case 2: run<(F::NK > 2 ? 2 : 0)>(acc, row0, col0, fq); break;
            case 3: run<(F::NK > 3 ? 3 : 0)>(acc, row0, col0, fq); break;
            case 4: run<(F::NK > 4 ? 4 : 0)>(acc, row0, col0, fq); break;
            default: run<(F::NK > 5 ? 5 : 0)>(acc, row0, col0, fq); break;
        }
    }
};

struct F1 {
    static constexpr int NK = 6; typedef int RowCtx;
    bf16_t* Z; const float* cosT; const float* sinT; float* LNS;
    __device__ __forceinline__ int kind(int cb) const { return cb < CV ? 0 : cb < CG ? 1 : cb < CU ? 2 : cb < CGV ? 3 : cb < CGA ? 4 : 5; }
    template <int K> static __device__ __forceinline__ constexpr int nred() { return K == 4 ? 2 : 0; }
    template <int K> __device__ __forceinline__ RowCtx row_begin(int row) const { return K == 0 ? tab_index(row) * 128 : 0; }
    template <int K> __device__ __forceinline__ void pair(RowCtx rc, int row, int c0, f32x4 v0, int c1, f32x4 v1, float (&red)[2]) const {
        bf16_t* zr = Z + (size_t)row * INW;
        if (K == 0) { const int i0 = c0 & 255; const f32x4 cs = *(const f32x4*)(cosT + rc + i0), sn = *(const f32x4*)(sinT + rc + i0);
            const f32x4 o0 = v0 * cs - v1 * sn, o1 = v1 * cs + v0 * sn; st_bf4(zr + c0, o0); st_bf4(zr + c1, o1); }
        else if (K == 1) { st_bf4(zr + c0, v0); st_bf4(zr + c1, v1); }
        else if (K == 2) { st_bf4(zr + c0, silu4(v0)); st_bf4(zr + c1, silu4(v1)); }
        else if (K == 3) { st_bf4(zr + c0, gelu4(v0)); st_bf4(zr + c1, gelu4(v1)); }
        else if (K == 4) { const f32x4 g0 = gelu4(v0), g1 = gelu4(v1); st_bf4(zr + c0, g0); st_bf4(zr + c1, g1);
            red[0] += sum4(g0) + sum4(g1); red[1] += sum4(g0 * g0) + sum4(g1 * g1); }
        else { st_bf4(zr + c0, sigmoid4(v0)); st_bf4(zr + c1, sigmoid4(v1)); }
    }
    template <int K> __device__ __forceinline__ void row_add(int row, const float (&red)[2]) const { atomicAdd(LNS + 2 * row, red[0]); atomicAdd(LNS + 2 * row + 1, red[1]); }
};
struct F2a {
    static constexpr int NK = 1; typedef int RowCtx;
    const bf16_t* Z; float* T;
    __device__ __forceinline__ int kind(int) const { return 0; }
    template <int K> static __device__ __forceinline__ constexpr int nred() { return 0; }
    template <int K> __device__ __forceinline__ RowCtx row_begin(int) const { return 0; }
    template <int K> __device__ __forceinline__ void pair(RowCtx, int row, int c0, f32x4 v0, int c1, f32x4 v1, float (&)[2]) const {
        const bf16_t* g = Z + (size_t)row * INW + CGA; float* t = T + (size_t)row * DM;
        *(f32x4*)(t + c0) = ld_bf4(g + c0) * v0; *(f32x4*)(t + c1) = ld_bf4(g + c1) * v1;
    }
    template <int K> __device__ __forceinline__ void row_add(int, const float (&)[2]) const {}
};
struct F2b {
    static constexpr int NK = 1; typedef int RowCtx;
    const bf16_t* Z; const float* T; bf16_t* MG;
    __device__ __forceinline__ int kind(int) const { return 0; }
    template <int K> static __device__ __forceinline__ constexpr int nred() { return 0; }
    template <int K> __device__ __forceinline__ RowCtx row_begin(int) const { return 0; }
    template <int K> __device__ __forceinline__ void pair(RowCtx, int row, int c0, f32x4 v0, int c1, f32x4 v1, float (&)[2]) const {
        const bf16_t* g = Z + (size_t)row * INW + CGB; const float* t = T + (size_t)row * DM; bf16_t* o = MG + (size_t)row * DM;
        st_bf4(o + c0, *(const f32x4*)(t + c0) + ld_bf4(g + c0) * v0); st_bf4(o + c1, *(const f32x4*)(t + c1) + ld_bf4(g + c1) * v1);
    }
    template <int K> __device__ __forceinline__ void row_add(int, const float (&)[2]) const {}
};
struct FRes {
    static constexpr int NK = 1; typedef const float* RowCtx;
    const float* baseP; const float* baseS; float* H; bf16_t* HB; float* SSQ;
    __device__ __forceinline__ int kind(int) const { return 0; }
    template <int K> static __device__ __forceinline__ constexpr int nred() { return 1; }
    template <int K> __device__ __forceinline__ RowCtx row_begin(int row) const { return row < MP ? baseP + (size_t)row * DM : baseS + (size_t)(row - MP) * DM; }
    template <int K> __device__ __forceinline__ void pair(RowCtx rc, int row, int c0, f32x4 v0, int c1, f32x4 v1, float (&red)[2]) const {
        const f32x4 h0 = *(const f32x4*)(rc + c0) + v0, h1 = *(const f32x4*)(rc + c1) + v1;
        float* h = H + (size_t)row * DM; bf16_t* hb = HB + (size_t)row * DM;
        *(f32x4*)(h + c0) = h0; *(f32x4*)(h + c1) = h1; st_bf4(hb + c0, h0); st_bf4(hb + c1, h1);
        red[0] += sum4(h0 * h0) + sum4(h1 * h1);
    }
    template <int K> __device__ __forceinline__ void row_add(int row, const float (&red)[2]) const { atomicAdd(SSQ + row, red[0]); }
};
struct F4 {
    static constexpr int NK = 1; typedef float RowCtx;
    const float* SSQ; bf16_t* U;
    __device__ __forceinline__ int kind(int) const { return 0; }
    template <int K> static __device__ __forceinline__ constexpr int nred() { return 0; }
    template <int K> __device__ __forceinline__ RowCtx row_begin(int row) const { return rsqrtf(SSQ[row] * (1.0f / DM) + EPS); }
    template <int K> __device__ __forceinline__ void pair(RowCtx rs, int row, int c0, f32x4 v0, int c1, f32x4 v1, float (&)[2]) const {
        bf16_t* u = U + (size_t)row * FF; const f32x4 z = (f32x4){0.f, 0.f, 0.f, 0.f};
        f32x4 a = __builtin_elementwise_max(v0 * rs, z), b = __builtin_elementwise_max(v1 * rs, z);
        st_bf4(u + c0, a * a); st_bf4(u + c1, b * b);
    }
    template <int K> __device__ __forceinline__ void row_add(int, const float (&)[2]) const {}
};
struct F6a {
    static constexpr int NK = 1; typedef int RowCtx;
    float* PE;
    __device__ __forceinline__ int kind(int) const { return 0; }
    template <int K> static __device__ __forceinline__ constexpr int nred() { return 0; }
    template <int K> __device__ __forceinline__ RowCtx row_begin(int) const { return 0; }
    template <int K> __device__ __forceinline__ void pair(RowCtx, int row, int c0, f32x4 v0, int c1, f32x4 v1, float (&)[2]) const {
        float* p = PE + (size_t)row * DM; *(f32x4*)(p + c0) = v0; *(f32x4*)(p + c1) = v1;
    }
    template <int K> __device__ __forceinline__ void row_add(int, const float (&)[2]) const {}
};
struct F6b {
    static constexpr int NK = 1; typedef float RowCtx;
    const float* SSQ3; const float* H2; const float* PE; float* H3; float* SSQ4;
    __device__ __forceinline__ int kind(int) const { return 0; }
    template <int K> static __device__ __forceinline__ constexpr int nred() { return 1; }
    template <int K> __device__ __forceinline__ RowCtx row_begin(int row) const { return rsqrtf(SSQ3[row] * (1.0f / DM) + EPS); }
    template <int K> __device__ __forceinline__ void pair(RowCtx rs, int row, int c0, f32x4 v0, int c1, f32x4 v1, float (&red)[2]) const {
        const size_t o = (size_t)row * DM;
        const f32x4 h0 = *(const f32x4*)(H2 + o + c0) + sigmoid4(v0 * rs) * *(const f32x4*)(PE + o + c0);
        const f32x4 h1 = *(const f32x4*)(H2 + o + c1) + sigmoid4(v1 * rs) * *(const f32x4*)(PE + o + c1);
        *(f32x4*)(H3 + o + c0) = h0; *(f32x4*)(H3 + o + c1) = h1;
        red[0] += sum4(h0 * h0) + sum4(h1 * h1);
    }
    template <int K> __device__ __forceinline__ void row_add(int row, const float (&red)[2]) const { atomicAdd(SSQ4 + row, red[0]); }
};

struct Ctx {
    LAS unsigned char* lds; int tid, lane, wave, vcu, G;
    const float* const* in; float* out; unsigned char* ws;
    template <class T> __device__ __forceinline__ T* w(size_t off) const { return (T*)(ws + off); }
};
enum { I_XP = 0, I_XS, I_PP, I_PS, I_ST, I_GMIX, I_WIN, I_GRET, I_WS, I_BS, I_GGM, I_WBRA, I_WBRB, I_WO, I_GMLP, I_WUP, I_WDN, I_GPLE, I_WPG, I_WPP, I_GFIN };

__device__ __forceinline__ void p0_transpose_item(const float* W, int K, int N, bf16_t* WT, LAS float* scr, int item, int lane, const float* rowg, int cs_lo, int cs_hi, float cs) {
    const int nblk = N / 32, kb = item / nblk, nb = item % nblk, k0 = 64 * kb, n0 = 32 * nb;
#pragma unroll 8
    for (int i = 0; i < 32; ++i) { const int kk = 2 * i + (lane >> 5); float wv = W[(size_t)(k0 + kk) * N + n0 + (lane & 31)]; if (rowg) wv *= rowg[k0 + kk]; scr[kk * 33 + (lane & 31)] = wv; }
    asm volatile("s_waitcnt lgkmcnt(0)" ::: "memory");
    const int c = lane & 7;
#pragma unroll
    for (int j = 0; j < 4; ++j) { const int n = (lane >> 3) + 8 * j; const LAS float* s = scr + (8 * c) * 33 + n; const float sc = (n0 + n >= cs_lo && n0 + n < cs_hi) ? cs : 1.0f;
        u32x4 o; o.x = pk2(s[0 * 33] * sc, s[1 * 33] * sc); o.y = pk2(s[2 * 33] * sc, s[3 * 33] * sc); o.z = pk2(s[4 * 33] * sc, s[5 * 33] * sc); o.w = pk2(s[6 * 33] * sc, s[7 * 33] * sc);
        *(u32x4*)(WT + (size_t)(n0 + n) * K + k0 + 8 * c) = o; }
    asm volatile("s_waitcnt lgkmcnt(0)" ::: "memory");
}
__device__ __forceinline__ double sin_poly(double x) {
    const double x2 = x * x; double r = -1.0 / 8841761993739701954543616000000.0;
    r = r * x2 + 1.0 / 10888869450418352160768000000.0;
    r = r * x2 - 1.0 / 15511210043330985984000000.0;
    r = r * x2 + 1.0 / 25852016738884976640000.0;
    r = r * x2 - 1.0 / 51090942171709440000.0;
    r = r * x2 + 1.0 / 121645100408832000.0;
    r = r * x2 - 1.0 / 355687428096000.0;
    r = r * x2 + 1.0 / 1307674368000.0;
    r = r * x2 - 1.0 / 6227020800.0;
    r = r * x2 + 1.0 / 39916800.0;
    r = r * x2 - 1.0 / 362880.0;
    r = r * x2 + 1.0 / 5040.0;
    r = r * x2 - 1.0 / 120.0;
    r = r * x2 + 1.0 / 6.0;
    r = r * x2 - 1.0;
    return -r * x;
}
__device__ __forceinline__ double cos_poly(double x) {
    const double x2 = x * x; double r = -1.0 / 265252859812191058636308480000000.0;
    r = r * x2 + 1.0 / 304888344611713860501504000000.0;
    r = r * x2 - 1.0 / 403291461126605635584000000.0;
    r = r * x2 + 1.0 / 620448401733239439360000.0;
    r = r * x2 - 1.0 / 1124000727777607680000.0;
    r = r * x2 + 1.0 / 2432902008176640000.0;
    r = r * x2 - 1.0 / 6402373705728000.0;
    r = r * x2 + 1.0 / 20922789888000.0;
    r = r * x2 - 1.0 / 87178291200.0;
    r = r * x2 + 1.0 / 479001600.0;
    r = r * x2 - 1.0 / 3628800.0;
    r = r * x2 + 1.0 / 40320.0;
    r = r * x2 - 1.0 / 720.0;
    r = r * x2 + 1.0 / 24.0;
    r = r * x2 - 0.5;
    r = r * x2 + 1.0;
    return r;
}
__device__ __forceinline__ void p0_prologue(const Ctx& C) {
    LAS float* scr = (LAS float*)(C.lds + C.wave * 16384);
    const int gw = C.vcu * NWAVES + C.wave, NGW = C.G * NWAVES, lane = C.lane;
    constexpr int I_IN = (DM / 64) * (INW / 32), I_BRA = (2048 / 64) * (DM / 32), I_SQ = (DM / 64) * (DM / 32), I_UP = (DM / 64) * (FF / 32), I_DN = (FF / 64) * (DM / 32), I_PPI = (PLE / 64) * (DM / 32);
    constexpr int NITEMS = I_IN + I_BRA + 3 * I_SQ + I_UP + I_DN + I_PPI;
    for (int it = gw; it < NITEMS; it += NGW) {
        int r = it;
        if (r < I_IN) { p0_transpose_item(C.in[I_WIN], DM, INW, C.w<bf16_t>(WS_WIN), scr, r, lane, nullptr, CK, CV, 0.0625f); continue; } r -= I_IN;
        if (r < I_BRA) { p0_transpose_item(C.in[I_WBRA], 2048, DM, C.w<bf16_t>(WS_WBRA), scr, r, lane, nullptr, 0, 0, 1.f); continue; } r -= I_BRA;
        if (r < I_SQ) { p0_transpose_item(C.in[I_WBRB], DM, DM, C.w<bf16_t>(WS_WBRB), scr, r, lane, nullptr, 0, 0, 1.f); continue; } r -= I_SQ;
        if (r < I_SQ) { p0_transpose_item(C.in[I_WO], DM, DM, C.w<bf16_t>(WS_WO), scr, r, lane, nullptr, 0, 0, 1.f); continue; } r -= I_SQ;
        if (r < I_SQ) { p0_transpose_item(C.in[I_WPG], DM, DM, C.w<bf16_t>(WS_WPG), scr, r, lane, C.in[I_GPLE], 0, 0, 1.f); continue; } r -= I_SQ;
        if (r < I_UP) { p0_transpose_item(C.in[I_WUP], DM, FF, C.w<bf16_t>(WS_WUP), scr, r, lane, C.in[I_GMLP], 0, 0, 1.f); continue; } r -= I_UP;
        if (r < I_DN) { p0_transpose_item(C.in[I_WDN], FF, DM, C.w<bf16_t>(WS_WDN), scr, r, lane, nullptr, 0, 0, 1.f); continue; } r -= I_DN;
        p0_transpose_item(C.in[I_WPP], PLE, DM, C.w<bf16_t>(WS_WPP), scr, r, lane, nullptr, 0, 0, 1.f);
    }
    const float* gm = C.in[I_GMIX];
    f32x4 gv[4];
#pragma unroll
    for (int j = 0; j < 4; ++j) gv[j] = ((const f32x4*)gm)[lane + 64 * j];
    bf16_t* XN = C.w<bf16_t>(WS_XN); bf16_t* PB = C.w<bf16_t>(WS_PB);
    for (int m = gw; m < MT; m += NGW) {
        const float* xrow = m < MP ? C.in[I_XP] + (size_t)m * DM : C.in[I_XS] + (size_t)(m - MP) * DM;
        const f32x4* xr = (const f32x4*)xrow + lane;
        f32x4 v[4]; float s = 0.f;
#pragma unroll
        for (int j = 0; j < 4; ++j) { v[j] = xr[64 * j]; s += sum4(v[j] * v[j]); }
        const float rstd = rsqrtf(wave_sum(s) * (1.f / DM) + EPS);
        u32x2* o8 = (u32x2*)(XN + (size_t)m * DM) + lane;
#pragma unroll
        for (int j = 0; j < 4; ++j) { const f32x4 y = v[j] * rstd * gv[j]; u32x2 w; w.x = pk2(y[0], y[1]); w.y = pk2(y[2], y[3]); o8[64 * j] = w; }
        const float* prow = m < MP ? C.in[I_PP] + (size_t)m * PLE : C.in[I_PS] + (size_t)(m - MP) * PLE;
        const f32x4 pv = ((const f32x4*)prow)[lane]; u32x2 pw; pw.x = pk2(pv[0], pv[1]); pw.y = pk2(pv[2], pv[3]);
        ((u32x2*)(PB + (size_t)m * PLE))[lane] = pw;
    }
    float* cosT = C.w<float>(WS_COS); float* sinT = C.w<float>(WS_SIN);
    for (int e = (C.vcu * NTHR + C.tid); e < NTAB * 128; e += C.G * NTHR) {
        const int ti = e >> 7, i = e & 127; const float pos = ti < 2048 ? (float)ti : (float)(16384 + ti - 2048);
        const float inv = (float)exp2(-(double)i * (13.287712379549449 / 128.0));
        const float ang = pos * inv;
        const double x = (double)ang; const double k = __builtin_rint(x * 0.15915494309189535);
        double r = __builtin_fma(-k, 6.283185307179586, x); r = __builtin_fma(-k, 2.4492935982947064e-16, r);
        cosT[e] = (float)cos_poly(r); sinT[e] = (float)sin_poly(r);
    }
}

template <class F> __device__ __forceinline__ void run_gemm(const Ctx& C, const bf16_t* A, const bf16_t* Bt, int M, int N, int K, const F& f) {
    asm volatile("" : "+s"(K));
    pg8::Gemm g{A, Bt, M, N, K}; pg8::StaticOrder S; S.init(M, N, C.G, (int)blockIdx.x);
    EpiGen<F> E{f};
    pg8::gemm_phase<EpiGen<F>, pg8::StaticOrder, true, true>((PG8_LAS unsigned char*)C.lds, g, S, E);
}

__device__ __forceinline__ void ret_simple_item(const Ctx& C, bool sample, int b, int h, int vs) {
    const int v = C.tid & 63, dg = C.wave, d0 = 32 * dg;
    const int L = sample ? 4 : 2048, row0 = sample ? MP + 4 * b : 2048 * b;
    const float gamma = 1.0f - exp2f(-5.0f - (float)h);
    float S[32];
    const size_t sbase = ((size_t)(b * 4 + h) * 256 + d0) * 512 + vs * 64 + v;
    if (sample) { const float* st = C.in[I_ST] + sbase;
#pragma unroll
        for (int j = 0; j < 32; ++j) S[j] = st[(size_t)j * 512]; }
    else {
#pragma unroll
        for (int j = 0; j < 32; ++j) S[j] = 0.f; }
    const bf16_t* Z = C.w<bf16_t>(WS_Z); bf16_t* OR = C.w<bf16_t>(WS_ORAW);
    LAS float* part = (LAS float*)C.lds;
    for (int t = 0; t < L; ++t) {
        const int row = row0 + t; const bf16_t* zr = Z + (size_t)row * INW;
        const float vv = bf2f(zr[CV + h * 512 + vs * 64 + v]);
        const u32x4* qp = (const u32x4*)(zr + CQ + h * 256 + d0); const u32x4* kp = (const u32x4*)(zr + CK + h * 256 + d0);
        float o = 0.f;
#pragma unroll
        for (int c = 0; c < 4; ++c) { const u32x4 qw = qp[c], kw = kp[c];
#pragma unroll
            for (int e = 0; e < 4; ++e) { const unsigned q2 = qw[e], k2 = kw[e]; const int j = c * 8 + e * 2;
                S[j] = gamma * S[j] + __uint_as_float(k2 << 16) * vv; o += __uint_as_float(q2 << 16) * S[j];
                S[j + 1] = gamma * S[j + 1] + __uint_as_float(k2 & 0xffff0000u) * vv; o += __uint_as_float(q2 & 0xffff0000u) * S[j + 1]; } }
        part[((t & 1) * 8 + dg) * 64 + v] = o;
        __syncthreads();
        if (dg == 0) { float ot = 0.f;
#pragma unroll
            for (int g = 0; g < 8; ++g) ot += part[((t & 1) * 8 + g) * 64 + v];
            OR[(size_t)row * 2048 + h * 512 + vs * 64 + v] = (bf16_t)f2bf(ot); }
    }
    float* so = C.out + (sample ? O_SRS : O_SRP) + sbase;
#pragma unroll
    for (int j = 0; j < 32; ++j) so[(size_t)j * 512] = S[j];
    __syncthreads();
}
typedef short bf16x8 __attribute__((ext_vector_type(8)));
typedef short s16x4 __attribute__((ext_vector_type(4)));
typedef short v4i16_t __attribute__((ext_vector_type(4)));
typedef float f32x16 __attribute__((ext_vector_type(16)));
constexpr int R_QS = 528, R_VS = 192, R_PS = 144;
constexpr int R_Q = 0, R_K = R_Q + 64 * R_QS, R_ST = R_K + 64 * R_QS, R_V = R_ST + 64 * R_QS, R_VD = R_V + 64 * R_VS, R_P = R_VD + 64 * R_VS, R_END = R_P + 64 * R_PS;
static_assert(R_END <= LDS_BYTES, "retention LDS map");
__device__ __forceinline__ s16x4 vtr(const LAS unsigned char* p) { return __builtin_bit_cast(s16x4, __builtin_amdgcn_ds_read_tr16_b64_v4i16((LAS v4i16_t*)p)); }
#define MFMA32(a, b, c) __builtin_amdgcn_mfma_f32_32x32x16_bf16((a), (b), (c), 0, 0, 0)
__device__ __forceinline__ bf16x8 tr_frag(const LAS unsigned char* a, int stride) { const s16x4 lo = vtr(a), hi = vtr(a + 4 * stride); return (bf16x8){lo[0], lo[1], lo[2], lo[3], hi[0], hi[1], hi[2], hi[3]}; }
__device__ __forceinline__ void ret_mfma_item(const Ctx& C, int b, int h, int vs) {
    const int tid = C.tid, lane = C.lane, wave = C.wave, l31_ = lane & 31, hh_ = lane >> 5;
    const LAS unsigned char* lds = C.lds;
    const bf16_t* Z = C.w<bf16_t>(WS_Z); bf16_t* OR = C.w<bf16_t>(WS_ORAW);
    const float lg = log2f(1.0f - exp2f(-5.0f - (float)h));
    const int row00 = b * 2048;
    for (int e = tid; e < 64 * R_QS / 16; e += NTHR) *(LAS u32x4*)(C.lds + R_ST + e * 16) = (u32x4){0u, 0u, 0u, 0u};
    f32x16 S0, S1;
#pragma unroll
    for (int i = 0; i < 16; ++i) { S0[i] = 0.f; S1[i] = 0.f; }
    u32x4 gq[4], gk[4], gv;
    const int qrow = tid >> 5, qch = tid & 31, vrow = tid >> 3, vch = tid & 7;
    const bf16_t* zq = Z + (size_t)row00 * INW + CQ + h * 256 + qch * 8;
    const bf16_t* zk = Z + (size_t)row00 * INW + CK + h * 256 + qch * 8;
    const bf16_t* zv = Z + (size_t)row00 * INW + CV + h * 512 + vs * 64 + vch * 8;
#define RET_LOAD(ci) do { _Pragma("unroll") for (int j = 0; j < 4; ++j) { const size_t ro = (size_t)((ci) * 64 + qrow + 16 * j) * INW; gq[j] = *(const u32x4*)(zq + ro); gk[j] = *(const u32x4*)(zk + ro); } \
        gv = *(const u32x4*)(zv + (size_t)((ci) * 64 + vrow) * INW); } while (0)
    RET_LOAD(0);
    const float vdsc = exp2f((float)(63 - vrow) * lg);
    const float g64 = exp2f(64.0f * lg);
    for (int ci = 0; ci < 32; ++ci) {
        int l31 = l31_, hh = hh_; asm volatile("" : "+v"(l31), "+v"(hh));
#pragma unroll
        for (int j = 0; j < 4; ++j) { *(LAS u32x4*)(C.lds + R_Q + (qrow + 16 * j) * R_QS + qch * 16) = gq[j]; *(LAS u32x4*)(C.lds + R_K + (qrow + 16 * j) * R_QS + qch * 16) = gk[j]; }
        *(LAS u32x4*)(C.lds + R_V + vrow * R_VS + vch * 16) = gv;
        { u32x4 d;
#pragma unroll
          for (int e = 0; e < 4; ++e) { const unsigned w = gv[e]; d[e] = pk2(__uint_as_float(w << 16) * vdsc, __uint_as_float(w & 0xffff0000u) * vdsc); }
          *(LAS u32x4*)(C.lds + R_VD + vrow * R_VS + vch * 16) = d; }
        __syncthreads();
        if (ci + 1 < 32) RET_LOAD(ci + 1);
        const int rowoff = l31, koff = 16 * hh;
        const int tr_q = (l31 & 15) >> 2, tr_p = l31 & 3, tr_blk = (l31 >> 4) & 1;
        f32x16 acc;
#pragma unroll
        for (int i = 0; i < 16; ++i) acc[i] = 0.f;
        if (wave < 3) {
            const int st = wave >> 1, tt = wave == 0 ? 0 : 1;
            const LAS unsigned char* pa = lds + R_K + (32 * st + rowoff) * R_QS + koff;
            const LAS unsigned char* pb = lds + R_Q + (32 * tt + rowoff) * R_QS + koff;
#pragma unroll 4
            for (int ks = 0; ks < 16; ++ks) acc = MFMA32(*(const LAS bf16x8*)(pa + ks * 32), *(const LAS bf16x8*)(pb + ks * 32), acc);
            const int t = 32 * tt + l31;
#pragma unroll
            for (int g = 0; g < 4; ++g) { float pv[4];
#pragma unroll
                for (int e = 0; e < 4; ++e) { const int s = 32 * st + 8 * g + 4 * hh + e; pv[e] = (t >= s) ? acc[4 * g + e] * __builtin_amdgcn_exp2f((float)(t - s) * lg) : 0.f; }
                u32x2 w; w.x = cvtpk(pv[0], pv[1]); w.y = cvtpk(pv[2], pv[3]);
                *(LAS u32x2*)(C.lds + R_P + t * R_PS + (32 * st + 8 * g + 4 * hh) * 2) = w; }
        } else if (wave >= 4) {
            const int tt = (wave >> 1) & 1, vt = wave & 1;
            const LAS unsigned char* pa = lds + R_Q + (32 * tt + rowoff) * R_QS + koff;
            const LAS unsigned char* pb = lds + R_ST + (32 * vt + rowoff) * R_QS + koff;
#pragma unroll 4
            for (int ks = 0; ks < 16; ++ks) acc = MFMA32(*(const LAS bf16x8*)(pa + ks * 32), *(const LAS bf16x8*)(pb + ks * 32), acc);
#pragma unroll
            for (int i = 0; i < 16; ++i) { const int t = 32 * tt + (i & 3) + 8 * (i >> 2) + 4 * hh; acc[i] *= __builtin_amdgcn_exp2f((float)(t + 1) * lg); }
        }
        __syncthreads();
        if (wave >= 4) {
            const int tt = (wave >> 1) & 1, vt = wave & 1;
            const LAS unsigned char* pa = lds + R_P + (32 * tt + rowoff) * R_PS + koff;
            const LAS unsigned char* pb = lds + R_V + (8 * hh + tr_q) * R_VS + (32 * vt + 16 * tr_blk + 4 * tr_p) * 2;
            for (int ks = 0; ks < 2 * tt + 2; ++ks) acc = MFMA32(*(const LAS bf16x8*)(pa + ks * 32), tr_frag(pb + 16 * ks * R_VS, R_VS), acc);
            bf16_t* orow = OR + (size_t)(row00 + ci * 64 + 32 * tt) * 2048 + h * 512 + vs * 64 + 32 * vt + l31;
#pragma unroll
            for (int i = 0; i < 16; ++i) { const int tl = (i & 3) + 8 * (i >> 2) + 4 * hh; orow[(size_t)tl * 2048] = (bf16_t)f2bf(acc[i]); }
        }
        {
#pragma unroll
            for (int i = 0; i < 16; ++i) { S0[i] *= g64; S1[i] *= g64; }
            const LAS unsigned char* pa = lds + R_K + (8 * hh + tr_q) * R_QS + (32 * wave + 16 * tr_blk + 4 * tr_p) * 2;
            const LAS unsigned char* pb = lds + R_VD + (8 * hh + tr_q) * R_VS + (16 * tr_blk + 4 * tr_p) * 2;
#pragma unroll
            for (int ks = 0; ks < 4; ++ks) { const bf16x8 a = tr_frag(pa + 16 * ks * R_QS, R_QS);
                S0 = MFMA32(a, tr_frag(pb + 16 * ks * R_VS, R_VS), S0); S1 = MFMA32(a, tr_frag(pb + 16 * ks * R_VS + 64, R_VS), S1); }
#pragma unroll
            for (int g = 0; g < 4; ++g) { u32x2 w0, w1; w0.x = cvtpk(S0[4 * g], S0[4 * g + 1]); w0.y = cvtpk(S0[4 * g + 2], S0[4 * g + 3]); w1.x = cvtpk(S1[4 * g], S1[4 * g + 1]); w1.y = cvtpk(S1[4 * g + 2], S1[4 * g + 3]);
                *(LAS u32x2*)(C.lds + R_ST + l31 * R_QS + (32 * wave + 8 * g + 4 * hh) * 2) = w0;
                *(LAS u32x2*)(C.lds + R_ST + (32 + l31) * R_QS + (32 * wave + 8 * g + 4 * hh) * 2) = w1; }
        }
        __syncthreads();
    }
#undef RET_LOAD
    float* so = C.out + O_SRP + ((size_t)(b * 4 + h) * 256 + 32 * wave) * 512 + vs * 64 + l31_;
#pragma unroll
    for (int i = 0; i < 16; ++i) { const int dl = (i & 3) + 8 * (i >> 2) + 4 * hh_; so[(size_t)dl * 512] = S0[i]; so[(size_t)dl * 512 + 32] = S1[i]; }
}
__device__ __forceinline__ void p2_retention_simple(const Ctx& C) {
#ifdef RET_SIMPLE
    for (int it = C.vcu; it < 256; it += C.G) ret_simple_item(C, false, it >> 5, (it >> 3) & 3, it & 7);
#else
    for (int it = C.vcu; it < 256; it += C.G) ret_mfma_item(C, it >> 5, (it >> 3) & 3, it & 7);
    __syncthreads();
#endif
    for (int it = C.vcu; it < 4096; it += C.G) ret_simple_item(C, true, it >> 5, (it >> 3) & 3, it & 7);
}
template <int CH> __device__ __forceinline__ void gate_simple_item(const Ctx& C, int row0, float* gmv_out) {
    LAS float* gvl = (LAS float*)C.lds;
    LAS float* wl = (LAS float*)(C.lds + 65536);
    const bf16_t* Z = C.w<bf16_t>(WS_Z); const float* LNS = C.w<float>(WS_LNS); bf16_t* YB = C.w<bf16_t>(WS_YB);
    const float* w_s = C.in[I_WS]; const float* b_s = C.in[I_BS]; const float* g_gm = C.in[I_GGM];
    for (int g = 0; g < 8; ++g) {
        for (int e = C.tid; e < CH * 128; e += NTHR) { const int m = e >> 7, ch = e & 127; const int row = row0 + m;
            const float mu = LNS[2 * row] * (1.f / 1024.f), var = LNS[2 * row + 1] * (1.f / 1024.f) - mu * mu, rstd = rsqrtf(var + EPS);
            const float x = bf2f(Z[(size_t)row * INW + CGV + g * 128 + ch]); const float y = (x - mu) * rstd * g_gm[g * 128 + ch];
            gvl[e] = y; if (gmv_out) gmv_out[(size_t)m * 1024 + g * 128 + ch] = y;
            wl[e] = (ch < CH) ? w_s[((size_t)g * 128 + m) * 128 + ch] : 0.f; }
        __syncthreads();
        const int ch = C.tid & 127;
        for (int n = C.tid >> 7; n < CH; n += 4) { float acc = b_s[g * 128 + n];
            for (int m = 0; m <= n; ++m) acc += wl[n * 128 + m] * gvl[m * 128 + ch];
            const int row = row0 + n; const float u = bf2f(Z[(size_t)row * INW + CU + g * 128 + ch]);
            YB[(size_t)row * DM + g * 128 + ch] = (bf16_t)f2bf(u * acc); }
        __syncthreads();
    }
}
__device__ __forceinline__ void p2_gating_simple(const Ctx& C) {
    for (int it = C.vcu; it < 128; it += C.G) gate_simple_item<128>(C, (it >> 4) * 2048 + (it & 15) * 128, nullptr);
    for (int it = C.vcu; it < 128; it += C.G) gate_simple_item<4>(C, MP + 4 * it, C.out + O_GMV + (size_t)it * 4 * 1024);
}
__device__ __forceinline__ void p3_finalize_ya(const Ctx& C) {
    const bf16_t* Z = C.w<bf16_t>(WS_Z); const bf16_t* OR = C.w<bf16_t>(WS_ORAW); bf16_t* YA = C.w<bf16_t>(WS_YA);
    const float* g_ret = C.in[I_GRET];
    const int gw = C.vcu * NWAVES + C.wave, NGW = C.G * NWAVES, lane = C.lane;
    for (int row = gw; row < MT; row += NGW) {
        f32x4 o[8]; float rs[4];
#pragma unroll
        for (int j = 0; j < 8; ++j) o[j] = ld_bf4(OR + (size_t)row * 2048 + 4 * lane + 256 * j);
#pragma unroll
        for (int hd = 0; hd < 4; ++hd) rs[hd] = rsqrtf(wave_sum(sum4(o[2 * hd] * o[2 * hd]) + sum4(o[2 * hd + 1] * o[2 * hd + 1])) * (1.f / 512.f) + EPS);
#pragma unroll
        for (int j = 0; j < 8; ++j) { const int c = 4 * lane + 256 * j;
            const f32x4 gz = ld_bf4(Z + (size_t)row * INW + CG + c), gr = *(const f32x4*)(g_ret + c);
            st_bf4(YA + (size_t)row * 2048 + c, gz * o[j] * rs[j >> 1] * gr); }
    }
}
__device__ __forceinline__ void p9_final_norm(const Ctx& C) {
    const float* H3 = C.w<float>(WS_H3); const float* SSQ4 = C.w<float>(WS_SSQ4); const float* gf = C.in[I_GFIN];
    const int gw = C.vcu * NWAVES + C.wave, NGW = C.G * NWAVES, lane = C.lane;
    f32x4 gv[4];
#pragma unroll
    for (int j = 0; j < 4; ++j) gv[j] = ((const f32x4*)gf)[lane + 64 * j];
    for (int row = gw; row < MT; row += NGW) {
        const float rs = rsqrtf(SSQ4[row] * (1.f / DM) + EPS);
        const f32x4* hr = (const f32x4*)(H3 + (size_t)row * DM) + lane; f32x4* o = (f32x4*)(C.out + O_Y + (size_t)row * DM) + lane;
#pragma unroll
        for (int j = 0; j < 4; ++j) o[64 * j] = hr[64 * j] * rs * gv[j];
    }
}

#ifdef DBG_EXPORT
__device__ __forceinline__ void dbg_export(const Ctx& C) {
    const bf16_t* Z = C.w<bf16_t>(WS_Z); const bf16_t* YA = C.w<bf16_t>(WS_YA); const bf16_t* YB = C.w<bf16_t>(WS_YB);
    const int gw = C.vcu * NWAVES + C.wave, NGW = C.G * NWAVES, lane = C.lane;
    for (int row = gw; row < MT; row += NGW)
        for (int j = 0; j < 4; ++j) { const int c = 4 * lane + 256 * j;
            f32x4 v = (f32x4){0.f, 0.f, 0.f, 0.f};
#if DBG_EXPORT == 1
            v = ld_bf4(YB + (size_t)row * DM + c);
#elif DBG_EXPORT == 4
            v = ld_bf4(YA + (size_t)row * 2048 + c) + ld_bf4(YA + (size_t)row * 2048 + 1024 + c);
#elif DBG_EXPORT == 5
            v = ld_bf4(Z + (size_t)row * INW + CGA + c) + ld_bf4(Z + (size_t)row * INW + CGB + c);
#elif DBG_EXPORT == 6
            v = ld_bf4(C.w<bf16_t>(WS_ORAW) + (size_t)row * 2048 + c) + ld_bf4(C.w<bf16_t>(WS_ORAW) + (size_t)row * 2048 + 1024 + c);
#elif DBG_EXPORT == 7
            v = ld_bf4(Z + (size_t)row * INW + CG + c) + ld_bf4(Z + (size_t)row * INW + CG + 1024 + c);
#elif DBG_EXPORT == 8
            v = ld_bf4(Z + (size_t)row * INW + CQ + c);
#endif
            *(f32x4*)(C.out + O_Y + (size_t)row * DM + c) = v; }
}
#endif
constexpr int NPHASE = 10;
__global__ void __launch_bounds__(NTHR, 2) mk_fwd(Args args) {
    extern __shared__ __attribute__((aligned(16))) unsigned char lds_raw[];
    Ctx C;
    C.lds = (LAS unsigned char*)lds_raw; C.tid = threadIdx.x; C.lane = C.tid & 63; C.wave = __builtin_amdgcn_readfirstlane(C.tid >> 6);
    C.G = gridDim.x; { const int bx = blockIdx.x; C.vcu = (C.G % 8 == 0) ? (bx % 8) * (C.G / 8) + bx / 8 : bx; }
    C.in = args.in; C.out = args.out; C.ws = args.ws;
    const int lo = args.ph_lo, hi = args.ph_hi;
#define IN(k) (lo <= (k) && (k) < hi)
#define SEAM(k) do { if (IN(k) && IN((k) + 1)) { GRID_BAR(); } } while (0)
#define GRID_BAR() do { cooperative_groups::this_grid().sync(); } while (0)
    if (IN(0)) { p0_prologue(C); } SEAM(0);
    if (IN(1)) { F1 f{C.w<bf16_t>(WS_Z), C.w<float>(WS_COS), C.w<float>(WS_SIN), C.w<float>(WS_LNS)}; run_gemm(C, C.w<bf16_t>(WS_XN), C.w<bf16_t>(WS_WIN), MT, INW, DM, f); } SEAM(1);
    if (IN(2)) { p2_retention_simple(C); p2_gating_simple(C); } SEAM(2);
    if (IN(3)) { p3_finalize_ya(C); } SEAM(3);
    if (IN(4)) { { F2a f{C.w<bf16_t>(WS_Z), C.w<float>(WS_T)}; run_gemm(C, C.w<bf16_t>(WS_YA), C.w<bf16_t>(WS_WBRA), MT, DM, 2048, f); }
                 { F2b f{C.w<bf16_t>(WS_Z), C.w<float>(WS_T), C.w<bf16_t>(WS_MG)}; run_gemm(C, C.w<bf16_t>(WS_YB), C.w<bf16_t>(WS_WBRB), MT, DM, DM, f); } } SEAM(4);
    if (IN(5)) { FRes f{C.in[I_XP], C.in[I_XS], C.w<float>(WS_H1), C.w<bf16_t>(WS_H1B), C.w<float>(WS_SSQ2)}; run_gemm(C, C.w<bf16_t>(WS_MG), C.w<bf16_t>(WS_WO), MT, DM, DM, f); } SEAM(5);
    if (IN(6)) { F4 f{C.w<float>(WS_SSQ2), C.w<bf16_t>(WS_U)}; run_gemm(C, C.w<bf16_t>(WS_H1B), C.w<bf16_t>(WS_WUP), MT, FF, DM, f); } SEAM(6);
    if (IN(7)) { FRes f{C.w<float>(WS_H1), C.w<float>(WS_H1) + (size_t)MP * DM, C.w<float>(WS_H2), C.w<bf16_t>(WS_H2B), C.w<float>(WS_SSQ3)}; run_gemm(C, C.w<bf16_t>(WS_U), C.w<bf16_t>(WS_WDN), MT, DM, FF, f); } SEAM(7);
    if (IN(8)) { { F6a f{C.w<float>(WS_PE)}; run_gemm(C, C.w<bf16_t>(WS_PB), C.w<bf16_t>(WS_WPP), MT, DM, PLE, f); }
                 { F6b f{C.w<float>(WS_SSQ3), C.w<float>(WS_H2), C.w<float>(WS_PE), C.w<float>(WS_H3), C.w<float>(WS_SSQ4)}; run_gemm(C, C.w<bf16_t>(WS_H2B), C.w<bf16_t>(WS_WPG), MT, DM, DM, f); } } SEAM(8);
    if (IN(9)) { p9_final_norm(C); }
#ifdef DBG_EXPORT
    if (IN(10)) { dbg_export(C); }
#endif
#undef IN
#undef SEAM
#undef GRID_BAR
}
}

extern "C" void kernel_launch(void* const* d_in, const int* in_sizes, int n_in, void* d_out, int out_size, void* d_ws, size_t ws_size, hipStream_t stream) {
    using namespace mk;
    static int grid = 0;
    if (grid == 0) {
        if (n_in != 21 || (size_t)out_size != O_END || ws_size < WS_END) { fprintf(stderr, "kernel_launch: unexpected shapes: n_in %d out %d ws %zu (need %zu)\n", n_in, out_size, ws_size, (size_t)WS_END); grid = -1; return; }
        int dev = 0, cus = 0;
        if (hipGetDevice(&dev) != hipSuccess || hipDeviceGetAttribute(&cus, hipDeviceAttributeMultiprocessorCount, dev) != hipSuccess) { grid = -1; return; }
        if (hipFuncSetAttribute((const void*)mk_fwd, hipFuncAttributeMaxDynamicSharedMemorySize, LDS_BYTES) != hipSuccess) { fprintf(stderr, "kernel_launch: hipFuncSetAttribute failed\n"); grid = -1; return; }
        int per_cu = 0;
        if (hipOccupancyMaxActiveBlocksPerMultiprocessor(&per_cu, (const void*)mk_fwd, NTHR, LDS_BYTES) != hipSuccess || per_cu < 1) { fprintf(stderr, "kernel_launch: occupancy query says %d blocks/CU\n", per_cu); (void)hipGetLastError(); grid = -1; return; }
        grid = cus;
    }
    if (grid < 0) return;
    (void)hipMemsetAsync((char*)d_ws, 0, WS_ZERO_END, stream);
    Args a{};
    for (int i = 0; i < 21; ++i) a.in[i] = (const float*)d_in[i];
    a.out = (float*)d_out; a.ws = (unsigned char*)d_ws;
#ifdef MK_MULTI
    for (int p = 0; p < NPHASE; ++p) { a.ph_lo = p; a.ph_hi = p + 1; hipLaunchKernelGGL(mk_fwd, dim3(grid), dim3(NTHR), LDS_BYTES, stream, a); }
#else
    a.ph_lo = 0; a.ph_hi = NPHASE;
    void* kargs[] = {&a};
    const hipError_t le = hipLaunchCooperativeKernel((const void*)mk_fwd, dim3(grid), dim3(NTHR), kargs, LDS_BYTES, stream);
    if (le != hipSuccess) fprintf(stderr, "kernel_launch: cooperative launch failed: %s (grid %d)\n", hipGetErrorString(le), grid);
#endif
}
```

```cpp
#include <hip/hip_runtime.h>
#include <hip/hip_cooperative_groups.h>
#include <cstdio>
#include <cstdint>
namespace pg8 {
#define PG8_LAS __attribute__((address_space(3)))
typedef unsigned short bf16_t;
typedef short bf16x8 __attribute__((ext_vector_type(8)));
typedef float f32x4 __attribute__((ext_vector_type(4)));
typedef unsigned u32x4 __attribute__((ext_vector_type(4)));
constexpr int BM = 256, BK = 64, HALF = 128, HTB = HALF * BK * 2  , STAGE_BYTES = 8 * HTB, NXCD = 8, WGM = 8;

__host__ __device__ __forceinline__ int lds_byte(int r, int c) { const int st = (r >> 4) * 2 + (c >> 5), rr = r & 15, cc = c & 31, ob = rr * 64 + cc * 2; return st * 1024 + (ob ^ (((ob >> 9) & 1) << 5)); }
__host__ __device__ __forceinline__ void stage_rc(int b, int& R, int& C) { const int st = b / 1024, sb = b % 1024, swz = sb ^ (((sb >> 9) & 1) << 5); R = (st >> 1) * 16 + swz / 64; C = (st & 1) * 32 + (swz % 64) / 2; }
__host__ __device__ __forceinline__ int perm32(int rho) { const int n = rho >> 4, i = rho & 15; return 8 * (i >> 2) + 4 * n + (i & 3); }

struct Unit { int pm, pn; };
struct Gemm { const bf16_t* A; const bf16_t* Bt; int M, N, K; };

struct StaticOrder {
    int nM, nN, nwg, G, c;
    __host__ __device__ void init(int M, int N, int G_, int c_) { nM = M / BM; nN = N / BM; nwg = nM * nN; G = G_; c = c_; }
    __host__ __device__ bool next(int i, Unit& u) const {
        const long L = (long)i * G + c; if (L >= nwg) return false;
        int wgid = (int)L; { const int q = nwg / NXCD, r = nwg % NXCD, xcd = wgid % NXCD, off = wgid / NXCD; wgid = (xcd < r ? xcd * (q + 1) : r * (q + 1) + (xcd - r) * q) + off; }
        const int nig = WGM * nN, gid = wgid / nig, fm = gid * WGM, gsz = (nM - fm) < WGM ? (nM - fm) : WGM;
        u.pm = fm + ((wgid % nig) % gsz); u.pn = (wgid % nig) / gsz; return true;
    }
    __device__ __forceinline__ void a_ready(const Unit&) const {}
    __device__ __forceinline__ void done(const Unit&) const {}
};

__device__ __forceinline__ unsigned cvt_pk_bf16(float lo, float hi) { unsigned r; asm volatile("v_cvt_pk_bf16_f32 %0, %1, %2" : "=v"(r) : "v"(lo), "v"(hi)); return r; }
typedef float f32x2 __attribute__((ext_vector_type(2)));
__device__ __forceinline__ f32x2 gelu_pk(f32x2 v) {
    const f32x2 av = __builtin_elementwise_abs(v), d = av * 0.2316418882f + 1.0f;
    f32x2 t; t.x = __builtin_amdgcn_rcpf(d.x); t.y = __builtin_amdgcn_rcpf(d.y);
    f32x2 q = t * 0.5307027145f + (-0.7265760135f); q = q * t + 0.7107068705f; q = q * t + (-0.142248368f); q = q * t + 0.127414796f; q = q * t;
    const f32x2 s = (v * v) * (-0.72134752044f);
    f32x2 e; e.x = __builtin_amdgcn_exp2f(s.x); e.y = __builtin_amdgcn_exp2f(s.y);
    const f32x2 m = v * (q * e), r = v - m;
    f32x2 o; o.x = v.x < 0.f ? m.x : r.x; o.y = v.y < 0.f ? m.y : r.y; return o;
}
template <class Epi, class Sched, bool ALIGN_EPI = false, bool SP2 = false>
__device__ __forceinline__ void gemm_phase(PG8_LAS unsigned char* lds, const Gemm g, const Sched& S, const Epi& E) {
    const int tid = threadIdx.x, wid = __builtin_amdgcn_readfirstlane(tid >> 6), lane = tid & 63, wr = wid >> 2, wc = wid & 3, fr = lane & 15, fq = lane >> 4;
    const int K = g.K, nt = K / BK;
    unsigned voffA[2], voffB[2];
#pragma unroll
    for (int i = 0; i < 2; ++i) { int R, C; stage_rc(tid * 16 + i * 8192, R, C); const int Rb = Epi::PERM ? ((R & ~31) + perm32(R & 31)) : R;
        voffA[i] = (unsigned)(R * K + C) * 2u; voffB[i] = (unsigned)(Rb * K + C) * 2u; }
    const size_t kstep = (size_t)(BK * 2);
    const size_t hstep = (size_t)HALF * K * 2;
    const size_t tstep = 2 * hstep;
    const unsigned ldsw = (unsigned)wid * 1024u;
    const int aoff = lds_byte(wr * 64 + fr, fq * 8), boff = lds_byte(wc * 32 + fr, fq * 8);
#define PG8_SA(b, h) (((b) * 2 + (h)) * HTB)
#define PG8_SB(b, h) ((4 + (b) * 2 + (h)) * HTB)
#define PG8_STAGE(bufoff, gbase, voff) do { _Pragma("unroll") for (int _i = 0; _i < 2; ++_i) \
        __builtin_amdgcn_global_load_lds((const unsigned*)((const char*)(gbase) + (voff)[_i]), (PG8_LAS unsigned*)(lds + (bufoff) + ldsw + _i * 8192), 16, 0, 0); } while (0)
#define PG8_LDA(dst, b, h) do { _Pragma("unroll") for (int m = 0; m < 4; ++m) _Pragma("unroll") for (int k = 0; k < 2; ++k) dst[m][k] = *(const PG8_LAS bf16x8*)(lds + PG8_SA(b, h) + aoff + m * 2048 + k * 1024); } while (0)
#define PG8_LDB(dst, b, h) do { _Pragma("unroll") for (int n = 0; n < 2; ++n) _Pragma("unroll") for (int k = 0; k < 2; ++k) dst[n][k] = *(const PG8_LAS bf16x8*)(lds + PG8_SB(b, h) + boff + n * 2048 + k * 1024); } while (0)
#define PG8_MMA(ai, bj, At, Bt) do { __builtin_amdgcn_s_setprio(1); _Pragma("unroll") for (int m = 0; m < 4; ++m) _Pragma("unroll") for (int n = 0; n < 2; ++n) _Pragma("unroll") for (int k = 0; k < 2; ++k) \
        acc[ai][bj][m][n] = __builtin_amdgcn_mfma_f32_16x16x32_bf16(Bt[n][k], At[m][k], acc[ai][bj][m][n], 0, 0, 0); __builtin_amdgcn_s_setprio(0); } while (0)
#define PG8_WAIT_V(n) asm volatile("s_waitcnt vmcnt(" #n ")" ::: "memory")
#define PG8_WAIT_L(n) asm volatile("s_waitcnt lgkmcnt(" #n ")" ::: "memory")
#define PG8_BAR __builtin_amdgcn_s_barrier()
#define PG8_SCHED __builtin_amdgcn_sched_barrier(0)
    Unit cur, nxt; int ui = 0;
    if (!S.next(0, cur)) return;
    f32x4 acc[2][2][4][2];
#pragma unroll
    for (int a = 0; a < 2; ++a)
#pragma unroll
        for (int b = 0; b < 2; ++b)
#pragma unroll
            for (int m = 0; m < 4; ++m)
#pragma unroll
                for (int n = 0; n < 2; ++n) acc[a][b][m][n] = (f32x4){0.f, 0.f, 0.f, 0.f};
    bf16x8 At[4][2], B0[2][2], B1[2][2];
    const char* cA = (const char*)g.A + (size_t)cur.pm * tstep; const char* cB = (const char*)g.Bt + (size_t)cur.pn * tstep;
    S.a_ready(cur);
    if constexpr (SP2) {
        PG8_STAGE(PG8_SB(0, 0), cB, voffB); PG8_STAGE(PG8_SB(0, 1), cB + hstep, voffB); PG8_STAGE(PG8_SA(0, 0), cA, voffA); PG8_STAGE(PG8_SA(0, 1), cA + hstep, voffA);
        if (wr == 1) PG8_BAR;
        PG8_WAIT_V(2); PG8_BAR;
        PG8_STAGE(PG8_SB(1, 0), cB + kstep, voffB); PG8_STAGE(PG8_SA(1, 0), cA + kstep, voffA); PG8_STAGE(PG8_SB(1, 1), cB + hstep + kstep, voffB);
        PG8_WAIT_V(6); PG8_BAR;
    } else {
        PG8_STAGE(PG8_SB(0, 0), cB, voffB); PG8_STAGE(PG8_SA(0, 0), cA, voffA); PG8_STAGE(PG8_SB(0, 1), cB + hstep, voffB); PG8_STAGE(PG8_SA(0, 1), cA + hstep, voffA);
        if (wr == 1) PG8_BAR;
        PG8_WAIT_V(4); PG8_BAR;
        PG8_STAGE(PG8_SB(1, 0), cB + kstep, voffB); PG8_STAGE(PG8_SA(1, 0), cA + kstep, voffA); PG8_STAGE(PG8_SB(1, 1), cB + hstep + kstep, voffB);
        PG8_WAIT_V(6); PG8_BAR;
    }
    for (;;) {
        const bool has_next = S.next(ui + 1, nxt);
        const char* nA = has_next ? (const char*)g.A + (size_t)nxt.pm * tstep : cA; const char* nB = has_next ? (const char*)g.Bt + (size_t)nxt.pn * tstep : cB;
        for (int t = 0; t < nt; t += 2) {
            const bool last = (t == nt - 2);
            const char* a1 = cA + (size_t)(t + 1) * kstep;
            const char* a2 = last ? nA : cA + (size_t)(t + 2) * kstep; const char* b2 = last ? nB : cB + (size_t)(t + 2) * kstep;
            const char* a3 = a2 + kstep; const char* b3 = b2 + kstep;
            if (last && has_next) S.a_ready(nxt);
            if constexpr (SP2) {
            PG8_LDB(B0, 0, 0); PG8_LDB(B1, 0, 1); PG8_SCHED; PG8_LDA(At, 0, 0); PG8_STAGE(PG8_SA(1, 1), a1 + hstep, voffA);
            PG8_WAIT_V(8); PG8_WAIT_L(0); PG8_BAR; PG8_MMA(0, 0, At, B0); PG8_MMA(0, 1, At, B1); PG8_BAR; PG8_SCHED;
            PG8_LDA(At, 0, 1); PG8_STAGE(PG8_SB(0, 0), b2, voffB); PG8_STAGE(PG8_SB(0, 1), b2 + hstep, voffB); PG8_STAGE(PG8_SA(0, 0), a2, voffA);
            PG8_WAIT_V(8); PG8_WAIT_L(0); PG8_BAR; PG8_MMA(1, 0, At, B0); PG8_MMA(1, 1, At, B1); PG8_BAR; PG8_SCHED;
            PG8_LDB(B0, 1, 0); PG8_LDB(B1, 1, 1); PG8_SCHED; PG8_LDA(At, 1, 0); PG8_STAGE(PG8_SA(0, 1), a2 + hstep, voffA);
            PG8_WAIT_V(8); PG8_WAIT_L(0); PG8_BAR; PG8_MMA(0, 0, At, B0); PG8_MMA(0, 1, At, B1); PG8_BAR; PG8_SCHED;
            PG8_LDA(At, 1, 1); PG8_STAGE(PG8_SB(1, 0), b3, voffB); PG8_STAGE(PG8_SB(1, 1), b3 + hstep, voffB); PG8_STAGE(PG8_SA(1, 0), a3, voffA);
            PG8_WAIT_V(8); PG8_WAIT_L(0); PG8_BAR; PG8_MMA(1, 0, At, B0); PG8_MMA(1, 1, At, B1); PG8_BAR; PG8_SCHED;
            } else {
            PG8_LDB(B0, 0, 0); PG8_SCHED; PG8_LDA(At, 0, 0); PG8_STAGE(PG8_SA(1, 1), a1 + hstep, voffA);
            PG8_WAIT_L(8); PG8_BAR; PG8_WAIT_L(0); PG8_MMA(0, 0, At, B0); PG8_BAR; PG8_SCHED;
            PG8_LDB(B1, 0, 1); PG8_STAGE(PG8_SB(0, 0), b2, voffB);
            PG8_BAR; PG8_WAIT_L(0); PG8_MMA(0, 1, At, B1); PG8_BAR;
            PG8_LDA(At, 0, 1); PG8_STAGE(PG8_SA(0, 0), a2, voffA);
            PG8_BAR; PG8_WAIT_L(0); PG8_MMA(1, 0, At, B0); PG8_BAR; PG8_SCHED;
            PG8_STAGE(PG8_SB(0, 1), b2 + hstep, voffB);
            PG8_WAIT_V(6); PG8_BAR; PG8_MMA(1, 1, At, B1); PG8_BAR;
            PG8_LDB(B0, 1, 0); PG8_SCHED; PG8_LDA(At, 1, 0); PG8_STAGE(PG8_SA(0, 1), a2 + hstep, voffA);
            PG8_WAIT_L(8); PG8_BAR; PG8_WAIT_L(0); PG8_MMA(0, 0, At, B0); PG8_BAR; PG8_SCHED;
            PG8_LDB(B1, 1, 1); PG8_STAGE(PG8_SB(1, 0), b3, voffB);
            PG8_BAR; PG8_WAIT_L(0); PG8_MMA(0, 1, At, B1); PG8_BAR;
            PG8_LDA(At, 1, 1); PG8_STAGE(PG8_SA(1, 0), a3, voffA);
            PG8_BAR; PG8_WAIT_L(0); PG8_MMA(1, 0, At, B0); PG8_BAR; PG8_SCHED;
            PG8_STAGE(PG8_SB(1, 1), b3 + hstep, voffB);
            PG8_WAIT_V(6); PG8_BAR; PG8_MMA(1, 1, At, B1); PG8_BAR;
            }
        }
        if constexpr (ALIGN_EPI) { if (wr == 0) PG8_BAR; }
        if constexpr (!Epi::AFTER_DRAIN) { E(acc, cur, wr, wc, fr, fq); S.done(cur); }
        if (!has_next) break;
#pragma unroll
        for (int a = 0; a < 2; ++a)
#pragma unroll
            for (int b = 0; b < 2; ++b)
#pragma unroll
                for (int m = 0; m < 4; ++m)
#pragma unroll
                    for (int n = 0; n < 2; ++n) acc[a][b][m][n] = (f32x4){0.f, 0.f, 0.f, 0.f};
        cur = nxt; cA = nA; cB = nB; ++ui;
        if constexpr (ALIGN_EPI) { if (wr == 1) PG8_BAR; }
    }
    PG8_WAIT_V(0);
    if constexpr (!ALIGN_EPI) { if (wr == 0) PG8_BAR; }
    PG8_BAR;
    if constexpr (Epi::AFTER_DRAIN) { E.fused(acc, cur, wr, wc, fr, fq, lds, wid, lane); S.done(cur); }
#undef PG8_SA
#undef PG8_SB
#undef PG8_STAGE
#undef PG8_LDA
#undef PG8_LDB
#undef PG8_MMA
#undef PG8_WAIT_V
#undef PG8_WAIT_L
#undef PG8_BAR
#undef PG8_SCHED
}
}

namespace mk {
using pg8::bf16_t; using pg8::f32x4; using pg8::f32x2; using pg8::Unit; using pg8::cvt_pk_bf16; using pg8::gelu_pk;
typedef unsigned u32x2 __attribute__((ext_vector_type(2)));
typedef unsigned u32x4 __attribute__((ext_vector_type(4)));
#define LAS __attribute__((address_space(3)))

constexpr int MP = 16384, MS = 512, MT = MP + MS, DM = 1024, INW = 10240, FF = 4096, PLE = 256;
constexpr int CQ = 0, CK = 1024, CV = 2048, CG = 4096, CU = 6144, CGV = 7168, CGA = 8192, CGB = 9216;
constexpr int NTAB = 2048 + 4;
constexpr float EPS = 1e-6f;
constexpr int NWAVES = 8, NTHR = 512;

constexpr size_t O_Y = 0;
constexpr size_t O_SRP = (size_t)MT * DM;
constexpr size_t O_SRS = O_SRP + (size_t)8 * 4 * 256 * 512;
constexpr size_t O_GMV = O_SRS + (size_t)128 * 4 * 256 * 512;
constexpr size_t O_END = O_GMV + (size_t)128 * 4 * 1024;

constexpr size_t al256(size_t x) { return (x + 255) & ~(size_t)255; }
constexpr size_t WS_CTL = 0, CTL_BYTES = 1u << 20;
constexpr size_t WS_LNS = WS_CTL + CTL_BYTES;
constexpr size_t WS_SSQO = WS_LNS + al256((size_t)MT * 2 * 4);
constexpr size_t WS_SSQ2 = WS_SSQO + al256((size_t)MT * 4 * 4);
constexpr size_t WS_SSQ3 = WS_SSQ2 + al256((size_t)MT * 4);
constexpr size_t WS_SSQ4 = WS_SSQ3 + al256((size_t)MT * 4);
constexpr size_t WS_ZERO_END = WS_SSQ4 + al256((size_t)MT * 4);
constexpr size_t WS_COS = al256(WS_ZERO_END);
constexpr size_t WS_SIN = WS_COS + al256((size_t)NTAB * 128 * 4);
constexpr size_t WS_WIN = WS_SIN + al256((size_t)NTAB * 128 * 4);
constexpr size_t WS_WBRA = WS_WIN + (size_t)INW * DM * 2;
constexpr size_t WS_WBRB = WS_WBRA + (size_t)DM * 2048 * 2;
constexpr size_t WS_WO = WS_WBRB + (size_t)DM * DM * 2;
constexpr size_t WS_WUP = WS_WO + (size_t)DM * DM * 2;
constexpr size_t WS_WDN = WS_WUP + (size_t)FF * DM * 2;
constexpr size_t WS_WPG = WS_WDN + (size_t)DM * FF * 2;
constexpr size_t WS_WPP = WS_WPG + (size_t)DM * DM * 2;
constexpr size_t WS_WSB = WS_WPP + (size_t)DM * PLE * 2;
constexpr size_t WS_XN = WS_WSB + (size_t)8 * 128 * 128 * 2;
constexpr size_t WS_PB = WS_XN + (size_t)MT * DM * 2;
constexpr size_t WS_A = WS_PB + (size_t)MT * PLE * 2;
constexpr size_t WS_Z = WS_A;
constexpr size_t WS_U = WS_A;
constexpr size_t WS_H2 = WS_U + (size_t)MT * FF * 2;
constexpr size_t WS_H2B = WS_H2 + (size_t)MT * DM * 4;
constexpr size_t WS_PE = WS_H2B + (size_t)MT * DM * 2;
constexpr size_t WS_A_END = WS_A + (size_t)MT * INW * 2;
static_assert(WS_PE + (size_t)MT * DM * 4 <= WS_A_END, "region A overlay");
constexpr size_t WS_ORAW = WS_A_END;
constexpr size_t WS_H3 = WS_ORAW;
constexpr size_t WS_YA = WS_ORAW + (size_t)MT * 2048 * 2;
constexpr size_t WS_YB = WS_YA + (size_t)MT * 2048 * 2;
constexpr size_t WS_T = WS_YB + (size_t)MT * DM * 2;
constexpr size_t WS_MG = WS_T + (size_t)MT * DM * 4;
constexpr size_t WS_H1 = WS_MG + (size_t)MT * DM * 2;
constexpr size_t WS_H1B = WS_H1 + (size_t)MT * DM * 4;
constexpr size_t WS_END = WS_H1B + (size_t)MT * DM * 2;

constexpr int LDS_RING = 131072, LDS_BYTES = 139264, LDS_MISC = LDS_BYTES - 256;

struct Args {
    const float* in[21]; float* out; unsigned char* ws; int ph_lo, ph_hi;
};

__device__ __forceinline__ float bf2f(unsigned short u) { return __uint_as_float((unsigned)u << 16); }
__device__ __forceinline__ unsigned f2bf(float f) { unsigned u = __float_as_uint(f); return (u + 0x7fffu + ((u >> 16) & 1u)) >> 16; }
__device__ __forceinline__ unsigned pk2(float lo, float hi) { return f2bf(lo) | (f2bf(hi) << 16); }
__device__ __forceinline__ f32x4 ld_bf4(const bf16_t* p) { const u32x2 w = *(const u32x2*)p; return (f32x4){__uint_as_float(w.x << 16), __uint_as_float(w.x & 0xffff0000u), __uint_as_float(w.y << 16), __uint_as_float(w.y & 0xffff0000u)}; }
typedef float f32x2_t __attribute__((ext_vector_type(2))); typedef __bf16 bf16x2_t __attribute__((ext_vector_type(2)));
__device__ __forceinline__ unsigned cvtpk(float lo, float hi) { const f32x2_t v = {lo, hi}; const bf16x2_t b = __builtin_convertvector(v, bf16x2_t); return __builtin_bit_cast(unsigned, b); }
__device__ __forceinline__ void st_bf4(bf16_t* p, f32x4 v) { u32x2 w; w.x = cvtpk(v[0], v[1]); w.y = cvtpk(v[2], v[3]); *(u32x2*)p = w; }
__device__ __forceinline__ float sigmoidf_(float x) { return __builtin_amdgcn_rcpf(1.0f + __builtin_amdgcn_exp2f(-1.4426950408889634f * x)); }
__device__ __forceinline__ f32x4 sigmoid4(f32x4 v) { return (f32x4){sigmoidf_(v[0]), sigmoidf_(v[1]), sigmoidf_(v[2]), sigmoidf_(v[3])}; }
__device__ __forceinline__ f32x4 silu4(f32x4 v) { return v * sigmoid4(v); }
__device__ __forceinline__ f32x4 gelu4(f32x4 v) { const f32x2 a = gelu_pk((f32x2){v[0], v[1]}), b = gelu_pk((f32x2){v[2], v[3]}); return (f32x4){a.x, a.y, b.x, b.y}; }
__device__ __forceinline__ float sum4(f32x4 v) { return (v[0] + v[1]) + (v[2] + v[3]); }
__device__ __forceinline__ float wave_sum(float v) {
#pragma unroll
    for (int o = 1; o < 64; o <<= 1) v += __shfl_xor(v, o);
    return v;
}
__device__ __forceinline__ int tab_index(int row) { return row < MP ? (row & 2047) : 2048 + (row & 3); }

template <class F> struct EpiGen {
    static constexpr bool PERM = false, AFTER_DRAIN = false;
    F f;
    template <int KIND> __device__ __forceinline__ void run(const f32x4 (&acc)[2][2][4][2], int row0, int col0, int fq) const {
#pragma unroll
        for (int ai = 0; ai < 2; ++ai)
#pragma unroll
            for (int m = 0; m < 4; ++m) {
                const int row = row0 + ai * 128 + m * 16;
                float red[2] = {0.f, 0.f};
                const typename F::RowCtx rc = f.template row_begin<KIND>(row);
#pragma unroll
                for (int n = 0; n < 2; ++n) f.template pair<KIND>(rc, row, col0 + n * 16, acc[ai][0][m][n], col0 + 128 + n * 16, acc[ai][1][m][n], red);
                if (F::template nred<KIND>() > 0) {
                    red[0] += __shfl_xor(red[0], 16); red[0] += __shfl_xor(red[0], 32);
                    if (F::template nred<KIND>() > 1) { red[1] += __shfl_xor(red[1], 16); red[1] += __shfl_xor(red[1], 32); }
                    if (fq == 0) f.template row_add<KIND>(row, red);
                }
                asm volatile("" ::: "memory");
            }
    }
    __device__ __forceinline__ void operator()(const f32x4 (&acc)[2][2][4][2], const Unit& u, int wr, int wc, int fr, int fq) const {
        const int row0 = u.pm * 256 + wr * 64 + fr, col0 = u.pn * 256 + wc * 32 + 4 * fq;
        const int kind = f.kind(u.pn * 256);
        if (F::NK == 1) { run<0>(acc, row0, col0, fq); return; }
        switch (kind) {
            case 0: run<0>(acc, row0, col0, fq); break;
            case 1: run<(F::NK > 1 ? 1 : 0)>(acc, row0, col0, fq); break;
            case 2: run<(F::NK > 2 ? 2 : 0)>(acc, row0, col0, fq); break;
            case 3: run<(F::NK > 3 ? 3 : 0)>(acc, row0, col0, fq); break;
            case 4: run<(F::NK > 4 ? 4 : 0)>(acc, row0, col0, fq); break;
            default: run<(F::NK > 5 ? 5 : 0)>(acc, row0, col0, fq); break;
        }
    }
};

struct F1 {
    static constexpr int NK = 6; typedef int RowCtx;
    bf16_t* Z; const float* cosT; const float* sinT; float* LNS;
    __device__ __forceinline__ int kind(int cb) const { return cb < CV ? 0 : cb < CG ? 1 : cb < CU ? 2 : cb < CGV ? 3 : cb < CGA ? 4 : 5; }
    template <int K> static __device__ __forceinline__ constexpr int nred() { return K == 4 ? 2 : 0; }
    template <int K> __device__ __forceinline__ RowCtx row_begin(int row) const { return K == 0 ? tab_index(row) * 128 : 0; }
    template <int K> __device__ __forceinline__ void pair(RowCtx rc, int row, int c0, f32x4 v0, int c1, f32x4 v1, float (&red)[2]) const {
        bf16_t* zr = Z + (size_t)row * INW;
        if (K == 0) { const int i0 = c0 & 255; const f32x4 cs = *(const f32x4*)(cosT + rc + i0), sn = *(const f32x4*)(sinT + rc + i0);
            const f32x4 o0 = v0 * cs - v1 * sn, o1 = v1 * cs + v0 * sn; st_bf4(zr + c0, o0); st_bf4(zr + c1, o1); }
        else if (K == 1) { st_bf4(zr + c0, v0); st_bf4(zr + c1, v1); }
        else if (K == 2) { st_bf4(zr + c0, silu4(v0)); st_bf4(zr + c1, silu4(v1)); }
        else if (K == 3) { st_bf4(zr + c0, gelu4(v0)); st_bf4(zr + c1, gelu4(v1)); }
        else if (K == 4) { const f32x4 g0 = gelu4(v0), g1 = gelu4(v1); st_bf4(zr + c0, g0); st_bf4(zr + c1, g1);
            red[0] += sum4(g0) + sum4(g1); red[1] += sum4(g0 * g0) + sum4(g1 * g1); }
        else { st_bf4(zr + c0, sigmoid4(v0)); st_bf4(zr + c1, sigmoid4(v1)); }
    }
    template <int K> __device__ __forceinline__ void row_add(int row, const float (&red)[2]) const { atomicAdd(LNS + 2 * row, red[0]); atomicAdd(LNS + 2 * row + 1, red[1]); }
};
struct F2a {
    static constexpr int NK = 1; typedef int RowCtx;
    const bf16_t* Z; float* T;
    __device__ __forceinline__ int kind(int) const { return 0; }
    template <int K> static __device__ __forceinline__ constexpr int nred() { return 0; }
    template <int K> __device__ __forceinline__ RowCtx row_begin(int) const { return 0; }
    template <int K> __device__ __forceinline__ void pair(RowCtx, int row, int c0, f32x4 v0, int c1, f32x4 v1, float (&)[2]) const {
        const bf16_t* g = Z + (size_t)row * INW + CGA; float* t = T + (size_t)row * DM;
        *(f32x4*)(t + c0) = ld_bf4(g + c0) * v0; *(f32x4*)(t + c1) = ld_bf4(g + c1) * v1;
    }
    template <int K> __device__ __forceinline__ void row_add(int, const float (&)[2]) const {}
};
struct F2b {
    static constexpr int NK = 1; typedef int RowCtx;
    const bf16_t* Z; const float* T; bf16_t* MG;
    __device__ __forceinline__ int kind(int) const { return 0; }
    template <int K> static __device__ __forceinline__ constexpr int nred() { return 0; }
    template <int K> __device__ __forceinline__ RowCtx row_begin(int) const { return 0; }
    template <int K> __device__ __forceinline__ void pair(RowCtx, int row, int c0, f32x4 v0, int c1, f32x4 v1, float (&)[2]) const {
        const bf16_t* g = Z + (size_t)row * INW + CGB; const float* t = T + (size_t)row * DM; bf16_t* o = MG + (size_t)row * DM;
        st_bf4(o + c0, *(const f32x4*)(t + c0) + ld_bf4(g + c0) * v0); st_bf4(o + c1, *(const f32x4*)(t + c1) + ld_bf4(g + c1) * v1);
    }
    template <int K> __device__ __forceinline__ void row_add(int, const float (&)[2]) const {}
};
struct FRes {
    static constexpr int NK = 1; typedef const float* RowCtx;
    const float* baseP; const float* baseS; float* H; bf16_t* HB; float* SSQ;
    __device__ __forceinline__ int kind(int) const { return 0; }
    template <int K> static __device__ __forceinline__ constexpr int nred() { return 1; }
    template <int K> __device__ __forceinline__ RowCtx row_begin(int row) const { return row < MP ? baseP + (size_t)row * DM : baseS + (size_t)(row - MP) * DM; }
    template <int K> __device__ __forceinline__ void pair(RowCtx rc, int row, int c0, f32x4 v0, int c1, f32x4 v1, float (&red)[2]) const {
        const f32x4 h0 = *(const f32x4*)(rc + c0) + v0, h1 = *(const f32x4*)(rc + c1) + v1;
        float* h = H + (size_t)row * DM; bf16_t* hb = HB + (size_t)row * DM;
        *(f32x4*)(h + c0) = h0; *(f32x4*)(h + c1) = h1; st_bf4(hb + c0, h0); st_bf4(hb + c1, h1);
        red[0] += sum4(h0 * h0) + sum4(h1 * h1);
    }
    template <int K> __device__ __forceinline__ void row_add(int row, const float (&red)[2]) const { atomicAdd(SSQ + row, red[0]); }
};
struct F4 {
    static constexpr int NK = 1; typedef float RowCtx;
    const float* SSQ; bf16_t* U;
    __device__ __forceinline__ int kind(int) const { return 0; }
    template <int K> static __device__ __forceinline__ constexpr int nred() { return 0; }
    template <int K> __device__ __forceinline__ RowCtx row_begin(int row) const { return rsqrtf(SSQ[row] * (1.0f / DM) + EPS); }
    template <int K> __device__ __forceinline__ void pair(RowCtx rs, int row, int c0, f32x4 v0, int c1, f32x4 v1, float (&)[2]) const {
        bf16_t* u = U + (size_t)row * FF; const f32x4 z = (f32x4){0.f, 0.f, 0.f, 0.f};
        f32x4 a = __builtin_elementwise_max(v0 * rs, z), b = __builtin_elementwise_max(v1 * rs, z);
        st_bf4(u + c0, a * a); st_bf4(u + c1, b * b);
    }
    template <int K> __device__ __forceinline__ void row_add(int, const float (&)[2]) const {}
};
struct F6a {
    static constexpr int NK = 1; typedef int RowCtx;
    float* PE;
    __device__ __forceinline__ int kind(int) const { return 0; }
    template <int K> static __device__ __forceinline__ constexpr int nred() { return 0; }
    template <int K> __device__ __forceinline__ RowCtx row_begin(int) const { return 0; }
    template <int K> __device__ __forceinline__ void pair(RowCtx, int row, int c0, f32x4 v0, int c1, f32x4 v1, float (&)[2]) const {
        float* p = PE + (size_t)row * DM; *(f32x4*)(p + c0) = v0; *(f32x4*)(p + c1) = v1;
    }
    template <int K> __device__ __forceinline__ void row_add(int, const float (&)[2]) const {}
};
struct F6b {
    static constexpr int NK = 1; typedef float RowCtx;
    const float* SSQ3; const float* H2; const float* PE; float* H3; float* SSQ4;
    __device__ __forceinline__ int kind(int) const { return 0; }
    template <int K> static __device__ __forceinline__ constexpr int nred() { return 1; }
    template <int K> __device__ __forceinline__ RowCtx row_begin(int row) const { return rsqrtf(SSQ3[row] * (1.0f / DM) + EPS); }
    template <int K> __device__ __forceinline__ void pair(RowCtx rs, int row, int c0, f32x4 v0, int c1, f32x4 v1, float (&red)[2]) const {
        const size_t o = (size_t)row * DM;
        const f32x4 h0 = *(const f32x4*)(H2 + o + c0) + sigmoid4(v0 * rs) * *(const f32x4*)(PE + o + c0);
        const f32x4 h1 = *(const f32x4*)(H2 + o + c1) + sigmoid4(v1 * rs) * *(const f32x4*)(PE + o + c1);
        *(f32x4*)(H3 + o + c0) = h0; *(f32x4*)(H3 + o + c1) = h1;
        red[0] += sum4(h0 * h0) + sum4(h1 * h1);
    }
    template <int K> __device__ __forceinline__ void row_add(int row, const float (&red)[2]) const { atomicAdd(SSQ4 + row, red[0]); }
};
#define XB_TMO      128
#define XB_XCNT(j)  (256  + 64 * (j))
#define XB_XSUB(j)  (1280 + 64 * (j))
#define XB_XGEN(j)  (2304 + 64 * (j))
#define XB_TOP      3328
#define XB_TOPGEN   3392
#define XCD_BAR_WORDS 3456
#define XB_SPIN_CAP (1u << 21)

__device__ __forceinline__ unsigned xb_ld(unsigned* p)              { return __hip_atomic_load(p, __ATOMIC_RELAXED, __HIP_MEMORY_SCOPE_AGENT); }
__device__ __forceinline__ unsigned xb_add(unsigned* p, unsigned v) { return __hip_atomic_fetch_add(p, v, __ATOMIC_RELAXED, __HIP_MEMORY_SCOPE_AGENT); }
__device__ __forceinline__ unsigned xb_xcc_id() { return (unsigned)__builtin_amdgcn_s_getreg((3 << 11) | 20) & 0xFu; }
#define XB_SPIN(cond, bar) do { unsigned _sp = 0; while (cond) { __builtin_amdgcn_s_sleep(1); \
    if ((++_sp & 255u) == 0u) { if (xb_ld(&(bar)[XB_TMO])) break; if (_sp > XB_SPIN_CAP) { atomicAdd(&(bar)[XB_TMO], 1u); break; } } } } while (0)

struct XcdBarrier {
    unsigned* bar; unsigned x;
    volatile LAS unsigned* st;
};

__device__ __forceinline__ XcdBarrier xcd_barrier_post(unsigned* bar, volatile LAS unsigned* st) {
    XcdBarrier b; b.bar = bar; b.x = xb_xcc_id(); b.st = st;
    if (threadIdx.x == 0) (void)xb_add(&bar[XB_XCNT(b.x)], 1u);
    return b;
}
__device__ __forceinline__ void xcd_barrier_complete(unsigned* bar, unsigned x, unsigned& nloc, unsigned& nx) {
    const unsigned G = gridDim.x * gridDim.y * gridDim.z;
    unsigned sum, cnt, mine, sp = 0u;
    for (;;) {
        sum = 0u; cnt = 0u; mine = 0u;
#pragma unroll
        for (unsigned j = 0; j < 16; ++j) { const unsigned c = xb_ld(&bar[XB_XCNT(j)]); sum += c; cnt += (c > 0u) ? 1u : 0u; mine = (j == x) ? c : mine; }
        if (sum == G) break;
        __builtin_amdgcn_s_sleep(1);
        if ((++sp & 255u) == 0u) { if (xb_ld(&bar[XB_TMO])) break; if (sp > XB_SPIN_CAP) { atomicAdd(&bar[XB_TMO], 1u); break; } }
    }
    nloc = mine > 0u ? mine : 1u; nx = cnt > 0u ? cnt : 1u;
}

__device__ __forceinline__ void xcd_barrier(const XcdBarrier& b) {
    asm volatile("s_waitcnt vmcnt(0)" ::: "memory");
    __syncthreads();
    if (threadIdx.x == 0) {
        unsigned* bar = b.bar;
        __builtin_amdgcn_s_waitcnt(0);
        unsigned nloc = b.st[0], nx = b.st[1];
        if (nloc == 0u) { xcd_barrier_complete(bar, b.x, nloc, nx); b.st[0] = nloc; b.st[1] = nx; }
        const unsigned old = xb_add(&bar[XB_XSUB(b.x)], 1u);
        const unsigned gen = old / nloc;
        if (old + 1u == (gen + 1u) * nloc) {
            __builtin_amdgcn_fence(__ATOMIC_RELEASE, "agent");
            asm volatile("s_waitcnt vmcnt(0)" ::: "memory");
            const unsigned og = xb_add(&bar[XB_TOP], 1u);
            const unsigned tg = og / nx;
            if (og + 1u == (tg + 1u) * nx) xb_add(&bar[XB_TOPGEN], 1u);
            else XB_SPIN(xb_ld(&bar[XB_TOPGEN]) == tg, bar);
            __builtin_amdgcn_fence(__ATOMIC_ACQUIRE, "agent");
            xb_add(&bar[XB_XGEN(b.x)], 1u);
            asm volatile("s_waitcnt vmcnt(0)" ::: "memory");
        } else {
            XB_SPIN(xb_ld(&bar[XB_XGEN(b.x)]) == gen, bar);
            __builtin_amdgcn_fence(__ATOMIC_ACQUIRE, "agent");
            asm volatile("s_waitcnt vmcnt(0)" ::: "memory");
        }
    }
    __syncthreads();
}

struct Ctx {
    LAS unsigned char* lds; int tid, lane, wave, vcu, G;
    const float* const* in; float* out; unsigned char* ws;
    template <class T> __device__ __forceinline__ T* w(size_t off) const { return (T*)(ws + off); }
};
enum { I_XP = 0, I_XS, I_PP, I_PS, I_ST, I_GMIX, I_WIN, I_GRET, I_WS, I_BS, I_GGM, I_WBRA, I_WBRB, I_WO, I_GMLP, I_WUP, I_WDN, I_GPLE, I_WPG, I_WPP, I_GFIN };

__device__ __forceinline__ void p0_transpose_item(const float* W, int K, int N, bf16_t* WT, LAS float* scr, int item, int lane, const float* rowg, int cs_lo, int cs_hi, float cs) {
    const int nblk = N / 32, kb = item / nblk, nb = item % nblk, k0 = 64 * kb, n0 = 32 * nb;
#pragma unroll 8
    for (int i = 0; i < 32; ++i) { const int kk = 2 * i + (lane >> 5); float wv = W[(size_t)(k0 + kk) * N + n0 + (lane & 31)]; if (rowg) wv *= rowg[k0 + kk]; scr[kk * 33 + (lane & 31)] = wv; }
    asm volatile("s_waitcnt lgkmcnt(0)" ::: "memory");
    const int c = lane & 7;
#pragma unroll
    for (int j = 0; j < 4; ++j) { const int n = (lane >> 3) + 8 * j; const LAS float* s = scr + (8 * c) * 33 + n; const float sc = (n0 + n >= cs_lo && n0 + n < cs_hi) ? cs : 1.0f;
        u32x4 o; o.x = pk2(s[0 * 33] * sc, s[1 * 33] * sc); o.y = pk2(s[2 * 33] * sc, s[3 * 33] * sc); o.z = pk2(s[4 * 33] * sc, s[5 * 33] * sc); o.w = pk2(s[6 * 33] * sc, s[7 * 33] * sc);
        *(u32x4*)(WT + (size_t)(n0 + n) * K + k0 + 8 * c) = o; }
    asm volatile("s_waitcnt lgkmcnt(0)" ::: "memory");
}
__device__ __forceinline__ double sin_poly(double x) {
    const double x2 = x * x; double r = -1.0 / 8841761993739701954543616000000.0;
    r = r * x2 + 1.0 / 10888869450418352160768000000.0;
    r = r * x2 - 1.0 / 15511210043330985984000000.0;
    r = r * x2 + 1.0 / 25852016738884976640000.0;
    r = r * x2 - 1.0 / 51090942171709440000.0;
    r = r * x2 + 1.0 / 121645100408832000.0;
    r = r * x2 - 1.0 / 355687428096000.0;
    r = r * x2 + 1.0 / 1307674368000.0;
    r = r * x2 - 1.0 / 6227020800.0;
    r = r * x2 + 1.0 / 39916800.0;
    r = r * x2 - 1.0 / 362880.0;
    r = r * x2 + 1.0 / 5040.0;
    r = r * x2 - 1.0 / 120.0;
    r = r * x2 + 1.0 / 6.0;
    r = r * x2 - 1.0;
    return -r * x;
}
__device__ __forceinline__ double cos_poly(double x) {
    const double x2 = x * x; double r = -1.0 / 265252859812191058636308480000000.0;
    r = r * x2 + 1.0 / 304888344611713860501504000000.0;
    r = r * x2 - 1.0 / 403291461126605635584000000.0;
    r = r * x2 + 1.0 / 620448401733239439360000.0;
    r = r * x2 - 1.0 / 1124000727777607680000.0;
    r = r * x2 + 1.0 / 2432902008176640000.0;
    r = r * x2 - 1.0 / 6402373705728000.0;
    r = r * x2 + 1.0 / 20922789888000.0;
    r = r * x2 - 1.0 / 87178291200.0;
    r = r * x2 + 1.0 / 479001600.0;
    r = r * x2 - 1.0 / 3628800.0;
    r = r * x2 + 1.0 / 40320.0;
    r = r * x2 - 1.0 / 720.0;
    r = r * x2 + 1.0 / 24.0;
    r = r * x2 - 0.5;
    r = r * x2 + 1.0;
    return r;
}
__device__ __forceinline__ void p0_prologue(const Ctx& C) {
    LAS float* scr = (LAS float*)(C.lds + C.wave * 16384);
    const int gw = C.vcu * NWAVES + C.wave, NGW = C.G * NWAVES, lane = C.lane;
    constexpr int I_IN = (DM / 64) * (INW / 32), I_BRA = (2048 / 64) * (DM / 32), I_SQ = (DM / 64) * (DM / 32), I_UP = (DM / 64) * (FF / 32), I_DN = (FF / 64) * (DM / 32), I_PPI = (PLE / 64) * (DM / 32);
    constexpr int NITEMS = I_IN + I_BRA + 3 * I_SQ + I_UP + I_DN + I_PPI;
    for (int it = gw; it < NITEMS; it += NGW) {
        int r = it;
        if (r < I_IN) { p0_transpose_item(C.in[I_WIN], DM, INW, C.w<bf16_t>(WS_WIN), scr, r, lane, nullptr, CK, CV, 0.0625f); continue; } r -= I_IN;
        if (r < I_BRA) { p0_transpose_item(C.in[I_WBRA], 2048, DM, C.w<bf16_t>(WS_WBRA), scr, r, lane, nullptr, 0, 0, 1.f); continue; } r -= I_BRA;
        if (r < I_SQ) { p0_transpose_item(C.in[I_WBRB], DM, DM, C.w<bf16_t>(WS_WBRB), scr, r, lane, nullptr, 0, 0, 1.f); continue; } r -= I_SQ;
        if (r < I_SQ) { p0_transpose_item(C.in[I_WO], DM, DM, C.w<bf16_t>(WS_WO), scr, r, lane, nullptr, 0, 0, 1.f); continue; } r -= I_SQ;
        if (r < I_SQ) { p0_transpose_item(C.in[I_WPG], DM, DM, C.w<bf16_t>(WS_WPG), scr, r, lane, C.in[I_GPLE], 0, 0, 1.f); continue; } r -= I_SQ;
        if (r < I_UP) { p0_transpose_item(C.in[I_WUP], DM, FF, C.w<bf16_t>(WS_WUP), scr, r, lane, C.in[I_GMLP], 0, 0, 1.f); continue; } r -= I_UP;
        if (r < I_DN) { p0_transpose_item(C.in[I_WDN], FF, DM, C.w<bf16_t>(WS_WDN), scr, r, lane, nullptr, 0, 0, 1.f); continue; } r -= I_DN;
        p0_transpose_item(C.in[I_WPP], PLE, DM, C.w<bf16_t>(WS_WPP), scr, r, lane, nullptr, 0, 0, 1.f);
    }
    const float* gm = C.in[I_GMIX];
    f32x4 gv[4];
#pragma unroll
    for (int j = 0; j < 4; ++j) gv[j] = ((const f32x4*)gm)[lane + 64 * j];
    bf16_t* XN = C.w<bf16_t>(WS_XN); bf16_t* PB = C.w<bf16_t>(WS_PB);
    for (int m = gw; m < MT; m += NGW) {
        const float* xrow = m < MP ? C.in[I_XP] + (size_t)m * DM : C.in[I_XS] + (size_t)(m - MP) * DM;
        const f32x4* xr = (const f32x4*)xrow + lane;
        f32x4 v[4]; float s = 0.f;
#pragma unroll
        for (int j = 0; j < 4; ++j) { v[j] = xr[64 * j]; s += sum4(v[j] * v[j]); }
        const float rstd = rsqrtf(wave_sum(s) * (1.f / DM) + EPS);
        u32x2* o8 = (u32x2*)(XN + (size_t)m * DM) + lane;
#pragma unroll
        for (int j = 0; j < 4; ++j) { const f32x4 y = v[j] * rstd * gv[j]; u32x2 w; w.x = pk2(y[0], y[1]); w.y = pk2(y[2], y[3]); o8[64 * j] = w; }
        const float* prow = m < MP ? C.in[I_PP] + (size_t)m * PLE : C.in[I_PS] + (size_t)(m - MP) * PLE;
        const f32x4 pv = ((const f32x4*)prow)[lane]; u32x2 pw; pw.x = pk2(pv[0], pv[1]); pw.y = pk2(pv[2], pv[3]);
        ((u32x2*)(PB + (size_t)m * PLE))[lane] = pw;
    }
    { const float* w_s = C.in[I_WS]; bf16_t* WSB = C.w<bf16_t>(WS_WSB);
      for (int e = (C.vcu * NTHR + C.tid); e < 8 * 128 * 128; e += C.G * NTHR) { const int n = (e >> 7) & 127, m = e & 127; WSB[e] = (bf16_t)f2bf(m <= n ? w_s[e] : 0.f); } }
    float* cosT = C.w<float>(WS_COS); float* sinT = C.w<float>(WS_SIN);
    for (int e = (C.vcu * NTHR + C.tid); e < NTAB * 128; e += C.G * NTHR) {
        const int ti = e >> 7, i = e & 127; const float pos = ti < 2048 ? (float)ti : (float)(16384 + ti - 2048);
        const float inv = (float)exp2(-(double)i * (13.287712379549449 / 128.0));
        const float ang = pos * inv;
        const double x = (double)ang; const double k = __builtin_rint(x * 0.15915494309189535);
        double r = __builtin_fma(-k, 6.283185307179586, x); r = __builtin_fma(-k, 2.4492935982947064e-16, r);
        cosT[e] = (float)cos_poly(r); sinT[e] = (float)sin_poly(r);
    }
}

template <class F> __device__ __forceinline__ void run_gemm(const Ctx& C, const bf16_t* A, const bf16_t* Bt, int M, int N, int K, const F& f) {
    asm volatile("" : "+s"(K));
    pg8::Gemm g{A, Bt, M, N, K}; pg8::StaticOrder S; S.init(M, N, C.G, (int)blockIdx.x);
    EpiGen<F> E{f};
    pg8::gemm_phase<EpiGen<F>, pg8::StaticOrder, true, true>((PG8_LAS unsigned char*)C.lds, g, S, E);
}

__device__ __forceinline__ void ret_simple_item(const Ctx& C, bool sample, int b, int h, int vs) {
    const int v = C.tid & 63, dg = C.wave, d0 = 32 * dg;
    const int L = sample ? 4 : 2048, row0 = sample ? MP + 4 * b : 2048 * b;
    const float gamma = 1.0f - exp2f(-5.0f - (float)h);
    float S[32];
    const size_t sbase = ((size_t)(b * 4 + h) * 256 + d0) * 512 + vs * 64 + v;
    if (sample) { const float* st = C.in[I_ST] + sbase;
#pragma unroll
        for (int j = 0; j < 32; ++j) S[j] = st[(size_t)j * 512]; }
    else {
#pragma unroll
        for (int j = 0; j < 32; ++j) S[j] = 0.f; }
    const bf16_t* Z = C.w<bf16_t>(WS_Z); bf16_t* OR = C.w<bf16_t>(WS_ORAW);
    LAS float* part = (LAS float*)C.lds;
    for (int t = 0; t < L; ++t) {
        const int row = row0 + t; const bf16_t* zr = Z + (size_t)row * INW;
        const float vv = bf2f(zr[CV + h * 512 + vs * 64 + v]);
        const u32x4* qp = (const u32x4*)(zr + CQ + h * 256 + d0); const u32x4* kp = (const u32x4*)(zr + CK + h * 256 + d0);
        float o = 0.f;
#pragma unroll
        for (int c = 0; c < 4; ++c) { const u32x4 qw = qp[c], kw = kp[c];
#pragma unroll
            for (int e = 0; e < 4; ++e) { const unsigned q2 = qw[e], k2 = kw[e]; const int j = c * 8 + e * 2;
                S[j] = gamma * S[j] + __uint_as_float(k2 << 16) * vv; o += __uint_as_float(q2 << 16) * S[j];
                S[j + 1] = gamma * S[j + 1] + __uint_as_float(k2 & 0xffff0000u) * vv; o += __uint_as_float(q2 & 0xffff0000u) * S[j + 1]; } }
        part[((t & 1) * 8 + dg) * 64 + v] = o;
        __syncthreads();
        if (dg == 0) { float ot = 0.f;
#pragma unroll
            for (int g = 0; g < 8; ++g) ot += part[((t & 1) * 8 + g) * 64 + v];
            OR[(size_t)row * 2048 + h * 512 + vs * 64 + v] = (bf16_t)f2bf(ot); }
    }
    float* so = C.out + (sample ? O_SRS : O_SRP) + sbase;
#pragma unroll
    for (int j = 0; j < 32; ++j) so[(size_t)j * 512] = S[j];
    __syncthreads();
}
typedef short bf16x8 __attribute__((ext_vector_type(8)));
typedef short s16x4 __attribute__((ext_vector_type(4)));
typedef short v4i16_t __attribute__((ext_vector_type(4)));
typedef float f32x16 __attribute__((ext_vector_type(16)));
constexpr int R_QS = 528, R_VS = 192, R_PS = 144;
constexpr int R_Q = 0, R_K = R_Q + 64 * R_QS, R_ST = R_K + 64 * R_QS, R_V = R_ST + 64 * R_QS, R_VD = R_V + 64 * R_VS, R_P = R_VD + 64 * R_VS, R_END = R_P + 64 * R_PS;
static_assert(R_END <= LDS_MISC, "retention LDS map");
__device__ __forceinline__ s16x4 vtr(const LAS unsigned char* p) { return __builtin_bit_cast(s16x4, __builtin_amdgcn_ds_read_tr16_b64_v4i16((LAS v4i16_t*)p)); }
#define MFMA32(a, b, c) __builtin_amdgcn_mfma_f32_32x32x16_bf16((a), (b), (c), 0, 0, 0)
__device__ __forceinline__ bf16x8 tr_frag(const LAS unsigned char* a, int stride) { const s16x4 lo = vtr(a), hi = vtr(a + 4 * stride); return (bf16x8){lo[0], lo[1], lo[2], lo[3], hi[0], hi[1], hi[2], hi[3]}; }
__device__ __forceinline__ void ret_mfma_item(const Ctx& C, int b, int h, int vs) {
    const int tid = C.tid, lane = C.lane, wave = C.wave, l31_ = lane & 31, hh_ = lane >> 5;
    const LAS unsigned char* lds = C.lds;
    const bf16_t* Z = C.w<bf16_t>(WS_Z); bf16_t* OR = C.w<bf16_t>(WS_ORAW);
    const float lg = log2f(1.0f - exp2f(-5.0f - (float)h));
    const int row00 = b * 2048;
    for (int e = tid; e < 64 * R_QS / 16; e += NTHR) *(LAS u32x4*)(C.lds + R_ST + e * 16) = (u32x4){0u, 0u, 0u, 0u};
    f32x16 S0, S1;
#pragma unroll
    for (int i = 0; i < 16; ++i) { S0[i] = 0.f; S1[i] = 0.f; }
    u32x4 gq[4], gk[4], gv;
    const int qrow = tid >> 5, qch = tid & 31, vrow = tid >> 3, vch = tid & 7;
    const bf16_t* zq = Z + (size_t)row00 * INW + CQ + h * 256 + qch * 8;
    const bf16_t* zk = Z + (size_t)row00 * INW + CK + h * 256 + qch * 8;
    const bf16_t* zv = Z + (size_t)row00 * INW + CV + h * 512 + vs * 64 + vch * 8;
#define RET_LOAD(ci) do { _Pragma("unroll") for (int j = 0; j < 4; ++j) { const size_t ro = (size_t)((ci) * 64 + qrow + 16 * j) * INW; gq[j] = *(const u32x4*)(zq + ro); gk[j] = *(const u32x4*)(zk + ro); } \
        gv = *(const u32x4*)(zv + (size_t)((ci) * 64 + vrow) * INW); } while (0)
    RET_LOAD(0);
    const float vdsc = exp2f((float)(63 - vrow) * lg);
    const float g64 = exp2f(64.0f * lg);
    for (int ci = 0; ci < 32; ++ci) {
        int l31 = l31_, hh = hh_; asm volatile("" : "+v"(l31), "+v"(hh));
#pragma unroll
        for (int j = 0; j < 4; ++j) { *(LAS u32x4*)(C.lds + R_Q + (qrow + 16 * j) * R_QS + qch * 16) = gq[j]; *(LAS u32x4*)(C.lds + R_K + (qrow + 16 * j) * R_QS + qch * 16) = gk[j]; }
        *(LAS u32x4*)(C.lds + R_V + vrow * R_VS + vch * 16) = gv;
        { u32x4 d;
#pragma unroll
          for (int e = 0; e < 4; ++e) { const unsigned w = gv[e]; d[e] = pk2(__uint_as_float(w << 16) * vdsc, __uint_as_float(w & 0xffff0000u) * vdsc); }
          *(LAS u32x4*)(C.lds + R_VD + vrow * R_VS + vch * 16) = d; }
        __syncthreads();
        if (ci + 1 < 32) RET_LOAD(ci + 1);
        const int rowoff = l31, koff = 16 * hh;
        const int tr_q = (l31 & 15) >> 2, tr_p = l31 & 3, tr_blk = (l31 >> 4) & 1;
        f32x16 acc;
#pragma unroll
        for (int i = 0; i < 16; ++i) acc[i] = 0.f;
        if (wave < 3) {
            const int st = wave >> 1, tt = wave == 0 ? 0 : 1;
            const LAS unsigned char* pa = lds + R_K + (32 * st + rowoff) * R_QS + koff;
            const LAS unsigned char* pb = lds + R_Q + (32 * tt + rowoff) * R_QS + koff;
#pragma unroll 4
            for (int ks = 0; ks < 16; ++ks) acc = MFMA32(*(const LAS bf16x8*)(pa + ks * 32), *(const LAS bf16x8*)(pb + ks * 32), acc);
            const int t = 32 * tt + l31;
#pragma unroll
            for (int g = 0; g < 4; ++g) { float pv[4];
#pragma unroll
                for (int e = 0; e < 4; ++e) { const int s = 32 * st + 8 * g + 4 * hh + e; pv[e] = (t >= s) ? acc[4 * g + e] * __builtin_amdgcn_exp2f((float)(t - s) * lg) : 0.f; }
                u32x2 w; w.x = cvtpk(pv[0], pv[1]); w.y = cvtpk(pv[2], pv[3]);
                *(LAS u32x2*)(C.lds + R_P + t * R_PS + (32 * st + 8 * g + 4 * hh) * 2) = w; }
        } else if (wave >= 4) {
            const int tt = (wave >> 1) & 1, vt = wave & 1;
            const LAS unsigned char* pa = lds + R_Q + (32 * tt + rowoff) * R_QS + koff;
            const LAS unsigned char* pb = lds + R_ST + (32 * vt + rowoff) * R_QS + koff;
#pragma unroll 4
            for (int ks = 0; ks < 16; ++ks) acc = MFMA32(*(const LAS bf16x8*)(pa + ks * 32), *(const LAS bf16x8*)(pb + ks * 32), acc);
#pragma unroll
            for (int i = 0; i < 16; ++i) { const int t = 32 * tt + (i & 3) + 8 * (i >> 2) + 4 * hh; acc[i] *= __builtin_amdgcn_exp2f((float)(t + 1) * lg); }
        }
        __syncthreads();
        if (wave >= 4) {
            const int tt = (wave >> 1) & 1, vt = wave & 1;
            const LAS unsigned char* pa = lds + R_P + (32 * tt + rowoff) * R_PS + koff;
            const LAS unsigned char* pb = lds + R_V + (8 * hh + tr_q) * R_VS + (32 * vt + 16 * tr_blk + 4 * tr_p) * 2;
            for (int ks = 0; ks < 2 * tt + 2; ++ks) acc = MFMA32(*(const LAS bf16x8*)(pa + ks * 32), tr_frag(pb + 16 * ks * R_VS, R_VS), acc);
            bf16_t* orow = OR + (size_t)(row00 + ci * 64 + 32 * tt) * 2048 + h * 512 + vs * 64 + 32 * vt + l31;
#pragma unroll
            for (int i = 0; i < 16; ++i) { const int tl = (i & 3) + 8 * (i >> 2) + 4 * hh; orow[(size_t)tl * 2048] = (bf16_t)f2bf(acc[i]); }
        }
        {
#pragma unroll
            for (int i = 0; i < 16; ++i) { S0[i] *= g64; S1[i] *= g64; }
            const LAS unsigned char* pa = lds + R_K + (8 * hh + tr_q) * R_QS + (32 * wave + 16 * tr_blk + 4 * tr_p) * 2;
            const LAS unsigned char* pb = lds + R_VD + (8 * hh + tr_q) * R_VS + (16 * tr_blk + 4 * tr_p) * 2;
#pragma unroll
            for (int ks = 0; ks < 4; ++ks) { const bf16x8 a = tr_frag(pa + 16 * ks * R_QS, R_QS);
                S0 = MFMA32(a, tr_frag(pb + 16 * ks * R_VS, R_VS), S0); S1 = MFMA32(a, tr_frag(pb + 16 * ks * R_VS + 64, R_VS), S1); }
#pragma unroll
            for (int g = 0; g < 4; ++g) { u32x2 w0, w1; w0.x = cvtpk(S0[4 * g], S0[4 * g + 1]); w0.y = cvtpk(S0[4 * g + 2], S0[4 * g + 3]); w1.x = cvtpk(S1[4 * g], S1[4 * g + 1]); w1.y = cvtpk(S1[4 * g + 2], S1[4 * g + 3]);
                *(LAS u32x2*)(C.lds + R_ST + l31 * R_QS + (32 * wave + 8 * g + 4 * hh) * 2) = w0;
                *(LAS u32x2*)(C.lds + R_ST + (32 + l31) * R_QS + (32 * wave + 8 * g + 4 * hh) * 2) = w1; }
        }
        __syncthreads();
    }
#undef RET_LOAD
    float* so = C.out + O_SRP + ((size_t)(b * 4 + h) * 256 + 32 * wave) * 512 + vs * 64 + l31_;
#pragma unroll
    for (int i = 0; i < 16; ++i) { const int dl = (i & 3) + 8 * (i >> 2) + 4 * hh_; so[(size_t)dl * 512] = S0[i]; so[(size_t)dl * 512 + 32] = S1[i]; }
}
__device__ __forceinline__ void p2_retention_simple(const Ctx& C) {
#ifdef RET_SIMPLE
    for (int it = C.vcu; it < 256; it += C.G) ret_simple_item(C, false, it >> 5, (it >> 3) & 3, it & 7);
#else
    for (int it = C.vcu; it < 256; it += C.G) ret_mfma_item(C, it >> 5, (it >> 3) & 3, it & 7);
    __syncthreads();
#endif
    for (int it = C.vcu; it < 4096; it += C.G) ret_simple_item(C, true, it >> 5, (it >> 3) & 3, it & 7);
}
constexpr int G_WS = 272, G_GS = 320, G_W = 0, G_G = G_W + 128 * G_WS, G_END = G_G + 128 * G_GS;
static_assert(G_END <= LDS_MISC, "gating LDS map");
__device__ __forceinline__ void p2_gating_mfma(const Ctx& C) {
    const int tid = C.tid, wave = C.wave, l31 = C.lane & 31, hh = C.lane >> 5;
    const LAS unsigned char* lds = C.lds;
    const bf16_t* Z = C.w<bf16_t>(WS_Z); const float* LNS = C.w<float>(WS_LNS); bf16_t* YB = C.w<bf16_t>(WS_YB); const bf16_t* WSB = C.w<bf16_t>(WS_WSB);
    const float* b_s = C.in[I_BS]; const float* g_gm = C.in[I_GGM];
    int g_staged = -1;
    for (int it = C.vcu; it < 1024; it += C.G) {
        const int g = it & 7, row0 = (it >> 3) * 128;
        __syncthreads();
        if (g != g_staged) { g_staged = g;
#pragma unroll
            for (int j = 0; j < 4; ++j) { const int idx = tid + NTHR * j, r = idx >> 4, c16 = idx & 15;
                *(LAS u32x4*)(C.lds + G_W + r * G_WS + c16 * 16) = *(const u32x4*)(WSB + ((size_t)g * 128 + r) * 128 + c16 * 8); } }
        { const int c16 = tid & 15; const f32x4 gg0 = *(const f32x4*)(g_gm + g * 128 + c16 * 8), gg1 = *(const f32x4*)(g_gm + g * 128 + c16 * 8 + 4);
#pragma unroll
          for (int j = 0; j < 4; ++j) { const int m = (tid >> 4) + 32 * j, row = row0 + m;
              const float mu = LNS[2 * row] * (1.f / 1024.f), var = LNS[2 * row + 1] * (1.f / 1024.f) - mu * mu, rstd = rsqrtf(var + EPS);
              const bf16_t* src = Z + (size_t)row * INW + CGV + g * 128 + c16 * 8;
              const f32x4 x0 = ld_bf4(src), x1 = ld_bf4(src + 4);
              const f32x4 y0 = (x0 - mu) * rstd * gg0, y1 = (x1 - mu) * rstd * gg1;
              u32x4 w; w.x = cvtpk(y0[0], y0[1]); w.y = cvtpk(y0[2], y0[3]); w.z = cvtpk(y1[0], y1[1]); w.w = cvtpk(y1[2], y1[3]);
              *(LAS u32x4*)(C.lds + G_G + m * G_GS + c16 * 16) = w; } }
        __syncthreads();
        const int nt = wave >> 1, ct0 = 2 * (wave & 1);
        f32x16 a0, a1;
#pragma unroll
        for (int i = 0; i < 16; ++i) { a0[i] = 0.f; a1[i] = 0.f; }
        const int tr_q = (l31 & 15) >> 2, tr_p = l31 & 3, tr_blk = (l31 >> 4) & 1;
        const LAS unsigned char* pw = lds + G_W + (32 * nt + l31) * G_WS + 16 * hh;
        const LAS unsigned char* pg = lds + G_G + (8 * hh + tr_q) * G_GS + (32 * ct0 + 16 * tr_blk + 4 * tr_p) * 2;
        for (int ks = 0; ks < 2 * nt + 2; ++ks) { const bf16x8 bw = *(const LAS bf16x8*)(pw + ks * 32);
            a0 = MFMA32(tr_frag(pg + 16 * ks * G_GS, G_GS), bw, a0); a1 = MFMA32(tr_frag(pg + 16 * ks * G_GS + 64, G_GS), bw, a1); }
        const int n = 32 * nt + l31, row = row0 + n; const float bias = b_s[g * 128 + n];
        const bf16_t* up = Z + (size_t)row * INW + CU + g * 128 + 32 * ct0 + 4 * hh; bf16_t* yp = YB + (size_t)row * DM + g * 128 + 32 * ct0 + 4 * hh;
#pragma unroll
        for (int q4 = 0; q4 < 4; ++q4) {
            const f32x4 o0 = (f32x4){a0[4 * q4], a0[4 * q4 + 1], a0[4 * q4 + 2], a0[4 * q4 + 3]} + bias, o1 = (f32x4){a1[4 * q4], a1[4 * q4 + 1], a1[4 * q4 + 2], a1[4 * q4 + 3]} + bias;
            st_bf4(yp + 8 * q4, ld_bf4(up + 8 * q4) * o0); st_bf4(yp + 32 + 8 * q4, ld_bf4(up + 32 + 8 * q4) * o1); }
    }
    __syncthreads();
}
template <int CH> __device__ __forceinline__ void gate_simple_item(const Ctx& C, int row0, float* gmv_out) {
    LAS float* gvl = (LAS float*)C.lds;
    LAS float* wl = (LAS float*)(C.lds + 65536);
    const bf16_t* Z = C.w<bf16_t>(WS_Z); const float* LNS = C.w<float>(WS_LNS); bf16_t* YB = C.w<bf16_t>(WS_YB);
    const float* w_s = C.in[I_WS]; const float* b_s = C.in[I_BS]; const float* g_gm = C.in[I_GGM];
    for (int g = 0; g < 8; ++g) {
        for (int e = C.tid; e < CH * 128; e += NTHR) { const int m = e >> 7, ch = e & 127; const int row = row0 + m;
            const float mu = LNS[2 * row] * (1.f / 1024.f), var = LNS[2 * row + 1] * (1.f / 1024.f) - mu * mu, rstd = rsqrtf(var + EPS);
            const float x = bf2f(Z[(size_t)row * INW + CGV + g * 128 + ch]); const float y = (x - mu) * rstd * g_gm[g * 128 + ch];
            gvl[e] = y; if (gmv_out) gmv_out[(size_t)m * 1024 + g * 128 + ch] = y;
            wl[e] = (ch < CH) ? w_s[((size_t)g * 128 + m) * 128 + ch] : 0.f; }
        __syncthreads();
        const int ch = C.tid & 127;
        for (int n = C.tid >> 7; n < CH; n += 4) { float acc = b_s[g * 128 + n];
            for (int m = 0; m <= n; ++m) acc += wl[n * 128 + m] * gvl[m * 128 + ch];
            const int row = row0 + n; const float u = bf2f(Z[(size_t)row * INW + CU + g * 128 + ch]);
            YB[(size_t)row * DM + g * 128 + ch] = (bf16_t)f2bf(u * acc); }
        __syncthreads();
    }
}
__device__ __forceinline__ void p2_gating_simple(const Ctx& C) {
#ifdef GATE_SIMPLE
    for (int it = C.vcu; it < 128; it += C.G) gate_simple_item<128>(C, (it >> 4) * 2048 + (it & 15) * 128, nullptr);
#else
    p2_gating_mfma(C);
#endif
    for (int it = C.vcu; it < 128; it += C.G) gate_simple_item<4>(C, MP + 4 * it, C.out + O_GMV + (size_t)it * 4 * 1024);
}
__device__ __forceinline__ void p3_finalize_ya(const Ctx& C) {
    const bf16_t* Z = C.w<bf16_t>(WS_Z); const bf16_t* OR = C.w<bf16_t>(WS_ORAW); bf16_t* YA = C.w<bf16_t>(WS_YA);
    const float* g_ret = C.in[I_GRET];
    const int gw = C.vcu * NWAVES + C.wave, NGW = C.G * NWAVES, lane = C.lane;
    for (int row = gw; row < MT; row += NGW) {
        f32x4 o[8]; float rs[4];
#pragma unroll
        for (int j = 0; j < 8; ++j) o[j] = ld_bf4(OR + (size_t)row * 2048 + 4 * lane + 256 * j);
#pragma unroll
        for (int hd = 0; hd < 4; ++hd) rs[hd] = rsqrtf(wave_sum(sum4(o[2 * hd] * o[2 * hd]) + sum4(o[2 * hd + 1] * o[2 * hd + 1])) * (1.f / 512.f) + EPS);
#pragma unroll
        for (int j = 0; j < 8; ++j) { const int c = 4 * lane + 256 * j;
            const f32x4 gz = ld_bf4(Z + (size_t)row * INW + CG + c), gr = *(const f32x4*)(g_ret + c);
            st_bf4(YA + (size_t)row * 2048 + c, gz * o[j] * rs[j >> 1] * gr); }
    }
}
__device__ __forceinline__ void p9_final_norm(const Ctx& C) {
    const float* H3 = C.w<float>(WS_H3); const float* SSQ4 = C.w<float>(WS_SSQ4); const float* gf = C.in[I_GFIN];
    const int gw = C.vcu * NWAVES + C.wave, NGW = C.G * NWAVES, lane = C.lane;
    f32x4 gv[4];
#pragma unroll
    for (int j = 0; j < 4; ++j) gv[j] = ((const f32x4*)gf)[lane + 64 * j];
    for (int row = gw; row < MT; row += NGW) {
        const float rs = rsqrtf(SSQ4[row] * (1.f / DM) + EPS);
        const f32x4* hr = (const f32x4*)(H3 + (size_t)row * DM) + lane; f32x4* o = (f32x4*)(C.out + O_Y + (size_t)row * DM) + lane;
#pragma unroll
        for (int j = 0; j < 4; ++j) o[64 * j] = hr[64 * j] * rs * gv[j];
    }
}

#ifdef DBG_EXPORT
__device__ __forceinline__ void dbg_export(const Ctx& C) {
    const bf16_t* Z = C.w<bf16_t>(WS_Z); const bf16_t* YA = C.w<bf16_t>(WS_YA); const bf16_t* YB = C.w<bf16_t>(WS_YB);
    const int gw = C.vcu * NWAVES + C.wave, NGW = C.G * NWAVES, lane = C.lane;
    for (int row = gw; row < MT; row += NGW)
        for (int j = 0; j < 4; ++j) { const int c = 4 * lane + 256 * j;
            f32x4 v = (f32x4){0.f, 0.f, 0.f, 0.f};
#if DBG_EXPORT == 1
            v = ld_bf4(YB + (size_t)row * DM + c);
#elif DBG_EXPORT == 4
            v = ld_bf4(YA + (size_t)row * 2048 + c) + ld_bf4(YA + (size_t)row * 2048 + 1024 + c);
#elif DBG_EXPORT == 5
            v = ld_bf4(Z + (size_t)row * INW + CGA + c) + ld_bf4(Z + (size_t)row * INW + CGB + c);
#elif DBG_EXPORT == 6
            v = ld_bf4(C.w<bf16_t>(WS_ORAW) + (size_t)row * 2048 + c) + ld_bf4(C.w<bf16_t>(WS_ORAW) + (size_t)row * 2048 + 1024 + c);
#elif DBG_EXPORT == 7
            v = ld_bf4(Z + (size_t)row * INW + CG + c) + ld_bf4(Z + (size_t)row * INW + CG + 1024 + c);
#elif DBG_EXPORT == 8
            v = ld_bf4(Z + (size_t)row * INW + CQ + c);
#endif
            *(f32x4*)(C.out + O_Y + (size_t)row * DM + c) = v; }
}
#endif
constexpr int NPHASE = 10;
__global__ void __launch_bounds__(NTHR, 2) mk_fwd(Args args) {
    extern __shared__ __attribute__((aligned(16))) unsigned char lds_raw[];
    Ctx C;
    C.lds = (LAS unsigned char*)lds_raw; C.tid = threadIdx.x; C.lane = C.tid & 63; C.wave = __builtin_amdgcn_readfirstlane(C.tid >> 6);
    C.G = gridDim.x; { const int bx = blockIdx.x; C.vcu = (C.G % 8 == 0) ? (bx % 8) * (C.G / 8) + bx / 8 : bx; }
    C.in = args.in; C.out = args.out; C.ws = args.ws;
    const int lo = args.ph_lo, hi = args.ph_hi;
    if (C.tid < 64) ((LAS unsigned*)(C.lds + LDS_MISC))[C.tid] = 0u;
    __syncthreads();
    const XcdBarrier bar = xcd_barrier_post((unsigned*)(args.ws + WS_CTL) + 4096, (volatile LAS unsigned*)(C.lds + LDS_MISC));
#define IN(k) (lo <= (k) && (k) < hi)
#define SEAM(k) do { if (IN(k) && IN((k) + 1)) { GRID_BAR(); } } while (0)
#define GRID_BAR() do { xcd_barrier(bar); } while (0)
    if (IN(0)) { p0_prologue(C); } if (IN(0) && IN(1)) cooperative_groups::this_grid().sync();
    if (IN(1)) { F1 f{C.w<bf16_t>(WS_Z), C.w<float>(WS_COS), C.w<float>(WS_SIN), C.w<float>(WS_LNS)}; run_gemm(C, C.w<bf16_t>(WS_XN), C.w<bf16_t>(WS_WIN), MT, INW, DM, f); } SEAM(1);
    if (IN(2)) { p2_retention_simple(C); p2_gating_simple(C); } SEAM(2);
    if (IN(3)) { p3_finalize_ya(C); } SEAM(3);
    if (IN(4)) { { F2a f{C.w<bf16_t>(WS_Z), C.w<float>(WS_T)}; run_gemm(C, C.w<bf16_t>(WS_YA), C.w<bf16_t>(WS_WBRA), MT, DM, 2048, f); }
                 { F2b f{C.w<bf16_t>(WS_Z), C.w<float>(WS_T), C.w<bf16_t>(WS_MG)}; run_gemm(C, C.w<bf16_t>(WS_YB), C.w<bf16_t>(WS_WBRB), MT, DM, DM, f); } } SEAM(4);
    if (IN(5)) { FRes f{C.in[I_XP], C.in[I_XS], C.w<float>(WS_H1), C.w<bf16_t>(WS_H1B), C.w<float>(WS_SSQ2)}; run_gemm(C, C.w<bf16_t>(WS_MG), C.w<bf16_t>(WS_WO), MT, DM, DM, f); } SEAM(5);
    if (IN(6)) { F4 f{C.w<float>(WS_SSQ2), C.w<bf16_t>(WS_U)}; run_gemm(C, C.w<bf16_t>(WS_H1B), C.w<bf16_t>(WS_WUP), MT, FF, DM, f); } SEAM(6);
    if (IN(7)) { FRes f{C.w<float>(WS_H1), C.w<float>(WS_H1) + (size_t)MP * DM, C.w<float>(WS_H2), C.w<bf16_t>(WS_H2B), C.w<float>(WS_SSQ3)}; run_gemm(C, C.w<bf16_t>(WS_U), C.w<bf16_t>(WS_WDN), MT, DM, FF, f); } SEAM(7);
    if (IN(8)) { { F6a f{C.w<float>(WS_PE)}; run_gemm(C, C.w<bf16_t>(WS_PB), C.w<bf16_t>(WS_WPP), MT, DM, PLE, f); }
                 { F6b f{C.w<float>(WS_SSQ3), C.w<float>(WS_H2), C.w<float>(WS_PE), C.w<float>(WS_H3), C.w<float>(WS_SSQ4)}; run_gemm(C, C.w<bf16_t>(WS_H2B), C.w<bf16_t>(WS_WPG), MT, DM, DM, f); } } SEAM(8);
    if (IN(9)) { p9_final_norm(C); }
#ifdef DBG_EXPORT
    if (IN(10)) { dbg_export(C); }
#endif
#undef IN
#undef SEAM
#undef GRID_BAR
}
}

extern "C" void kernel_launch(void* const* d_in, const int* in_sizes, int n_in, void* d_out, int out_size, void* d_ws, size_t ws_size, hipStream_t stream) {
    using namespace mk;
    static int grid = 0;
    if (grid == 0) {
        if (n_in != 21 || (size_t)out_size != O_END || ws_size < WS_END) { fprintf(stderr, "kernel_launch: unexpected shapes: n_in %d out %d ws %zu (need %zu)\n", n_in, out_size, ws_size, (size_t)WS_END); grid = -1; return; }
        int dev = 0, cus = 0;
        if (hipGetDevice(&dev) != hipSuccess || hipDeviceGetAttribute(&cus, hipDeviceAttributeMultiprocessorCount, dev) != hipSuccess) { grid = -1; return; }
        if (hipFuncSetAttribute((const void*)mk_fwd, hipFuncAttributeMaxDynamicSharedMemorySize, LDS_BYTES) != hipSuccess) { fprintf(stderr, "kernel_launch: hipFuncSetAttribute failed\n"); grid = -1; return; }
        int per_cu = 0;
        if (hipOccupancyMaxActiveBlocksPerMultiprocessor(&per_cu, (const void*)mk_fwd, NTHR, LDS_BYTES) != hipSuccess || per_cu < 1) { fprintf(stderr, "kernel_launch: occupancy query says %d blocks/CU\n", per_cu); (void)hipGetLastError(); grid = -1; return; }
        grid = cus;
    }
    if (grid < 0) return;
    (void)hipMemsetAsync((char*)d_ws, 0, WS_ZERO_END, stream);
    Args a{};
    for (int i = 0; i < 21; ++i) a.in[i] = (const float*)d_in[i];
    a.out = (float*)d_out; a.ws = (unsigned char*)d_ws;
#ifdef MK_MULTI
    for (int p = 0; p < NPHASE; ++p) { a.ph_lo = p; a.ph_hi = p + 1; hipLaunchKernelGGL(mk_fwd, dim3(grid), dim3(NTHR), LDS_BYTES, stream, a); }
#else
    a.ph_lo = 0; a.ph_hi = NPHASE;
    void* kargs[] = {&a};
    const hipError_t le = hipLaunchCooperativeKernel((const void*)mk_fwd, dim3(grid), dim3(NTHR), kargs, LDS_BYTES, stream);
    if (le != hipSuccess) fprintf(stderr, "kernel_launch: cooperative launch failed: %s (grid %d)\n", hipGetErrorString(le), grid);
#endif
}
```

```cpp
#include <hip/hip_runtime.h>
#include <hip/hip_cooperative_groups.h>
#include <cstdio>
#include <cstdint>
namespace pg8 {
#define PG8_LAS __attribute__((address_space(3)))
typedef unsigned short bf16_t;
typedef short bf16x8 __attribute__((ext_vector_type(8)));
typedef float f32x4 __attribute__((ext_vector_type(4)));
typedef unsigned u32x4 __attribute__((ext_vector_type(4)));
constexpr int BM = 256, BK = 64, HALF = 128, HTB = HALF * BK * 2  , STAGE_BYTES = 8 * HTB, NXCD = 8, WGM = 8;

__host__ __device__ __forceinline__ int lds_byte(int r, int c) { const int st = (r >> 4) * 2 + (c >> 5), rr = r & 15, cc = c & 31, ob = rr * 64 + cc * 2; return st * 1024 + (ob ^ (((ob >> 9) & 1) << 5)); }
__host__ __device__ __forceinline__ void stage_rc(int b, int& R, int& C) { const int st = b / 1024, sb = b % 1024, swz = sb ^ (((sb >> 9) & 1) << 5); R = (st >> 1) * 16 + swz / 64; C = (st & 1) * 32 + (swz % 64) / 2; }
__host__ __device__ __forceinline__ int perm32(int rho) { const int n = rho >> 4, i = rho & 15; return 8 * (i >> 2) + 4 * n + (i & 3); }

struct Unit { int pm, pn; };
struct Gemm { const bf16_t* A; const bf16_t* Bt; int M, N, K; };

struct StaticOrder {
    int nM, nN, nwg, G, c;
    __host__ __device__ void init(int M, int N, int G_, int c_) { nM = M / BM; nN = N / BM; nwg = nM * nN; G = G_; c = c_; }
    __host__ __device__ bool next(int i, Unit& u) const {
        const long L = (long)i * G + c; if (L >= nwg) return false;
        int wgid = (int)L; { const int q = nwg / NXCD, r = nwg % NXCD, xcd = wgid % NXCD, off = wgid / NXCD; wgid = (xcd < r ? xcd * (q + 1) : r * (q + 1) + (xcd - r) * q) + off; }
        const int nig = WGM * nN, gid = wgid / nig, fm = gid * WGM, gsz = (nM - fm) < WGM ? (nM - fm) : WGM;
        u.pm = fm + ((wgid % nig) % gsz); u.pn = (wgid % nig) / gsz; return true;
    }
    __device__ __forceinline__ void a_ready(const Unit&) const {}
    __device__ __forceinline__ void done(const Unit&) const {}
};

__device__ __forceinline__ unsigned cvt_pk_bf16(float lo, float hi) { unsigned r; asm volatile("v_cvt_pk_bf16_f32 %0, %1, %2" : "=v"(r) : "v"(lo), "v"(hi)); return r; }
typedef float f32x2 __attribute__((ext_vector_type(2)));
__device__ __forceinline__ f32x2 gelu_pk(f32x2 v) {
    const f32x2 av = __builtin_elementwise_abs(v), d = av * 0.2316418882f + 1.0f;
    f32x2 t; t.x = __builtin_amdgcn_rcpf(d.x); t.y = __builtin_amdgcn_rcpf(d.y);
    f32x2 q = t * 0.5307027145f + (-0.7265760135f); q = q * t + 0.7107068705f; q = q * t + (-0.142248368f); q = q * t + 0.127414796f; q = q * t;
    const f32x2 s = (v * v) * (-0.72134752044f);
    f32x2 e; e.x = __builtin_amdgcn_exp2f(s.x); e.y = __builtin_amdgcn_exp2f(s.y);
    const f32x2 m = v * (q * e), r = v - m;
    f32x2 o; o.x = v.x < 0.f ? m.x : r.x; o.y = v.y < 0.f ? m.y : r.y; return o;
}
template <class Epi, class Sched, bool ALIGN_EPI = false, bool SP2 = false>
__device__ __forceinline__ void gemm_phase(PG8_LAS unsigned char* lds, const Gemm g, const Sched& S, const Epi& E) {
    const int tid = threadIdx.x, wid = __builtin_amdgcn_readfirstlane(tid >> 6), lane = tid & 63, wr = wid >> 2, wc = wid & 3, fr = lane & 15, fq = lane >> 4;
    const int K = g.K, nt = K / BK;
    unsigned voffA[2], voffB[2];
#pragma unroll
    for (int i = 0; i < 2; ++i) { int R, C; stage_rc(tid * 16 + i * 8192, R, C); const int Rb = Epi::PERM ? ((R & ~31) + perm32(R & 31)) : R;
        voffA[i] = (unsigned)(R * K + C) * 2u; voffB[i] = (unsigned)(Rb * K + C) * 2u; }
    const size_t kstep = (size_t)(BK * 2);
    const size_t hstep = (size_t)HALF * K * 2;
    const size_t tstep = 2 * hstep;
    const unsigned ldsw = (unsigned)wid * 1024u;
    const int aoff = lds_byte(wr * 64 + fr, fq * 8), boff = lds_byte(wc * 32 + fr, fq * 8);
#define PG8_SA(b, h) (((b) * 2 + (h)) * HTB)
#define PG8_SB(b, h) ((4 + (b) * 2 + (h)) * HTB)
#define PG8_STAGE(bufoff, gbase, voff) do { _Pragma("unroll") for (int _i = 0; _i < 2; ++_i) \
        __builtin_amdgcn_global_load_lds((const unsigned*)((const char*)(gbase) + (voff)[_i]), (PG8_LAS unsigned*)(lds + (bufoff) + ldsw + _i * 8192), 16, 0, 0); } while (0)
#define PG8_LDA(dst, b, h) do { _Pragma("unroll") for (int m = 0; m < 4; ++m) _Pragma("unroll") for (int k = 0; k < 2; ++k) dst[m][k] = *(const PG8_LAS bf16x8*)(lds + PG8_SA(b, h) + aoff + m * 2048 + k * 1024); } while (0)
#define PG8_LDB(dst, b, h) do { _Pragma("unroll") for (int n = 0; n < 2; ++n) _Pragma("unroll") for (int k = 0; k < 2; ++k) dst[n][k] = *(const PG8_LAS bf16x8*)(lds + PG8_SB(b, h) + boff + n * 2048 + k * 1024); } while (0)
#define PG8_MMA(ai, bj, At, Bt) do { __builtin_amdgcn_s_setprio(1); _Pragma("unroll") for (int m = 0; m < 4; ++m) _Pragma("unroll") for (int n = 0; n < 2; ++n) _Pragma("unroll") for (int k = 0; k < 2; ++k) \
        acc[ai][bj][m][n] = __builtin_amdgcn_mfma_f32_16x16x32_bf16(Bt[n][k], At[m][k], acc[ai][bj][m][n], 0, 0, 0); __builtin_amdgcn_s_setprio(0); } while (0)
#define PG8_WAIT_V(n) asm volatile("s_waitcnt vmcnt(" #n ")" ::: "memory")
#define PG8_WAIT_L(n) asm volatile("s_waitcnt lgkmcnt(" #n ")" ::: "memory")
#define PG8_BAR __builtin_amdgcn_s_barrier()
#define PG8_SCHED __builtin_amdgcn_sched_barrier(0)
    Unit cur, nxt; int ui = 0;
    if (!S.next(0, cur)) return;
    f32x4 acc[2][2][4][2];
#pragma unroll
    for (int a = 0; a < 2; ++a)
#pragma unroll
        for (int b = 0; b < 2; ++b)
#pragma unroll
            for (int m = 0; m < 4; ++m)
#pragma unroll
                for (int n = 0; n < 2; ++n) acc[a][b][m][n] = (f32x4){0.f, 0.f, 0.f, 0.f};
    bf16x8 At[4][2], B0[2][2], B1[2][2];
    const char* cA = (const char*)g.A + (size_t)cur.pm * tstep; const char* cB = (const char*)g.Bt + (size_t)cur.pn * tstep;
    S.a_ready(cur);
    if constexpr (SP2) {
        PG8_STAGE(PG8_SB(0, 0), cB, voffB); PG8_STAGE(PG8_SB(0, 1), cB + hstep, voffB); PG8_STAGE(PG8_SA(0, 0), cA, voffA); PG8_STAGE(PG8_SA(0, 1), cA + hstep, voffA);
        if (wr == 1) PG8_BAR;
        PG8_WAIT_V(2); PG8_BAR;
        PG8_STAGE(PG8_SB(1, 0), cB + kstep, voffB); PG8_STAGE(PG8_SA(1, 0), cA + kstep, voffA); PG8_STAGE(PG8_SB(1, 1), cB + hstep + kstep, voffB);
        PG8_WAIT_V(6); PG8_BAR;
    } else {
        PG8_STAGE(PG8_SB(0, 0), cB, voffB); PG8_STAGE(PG8_SA(0, 0), cA, voffA); PG8_STAGE(PG8_SB(0, 1), cB + hstep, voffB); PG8_STAGE(PG8_SA(0, 1), cA + hstep, voffA);
        if (wr == 1) PG8_BAR;
        PG8_WAIT_V(4); PG8_BAR;
        PG8_STAGE(PG8_SB(1, 0), cB + kstep, voffB); PG8_STAGE(PG8_SA(1, 0), cA + kstep, voffA); PG8_STAGE(PG8_SB(1, 1), cB + hstep + kstep, voffB);
        PG8_WAIT_V(6); PG8_BAR;
    }
    for (;;) {
        const bool has_next = S.next(ui + 1, nxt);
        const char* nA = has_next ? (const char*)g.A + (size_t)nxt.pm * tstep : cA; const char* nB = has_next ? (const char*)g.Bt + (size_t)nxt.pn * tstep : cB;
        for (int t = 0; t < nt; t += 2) {
            const bool last = (t == nt - 2);
            const char* a1 = cA + (size_t)(t + 1) * kstep;
            const char* a2 = last ? nA : cA + (size_t)(t + 2) * kstep; const char* b2 = last ? nB : cB + (size_t)(t + 2) * kstep;
            const char* a3 = a2 + kstep; const char* b3 = b2 + kstep;
            if (last && has_next) S.a_ready(nxt);
            if constexpr (SP2) {
            PG8_LDB(B0, 0, 0); PG8_LDB(B1, 0, 1); PG8_SCHED; PG8_LDA(At, 0, 0); PG8_STAGE(PG8_SA(1, 1), a1 + hstep, voffA);
            PG8_WAIT_V(8); PG8_WAIT_L(0); PG8_BAR; PG8_MMA(0, 0, At, B0); PG8_MMA(0, 1, At, B1); PG8_BAR; PG8_SCHED;
            PG8_LDA(At, 0, 1); PG8_STAGE(PG8_SB(0, 0), b2, voffB); PG8_STAGE(PG8_SB(0, 1), b2 + hstep, voffB); PG8_STAGE(PG8_SA(0, 0), a2, voffA);
            PG8_WAIT_V(8); PG8_WAIT_L(0); PG8_BAR; PG8_MMA(1, 0, At, B0); PG8_MMA(1, 1, At, B1); PG8_BAR; PG8_SCHED;
            PG8_LDB(B0, 1, 0); PG8_LDB(B1, 1, 1); PG8_SCHED; PG8_LDA(At, 1, 0); PG8_STAGE(PG8_SA(0, 1), a2 + hstep, voffA);
            PG8_WAIT_V(8); PG8_WAIT_L(0); PG8_BAR; PG8_MMA(0, 0, At, B0); PG8_MMA(0, 1, At, B1); PG8_BAR; PG8_SCHED;
            PG8_LDA(At, 1, 1); PG8_STAGE(PG8_SB(1, 0), b3, voffB); PG8_STAGE(PG8_SB(1, 1), b3 + hstep, voffB); PG8_STAGE(PG8_SA(1, 0), a3, voffA);
            PG8_WAIT_V(8); PG8_WAIT_L(0); PG8_BAR; PG8_MMA(1, 0, At, B0); PG8_MMA(1, 1, At, B1); PG8_BAR; PG8_SCHED;
            } else {
            PG8_LDB(B0, 0, 0); PG8_SCHED; PG8_LDA(At, 0, 0); PG8_STAGE(PG8_SA(1, 1), a1 + hstep, voffA);
            PG8_WAIT_L(8); PG8_BAR; PG8_WAIT_L(0); PG8_MMA(0, 0, At, B0); PG8_BAR; PG8_SCHED;
            PG8_LDB(B1, 0, 1); PG8_STAGE(PG8_SB(0, 0), b2, voffB);
            PG8_BAR; PG8_WAIT_L(0); PG8_MMA(0, 1, At, B1); PG8_BAR;
            PG8_LDA(At, 0, 1); PG8_STAGE(PG8_SA(0, 0), a2, voffA);
            PG8_BAR; PG8_WAIT_L(0); PG8_MMA(1, 0, At, B0); PG8_BAR; PG8_SCHED;
            PG8_STAGE(PG8_SB(0, 1), b2 + hstep, voffB);
            PG8_WAIT_V(6); PG8_BAR; PG8_MMA(1, 1, At, B1); PG8_BAR;
            PG8_LDB(B0, 1, 0); PG8_SCHED; PG8_LDA(At, 1, 0); PG8_STAGE(PG8_SA(0, 1), a2 + hstep, voffA);
            PG8_WAIT_L(8); PG8_BAR; PG8_WAIT_L(0); PG8_MMA(0, 0, At, B0); PG8_BAR; PG8_SCHED;
            PG8_LDB(B1, 1, 1); PG8_STAGE(PG8_SB(1, 0), b3, voffB);
            PG8_BAR; PG8_WAIT_L(0); PG8_MMA(0, 1, At, B1); PG8_BAR;
            PG8_LDA(At, 1, 1); PG8_STAGE(PG8_SA(1, 0), a3, voffA);
            PG8_BAR; PG8_WAIT_L(0); PG8_MMA(1, 0, At, B0); PG8_BAR; PG8_SCHED;
            PG8_STAGE(PG8_SB(1, 1), b3 + hstep, voffB);
            PG8_WAIT_V(6); PG8_BAR; PG8_MMA(1, 1, At, B1); PG8_BAR;
            }
        }
        if constexpr (ALIGN_EPI) { if (wr == 0) PG8_BAR; }
        if constexpr (!Epi::AFTER_DRAIN) { E(acc, cur, wr, wc, fr, fq); S.done(cur); }
        if (!has_next) break;
#pragma unroll
        for (int a = 0; a < 2; ++a)
#pragma unroll
            for (int b = 0; b < 2; ++b)
#pragma unroll
                for (int m = 0; m < 4; ++m)
#pragma unroll
                    for (int n = 0; n < 2; ++n) acc[a][b][m][n] = (f32x4){0.f, 0.f, 0.f, 0.f};
        cur = nxt; cA = nA; cB = nB; ++ui;
        if constexpr (ALIGN_EPI) { if (wr == 1) PG8_BAR; }
    }
    PG8_WAIT_V(0);
    if constexpr (!ALIGN_EPI) { if (wr == 0) PG8_BAR; }
    PG8_BAR;
    if constexpr (Epi::AFTER_DRAIN) { E.fused(acc, cur, wr, wc, fr, fq, lds, wid, lane); S.done(cur); }
#undef PG8_SA
#undef PG8_SB
#undef PG8_STAGE
#undef PG8_LDA
#undef PG8_LDB
#undef PG8_MMA
#undef PG8_WAIT_V
#undef PG8_WAIT_L
#undef PG8_BAR
#undef PG8_SCHED
}
}

namespace mk {
using pg8::bf16_t; using pg8::f32x4; using pg8::f32x2; using pg8::Unit; using pg8::cvt_pk_bf16; using pg8::gelu_pk;
typedef unsigned u32x2 __attribute__((ext_vector_type(2)));
typedef unsigned u32x4 __attribute__((ext_vector_type(4)));
#define LAS __attribute__((address_space(3)))

constexpr int MP = 16384, MS = 512, MT = MP + MS, DM = 1024, INW = 10240, FF = 4096, PLE = 256;
constexpr int CQ = 0, CK = 1024, CV = 2048, CG = 4096, CU = 6144, CGV = 7168, CGA = 8192, CGB = 9216;
constexpr int NTAB = 2048 + 4;
constexpr float EPS = 1e-6f;
constexpr int NWAVES = 8, NTHR = 512;

constexpr size_t O_Y = 0;
constexpr size_t O_SRP = (size_t)MT * DM;
constexpr size_t O_SRS = O_SRP + (size_t)8 * 4 * 256 * 512;
constexpr size_t O_GMV = O_SRS + (size_t)128 * 4 * 256 * 512;
constexpr size_t O_END = O_GMV + (size_t)128 * 4 * 1024;

constexpr size_t al256(size_t x) { return (x + 255) & ~(size_t)255; }
constexpr size_t WS_CTL = 0, CTL_BYTES = 1u << 20;
constexpr size_t WS_LNS = WS_CTL + CTL_BYTES;
constexpr size_t WS_SSQO = WS_LNS + al256((size_t)MT * 2 * 4);
constexpr size_t WS_SSQ2 = WS_SSQO + al256((size_t)MT * 4 * 4);
constexpr size_t WS_SSQ3 = WS_SSQ2 + al256((size_t)MT * 4);
constexpr size_t WS_SSQ4 = WS_SSQ3 + al256((size_t)MT * 4);
constexpr size_t WS_ZERO_END = WS_SSQ4 + al256((size_t)MT * 4);
constexpr size_t WS_COS = al256(WS_ZERO_END);
constexpr size_t WS_SIN = WS_COS + al256((size_t)NTAB * 128 * 4);
constexpr size_t WS_WIN = WS_SIN + al256((size_t)NTAB * 128 * 4);
constexpr size_t WS_WBRA = WS_WIN + (size_t)INW * DM * 2;
constexpr size_t WS_WBRB = WS_WBRA + (size_t)DM * 2048 * 2;
constexpr size_t WS_WO = WS_WBRB + (size_t)DM * DM * 2;
constexpr size_t WS_WUP = WS_WO + (size_t)DM * DM * 2;
constexpr size_t WS_WDN = WS_WUP + (size_t)FF * DM * 2;
constexpr size_t WS_WPG = WS_WDN + (size_t)DM * FF * 2;
constexpr size_t WS_WPP = WS_WPG + (size_t)DM * DM * 2;
constexpr size_t WS_WSB = WS_WPP + (size_t)DM * PLE * 2;
constexpr size_t WS_XN = WS_WSB + (size_t)8 * 128 * 128 * 2;
constexpr size_t WS_PB = WS_XN + (size_t)MT * DM * 2;
constexpr size_t WS_A = WS_PB + (size_t)MT * PLE * 2;
constexpr size_t WS_Z = WS_A;
constexpr size_t WS_U = WS_A;
constexpr size_t WS_H2 = WS_U + (size_t)MT * FF * 2;
constexpr size_t WS_H2B = WS_H2 + (size_t)MT * DM * 4;
constexpr size_t WS_PE = WS_H2B + (size_t)MT * DM * 2;
constexpr size_t WS_A_END = WS_A + (size_t)MT * INW * 2;
static_assert(WS_PE + (size_t)MT * DM * 4 <= WS_A_END, "region A overlay");
constexpr size_t WS_ORAW = WS_A_END;
constexpr size_t WS_H3 = WS_ORAW;
constexpr size_t WS_YA = WS_ORAW + (size_t)MT * 2048 * 2;
constexpr size_t WS_YB = WS_YA + (size_t)MT * 2048 * 2;
constexpr size_t WS_T = WS_YB + (size_t)MT * DM * 2;
constexpr size_t WS_MG = WS_T + (size_t)MT * DM * 4;
constexpr size_t WS_H1 = WS_MG + (size_t)MT * DM * 2;
constexpr size_t WS_H1B = WS_H1 + (size_t)MT * DM * 4;
constexpr size_t WS_END = WS_H1B + (size_t)MT * DM * 2;

constexpr int LDS_RING = 131072, LDS_BYTES = 139264, LDS_MISC = LDS_BYTES - 256;

struct Args {
    const float* in[21]; float* out; unsigned char* ws; int ph_lo, ph_hi;
};

__device__ __forceinline__ float bf2f(unsigned short u) { return __uint_as_float((unsigned)u << 16); }
__device__ __forceinline__ unsigned f2bf(float f) { unsigned u = __float_as_uint(f); return (u + 0x7fffu + ((u >> 16) & 1u)) >> 16; }
__device__ __forceinline__ unsigned pk2(float lo, float hi) { return f2bf(lo) | (f2bf(hi) << 16); }
__device__ __forceinline__ f32x4 ld_bf4(const bf16_t* p) { const u32x2 w = *(const u32x2*)p; return (f32x4){__uint_as_float(w.x << 16), __uint_as_float(w.x & 0xffff0000u), __uint_as_float(w.y << 16), __uint_as_float(w.y & 0xffff0000u)}; }
typedef float f32x2_t __attribute__((ext_vector_type(2))); typedef __bf16 bf16x2_t __attribute__((ext_vector_type(2)));
__device__ __forceinline__ unsigned cvtpk(float lo, float hi) { const f32x2_t v = {lo, hi}; const bf16x2_t b = __builtin_convertvector(v, bf16x2_t); return __builtin_bit_cast(unsigned, b); }
__device__ __forceinline__ void st_bf4(bf16_t* p, f32x4 v) { u32x2 w; w.x = cvtpk(v[0], v[1]); w.y = cvtpk(v[2], v[3]); *(u32x2*)p = w; }
__device__ __forceinline__ float sigmoidf_(float x) { return __builtin_amdgcn_rcpf(1.0f + __builtin_amdgcn_exp2f(-1.4426950408889634f * x)); }
__device__ __forceinline__ f32x4 sigmoid4(f32x4 v) { return (f32x4){sigmoidf_(v[0]), sigmoidf_(v[1]), sigmoidf_(v[2]), sigmoidf_(v[3])}; }
__device__ __forceinline__ f32x4 silu4(f32x4 v) { return v * sigmoid4(v); }
__device__ __forceinline__ f32x4 gelu4(f32x4 v) { const f32x2 a = gelu_pk((f32x2){v[0], v[1]}), b = gelu_pk((f32x2){v[2], v[3]}); return (f32x4){a.x, a.y, b.x, b.y}; }
__device__ __forceinline__ float sum4(f32x4 v) { return (v[0] + v[1]) + (v[2] + v[3]); }
__device__ __forceinline__ float wave_sum(float v) {
#pragma unroll
    for (int o = 1; o < 64; o <<= 1) v += __shfl_xor(v, o);
    return v;
}
__device__ __forceinline__ int tab_index(int row) { return row < MP ? (row & 2047) : 2048 + (row & 3); }

template <class F> struct EpiGen {
    static constexpr bool PERM = false, AFTER_DRAIN = false;
    F f;
    template <int KIND> __device__ __forceinline__ void run(const f32x4 (&acc)[2][2][4][2], int row0, int col0, int fq) const {
#pragma unroll
        for (int ai = 0; ai < 2; ++ai)
#pragma unroll
            for (int m = 0; m < 4; ++m) {
                const int row = row0 + ai * 128 + m * 16;
                float red[2] = {0.f, 0.f};
                const typename F::RowCtx rc = f.template row_begin<KIND>(row);
#pragma unroll
                for (int n = 0; n < 2; ++n) f.template pair<KIND>(rc, row, col0 + n * 16, acc[ai][0][m][n], col0 + 128 + n * 16, acc[ai][1][m][n], red);
                if (F::template nred<KIND>() > 0) {
                    red[0] += __shfl_xor(red[0], 16); red[0] += __shfl_xor(red[0], 32);
                    if (F::template nred<KIND>() > 1) { red[1] += __shfl_xor(red[1], 16); red[1] += __shfl_xor(red[1], 32); }
                    if (fq == 0) f.template row_add<KIND>(row, red);
                }
                asm volatile("" ::: "memory");
            }
    }
    __device__ __forceinline__ void operator()(const f32x4 (&acc)[2][2][4][2], const Unit& u, int wr, int wc, int fr, int fq) const {
        const int row0 = u.pm * 256 + wr * 64 + fr, col0 = u.pn * 256 + wc * 32 + 4 * fq;
        const int kind = f.kind(u.pn * 256);
        if (F::NK == 1) { run<0>(acc, row0, col0, fq); return; }
        switch (kind) {
            case 0: run<0>(acc, row0, col0, fq); break;
            case 1: run<(F::NK > 1 ? 1 : 0)>(acc, row0, col0, fq); break;
            case 2: run<(F::NK > 2 ? 2 : 0)>(acc, row0, col0, fq); break;
            case 3: run<(F::NK > 3 ? 3 : 0)>(acc, row0, col0, fq); break;
            case 4: run<(F::NK > 4 ? 4 : 0)>(acc, row0, col0, fq); break;
            default: run<(F::NK > 5 ? 5 : 0)>(acc, row0, col0, fq); break;
        }
    }
};

struct F1 {
    static constexpr int NK = 6; typedef int RowCtx;
    bf16_t* Z; const float* cosT; const float* sinT; float* LNS;
    __device__ __forceinline__ int kind(int cb) const { return cb < CV ? 0 : cb < CG ? 1 : cb < CU ? 2 : cb < CGV ? 3 : cb < CGA ? 4 : 5; }
    template <int K> static __device__ __forceinline__ constexpr int nred() { return K == 4 ? 2 : 0; }
    template <int K> __device__ __forceinline__ RowCtx row_begin(int row) const { return K == 0 ? tab_index(row) * 128 : 0; }
    template <int K> __device__ __forceinline__ void pair(RowCtx rc, int row, int c0, f32x4 v0, int c1, f32x4 v1, float (&red)[2]) const {
        bf16_t* zr = Z + (size_t)row * INW;
        if (K == 0) { const int i0 = c0 & 255; const f32x4 cs = *(const f32x4*)(cosT + rc + i0), sn = *(const f32x4*)(sinT + rc + i0);
            const f32x4 o0 = v0 * cs - v1 * sn, o1 = v1 * cs + v0 * sn; st_bf4(zr + c0, o0); st_bf4(zr + c1, o1); }
        else if (K == 1) { st_bf4(zr + c0, v0); st_bf4(zr + c1, v1); }
        else if (K == 2) { st_bf4(zr + c0, silu4(v0)); st_bf4(zr + c1, silu4(v1)); }
        else if (K == 3) { st_bf4(zr + c0, gelu4(v0)); st_bf4(zr + c1, gelu4(v1)); }
        else if (K == 4) { const f32x4 g0 = gelu4(v0), g1 = gelu4(v1); st_bf4(zr + c0, g0); st_bf4(zr + c1, g1);
            red[0] += sum4(g0) + sum4(g1); red[1] += sum4(g0 * g0) + sum4(g1 * g1); }
        else { st_bf4(zr + c0, sigmoid4(v0)); st_bf4(zr + c1, sigmoid4(v1)); }
    }
    template <int K> __device__ __forceinline__ void row_add(int row, const float (&red)[2]) const { atomicAdd(LNS + 2 * row, red[0]); atomicAdd(LNS + 2 * row + 1, red[1]); }
};
struct F2a {
    static constexpr int NK = 1; typedef int RowCtx;
    const bf16_t* Z; float* T;
    __device__ __forceinline__ int kind(int) const { return 0; }
    template <int K> static __device__ __forceinline__ constexpr int nred() { return 0; }
    template <int K> __device__ __forceinline__ RowCtx row_begin(int) const { return 0; }
    template <int K> __device__ __forceinline__ void pair(RowCtx, int row, int c0, f32x4 v0, int c1, f32x4 v1, float (&)[2]) const {
        const bf16_t* g = Z + (size_t)row * INW + CGA; float* t = T + (size_t)row * DM;
        *(f32x4*)(t + c0) = ld_bf4(g + c0) * v0; *(f32x4*)(t + c1) = ld_bf4(g + c1) * v1;
    }
    template <int K> __device__ __forceinline__ void row_add(int, const float (&)[2]) const {}
};
struct F2b {
    static constexpr int NK = 1; typedef int RowCtx;
    const bf16_t* Z; const float* T; bf16_t* MG;
    __device__ __forceinline__ int kind(int) const { return 0; }
    template <int K> static __device__ __forceinline__ constexpr int nred() { return 0; }
    template <int K> __device__ __forceinline__ RowCtx row_begin(int) const { return 0; }
    template <int K> __device__ __forceinline__ void pair(RowCtx, int row, int c0, f32x4 v0, int c1, f32x4 v1, float (&)[2]) const {
        const bf16_t* g = Z + (size_t)row * INW + CGB; const float* t = T + (size_t)row * DM; bf16_t* o = MG + (size_t)row * DM;
        st_bf4(o + c0, *(const f32x4*)(t + c0) + ld_bf4(g + c0) * v0); st_bf4(o + c1, *(const f32x4*)(t + c1) + ld_bf4(g + c1) * v1);
    }
    template <int K> __device__ __forceinline__ void row_add(int, const float (&)[2]) const {}
};
struct FRes {
    static constexpr int NK = 1; typedef const float* RowCtx;
    const float* baseP; const float* baseS; float* H; bf16_t* HB; float* SSQ;
    __device__ __forceinline__ int kind(int) const { return 0; }
    template <int K> static __device__ __forceinline__ constexpr int nred() { return 1; }
    template <int K> __device__ __forceinline__ RowCtx row_begin(int row) const { return row < MP ? baseP + (size_t)row * DM : baseS + (size_t)(row - MP) * DM; }
    template <int K> __device__ __forceinline__ void pair(RowCtx rc, int row, int c0, f32x4 v0, int c1, f32x4 v1, float (&red)[2]) const {
        const f32x4 h0 = *(const f32x4*)(rc + c0) + v0, h1 = *(const f32x4*)(rc + c1) + v1;
        float* h = H + (size_t)row * DM; bf16_t* hb = HB + (size_t)row * DM;
        *(f32x4*)(h + c0) = h0; *(f32x4*)(h + c1) = h1; st_bf4(hb + c0, h0); st_bf4(hb + c1, h1);
        red[0] += sum4(h0 * h0) + sum4(h1 * h1);
    }
    template <int K> __device__ __forceinline__ void row_add(int row, const float (&red)[2]) const { atomicAdd(SSQ + row, red[0]); }
};
struct F4 {
    static constexpr int NK = 1; typedef float RowCtx;
    const float* SSQ; bf16_t* U;
    __device__ __forceinline__ int kind(int) const { return 0; }
    template <int K> static __device__ __forceinline__ constexpr int nred() { return 0; }
    template <int K> __device__ __forceinline__ RowCtx row_begin(int row) const { return rsqrtf(SSQ[row] * (1.0f / DM) + EPS); }
    template <int K> __device__ __forceinline__ void pair(RowCtx rs, int row, int c0, f32x4 v0, int c1, f32x4 v1, float (&)[2]) const {
        bf16_t* u = U + (size_t)row * FF; const f32x4 z = (f32x4){0.f, 0.f, 0.f, 0.f};
        f32x4 a = __builtin_elementwise_max(v0 * rs, z), b = __builtin_elementwise_max(v1 * rs, z);
        st_bf4(u + c0, a * a); st_bf4(u + c1, b * b);
    }
    template <int K> __device__ __forceinline__ void row_add(int, const float (&)[2]) const {}
};
struct F6a {
    static constexpr int NK = 1; typedef int RowCtx;
    float* PE;
    __device__ __forceinline__ int kind(int) const { return 0; }
    template <int K> static __device__ __forceinline__ constexpr int nred() { return 0; }
    template <int K> __device__ __forceinline__ RowCtx row_begin(int) const { return 0; }
    template <int K> __device__ __forceinline__ void pair(RowCtx, int row, int c0, f32x4 v0, int c1, f32x4 v1, float (&)[2]) const {
        float* p = PE + (size_t)row * DM; *(f32x4*)(p + c0) = v0; *(f32x4*)(p + c1) = v1;
    }
    template <int K> __device__ __forceinline__ void row_add(int, const float (&)[2]) const {}
};
struct F6b {
    static constexpr int NK = 1; typedef float RowCtx;
    const float* SSQ3; const float* H2; const float* PE; float* H3; float* SSQ4;
    __device__ __forceinline__ int kind(int) const { return 0; }
    template <int K> static __device__ __forceinline__ constexpr int nred() { return 1; }
    template <int K> __device__ __forceinline__ RowCtx row_begin(int row) const { return rsqrtf(SSQ3[row] * (1.0f / DM) + EPS); }
    template <int K> __device__ __forceinline__ void pair(RowCtx rs, int row, int c0, f32x4 v0, int c1, f32x4 v1, float (&red)[2]) const {
        const size_t o = (size_t)row * DM;
        const f32x4 h0 = *(const f32x4*)(H2 + o + c0) + sigmoid4(v0 * rs) * *(const f32x4*)(PE + o + c0);
        const f32x4 h1 = *(const f32x4*)(H2 + o + c1) + sigmoid4(v1 * rs) * *(const f32x4*)(PE + o + c1);
        *(f32x4*)(H3 + o + c0) = h0; *(f32x4*)(H3 + o + c1) = h1;
        red[0] += sum4(h0 * h0) + sum4(h1 * h1);
    }
    template <int K> __device__ __forceinline__ void row_add(int row, const float (&red)[2]) const { atomicAdd(SSQ4 + row, red[0]); }
};
#define XB_TMO      128
#define XB_XCNT(j)  (256  + 64 * (j))
#define XB_XSUB(j)  (1280 + 64 * (j))
#define XB_XGEN(j)  (2304 + 64 * (j))
#define XB_TOP      3328
#define XB_TOPGEN   3392
#define XCD_BAR_WORDS 3456
#define XB_SPIN_CAP (1u << 21)

__device__ __forceinline__ unsigned xb_ld(unsigned* p)              { return __hip_atomic_load(p, __ATOMIC_RELAXED, __HIP_MEMORY_SCOPE_AGENT); }
__device__ __forceinline__ unsigned xb_add(unsigned* p, unsigned v) { return __hip_atomic_fetch_add(p, v, __ATOMIC_RELAXED, __HIP_MEMORY_SCOPE_AGENT); }
__device__ __forceinline__ unsigned xb_xcc_id() { return (unsigned)__builtin_amdgcn_s_getreg((3 << 11) | 20) & 0xFu; }
#define XB_SPIN(cond, bar) do { unsigned _sp = 0; while (cond) { __builtin_amdgcn_s_sleep(1); \
    if ((++_sp & 255u) == 0u) { if (xb_ld(&(bar)[XB_TMO])) break; if (_sp > XB_SPIN_CAP) { atomicAdd(&(bar)[XB_TMO], 1u); break; } } } } while (0)

struct XcdBarrier {
    unsigned* bar; unsigned x;
    volatile LAS unsigned* st;
};

__device__ __forceinline__ XcdBarrier xcd_barrier_post(unsigned* bar, volatile LAS unsigned* st) {
    XcdBarrier b; b.bar = bar; b.x = xb_xcc_id(); b.st = st;
    if (threadIdx.x == 0) (void)xb_add(&bar[XB_XCNT(b.x)], 1u);
    return b;
}
__device__ __forceinline__ void xcd_barrier_complete(unsigned* bar, unsigned x, unsigned& nloc, unsigned& nx) {
    const unsigned G = gridDim.x * gridDim.y * gridDim.z;
    unsigned sum, cnt, mine, sp = 0u;
    for (;;) {
        sum = 0u; cnt = 0u; mine = 0u;
#pragma unroll
        for (unsigned j = 0; j < 16; ++j) { const unsigned c = xb_ld(&bar[XB_XCNT(j)]); sum += c; cnt += (c > 0u) ? 1u : 0u; mine = (j == x) ? c : mine; }
        if (sum == G) break;
        __builtin_amdgcn_s_sleep(1);
        if ((++sp & 255u) == 0u) { if (xb_ld(&bar[XB_TMO])) break; if (sp > XB_SPIN_CAP) { atomicAdd(&bar[XB_TMO], 1u); break; } }
    }
    nloc = mine > 0u ? mine : 1u; nx = cnt > 0u ? cnt : 1u;
}

__device__ __forceinline__ void xcd_barrier(const XcdBarrier& b) {
    asm volatile("s_waitcnt vmcnt(0)" ::: "memory");
    __syncthreads();
    if (threadIdx.x == 0) {
        unsigned* bar = b.bar;
        __builtin_amdgcn_s_waitcnt(0);
        unsigned nloc = b.st[0], nx = b.st[1];
        if (nloc == 0u) { xcd_barrier_complete(bar, b.x, nloc, nx); b.st[0] = nloc; b.st[1] = nx; }
        const unsigned old = xb_add(&bar[XB_XSUB(b.x)], 1u);
        const unsigned gen = old / nloc;
        if (old + 1u == (gen + 1u) * nloc) {
            __builtin_amdgcn_fence(__ATOMIC_RELEASE, "agent");
            asm volatile("s_waitcnt vmcnt(0)" ::: "memory");
            const unsigned og = xb_add(&bar[XB_TOP], 1u);
            const unsigned tg = og / nx;
            if (og + 1u == (tg + 1u) * nx) xb_add(&bar[XB_TOPGEN], 1u);
            else XB_SPIN(xb_ld(&bar[XB_TOPGEN]) == tg, bar);
            __builtin_amdgcn_fence(__ATOMIC_ACQUIRE, "agent");
            xb_add(&bar[XB_XGEN(b.x)], 1u);
            asm volatile("s_waitcnt vmcnt(0)" ::: "memory");
        } else {
            XB_SPIN(xb_ld(&bar[XB_XGEN(b.x)]) == gen, bar);
            __builtin_amdgcn_fence(__ATOMIC_ACQUIRE, "agent");
            asm volatile("s_waitcnt vmcnt(0)" ::: "memory");
        }
    }
    __syncthreads();
}

struct Ctx {
    LAS unsigned char* lds; int tid, lane, wave, vcu, G;
    const float* const* in; float* out; unsigned char* ws;
    template <class T> __device__ __forceinline__ T* w(size_t off) const { return (T*)(ws + off); }
};
enum { I_XP = 0, I_XS, I_PP, I_PS, I_ST, I_GMIX, I_WIN, I_GRET, I_WS, I_BS, I_GGM, I_WBRA, I_WBRB, I_WO, I_GMLP, I_WUP, I_WDN, I_GPLE, I_WPG, I_WPP, I_GFIN };

__device__ __forceinline__ void p0_transpose_item(const float* W, int K, int N, bf16_t* WT, LAS float* scr, int item, int lane, const float* rowg, int cs_lo, int cs_hi, float cs) {
    const int nblk = N / 32, kb = item / nblk, nb = item % nblk, k0 = 64 * kb, n0 = 32 * nb;
#pragma unroll 8
    for (int i = 0; i < 32; ++i) { const int kk = 2 * i + (lane >> 5); float wv = W[(size_t)(k0 + kk) * N + n0 + (lane & 31)]; if (rowg) wv *= rowg[k0 + kk]; scr[kk * 33 + (lane & 31)] = wv; }
    asm volatile("s_waitcnt lgkmcnt(0)" ::: "memory");
    const int c = lane & 7;
#pragma unroll
    for (int j = 0; j < 4; ++j) { const int n = (lane >> 3) + 8 * j; const LAS float* s = scr + (8 * c) * 33 + n; const float sc = (n0 + n >= cs_lo && n0 + n < cs_hi) ? cs : 1.0f;
        u32x4 o; o.x = pk2(s[0 * 33] * sc, s[1 * 33] * sc); o.y = pk2(s[2 * 33] * sc, s[3 * 33] * sc); o.z = pk2(s[4 * 33] * sc, s[5 * 33] * sc); o.w = pk2(s[6 * 33] * sc, s[7 * 33] * sc);
        *(u32x4*)(WT + (size_t)(n0 + n) * K + k0 + 8 * c) = o; }
    asm volatile("s_waitcnt lgkmcnt(0)" ::: "memory");
}
__device__ __forceinline__ double sin_poly(double x) {
    const double x2 = x * x; double r = -1.0 / 8841761993739701954543616000000.0;
    r = r * x2 + 1.0 / 10888869450418352160768000000.0;
    r = r * x2 - 1.0 / 15511210043330985984000000.0;
    r = r * x2 + 1.0 / 25852016738884976640000.0;
    r = r * x2 - 1.0 / 51090942171709440000.0;
    r = r * x2 + 1.0 / 121645100408832000.0;
    r = r * x2 - 1.0 / 355687428096000.0;
    r = r * x2 + 1.0 / 1307674368000.0;
    r = r * x2 - 1.0 / 6227020800.0;
    r = r * x2 + 1.0 / 39916800.0;
    r = r * x2 - 1.0 / 362880.0;
    r = r * x2 + 1.0 / 5040.0;
    r = r * x2 - 1.0 / 120.0;
    r = r * x2 + 1.0 / 6.0;
    r = r * x2 - 1.0;
    return -r * x;
}
__device__ __forceinline__ double cos_poly(double x) {
    const double x2 = x * x; double r = -1.0 / 265252859812191058636308480000000.0;
    r = r * x2 + 1.0 / 304888344611713860501504000000.0;
    r = r * x2 - 1.0 / 403291461126605635584000000.0;
    r = r * x2 + 1.0 / 620448401733239439360000.0;
    r = r * x2 - 1.0 / 1124000727777607680000.0;
    r = r * x2 + 1.0 / 2432902008176640000.0;
    r = r * x2 - 1.0 / 6402373705728000.0;
    r = r * x2 + 1.0 / 20922789888000.0;
    r = r * x2 - 1.0 / 87178291200.0;
    r = r * x2 + 1.0 / 479001600.0;
    r = r * x2 - 1.0 / 3628800.0;
    r = r * x2 + 1.0 / 40320.0;
    r = r * x2 - 1.0 / 720.0;
    r = r * x2 + 1.0 / 24.0;
    r = r * x2 - 0.5;
    r = r * x2 + 1.0;
    return r;
}
__device__ __forceinline__ void p0_prologue(const Ctx& C) {
    LAS float* scr = (LAS float*)(C.lds + C.wave * 16384);
    const int gw = C.vcu * NWAVES + C.wave, NGW = C.G * NWAVES, lane = C.lane;
    constexpr int I_IN = (DM / 64) * (INW / 32), I_BRA = (2048 / 64) * (DM / 32), I_SQ = (DM / 64) * (DM / 32), I_UP = (DM / 64) * (FF / 32), I_DN = (FF / 64) * (DM / 32), I_PPI = (PLE / 64) * (DM / 32);
    constexpr int NITEMS = I_IN + I_BRA + 3 * I_SQ + I_UP + I_DN + I_PPI;
    for (int it = gw; it < NITEMS; it += NGW) {
        int r = it;
        if (r < I_IN) { p0_transpose_item(C.in[I_WIN], DM, INW, C.w<bf16_t>(WS_WIN), scr, r, lane, nullptr, CK, CV, 0.0625f); continue; } r -= I_IN;
        if (r < I_BRA) { p0_transpose_item(C.in[I_WBRA], 2048, DM, C.w<bf16_t>(WS_WBRA), scr, r, lane, nullptr, 0, 0, 1.f); continue; } r -= I_BRA;
        if (r < I_SQ) { p0_transpose_item(C.in[I_WBRB], DM, DM, C.w<bf16_t>(WS_WBRB), scr, r, lane, nullptr, 0, 0, 1.f); continue; } r -= I_SQ;
        if (r < I_SQ) { p0_transpose_item(C.in[I_WO], DM, DM, C.w<bf16_t>(WS_WO), scr, r, lane, nullptr, 0, 0, 1.f); continue; } r -= I_SQ;
        if (r < I_SQ) { p0_transpose_item(C.in[I_WPG], DM, DM, C.w<bf16_t>(WS_WPG), scr, r, lane, C.in[I_GPLE], 0, 0, 1.f); continue; } r -= I_SQ;
        if (r < I_UP) { p0_transpose_item(C.in[I_WUP], DM, FF, C.w<bf16_t>(WS_WUP), scr, r, lane, C.in[I_GMLP], 0, 0, 1.f); continue; } r -= I_UP;
        if (r < I_DN) { p0_transpose_item(C.in[I_WDN], FF, DM, C.w<bf16_t>(WS_WDN), scr, r, lane, nullptr, 0, 0, 1.f); continue; } r -= I_DN;
        p0_transpose_item(C.in[I_WPP], PLE, DM, C.w<bf16_t>(WS_WPP), scr, r, lane, nullptr, 0, 0, 1.f);
    }
    const float* gm = C.in[I_GMIX];
    f32x4 gv[4];
#pragma unroll
    for (int j = 0; j < 4; ++j) gv[j] = ((const f32x4*)gm)[lane + 64 * j];
    bf16_t* XN = C.w<bf16_t>(WS_XN); bf16_t* PB = C.w<bf16_t>(WS_PB);
    for (int m = gw; m < MT; m += NGW) {
        const float* xrow = m < MP ? C.in[I_XP] + (size_t)m * DM : C.in[I_XS] + (size_t)(m - MP) * DM;
        const f32x4* xr = (const f32x4*)xrow + lane;
        f32x4 v[4]; float s = 0.f;
#pragma unroll
        for (int j = 0; j < 4; ++j) { v[j] = xr[64 * j]; s += sum4(v[j] * v[j]); }
        const float rstd = rsqrtf(wave_sum(s) * (1.f / DM) + EPS);
        u32x2* o8 = (u32x2*)(XN + (size_t)m * DM) + lane;
#pragma unroll
        for (int j = 0; j < 4; ++j) { const f32x4 y = v[j] * rstd * gv[j]; u32x2 w; w.x = pk2(y[0], y[1]); w.y = pk2(y[2], y[3]); o8[64 * j] = w; }
        const float* prow = m < MP ? C.in[I_PP] + (size_t)m * PLE : C.in[I_PS] + (size_t)(m - MP) * PLE;
        const f32x4 pv = ((const f32x4*)prow)[lane]; u32x2 pw; pw.x = pk2(pv[0], pv[1]); pw.y = pk2(pv[2], pv[3]);
        ((u32x2*)(PB + (size_t)m * PLE))[lane] = pw;
    }
    { const float* w_s = C.in[I_WS]; bf16_t* WSB = C.w<bf16_t>(WS_WSB);
      for (int e = (C.vcu * NTHR + C.tid); e < 8 * 128 * 128; e += C.G * NTHR) { const int n = (e >> 7) & 127, m = e & 127; WSB[e] = (bf16_t)f2bf(m <= n ? w_s[e] : 0.f); } }
    float* cosT = C.w<float>(WS_COS); float* sinT = C.w<float>(WS_SIN);
    for (int e = (C.vcu * NTHR + C.tid); e < NTAB * 128; e += C.G * NTHR) {
        const int ti = e >> 7, i = e & 127; const float pos = ti < 2048 ? (float)ti : (float)(16384 + ti - 2048);
        const float inv = (float)exp2(-(double)i * (13.287712379549449 / 128.0));
        const float ang = pos * inv;
        const double x = (double)ang; const double k = __builtin_rint(x * 0.15915494309189535);
        double r = __builtin_fma(-k, 6.283185307179586, x); r = __builtin_fma(-k, 2.4492935982947064e-16, r);
        cosT[e] = (float)cos_poly(r); sinT[e] = (float)sin_poly(r);
    }
}

template <class F> __device__ __forceinline__ void run_gemm(const Ctx& C, const bf16_t* A, const bf16_t* Bt, int M, int N, int K, const F& f) {
    asm volatile("" : "+s"(K));
    pg8::Gemm g{A, Bt, M, N, K}; pg8::StaticOrder S; S.init(M, N, C.G, (int)blockIdx.x);
    EpiGen<F> E{f};
    pg8::gemm_phase<EpiGen<F>, pg8::StaticOrder, true, true>((PG8_LAS unsigned char*)C.lds, g, S, E);
}

typedef short sbf16x8 __attribute__((ext_vector_type(8)));
typedef float sf32x16 __attribute__((ext_vector_type(16)));
template <class F, int KIND> __device__ __forceinline__ void small_epi(const F& f, int grow, int cA, int cB, f32x4 va, f32x4 vb, int q) {
    float red[2] = {0.f, 0.f};
    const typename F::RowCtx rc = f.template row_begin<KIND>(grow);
    f.template pair<KIND>(rc, grow, cA, va, cB, vb, red);
    if (F::template nred<KIND>() > 0) {
        red[0] += __shfl_xor(red[0], 1); red[0] += __shfl_xor(red[0], 2); red[0] += __shfl_xor(red[0], 4);
        if (F::template nred<KIND>() > 1) { red[1] += __shfl_xor(red[1], 1); red[1] += __shfl_xor(red[1], 2); red[1] += __shfl_xor(red[1], 4); }
        if (q == 0) f.template row_add<KIND>(grow, red);
    }
}
template <class F> __device__ __forceinline__ void small_gemm(const Ctx& C, const bf16_t* A, const bf16_t* Bt, int N, int K, const F& f, bool rot) {
    asm volatile("" : "+s"(K));
    const int ntile = 16 * (N / 64), Kw = K / 8;
    const int wave = C.wave, l31 = C.lane & 31, hh = C.lane >> 5, tid = C.tid;
    LAS float* red = (LAS float*)C.lds;
    for (int t = C.vcu; t < ntile; t += C.G) {
        const int rt = t & 15, ct = t >> 4;
        int cA = ct * 64, cB = cA + 32;
        if (rot && cA < CV) { cA = (ct >> 2) * 256 + (ct & 3) * 32; cB = cA + 128; }
        const int r0 = MP + 32 * rt;
        const bf16_t* pa = A + (size_t)(r0 + l31) * K + wave * Kw + 8 * hh;
        const bf16_t* pb0 = Bt + (size_t)(cA + l31) * K + wave * Kw + 8 * hh;
        const bf16_t* pb1 = Bt + (size_t)(cB + l31) * K + wave * Kw + 8 * hh;
        sf32x16 a0, a1;
#pragma unroll
        for (int i = 0; i < 16; ++i) { a0[i] = 0.f; a1[i] = 0.f; }
#pragma unroll 2
        for (int k = 0; k < Kw; k += 32) {
            const sbf16x8 fa0 = *(const sbf16x8*)(pa + k), fa1 = *(const sbf16x8*)(pa + k + 16);
            const sbf16x8 fb00 = *(const sbf16x8*)(pb0 + k), fb01 = *(const sbf16x8*)(pb0 + k + 16);
            const sbf16x8 fb10 = *(const sbf16x8*)(pb1 + k), fb11 = *(const sbf16x8*)(pb1 + k + 16);
            a0 = __builtin_amdgcn_mfma_f32_32x32x16_bf16(fa0, fb00, a0, 0, 0, 0); a1 = __builtin_amdgcn_mfma_f32_32x32x16_bf16(fa0, fb10, a1, 0, 0, 0);
            a0 = __builtin_amdgcn_mfma_f32_32x32x16_bf16(fa1, fb01, a0, 0, 0, 0); a1 = __builtin_amdgcn_mfma_f32_32x32x16_bf16(fa1, fb11, a1, 0, 0, 0);
        }
        __syncthreads();
#pragma unroll
        for (int i = 0; i < 16; ++i) { const int r = (i & 3) + 8 * (i >> 2) + 4 * hh; red[(wave * 32 + r) * 68 + l31] = a0[i]; red[(wave * 32 + r) * 68 + 32 + l31] = a1[i]; }
        __syncthreads();
        if (tid < 256) {
            const int r = tid >> 3, q = tid & 7;
            f32x4 va = (f32x4){0.f, 0.f, 0.f, 0.f}, vb = va;
#pragma unroll
            for (int w = 0; w < 8; ++w) { va = va + *(const LAS f32x4*)(red + (w * 32 + r) * 68 + 4 * q); vb = vb + *(const LAS f32x4*)(red + (w * 32 + r) * 68 + 32 + 4 * q); }
            const int grow = r0 + r, kind = f.kind(cA);
            if (F::NK == 1) small_epi<F, 0>(f, grow, cA + 4 * q, cB + 4 * q, va, vb, q);
            else switch (kind) {
                case 0: small_epi<F, 0>(f, grow, cA + 4 * q, cB + 4 * q, va, vb, q); break;
                case 1: small_epi<F, (F::NK > 1 ? 1 : 0)>(f, grow, cA + 4 * q, cB + 4 * q, va, vb, q); break;
                case 2: small_epi<F, (F::NK > 2 ? 2 : 0)>(f, grow, cA + 4 * q, cB + 4 * q, va, vb, q); break;
                case 3: small_epi<F, (F::NK > 3 ? 3 : 0)>(f, grow, cA + 4 * q, cB + 4 * q, va, vb, q); break;
                case 4: small_epi<F, (F::NK > 4 ? 4 : 0)>(f, grow, cA + 4 * q, cB + 4 * q, va, vb, q); break;
                default: small_epi<F, (F::NK > 5 ? 5 : 0)>(f, grow, cA + 4 * q, cB + 4 * q, va, vb, q); break;
            }
        }
    }
    __syncthreads();
}
template <class F> __device__ __forceinline__ void run_gemm_split(const Ctx& C, const bf16_t* A, const bf16_t* Bt, int N, int K, const F& f) {
    run_gemm(C, A, Bt, MP, N, K, f);
    small_gemm(C, A, Bt, N, K, f, false);
}
__device__ __forceinline__ void ret_simple_item(const Ctx& C, bool sample, int b, int h, int vs) {
    const int v = C.tid & 63, dg = C.wave, d0 = 32 * dg;
    const int L = sample ? 4 : 2048, row0 = sample ? MP + 4 * b : 2048 * b;
    const float gamma = 1.0f - exp2f(-5.0f - (float)h);
    float S[32];
    const size_t sbase = ((size_t)(b * 4 + h) * 256 + d0) * 512 + vs * 64 + v;
    if (sample) { const float* st = C.in[I_ST] + sbase;
#pragma unroll
        for (int j = 0; j < 32; ++j) S[j] = st[(size_t)j * 512]; }
    else {
#pragma unroll
        for (int j = 0; j < 32; ++j) S[j] = 0.f; }
    const bf16_t* Z = C.w<bf16_t>(WS_Z); bf16_t* OR = C.w<bf16_t>(WS_ORAW);
    LAS float* part = (LAS float*)C.lds;
    for (int t = 0; t < L; ++t) {
        const int row = row0 + t; const bf16_t* zr = Z + (size_t)row * INW;
        const float vv = bf2f(zr[CV + h * 512 + vs * 64 + v]);
        const u32x4* qp = (const u32x4*)(zr + CQ + h * 256 + d0); const u32x4* kp = (const u32x4*)(zr + CK + h * 256 + d0);
        float o = 0.f;
#pragma unroll
        for (int c = 0; c < 4; ++c) { const u32x4 qw = qp[c], kw = kp[c];
#pragma unroll
            for (int e = 0; e < 4; ++e) { const unsigned q2 = qw[e], k2 = kw[e]; const int j = c * 8 + e * 2;
                S[j] = gamma * S[j] + __uint_as_float(k2 << 16) * vv; o += __uint_as_float(q2 << 16) * S[j];
                S[j + 1] = gamma * S[j + 1] + __uint_as_float(k2 & 0xffff0000u) * vv; o += __uint_as_float(q2 & 0xffff0000u) * S[j + 1]; } }
        part[((t & 1) * 8 + dg) * 64 + v] = o;
        __syncthreads();
        if (dg == 0) { float ot = 0.f;
#pragma unroll
            for (int g = 0; g < 8; ++g) ot += part[((t & 1) * 8 + g) * 64 + v];
            OR[(size_t)row * 2048 + h * 512 + vs * 64 + v] = (bf16_t)f2bf(ot); }
    }
    float* so = C.out + (sample ? O_SRS : O_SRP) + sbase;
#pragma unroll
    for (int j = 0; j < 32; ++j) so[(size_t)j * 512] = S[j];
    __syncthreads();
}
typedef short bf16x8 __attribute__((ext_vector_type(8)));
typedef short s16x4 __attribute__((ext_vector_type(4)));
typedef short v4i16_t __attribute__((ext_vector_type(4)));
typedef float f32x16 __attribute__((ext_vector_type(16)));
constexpr int R_QS = 528, R_VS = 192, R_PS = 144;
constexpr int R_Q = 0, R_K = R_Q + 64 * R_QS, R_ST = R_K + 64 * R_QS, R_V = R_ST + 64 * R_QS, R_VD = R_V + 64 * R_VS, R_P = R_VD + 64 * R_VS, R_END = R_P + 64 * R_PS;
static_assert(R_END <= LDS_MISC, "retention LDS map");
__device__ __forceinline__ s16x4 vtr(const LAS unsigned char* p) { return __builtin_bit_cast(s16x4, __builtin_amdgcn_ds_read_tr16_b64_v4i16((LAS v4i16_t*)p)); }
#define MFMA32(a, b, c) __builtin_amdgcn_mfma_f32_32x32x16_bf16((a), (b), (c), 0, 0, 0)
__device__ __forceinline__ bf16x8 tr_frag(const LAS unsigned char* a, int stride) { const s16x4 lo = vtr(a), hi = vtr(a + 4 * stride); return (bf16x8){lo[0], lo[1], lo[2], lo[3], hi[0], hi[1], hi[2], hi[3]}; }
__device__ __forceinline__ void ret_mfma_item(const Ctx& C, int b, int h, int vs) {
    const int tid = C.tid, lane = C.lane, wave = C.wave, l31_ = lane & 31, hh_ = lane >> 5;
    const LAS unsigned char* lds = C.lds;
    const bf16_t* Z = C.w<bf16_t>(WS_Z); bf16_t* OR = C.w<bf16_t>(WS_ORAW);
    const float lg = log2f(1.0f - exp2f(-5.0f - (float)h));
    const int row00 = b * 2048;
    for (int e = tid; e < 64 * R_QS / 16; e += NTHR) *(LAS u32x4*)(C.lds + R_ST + e * 16) = (u32x4){0u, 0u, 0u, 0u};
    f32x16 S0, S1;
#pragma unroll
    for (int i = 0; i < 16; ++i) { S0[i] = 0.f; S1[i] = 0.f; }
    u32x4 gq[4], gk[4], gv;
    const int qrow = tid >> 5, qch = tid & 31, vrow = tid >> 3, vch = tid & 7;
    const bf16_t* zq = Z + (size_t)row00 * INW + CQ + h * 256 + qch * 8;
    const bf16_t* zk = Z + (size_t)row00 * INW + CK + h * 256 + qch * 8;
    const bf16_t* zv = Z + (size_t)row00 * INW + CV + h * 512 + vs * 64 + vch * 8;
#define RET_LOAD(ci) do { _Pragma("unroll") for (int j = 0; j < 4; ++j) { const size_t ro = (size_t)((ci) * 64 + qrow + 16 * j) * INW; gq[j] = *(const u32x4*)(zq + ro); gk[j] = *(const u32x4*)(zk + ro); } \
        gv = *(const u32x4*)(zv + (size_t)((ci) * 64 + vrow) * INW); } while (0)
    RET_LOAD(0);
    const float vdsc = exp2f((float)(63 - vrow) * lg);
    const float g64 = exp2f(64.0f * lg);
    for (int ci = 0; ci < 32; ++ci) {
        int l31 = l31_, hh = hh_; asm volatile("" : "+v"(l31), "+v"(hh));
#pragma unroll
        for (int j = 0; j < 4; ++j) { *(LAS u32x4*)(C.lds + R_Q + (qrow + 16 * j) * R_QS + qch * 16) = gq[j]; *(LAS u32x4*)(C.lds + R_K + (qrow + 16 * j) * R_QS + qch * 16) = gk[j]; }
        *(LAS u32x4*)(C.lds + R_V + vrow * R_VS + vch * 16) = gv;
        { u32x4 d;
#pragma unroll
          for (int e = 0; e < 4; ++e) { const unsigned w = gv[e]; d[e] = pk2(__uint_as_float(w << 16) * vdsc, __uint_as_float(w & 0xffff0000u) * vdsc); }
          *(LAS u32x4*)(C.lds + R_VD + vrow * R_VS + vch * 16) = d; }
        __syncthreads();
        if (ci + 1 < 32) RET_LOAD(ci + 1);
        const int rowoff = l31, koff = 16 * hh;
        const int tr_q = (l31 & 15) >> 2, tr_p = l31 & 3, tr_blk = (l31 >> 4) & 1;
        f32x16 acc;
#pragma unroll
        for (int i = 0; i < 16; ++i) acc[i] = 0.f;
        if (wave < 3) {
            const int st = wave >> 1, tt = wave == 0 ? 0 : 1;
            const LAS unsigned char* pa = lds + R_K + (32 * st + rowoff) * R_QS + koff;
            const LAS unsigned char* pb = lds + R_Q + (32 * tt + rowoff) * R_QS + koff;
#pragma unroll 4
            for (int ks = 0; ks < 16; ++ks) acc = MFMA32(*(const LAS bf16x8*)(pa + ks * 32), *(const LAS bf16x8*)(pb + ks * 32), acc);
            const int t = 32 * tt + l31;
#pragma unroll
            for (int g = 0; g < 4; ++g) { float pv[4];
#pragma unroll
                for (int e = 0; e < 4; ++e) { const int s = 32 * st + 8 * g + 4 * hh + e; pv[e] = (t >= s) ? acc[4 * g + e] * __builtin_amdgcn_exp2f((float)(t - s) * lg) : 0.f; }
                u32x2 w; w.x = cvtpk(pv[0], pv[1]); w.y = cvtpk(pv[2], pv[3]);
                *(LAS u32x2*)(C.lds + R_P + t * R_PS + (32 * st + 8 * g + 4 * hh) * 2) = w; }
        } else if (wave >= 4) {
            const int tt = (wave >> 1) & 1, vt = wave & 1;
            const LAS unsigned char* pa = lds + R_Q + (32 * tt + rowoff) * R_QS + koff;
            const LAS unsigned char* pb = lds + R_ST + (32 * vt + rowoff) * R_QS + koff;
#pragma unroll 4
            for (int ks = 0; ks < 16; ++ks) acc = MFMA32(*(const LAS bf16x8*)(pa + ks * 32), *(const LAS bf16x8*)(pb + ks * 32), acc);
#pragma unroll
            for (int i = 0; i < 16; ++i) { const int t = 32 * tt + (i & 3) + 8 * (i >> 2) + 4 * hh; acc[i] *= __builtin_amdgcn_exp2f((float)(t + 1) * lg); }
        }
        __syncthreads();
        if (wave >= 4) {
            const int tt = (wave >> 1) & 1, vt = wave & 1;
            const LAS unsigned char* pa = lds + R_P + (32 * tt + rowoff) * R_PS + koff;
            const LAS unsigned char* pb = lds + R_V + (8 * hh + tr_q) * R_VS + (32 * vt + 16 * tr_blk + 4 * tr_p) * 2;
            for (int ks = 0; ks < 2 * tt + 2; ++ks) acc = MFMA32(*(const LAS bf16x8*)(pa + ks * 32), tr_frag(pb + 16 * ks * R_VS, R_VS), acc);
            bf16_t* orow = OR + (size_t)(row00 + ci * 64 + 32 * tt) * 2048 + h * 512 + vs * 64 + 32 * vt + l31;
#pragma unroll
            for (int i = 0; i < 16; ++i) { const int tl = (i & 3) + 8 * (i >> 2) + 4 * hh; orow[(size_t)tl * 2048] = (bf16_t)f2bf(acc[i]); }
        }
        {
#pragma unroll
            for (int i = 0; i < 16; ++i) { S0[i] *= g64; S1[i] *= g64; }
            const LAS unsigned char* pa = lds + R_K + (8 * hh + tr_q) * R_QS + (32 * wave + 16 * tr_blk + 4 * tr_p) * 2;
            const LAS unsigned char* pb = lds + R_VD + (8 * hh + tr_q) * R_VS + (16 * tr_blk + 4 * tr_p) * 2;
#pragma unroll
            for (int ks = 0; ks < 4; ++ks) { const bf16x8 a = tr_frag(pa + 16 * ks * R_QS, R_QS);
                S0 = MFMA32(a, tr_frag(pb + 16 * ks * R_VS, R_VS), S0); S1 = MFMA32(a, tr_frag(pb + 16 * ks * R_VS + 64, R_VS), S1); }
#pragma unroll
            for (int g = 0; g < 4; ++g) { u32x2 w0, w1; w0.x = cvtpk(S0[4 * g], S0[4 * g + 1]); w0.y = cvtpk(S0[4 * g + 2], S0[4 * g + 3]); w1.x = cvtpk(S1[4 * g], S1[4 * g + 1]); w1.y = cvtpk(S1[4 * g + 2], S1[4 * g + 3]);
                *(LAS u32x2*)(C.lds + R_ST + l31 * R_QS + (32 * wave + 8 * g + 4 * hh) * 2) = w0;
                *(LAS u32x2*)(C.lds + R_ST + (32 + l31) * R_QS + (32 * wave + 8 * g + 4 * hh) * 2) = w1; }
        }
        __syncthreads();
    }
#undef RET_LOAD
    float* so = C.out + O_SRP + ((size_t)(b * 4 + h) * 256 + 32 * wave) * 512 + vs * 64 + l31_;
#pragma unroll
    for (int i = 0; i < 16; ++i) { const int dl = (i & 3) + 8 * (i >> 2) + 4 * hh_; so[(size_t)dl * 512] = S0[i]; so[(size_t)dl * 512 + 32] = S1[i]; }
}
__device__ __forceinline__ void p2_retention_simple(const Ctx& C) {
#ifdef RET_SIMPLE
    for (int it = C.vcu; it < 256; it += C.G) ret_simple_item(C, false, it >> 5, (it >> 3) & 3, it & 7);
#else
    for (int it = C.vcu; it < 256; it += C.G) ret_mfma_item(C, it >> 5, (it >> 3) & 3, it & 7);
    __syncthreads();
#endif
    for (int it = C.vcu; it < 4096; it += C.G) ret_simple_item(C, true, it >> 5, (it >> 3) & 3, it & 7);
}
constexpr int G_WS = 272, G_GS = 320, G_W = 0, G_G = G_W + 128 * G_WS, G_END = G_G + 128 * G_GS;
static_assert(G_END <= LDS_MISC, "gating LDS map");
__device__ __forceinline__ void p2_gating_mfma(const Ctx& C) {
    const int tid = C.tid, wave = C.wave, l31 = C.lane & 31, hh = C.lane >> 5;
    const LAS unsigned char* lds = C.lds;
    const bf16_t* Z = C.w<bf16_t>(WS_Z); const float* LNS = C.w<float>(WS_LNS); bf16_t* YB = C.w<bf16_t>(WS_YB); const bf16_t* WSB = C.w<bf16_t>(WS_WSB);
    const float* b_s = C.in[I_BS]; const float* g_gm = C.in[I_GGM];
    int g_staged = -1;
    for (int it = C.vcu; it < 1024; it += C.G) {
        const int g = it & 7, row0 = (it >> 3) * 128;
        __syncthreads();
        if (g != g_staged) { g_staged = g;
#pragma unroll
            for (int j = 0; j < 4; ++j) { const int idx = tid + NTHR * j, r = idx >> 4, c16 = idx & 15;
                *(LAS u32x4*)(C.lds + G_W + r * G_WS + c16 * 16) = *(const u32x4*)(WSB + ((size_t)g * 128 + r) * 128 + c16 * 8); } }
        { const int c16 = tid & 15; const f32x4 gg0 = *(const f32x4*)(g_gm + g * 128 + c16 * 8), gg1 = *(const f32x4*)(g_gm + g * 128 + c16 * 8 + 4);
#pragma unroll
          for (int j = 0; j < 4; ++j) { const int m = (tid >> 4) + 32 * j, row = row0 + m;
              const float mu = LNS[2 * row] * (1.f / 1024.f), var = LNS[2 * row + 1] * (1.f / 1024.f) - mu * mu, rstd = rsqrtf(var + EPS);
              const bf16_t* src = Z + (size_t)row * INW + CGV + g * 128 + c16 * 8;
              const f32x4 x0 = ld_bf4(src), x1 = ld_bf4(src + 4);
              const f32x4 y0 = (x0 - mu) * rstd * gg0, y1 = (x1 - mu) * rstd * gg1;
              u32x4 w; w.x = cvtpk(y0[0], y0[1]); w.y = cvtpk(y0[2], y0[3]); w.z = cvtpk(y1[0], y1[1]); w.w = cvtpk(y1[2], y1[3]);
              *(LAS u32x4*)(C.lds + G_G + m * G_GS + c16 * 16) = w; } }
        __syncthreads();
        const int nt = wave >> 1, ct0 = 2 * (wave & 1);
        f32x16 a0, a1;
#pragma unroll
        for (int i = 0; i < 16; ++i) { a0[i] = 0.f; a1[i] = 0.f; }
        const int tr_q = (l31 & 15) >> 2, tr_p = l31 & 3, tr_blk = (l31 >> 4) & 1;
        const LAS unsigned char* pw = lds + G_W + (32 * nt + l31) * G_WS + 16 * hh;
        const LAS unsigned char* pg = lds + G_G + (8 * hh + tr_q) * G_GS + (32 * ct0 + 16 * tr_blk + 4 * tr_p) * 2;
        for (int ks = 0; ks < 2 * nt + 2; ++ks) { const bf16x8 bw = *(const LAS bf16x8*)(pw + ks * 32);
            a0 = MFMA32(tr_frag(pg + 16 * ks * G_GS, G_GS), bw, a0); a1 = MFMA32(tr_frag(pg + 16 * ks * G_GS + 64, G_GS), bw, a1); }
        const int n = 32 * nt + l31, row = row0 + n; const float bias = b_s[g * 128 + n];
        const bf16_t* up = Z + (size_t)row * INW + CU + g * 128 + 32 * ct0 + 4 * hh; bf16_t* yp = YB + (size_t)row * DM + g * 128 + 32 * ct0 + 4 * hh;
#pragma unroll
        for (int q4 = 0; q4 < 4; ++q4) {
            const f32x4 o0 = (f32x4){a0[4 * q4], a0[4 * q4 + 1], a0[4 * q4 + 2], a0[4 * q4 + 3]} + bias, o1 = (f32x4){a1[4 * q4], a1[4 * q4 + 1], a1[4 * q4 + 2], a1[4 * q4 + 3]} + bias;
            st_bf4(yp + 8 * q4, ld_bf4(up + 8 * q4) * o0); st_bf4(yp + 32 + 8 * q4, ld_bf4(up + 32 + 8 * q4) * o1); }
    }
    __syncthreads();
}
template <int CH> __device__ __forceinline__ void gate_simple_item(const Ctx& C, int row0, float* gmv_out) {
    LAS float* gvl = (LAS float*)C.lds;
    LAS float* wl = (LAS float*)(C.lds + 65536);
    const bf16_t* Z = C.w<bf16_t>(WS_Z); const float* LNS = C.w<float>(WS_LNS); bf16_t* YB = C.w<bf16_t>(WS_YB);
    const float* w_s = C.in[I_WS]; const float* b_s = C.in[I_BS]; const float* g_gm = C.in[I_GGM];
    for (int g = 0; g < 8; ++g) {
        for (int e = C.tid; e < CH * 128; e += NTHR) { const int m = e >> 7, ch = e & 127; const int row = row0 + m;
            const float mu = LNS[2 * row] * (1.f / 1024.f), var = LNS[2 * row + 1] * (1.f / 1024.f) - mu * mu, rstd = rsqrtf(var + EPS);
            const float x = bf2f(Z[(size_t)row * INW + CGV + g * 128 + ch]); const float y = (x - mu) * rstd * g_gm[g * 128 + ch];
            gvl[e] = y; if (gmv_out) gmv_out[(size_t)m * 1024 + g * 128 + ch] = y;
            wl[e] = (ch < CH) ? w_s[((size_t)g * 128 + m) * 128 + ch] : 0.f; }
        __syncthreads();
        const int ch = C.tid & 127;
        for (int n = C.tid >> 7; n < CH; n += 4) { float acc = b_s[g * 128 + n];
            for (int m = 0; m <= n; ++m) acc += wl[n * 128 + m] * gvl[m * 128 + ch];
            const int row = row0 + n; const float u = bf2f(Z[(size_t)row * INW + CU + g * 128 + ch]);
            YB[(size_t)row * DM + g * 128 + ch] = (bf16_t)f2bf(u * acc); }
        __syncthreads();
    }
}
__device__ __forceinline__ void p2_gating_simple(const Ctx& C) {
#ifdef GATE_SIMPLE
    for (int it = C.vcu; it < 128; it += C.G) gate_simple_item<128>(C, (it >> 4) * 2048 + (it & 15) * 128, nullptr);
#else
    p2_gating_mfma(C);
#endif
    for (int it = C.vcu; it < 128; it += C.G) gate_simple_item<4>(C, MP + 4 * it, C.out + O_GMV + (size_t)it * 4 * 1024);
}
__device__ __forceinline__ void p3_finalize_ya(const Ctx& C) {
    const bf16_t* Z = C.w<bf16_t>(WS_Z); const bf16_t* OR = C.w<bf16_t>(WS_ORAW); bf16_t* YA = C.w<bf16_t>(WS_YA);
    const float* g_ret = C.in[I_GRET];
    const int gw = C.vcu * NWAVES + C.wave, NGW = C.G * NWAVES, lane = C.lane;
    for (int row = gw; row < MT; row += NGW) {
        f32x4 o[8]; float rs[4];
#pragma unroll
        for (int j = 0; j < 8; ++j) o[j] = ld_bf4(OR + (size_t)row * 2048 + 4 * lane + 256 * j);
#pragma unroll
        for (int hd = 0; hd < 4; ++hd) rs[hd] = rsqrtf(wave_sum(sum4(o[2 * hd] * o[2 * hd]) + sum4(o[2 * hd + 1] * o[2 * hd + 1])) * (1.f / 512.f) + EPS);
#pragma unroll
        for (int j = 0; j < 8; ++j) { const int c = 4 * lane + 256 * j;
            const f32x4 gz = ld_bf4(Z + (size_t)row * INW + CG + c), gr = *(const f32x4*)(g_ret + c);
            st_bf4(YA + (size_t)row * 2048 + c, gz * o[j] * rs[j >> 1] * gr); }
    }
}
__device__ __forceinline__ void p9_final_norm(const Ctx& C) {
    const float* H3 = C.w<float>(WS_H3); const float* SSQ4 = C.w<float>(WS_SSQ4); const float* gf = C.in[I_GFIN];
    const int gw = C.vcu * NWAVES + C.wave, NGW = C.G * NWAVES, lane = C.lane;
    f32x4 gv[4];
#pragma unroll
    for (int j = 0; j < 4; ++j) gv[j] = ((const f32x4*)gf)[lane + 64 * j];
    for (int row = gw; row < MT; row += NGW) {
        const float rs = rsqrtf(SSQ4[row] * (1.f / DM) + EPS);
        const f32x4* hr = (const f32x4*)(H3 + (size_t)row * DM) + lane; f32x4* o = (f32x4*)(C.out + O_Y + (size_t)row * DM) + lane;
#pragma unroll
        for (int j = 0; j < 4; ++j) o[64 * j] = hr[64 * j] * rs * gv[j];
    }
}

#ifdef DBG_EXPORT
__device__ __forceinline__ void dbg_export(const Ctx& C) {
    const bf16_t* Z = C.w<bf16_t>(WS_Z); const bf16_t* YA = C.w<bf16_t>(WS_YA); const bf16_t* YB = C.w<bf16_t>(WS_YB);
    const int gw = C.vcu * NWAVES + C.wave, NGW = C.G * NWAVES, lane = C.lane;
    for (int row = gw; row < MT; row += NGW)
        for (int j = 0; j < 4; ++j) { const int c = 4 * lane + 256 * j;
            f32x4 v = (f32x4){0.f, 0.f, 0.f, 0.f};
#if DBG_EXPORT == 1
            v = ld_bf4(YB + (size_t)row * DM + c);
#elif DBG_EXPORT == 4
            v = ld_bf4(YA + (size_t)row * 2048 + c) + ld_bf4(YA + (size_t)row * 2048 + 1024 + c);
#elif DBG_EXPORT == 5
            v = ld_bf4(Z + (size_t)row * INW + CGA + c) + ld_bf4(Z + (size_t)row * INW + CGB + c);
#elif DBG_EXPORT == 6
            v = ld_bf4(C.w<bf16_t>(WS_ORAW) + (size_t)row * 2048 + c) + ld_bf4(C.w<bf16_t>(WS_ORAW) + (size_t)row * 2048 + 1024 + c);
#elif DBG_EXPORT == 7
            v = ld_bf4(Z + (size_t)row * INW + CG + c) + ld_bf4(Z + (size_t)row * INW + CG + 1024 + c);
#elif DBG_EXPORT == 8
            v = ld_bf4(Z + (size_t)row * INW + CQ + c);
#endif
            *(f32x4*)(C.out + O_Y + (size_t)row * DM + c) = v; }
}
#endif
constexpr int NPHASE = 10;
__global__ void __launch_bounds__(NTHR, 2) mk_fwd(Args args) {
    extern __shared__ __attribute__((aligned(16))) unsigned char lds_raw[];
    Ctx C;
    C.lds = (LAS unsigned char*)lds_raw; C.tid = threadIdx.x; C.lane = C.tid & 63; C.wave = __builtin_amdgcn_readfirstlane(C.tid >> 6);
    C.G = gridDim.x; { const int bx = blockIdx.x; C.vcu = (C.G % 8 == 0) ? (bx % 8) * (C.G / 8) + bx / 8 : bx; }
    C.in = args.in; C.out = args.out; C.ws = args.ws;
    const int lo = args.ph_lo, hi = args.ph_hi;
    if (C.tid < 64) ((LAS unsigned*)(C.lds + LDS_MISC))[C.tid] = 0u;
    __syncthreads();
    const XcdBarrier bar = xcd_barrier_post((unsigned*)(args.ws + WS_CTL) + 4096, (volatile LAS unsigned*)(C.lds + LDS_MISC));
#define IN(k) (lo <= (k) && (k) < hi)
#define SEAM(k) do { if (IN(k) && IN((k) + 1)) { GRID_BAR(); } } while (0)
#define GRID_BAR() do { xcd_barrier(bar); } while (0)
    if (IN(0)) { p0_prologue(C); } if (IN(0) && IN(1)) cooperative_groups::this_grid().sync();
    if (IN(1)) { F1 f{C.w<bf16_t>(WS_Z), C.w<float>(WS_COS), C.w<float>(WS_SIN), C.w<float>(WS_LNS)}; run_gemm(C, C.w<bf16_t>(WS_XN), C.w<bf16_t>(WS_WIN), MT, INW, DM, f); } SEAM(1);
    if (IN(2)) { p2_retention_simple(C); p2_gating_simple(C); } SEAM(2);
    if (IN(3)) { p3_finalize_ya(C); } SEAM(3);
    if (IN(4)) { { F2a f{C.w<bf16_t>(WS_Z), C.w<float>(WS_T)}; run_gemm_split(C, C.w<bf16_t>(WS_YA), C.w<bf16_t>(WS_WBRA), DM, 2048, f); }
                 { F2b f{C.w<bf16_t>(WS_Z), C.w<float>(WS_T), C.w<bf16_t>(WS_MG)}; run_gemm_split(C, C.w<bf16_t>(WS_YB), C.w<bf16_t>(WS_WBRB), DM, DM, f); } } SEAM(4);
    if (IN(5)) { FRes f{C.in[I_XP], C.in[I_XS], C.w<float>(WS_H1), C.w<bf16_t>(WS_H1B), C.w<float>(WS_SSQ2)}; run_gemm_split(C, C.w<bf16_t>(WS_MG), C.w<bf16_t>(WS_WO), DM, DM, f); } SEAM(5);
    if (IN(6)) { F4 f{C.w<float>(WS_SSQ2), C.w<bf16_t>(WS_U)}; run_gemm_split(C, C.w<bf16_t>(WS_H1B), C.w<bf16_t>(WS_WUP), FF, DM, f); } SEAM(6);
    if (IN(7)) { FRes f{C.w<float>(WS_H1), C.w<float>(WS_H1) + (size_t)MP * DM, C.w<float>(WS_H2), C.w<bf16_t>(WS_H2B), C.w<float>(WS_SSQ3)}; run_gemm_split(C, C.w<bf16_t>(WS_U), C.w<bf16_t>(WS_WDN), DM, FF, f); } SEAM(7);
    if (IN(8)) { { F6a f{C.w<float>(WS_PE)}; run_gemm_split(C, C.w<bf16_t>(WS_PB), C.w<bf16_t>(WS_WPP), DM, PLE, f); }
                 { F6b f{C.w<float>(WS_SSQ3), C.w<float>(WS_H2), C.w<float>(WS_PE), C.w<float>(WS_H3), C.w<float>(WS_SSQ4)}; run_gemm_split(C, C.w<bf16_t>(WS_H2B), C.w<bf16_t>(WS_WPG), DM, DM, f); } } SEAM(8);
    if (IN(9)) { p9_final_norm(C); }
#ifdef DBG_EXPORT
    if (IN(10)) { dbg_export(C); }
#endif
#undef IN
#undef SEAM
#undef GRID_BAR
}
}

extern "C" void kernel_launch(void* const* d_in, const int* in_sizes, int n_in, void* d_out, int out_size, void* d_ws, size_t ws_size, hipStream_t stream) {
    using namespace mk;
    static int grid = 0;
    if (grid == 0) {
        if (n_in != 21 || (size_t)out_size != O_END || ws_size < WS_END) { fprintf(stderr, "kernel_launch: unexpected shapes: n_in %d out %d ws %zu (need %zu)\n", n_in, out_size, ws_size, (size_t)WS_END); grid = -1; return; }
        int dev = 0, cus = 0;
        if (hipGetDevice(&dev) != hipSuccess || hipDeviceGetAttribute(&cus, hipDeviceAttributeMultiprocessorCount, dev) != hipSuccess) { grid = -1; return; }
        if (hipFuncSetAttribute((const void*)mk_fwd, hipFuncAttributeMaxDynamicSharedMemorySize, LDS_BYTES) != hipSuccess) { fprintf(stderr, "kernel_launch: hipFuncSetAttribute failed\n"); grid = -1; return; }
        int per_cu = 0;
        if (hipOccupancyMaxActiveBlocksPerMultiprocessor(&per_cu, (const void*)mk_fwd, NTHR, LDS_BYTES) != hipSuccess || per_cu < 1) { fprintf(stderr, "kernel_launch: occupancy query says %d blocks/CU\n", per_cu); (void)hipGetLastError(); grid = -1; return; }
        grid = cus;
    }
    if (grid < 0) return;
    (void)hipMemsetAsync((char*)d_ws, 0, WS_ZERO_END, stream);
    Args a{};
    for (int i = 0; i < 21; ++i) a.in[i] = (const float*)d_in[i];
    a.out = (float*)d_out; a.ws = (unsigned char*)d_ws;
#ifdef MK_MULTI
    for (int p = 0; p < NPHASE; ++p) { a.ph_lo = p; a.ph_hi = p + 1; hipLaunchKernelGGL(mk_fwd, dim3(grid), dim3(NTHR), LDS_BYTES, stream, a); }
#else
    a.ph_lo = 0; a.ph_hi = NPHASE;
    void* kargs[] = {&a};
    const hipError_t le = hipLaunchCooperativeKernel((const void*)mk_fwd, dim3(grid), dim3(NTHR), kargs, LDS_BYTES, stream);
    if (le != hipSuccess) fprintf(stderr, "kernel_launch: cooperative launch failed: %s (grid %d)\n", hipGetErrorString(le), grid);
#endif
}
```

```cpp
#include <hip/hip_runtime.h>
#include <hip/hip_cooperative_groups.h>
#include <cstdio>
#include <cstdint>
namespace pg8 {
#define PG8_LAS __attribute__((address_space(3)))
typedef unsigned short bf16_t;
typedef short bf16x8 __attribute__((ext_vector_type(8)));
typedef float f32x4 __attribute__((ext_vector_type(4)));
typedef unsigned u32x4 __attribute__((ext_vector_type(4)));
constexpr int BM = 256, BK = 64, HALF = 128, HTB = HALF * BK * 2  , STAGE_BYTES = 8 * HTB, NXCD = 8, WGM = 8;

__host__ __device__ __forceinline__ int lds_byte(int r, int c) { const int st = (r >> 4) * 2 + (c >> 5), rr = r & 15, cc = c & 31, ob = rr * 64 + cc * 2; return st * 1024 + (ob ^ (((ob >> 9) & 1) << 5)); }
__host__ __device__ __forceinline__ void stage_rc(int b, int& R, int& C) { const int st = b / 1024, sb = b % 1024, swz = sb ^ (((sb >> 9) & 1) << 5); R = (st >> 1) * 16 + swz / 64; C = (st & 1) * 32 + (swz % 64) / 2; }
__host__ __device__ __forceinline__ int perm32(int rho) { const int n = rho >> 4, i = rho & 15; return 8 * (i >> 2) + 4 * n + (i & 3); }

struct Unit { int pm, pn; };
struct Gemm { const bf16_t* A; const bf16_t* Bt; int M, N, K; };

struct StaticOrder {
    int nM, nN, nwg, G, c;
    __host__ __device__ void init(int M, int N, int G_, int c_) { nM = M / BM; nN = N / BM; nwg = nM * nN; G = G_; c = c_; }
    __host__ __device__ bool next(int i, Unit& u) const {
        const long L = (long)i * G + c; if (L >= nwg) return false;
        int wgid = (int)L; { const int q = nwg / NXCD, r = nwg % NXCD, xcd = wgid % NXCD, off = wgid / NXCD; wgid = (xcd < r ? xcd * (q + 1) : r * (q + 1) + (xcd - r) * q) + off; }
        const int nig = WGM * nN, gid = wgid / nig, fm = gid * WGM, gsz = (nM - fm) < WGM ? (nM - fm) : WGM;
        u.pm = fm + ((wgid % nig) % gsz); u.pn = (wgid % nig) / gsz; return true;
    }
    __device__ __forceinline__ void a_ready(const Unit&) const {}
    __device__ __forceinline__ void done(const Unit&) const {}
};

__device__ __forceinline__ unsigned cvt_pk_bf16(float lo, float hi) { unsigned r; asm volatile("v_cvt_pk_bf16_f32 %0, %1, %2" : "=v"(r) : "v"(lo), "v"(hi)); return r; }
typedef float f32x2 __attribute__((ext_vector_type(2)));
__device__ __forceinline__ f32x2 gelu_pk(f32x2 v) {
    const f32x2 av = __builtin_elementwise_abs(v), d = av * 0.2316418882f + 1.0f;
    f32x2 t; t.x = __builtin_amdgcn_rcpf(d.x); t.y = __builtin_amdgcn_rcpf(d.y);
    f32x2 q = t * 0.5307027145f + (-0.7265760135f); q = q * t + 0.7107068705f; q = q * t + (-0.142248368f); q = q * t + 0.127414796f; q = q * t;
    const f32x2 s = (v * v) * (-0.72134752044f);
    f32x2 e; e.x = __builtin_amdgcn_exp2f(s.x); e.y = __builtin_amdgcn_exp2f(s.y);
    const f32x2 m = v * (q * e), r = v - m;
    f32x2 o; o.x = v.x < 0.f ? m.x : r.x; o.y = v.y < 0.f ? m.y : r.y; return o;
}
template <class Epi, class Sched, bool ALIGN_EPI = false, bool SP2 = false>
__device__ __forceinline__ void gemm_phase(PG8_LAS unsigned char* lds, const Gemm g, const Sched& S, const Epi& E) {
    const int tid = threadIdx.x, wid = __builtin_amdgcn_readfirstlane(tid >> 6), lane = tid & 63, wr = wid >> 2, wc = wid & 3, fr = lane & 15, fq = lane >> 4;
    const int K = g.K, nt = K / BK;
    unsigned voffA[2], voffB[2];
#pragma unroll
    for (int i = 0; i < 2; ++i) { int R, C; stage_rc(tid * 16 + i * 8192, R, C); const int Rb = Epi::PERM ? ((R & ~31) + perm32(R & 31)) : R;
        voffA[i] = (unsigned)(R * K + C) * 2u; voffB[i] = (unsigned)(Rb * K + C) * 2u; }
    const size_t kstep = (size_t)(BK * 2);
    const size_t hstep = (size_t)HALF * K * 2;
    const size_t tstep = 2 * hstep;
    const unsigned ldsw = (unsigned)wid * 1024u;
    const int aoff = lds_byte(wr * 64 + fr, fq * 8), boff = lds_byte(wc * 32 + fr, fq * 8);
#define PG8_SA(b, h) (((b) * 2 + (h)) * HTB)
#define PG8_SB(b, h) ((4 + (b) * 2 + (h)) * HTB)
#define PG8_STAGE(bufoff, gbase, voff) do { _Pragma("unroll") for (int _i = 0; _i < 2; ++_i) \
        __builtin_amdgcn_global_load_lds((const unsigned*)((const char*)(gbase) + (voff)[_i]), (PG8_LAS unsigned*)(lds + (bufoff) + ldsw + _i * 8192), 16, 0, 0); } while (0)
#define PG8_LDA(dst, b, h) do { _Pragma("unroll") for (int m = 0; m < 4; ++m) _Pragma("unroll") for (int k = 0; k < 2; ++k) dst[m][k] = *(const PG8_LAS bf16x8*)(lds + PG8_SA(b, h) + aoff + m * 2048 + k * 1024); } while (0)
#define PG8_LDB(dst, b, h) do { _Pragma("unroll") for (int n = 0; n < 2; ++n) _Pragma("unroll") for (int k = 0; k < 2; ++k) dst[n][k] = *(const PG8_LAS bf16x8*)(lds + PG8_SB(b, h) + boff + n * 2048 + k * 1024); } while (0)
#define PG8_MMA(ai, bj, At, Bt) do { __builtin_amdgcn_s_setprio(1); _Pragma("unroll") for (int m = 0; m < 4; ++m) _Pragma("unroll") for (int n = 0; n < 2; ++n) _Pragma("unroll") for (int k = 0; k < 2; ++k) \
        acc[ai][bj][m][n] = __builtin_amdgcn_mfma_f32_16x16x32_bf16(Bt[n][k], At[m][k], acc[ai][bj][m][n], 0, 0, 0); __builtin_amdgcn_s_setprio(0); } while (0)
#define PG8_WAIT_V(n) asm volatile("s_waitcnt vmcnt(" #n ")" ::: "memory")
#define PG8_WAIT_L(n) asm volatile("s_waitcnt lgkmcnt(" #n ")" ::: "memory")
#define PG8_BAR __builtin_amdgcn_s_barrier()
#define PG8_SCHED __builtin_amdgcn_sched_barrier(0)
    Unit cur, nxt; int ui = 0;
    if (!S.next(0, cur)) return;
    f32x4 acc[2][2][4][2];
#pragma unroll
    for (int a = 0; a < 2; ++a)
#pragma unroll
        for (int b = 0; b < 2; ++b)
#pragma unroll
            for (int m = 0; m < 4; ++m)
#pragma unroll
                for (int n = 0; n < 2; ++n) acc[a][b][m][n] = (f32x4){0.f, 0.f, 0.f, 0.f};
    bf16x8 At[4][2], B0[2][2], B1[2][2];
    const char* cA = (const char*)g.A + (size_t)cur.pm * tstep; const char* cB = (const char*)g.Bt + (size_t)cur.pn * tstep;
    S.a_ready(cur);
    if constexpr (SP2) {
        PG8_STAGE(PG8_SB(0, 0), cB, voffB); PG8_STAGE(PG8_SB(0, 1), cB + hstep, voffB); PG8_STAGE(PG8_SA(0, 0), cA, voffA); PG8_STAGE(PG8_SA(0, 1), cA + hstep, voffA);
        if (wr == 1) PG8_BAR;
        PG8_WAIT_V(2); PG8_BAR;
        PG8_STAGE(PG8_SB(1, 0), cB + kstep, voffB); PG8_STAGE(PG8_SA(1, 0), cA + kstep, voffA); PG8_STAGE(PG8_SB(1, 1), cB + hstep + kstep, voffB);
        PG8_WAIT_V(6); PG8_BAR;
    } else {
        PG8_STAGE(PG8_SB(0, 0), cB, voffB); PG8_STAGE(PG8_SA(0, 0), cA, voffA); PG8_STAGE(PG8_SB(0, 1), cB + hstep, voffB); PG8_STAGE(PG8_SA(0, 1), cA + hstep, voffA);
        if (wr == 1) PG8_BAR;
        PG8_WAIT_V(4); PG8_BAR;
        PG8_STAGE(PG8_SB(1, 0), cB + kstep, voffB); PG8_STAGE(PG8_SA(1, 0), cA + kstep, voffA); PG8_STAGE(PG8_SB(1, 1), cB + hstep + kstep, voffB);
        PG8_WAIT_V(6); PG8_BAR;
    }
    for (;;) {
        const bool has_next = S.next(ui + 1, nxt);
        const char* nA = has_next ? (const char*)g.A + (size_t)nxt.pm * tstep : cA; const char* nB = has_next ? (const char*)g.Bt + (size_t)nxt.pn * tstep : cB;
        for (int t = 0; t < nt; t += 2) {
            const bool last = (t == nt - 2);
            const char* a1 = cA + (size_t)(t + 1) * kstep;
            const char* a2 = last ? nA : cA + (size_t)(t + 2) * kstep; const char* b2 = last ? nB : cB + (size_t)(t + 2) * kstep;
            const char* a3 = a2 + kstep; const char* b3 = b2 + kstep;
            if (last && has_next) S.a_ready(nxt);
            if constexpr (SP2) {
            PG8_LDB(B0, 0, 0); PG8_LDB(B1, 0, 1); PG8_SCHED; PG8_LDA(At, 0, 0); PG8_STAGE(PG8_SA(1, 1), a1 + hstep, voffA);
            PG8_WAIT_V(8); PG8_WAIT_L(0); PG8_BAR; PG8_MMA(0, 0, At, B0); PG8_MMA(0, 1, At, B1); PG8_BAR; PG8_SCHED;
            PG8_LDA(At, 0, 1); PG8_STAGE(PG8_SB(0, 0), b2, voffB); PG8_STAGE(PG8_SB(0, 1), b2 + hstep, voffB); PG8_STAGE(PG8_SA(0, 0), a2, voffA);
            PG8_WAIT_V(8); PG8_WAIT_L(0); PG8_BAR; PG8_MMA(1, 0, At, B0); PG8_MMA(1, 1, At, B1); PG8_BAR; PG8_SCHED;
            PG8_LDB(B0, 1, 0); PG8_LDB(B1, 1, 1); PG8_SCHED; PG8_LDA(At, 1, 0); PG8_STAGE(PG8_SA(0, 1), a2 + hstep, voffA);
            PG8_WAIT_V(8); PG8_WAIT_L(0); PG8_BAR; PG8_MMA(0, 0, At, B0); PG8_MMA(0, 1, At, B1); PG8_BAR; PG8_SCHED;
            PG8_LDA(At, 1, 1); PG8_STAGE(PG8_SB(1, 0), b3, voffB); PG8_STAGE(PG8_SB(1, 1), b3 + hstep, voffB); PG8_STAGE(PG8_SA(1, 0), a3, voffA);
            PG8_WAIT_V(8); PG8_WAIT_L(0); PG8_BAR; PG8_MMA(1, 0, At, B0); PG8_MMA(1, 1, At, B1); PG8_BAR; PG8_SCHED;
            } else {
            PG8_LDB(B0, 0, 0); PG8_SCHED; PG8_LDA(At, 0, 0); PG8_STAGE(PG8_SA(1, 1), a1 + hstep, voffA);
            PG8_WAIT_L(8); PG8_BAR; PG8_WAIT_L(0); PG8_MMA(0, 0, At, B0); PG8_BAR; PG8_SCHED;
            PG8_LDB(B1, 0, 1); PG8_STAGE(PG8_SB(0, 0), b2, voffB);
            PG8_BAR; PG8_WAIT_L(0); PG8_MMA(0, 1, At, B1); PG8_BAR;
            PG8_LDA(At, 0, 1); PG8_STAGE(PG8_SA(0, 0), a2, voffA);
            PG8_BAR; PG8_WAIT_L(0); PG8_MMA(1, 0, At, B0); PG8_BAR; PG8_SCHED;
            PG8_STAGE(PG8_SB(0, 1), b2 + hstep, voffB);
            PG8_WAIT_V(6); PG8_BAR; PG8_MMA(1, 1, At, B1); PG8_BAR;
            PG8_LDB(B0, 1, 0); PG8_SCHED; PG8_LDA(At, 1, 0); PG8_STAGE(PG8_SA(0, 1), a2 + hstep, voffA);
            PG8_WAIT_L(8); PG8_BAR; PG8_WAIT_L(0); PG8_MMA(0, 0, At, B0); PG8_BAR; PG8_SCHED;
            PG8_LDB(B1, 1, 1); PG8_STAGE(PG8_SB(1, 0), b3, voffB);
            PG8_BAR; PG8_WAIT_L(0); PG8_MMA(0, 1, At, B1); PG8_BAR;
            PG8_LDA(At, 1, 1); PG8_STAGE(PG8_SA(1, 0), a3, voffA);
            PG8_BAR; PG8_WAIT_L(0); PG8_MMA(1, 0, At, B0); PG8_BAR; PG8_SCHED;
            PG8_STAGE(PG8_SB(1, 1), b3 + hstep, voffB);
            PG8_WAIT_V(6); PG8_BAR; PG8_MMA(1, 1, At, B1); PG8_BAR;
            }
        }
        if constexpr (ALIGN_EPI) { if (wr == 0) PG8_BAR; }
        if constexpr (!Epi::AFTER_DRAIN) { E(acc, cur, wr, wc, fr, fq); S.done(cur); }
        if (!has_next) break;
#pragma unroll
        for (int a = 0; a < 2; ++a)
#pragma unroll
            for (int b = 0; b < 2; ++b)
#pragma unroll
                for (int m = 0; m < 4; ++m)
#pragma unroll
                    for (int n = 0; n < 2; ++n) acc[a][b][m][n] = (f32x4){0.f, 0.f, 0.f, 0.f};
        cur = nxt; cA = nA; cB = nB; ++ui;
        if constexpr (ALIGN_EPI) { if (wr == 1) PG8_BAR; }
    }
    PG8_WAIT_V(0);
    if constexpr (!ALIGN_EPI) { if (wr == 0) PG8_BAR; }
    PG8_BAR;
    if constexpr (Epi::AFTER_DRAIN) { E.fused(acc, cur, wr, wc, fr, fq, lds, wid, lane); S.done(cur); }
#undef PG8_SA
#undef PG8_SB
#undef PG8_STAGE
#undef PG8_LDA
#undef PG8_LDB
#undef PG8_MMA
#undef PG8_WAIT_V
#undef PG8_WAIT_L
#undef PG8_BAR
#undef PG8_SCHED
}
}

namespace mk {
using pg8::bf16_t; using pg8::f32x4; using pg8::f32x2; using pg8::Unit; using pg8::cvt_pk_bf16; using pg8::gelu_pk;
typedef unsigned u32x2 __attribute__((ext_vector_type(2)));
typedef unsigned u32x4 __attribute__((ext_vector_type(4)));
#define LAS __attribute__((address_space(3)))

constexpr int MP = 16384, MS = 512, MT = MP + MS, DM = 1024, INW = 10240, FF = 4096, PLE = 256;
constexpr int CQ = 0, CK = 1024, CV = 2048, CG = 4096, CU = 6144, CGV = 7168, CGA = 8192, CGB = 9216;
constexpr int NTAB = 2048 + 4;
constexpr float EPS = 1e-6f;
constexpr int NWAVES = 8, NTHR = 512;

constexpr size_t O_Y = 0;
constexpr size_t O_SRP = (size_t)MT * DM;
constexpr size_t O_SRS = O_SRP + (size_t)8 * 4 * 256 * 512;
constexpr size_t O_GMV = O_SRS + (size_t)128 * 4 * 256 * 512;
constexpr size_t O_END = O_GMV + (size_t)128 * 4 * 1024;

constexpr size_t al256(size_t x) { return (x + 255) & ~(size_t)255; }
constexpr size_t WS_CTL = 0, CTL_BYTES = 1u << 20;
constexpr size_t WS_LNS = WS_CTL + CTL_BYTES;
constexpr size_t WS_SSQO = WS_LNS + al256((size_t)MT * 2 * 4);
constexpr size_t WS_SSQ2 = WS_SSQO + al256((size_t)MT * 4 * 4);
constexpr size_t WS_SSQ3 = WS_SSQ2 + al256((size_t)MT * 4);
constexpr size_t WS_SSQ4 = WS_SSQ3 + al256((size_t)MT * 4);
constexpr size_t WS_ZERO_END = WS_SSQ4 + al256((size_t)MT * 4);
constexpr size_t WS_COS = al256(WS_ZERO_END);
constexpr size_t WS_SIN = WS_COS + al256((size_t)NTAB * 128 * 4);
constexpr size_t WS_WIN = WS_SIN + al256((size_t)NTAB * 128 * 4);
constexpr size_t WS_WBRA = WS_WIN + (size_t)INW * DM * 2;
constexpr size_t WS_WBRB = WS_WBRA + (size_t)DM * 2048 * 2;
constexpr size_t WS_WO = WS_WBRB + (size_t)DM * DM * 2;
constexpr size_t WS_WUP = WS_WO + (size_t)DM * DM * 2;
constexpr size_t WS_WDN = WS_WUP + (size_t)FF * DM * 2;
constexpr size_t WS_WPG = WS_WDN + (size_t)DM * FF * 2;
constexpr size_t WS_WPP = WS_WPG + (size_t)DM * DM * 2;
constexpr size_t WS_WSB = WS_WPP + (size_t)DM * PLE * 2;
constexpr size_t WS_XN = WS_WSB + (size_t)8 * 128 * 128 * 2;
constexpr size_t WS_PB = WS_XN + (size_t)MT * DM * 2;
constexpr size_t WS_A = WS_PB + (size_t)MT * PLE * 2;
constexpr size_t WS_Z = WS_A;
constexpr size_t WS_U = WS_A;
constexpr size_t WS_H2 = WS_U + (size_t)MT * FF * 2;
constexpr size_t WS_H2B = WS_H2 + (size_t)MT * DM * 4;
constexpr size_t WS_PE = WS_H2B + (size_t)MT * DM * 2;
constexpr size_t WS_A_END = WS_A + (size_t)MT * INW * 2;
static_assert(WS_PE + (size_t)MT * DM * 4 <= WS_A_END, "region A overlay");
constexpr size_t WS_ORAW = WS_A_END;
constexpr size_t WS_H3 = WS_ORAW;
constexpr size_t WS_YA = WS_ORAW + (size_t)MT * 2048 * 2;
constexpr size_t WS_YB = WS_YA + (size_t)MT * 2048 * 2;
constexpr size_t WS_T = WS_YB + (size_t)MT * DM * 2;
constexpr size_t WS_MG = WS_T + (size_t)MT * DM * 4;
constexpr size_t WS_H1 = WS_MG + (size_t)MT * DM * 2;
constexpr size_t WS_H1B = WS_H1 + (size_t)MT * DM * 4;
constexpr size_t WS_END = WS_H1B + (size_t)MT * DM * 2;

constexpr int LDS_RING = 131072, LDS_BYTES = 139264, LDS_MISC = LDS_BYTES - 256;

struct Args {
    const float* in[21]; float* out; unsigned char* ws; int ph_lo, ph_hi;
};

__device__ __forceinline__ float bf2f(unsigned short u) { return __uint_as_float((unsigned)u << 16); }
__device__ __forceinline__ unsigned f2bf(float f) { unsigned u = __float_as_uint(f); return (u + 0x7fffu + ((u >> 16) & 1u)) >> 16; }
__device__ __forceinline__ unsigned pk2(float lo, float hi) { return f2bf(lo) | (f2bf(hi) << 16); }
__device__ __forceinline__ f32x4 ld_bf4(const bf16_t* p) { const u32x2 w = *(const u32x2*)p; return (f32x4){__uint_as_float(w.x << 16), __uint_as_float(w.x & 0xffff0000u), __uint_as_float(w.y << 16), __uint_as_float(w.y & 0xffff0000u)}; }
typedef float f32x2_t __attribute__((ext_vector_type(2))); typedef __bf16 bf16x2_t __attribute__((ext_vector_type(2)));
__device__ __forceinline__ unsigned cvtpk(float lo, float hi) { const f32x2_t v = {lo, hi}; const bf16x2_t b = __builtin_convertvector(v, bf16x2_t); return __builtin_bit_cast(unsigned, b); }
__device__ __forceinline__ void st_bf4(bf16_t* p, f32x4 v) { u32x2 w; w.x = cvtpk(v[0], v[1]); w.y = cvtpk(v[2], v[3]); *(u32x2*)p = w; }
__device__ __forceinline__ void ld_bf8(const bf16_t* p, f32x4& a, f32x4& b) { const u32x4 w = *(const u32x4*)p;
    a = (f32x4){__uint_as_float(w.x << 16), __uint_as_float(w.x & 0xffff0000u), __uint_as_float(w.y << 16), __uint_as_float(w.y & 0xffff0000u)};
    b = (f32x4){__uint_as_float(w.z << 16), __uint_as_float(w.z & 0xffff0000u), __uint_as_float(w.w << 16), __uint_as_float(w.w & 0xffff0000u)}; }
__device__ __forceinline__ void st_bf8(bf16_t* p, f32x4 a, f32x4 b) { u32x4 w; w.x = cvtpk(a[0], a[1]); w.y = cvtpk(a[2], a[3]); w.z = cvtpk(b[0], b[1]); w.w = cvtpk(b[2], b[3]); *(u32x4*)p = w; }
__device__ __forceinline__ float sigmoidf_(float x) { return __builtin_amdgcn_rcpf(1.0f + __builtin_amdgcn_exp2f(-1.4426950408889634f * x)); }
__device__ __forceinline__ f32x4 sigmoid4(f32x4 v) { return (f32x4){sigmoidf_(v[0]), sigmoidf_(v[1]), sigmoidf_(v[2]), sigmoidf_(v[3])}; }
__device__ __forceinline__ f32x4 silu4(f32x4 v) { return v * sigmoid4(v); }
__device__ __forceinline__ f32x4 gelu4(f32x4 v) { const f32x2 a = gelu_pk((f32x2){v[0], v[1]}), b = gelu_pk((f32x2){v[2], v[3]}); return (f32x4){a.x, a.y, b.x, b.y}; }
__device__ __forceinline__ float sum4(f32x4 v) { return (v[0] + v[1]) + (v[2] + v[3]); }
__device__ __forceinline__ float wave_sum(float v) {
#pragma unroll
    for (int o = 1; o < 64; o <<= 1) v += __shfl_xor(v, o);
    return v;
}
__device__ __forceinline__ int tab_index(int row) { return row < MP ? (row & 2047) : 2048 + (row & 3); }

template <class F> struct EpiGen {
    static constexpr bool PERM = true, AFTER_DRAIN = false;
    F f;
    template <int KIND> __device__ __forceinline__ void run(const f32x4 (&acc)[2][2][4][2], int row0, int col0, int fq) const {
#pragma unroll
        for (int ai = 0; ai < 2; ++ai)
#pragma unroll
            for (int m = 0; m < 4; ++m) {
                const int row = row0 + ai * 128 + m * 16;
                float red[2] = {0.f, 0.f};
                const typename F::RowCtx rc = f.template row_begin<KIND>(row);
                f.template oct<KIND>(rc, row, col0, acc[ai][0][m][0], acc[ai][0][m][1], col0 + 128, acc[ai][1][m][0], acc[ai][1][m][1], red);
                if (F::template nred<KIND>() > 0) {
                    red[0] += __shfl_xor(red[0], 16); red[0] += __shfl_xor(red[0], 32);
                    if (F::template nred<KIND>() > 1) { red[1] += __shfl_xor(red[1], 16); red[1] += __shfl_xor(red[1], 32); }
                    if (fq == 0) f.template row_add<KIND>(row, red);
                }
                asm volatile("" ::: "memory");
            }
    }
    __device__ __forceinline__ void operator()(const f32x4 (&acc)[2][2][4][2], const Unit& u, int wr, int wc, int fr, int fq) const {
        const int row0 = u.pm * 256 + wr * 64 + fr, col0 = u.pn * 256 + wc * 32 + 8 * fq;
        const int kind = f.kind(u.pn * 256);
        if (F::NK == 1) { run<0>(acc, row0, col0, fq); return; }
        switch (kind) {
            case 0: run<0>(acc, row0, col0, fq); break;
            case 1: run<(F::NK > 1 ? 1 : 0)>(acc, row0, col0, fq); break;
            case 2: run<(F::NK > 2 ? 2 : 0)>(acc, row0, col0, fq); break;
            case 3: run<(F::NK > 3 ? 3 : 0)>(acc, row0, col0, fq); break;
            case 4: run<(F::NK > 4 ? 4 : 0)>(acc, row0, col0, fq); break;
            default: run<(F::NK > 5 ? 5 : 0)>(acc, row0, col0, fq); break;
        }
    }
};
#define F_COMMON1 static constexpr int NK = 1; __device__ __forceinline__ int kind(int) const { return 0; }

struct F1 {
    static constexpr int NK = 6; typedef int RowCtx;
    bf16_t* Z; const float* cosT; const float* sinT; float* LNS;
    __device__ __forceinline__ int kind(int cb) const { return cb < CV ? 0 : cb < CG ? 1 : cb < CU ? 2 : cb < CGV ? 3 : cb < CGA ? 4 : 5; }
    template <int K> static __device__ __forceinline__ constexpr int nred() { return K == 4 ? 2 : 0; }
    template <int K> __device__ __forceinline__ RowCtx row_begin(int row) const { return K == 0 ? tab_index(row) * 128 : 0; }
    template <int K> __device__ __forceinline__ void oct(RowCtx rc, int row, int c0, f32x4 a0, f32x4 a1, int c1, f32x4 b0, f32x4 b1, float (&red)[2]) const {
        bf16_t* zr = Z + (size_t)row * INW;
        if (K == 0) { const int i0 = c0 & 255; const f32x4 cs0 = *(const f32x4*)(cosT + rc + i0), cs1 = *(const f32x4*)(cosT + rc + i0 + 4), sn0 = *(const f32x4*)(sinT + rc + i0), sn1 = *(const f32x4*)(sinT + rc + i0 + 4);
            st_bf8(zr + c0, a0 * cs0 - b0 * sn0, a1 * cs1 - b1 * sn1); st_bf8(zr + c1, b0 * cs0 + a0 * sn0, b1 * cs1 + a1 * sn1); }
        else if (K == 1) { st_bf8(zr + c0, a0, a1); st_bf8(zr + c1, b0, b1); }
        else if (K == 2) { st_bf8(zr + c0, silu4(a0), silu4(a1)); st_bf8(zr + c1, silu4(b0), silu4(b1)); }
        else if (K == 3) { st_bf8(zr + c0, gelu4(a0), gelu4(a1)); st_bf8(zr + c1, gelu4(b0), gelu4(b1)); }
        else if (K == 4) { const f32x4 g0 = gelu4(a0), g1 = gelu4(a1), g2 = gelu4(b0), g3 = gelu4(b1); st_bf8(zr + c0, g0, g1); st_bf8(zr + c1, g2, g3);
            red[0] += (sum4(g0) + sum4(g1)) + (sum4(g2) + sum4(g3)); red[1] += (sum4(g0 * g0) + sum4(g1 * g1)) + (sum4(g2 * g2) + sum4(g3 * g3)); }
        else { st_bf8(zr + c0, sigmoid4(a0), sigmoid4(a1)); st_bf8(zr + c1, sigmoid4(b0), sigmoid4(b1)); }
    }
    template <int K> __device__ __forceinline__ void row_add(int row, const float (&red)[2]) const { atomicAdd(LNS + 2 * row, red[0]); atomicAdd(LNS + 2 * row + 1, red[1]); }
};
struct F2a {
    F_COMMON1 typedef int RowCtx;
    const bf16_t* Z; bf16_t* T;
    template <int K> static __device__ __forceinline__ constexpr int nred() { return 0; }
    template <int K> __device__ __forceinline__ RowCtx row_begin(int) const { return 0; }
    template <int K> __device__ __forceinline__ void oct(RowCtx, int row, int c0, f32x4 a0, f32x4 a1, int c1, f32x4 b0, f32x4 b1, float (&)[2]) const {
        const bf16_t* g = Z + (size_t)row * INW + CGA; bf16_t* t = T + (size_t)row * DM; f32x4 g0, g1;
        ld_bf8(g + c0, g0, g1); st_bf8(t + c0, g0 * a0, g1 * a1); ld_bf8(g + c1, g0, g1); st_bf8(t + c1, g0 * b0, g1 * b1);
    }
    template <int K> __device__ __forceinline__ void row_add(int, const float (&)[2]) const {}
};
struct F2b {
    F_COMMON1 typedef int RowCtx;
    const bf16_t* Z; const bf16_t* T; bf16_t* MG;
    template <int K> static __device__ __forceinline__ constexpr int nred() { return 0; }
    template <int K> __device__ __forceinline__ RowCtx row_begin(int) const { return 0; }
    template <int K> __device__ __forceinline__ void oct(RowCtx, int row, int c0, f32x4 a0, f32x4 a1, int c1, f32x4 b0, f32x4 b1, float (&)[2]) const {
        const bf16_t* g = Z + (size_t)row * INW + CGB; const bf16_t* t = T + (size_t)row * DM; bf16_t* o = MG + (size_t)row * DM; f32x4 g0, g1, t0, t1;
        ld_bf8(g + c0, g0, g1); ld_bf8(t + c0, t0, t1); st_bf8(o + c0, t0 + g0 * a0, t1 + g1 * a1);
        ld_bf8(g + c1, g0, g1); ld_bf8(t + c1, t0, t1); st_bf8(o + c1, t0 + g0 * b0, t1 + g1 * b1);
    }
    template <int K> __device__ __forceinline__ void row_add(int, const float (&)[2]) const {}
};
template <bool BF> struct FRes {
    F_COMMON1 typedef size_t RowCtx;
    const float* baseP; const float* baseS; const bf16_t* baseB; bf16_t* HB; float* SSQ;
    template <int K> static __device__ __forceinline__ constexpr int nred() { return 1; }
    template <int K> __device__ __forceinline__ RowCtx row_begin(int row) const { return (size_t)row * DM; }
    template <int K> __device__ __forceinline__ void oct(RowCtx ro, int row, int c0, f32x4 a0, f32x4 a1, int c1, f32x4 b0, f32x4 b1, float (&red)[2]) const {
        f32x4 x0, x1, x2, x3;
        if (BF) { ld_bf8(baseB + ro + c0, x0, x1); ld_bf8(baseB + ro + c1, x2, x3); }
        else { const float* xr = row < MP ? baseP + ro : baseS + (ro - (size_t)MP * DM); x0 = *(const f32x4*)(xr + c0); x1 = *(const f32x4*)(xr + c0 + 4); x2 = *(const f32x4*)(xr + c1); x3 = *(const f32x4*)(xr + c1 + 4); }
        const f32x4 h0 = x0 + a0, h1 = x1 + a1, h2 = x2 + b0, h3 = x3 + b1;
        st_bf8(HB + ro + c0, h0, h1); st_bf8(HB + ro + c1, h2, h3);
        red[0] += (sum4(h0 * h0) + sum4(h1 * h1)) + (sum4(h2 * h2) + sum4(h3 * h3));
    }
    template <int K> __device__ __forceinline__ void row_add(int row, const float (&red)[2]) const { atomicAdd(SSQ + row, red[0]); }
};
struct F4 {
    F_COMMON1 typedef float RowCtx;
    const float* SSQ; bf16_t* U;
    template <int K> static __device__ __forceinline__ constexpr int nred() { return 0; }
    template <int K> __device__ __forceinline__ RowCtx row_begin(int row) const { return rsqrtf(SSQ[row] * (1.0f / DM) + EPS); }
    template <int K> __device__ __forceinline__ void oct(RowCtx rs, int row, int c0, f32x4 a0, f32x4 a1, int c1, f32x4 b0, f32x4 b1, float (&)[2]) const {
        bf16_t* u = U + (size_t)row * FF; const f32x4 z = (f32x4){0.f, 0.f, 0.f, 0.f};
        a0 = __builtin_elementwise_max(a0 * rs, z); a1 = __builtin_elementwise_max(a1 * rs, z); b0 = __builtin_elementwise_max(b0 * rs, z); b1 = __builtin_elementwise_max(b1 * rs, z);
        st_bf8(u + c0, a0 * a0, a1 * a1); st_bf8(u + c1, b0 * b0, b1 * b1);
    }
    template <int K> __device__ __forceinline__ void row_add(int, const float (&)[2]) const {}
};
struct F6a {
    F_COMMON1 typedef int RowCtx;
    bf16_t* PE;
    template <int K> static __device__ __forceinline__ constexpr int nred() { return 0; }
    template <int K> __device__ __forceinline__ RowCtx row_begin(int) const { return 0; }
    template <int K> __device__ __forceinline__ void oct(RowCtx, int row, int c0, f32x4 a0, f32x4 a1, int c1, f32x4 b0, f32x4 b1, float (&)[2]) const {
        bf16_t* p = PE + (size_t)row * DM; st_bf8(p + c0, a0, a1); st_bf8(p + c1, b0, b1);
    }
    template <int K> __device__ __forceinline__ void row_add(int, const float (&)[2]) const {}
};
struct F6b {
    F_COMMON1 typedef float RowCtx;
    const float* SSQ3; const bf16_t* H2; const bf16_t* PE; bf16_t* H3; float* SSQ4;
    template <int K> static __device__ __forceinline__ constexpr int nred() { return 1; }
    template <int K> __device__ __forceinline__ RowCtx row_begin(int row) const { return rsqrtf(SSQ3[row] * (1.0f / DM) + EPS); }
    template <int K> __device__ __forceinline__ void oct(RowCtx rs, int row, int c0, f32x4 a0, f32x4 a1, int c1, f32x4 b0, f32x4 b1, float (&red)[2]) const {
        const size_t o = (size_t)row * DM; f32x4 h0, h1, p0, p1;
        ld_bf8(H2 + o + c0, h0, h1); ld_bf8(PE + o + c0, p0, p1); h0 = h0 + sigmoid4(a0 * rs) * p0; h1 = h1 + sigmoid4(a1 * rs) * p1; st_bf8(H3 + o + c0, h0, h1);
        float s = sum4(h0 * h0) + sum4(h1 * h1);
        ld_bf8(H2 + o + c1, h0, h1); ld_bf8(PE + o + c1, p0, p1); h0 = h0 + sigmoid4(b0 * rs) * p0; h1 = h1 + sigmoid4(b1 * rs) * p1; st_bf8(H3 + o + c1, h0, h1);
        red[0] += s + sum4(h0 * h0) + sum4(h1 * h1);
    }
    template <int K> __device__ __forceinline__ void row_add(int row, const float (&red)[2]) const { atomicAdd(SSQ4 + row, red[0]); }
};
#define XB_TMO      128
#define XB_XCNT(j)  (256  + 64 * (j))
#define XB_XSUB(j)  (1280 + 64 * (j))
#define XB_XGEN(j)  (2304 + 64 * (j))
#define XB_TOP      3328
#define XB_TOPGEN   3392
#define XCD_BAR_WORDS 3456
#define XB_SPIN_CAP (1u << 21)

__device__ __forceinline__ unsigned xb_ld(unsigned* p)              { return __hip_atomic_load(p, __ATOMIC_RELAXED, __HIP_MEMORY_SCOPE_AGENT); }
__device__ __forceinline__ unsigned xb_add(unsigned* p, unsigned v) { return __hip_atomic_fetch_add(p, v, __ATOMIC_RELAXED, __HIP_MEMORY_SCOPE_AGENT); }
__device__ __forceinline__ unsigned xb_xcc_id() { return (unsigned)__builtin_amdgcn_s_getreg((3 << 11) | 20) & 0xFu; }
#define XB_SPIN(cond, bar) do { unsigned _sp = 0; while (cond) { __builtin_amdgcn_s_sleep(1); \
    if ((++_sp & 255u) == 0u) { if (xb_ld(&(bar)[XB_TMO])) break; if (_sp > XB_SPIN_CAP) { atomicAdd(&(bar)[XB_TMO], 1u); break; } } } } while (0)

struct XcdBarrier {
    unsigned* bar; unsigned x;
    volatile LAS unsigned* st;
};

__device__ __forceinline__ XcdBarrier xcd_barrier_post(unsigned* bar, volatile LAS unsigned* st) {
    XcdBarrier b; b.bar = bar; b.x = xb_xcc_id(); b.st = st;
    if (threadIdx.x == 0) (void)xb_add(&bar[XB_XCNT(b.x)], 1u);
    return b;
}
__device__ __forceinline__ void xcd_barrier_complete(unsigned* bar, unsigned x, unsigned& nloc, unsigned& nx) {
    const unsigned G = gridDim.x * gridDim.y * gridDim.z;
    unsigned sum, cnt, mine, sp = 0u;
    for (;;) {
        sum = 0u; cnt = 0u; mine = 0u;
#pragma unroll
        for (unsigned j = 0; j < 16; ++j) { const unsigned c = xb_ld(&bar[XB_XCNT(j)]); sum += c; cnt += (c > 0u) ? 1u : 0u; mine = (j == x) ? c : mine; }
        if (sum == G) break;
        __builtin_amdgcn_s_sleep(1);
        if ((++sp & 255u) == 0u) { if (xb_ld(&bar[XB_TMO])) break; if (sp > XB_SPIN_CAP) { atomicAdd(&bar[XB_TMO], 1u); break; } }
    }
    nloc = mine > 0u ? mine : 1u; nx = cnt > 0u ? cnt : 1u;
}

__device__ __forceinline__ void xcd_barrier(const XcdBarrier& b) {
    asm volatile("s_waitcnt vmcnt(0)" ::: "memory");
    __syncthreads();
    if (threadIdx.x == 0) {
        unsigned* bar = b.bar;
        __builtin_amdgcn_s_waitcnt(0);
        unsigned nloc = b.st[0], nx = b.st[1];
        if (nloc == 0u) { xcd_barrier_complete(bar, b.x, nloc, nx); b.st[0] = nloc; b.st[1] = nx; }
        const unsigned old = xb_add(&bar[XB_XSUB(b.x)], 1u);
        const unsigned gen = old / nloc;
        if (old + 1u == (gen + 1u) * nloc) {
            __builtin_amdgcn_fence(__ATOMIC_RELEASE, "agent");
            asm volatile("s_waitcnt vmcnt(0)" ::: "memory");
            const unsigned og = xb_add(&bar[XB_TOP], 1u);
            const unsigned tg = og / nx;
            if (og + 1u == (tg + 1u) * nx) xb_add(&bar[XB_TOPGEN], 1u);
            else XB_SPIN(xb_ld(&bar[XB_TOPGEN]) == tg, bar);
            __builtin_amdgcn_fence(__ATOMIC_ACQUIRE, "agent");
            xb_add(&bar[XB_XGEN(b.x)], 1u);
            asm volatile("s_waitcnt vmcnt(0)" ::: "memory");
        } else {
            XB_SPIN(xb_ld(&bar[XB_XGEN(b.x)]) == gen, bar);
            __builtin_amdgcn_fence(__ATOMIC_ACQUIRE, "agent");
            asm volatile("s_waitcnt vmcnt(0)" ::: "memory");
        }
    }
    __syncthreads();
}

struct Ctx {
    LAS unsigned char* lds; int tid, lane, wave, vcu, G;
    const float* const* in; float* out; unsigned char* ws;
    template <class T> __device__ __forceinline__ T* w(size_t off) const { return (T*)(ws + off); }
};
enum { I_XP = 0, I_XS, I_PP, I_PS, I_ST, I_GMIX, I_WIN, I_GRET, I_WS, I_BS, I_GGM, I_WBRA, I_WBRB, I_WO, I_GMLP, I_WUP, I_WDN, I_GPLE, I_WPG, I_WPP, I_GFIN };

__device__ __forceinline__ void p0_transpose_item(const float* W, int K, int N, bf16_t* WT, LAS float* scr, int item, int lane, const float* rowg, int cs_lo, int cs_hi, float cs) {
    const int nblk = N / 32, kb = item / nblk, nb = item % nblk, k0 = 64 * kb, n0 = 32 * nb;
#pragma unroll 8
    for (int i = 0; i < 32; ++i) { const int kk = 2 * i + (lane >> 5); float wv = W[(size_t)(k0 + kk) * N + n0 + (lane & 31)]; if (rowg) wv *= rowg[k0 + kk]; scr[kk * 33 + (lane & 31)] = wv; }
    asm volatile("s_waitcnt lgkmcnt(0)" ::: "memory");
    const int c = lane & 7;
#pragma unroll
    for (int j = 0; j < 4; ++j) { const int n = (lane >> 3) + 8 * j; const LAS float* s = scr + (8 * c) * 33 + n; const float sc = (n0 + n >= cs_lo && n0 + n < cs_hi) ? cs : 1.0f;
        u32x4 o; o.x = pk2(s[0 * 33] * sc, s[1 * 33] * sc); o.y = pk2(s[2 * 33] * sc, s[3 * 33] * sc); o.z = pk2(s[4 * 33] * sc, s[5 * 33] * sc); o.w = pk2(s[6 * 33] * sc, s[7 * 33] * sc);
        *(u32x4*)(WT + (size_t)(n0 + n) * K + k0 + 8 * c) = o; }
    asm volatile("s_waitcnt lgkmcnt(0)" ::: "memory");
}
__device__ __forceinline__ double sin_poly(double x) {
    const double x2 = x * x; double r = -1.0 / 8841761993739701954543616000000.0;
    r = r * x2 + 1.0 / 10888869450418352160768000000.0;
    r = r * x2 - 1.0 / 15511210043330985984000000.0;
    r = r * x2 + 1.0 / 25852016738884976640000.0;
    r = r * x2 - 1.0 / 51090942171709440000.0;
    r = r * x2 + 1.0 / 121645100408832000.0;
    r = r * x2 - 1.0 / 355687428096000.0;
    r = r * x2 + 1.0 / 1307674368000.0;
    r = r * x2 - 1.0 / 6227020800.0;
    r = r * x2 + 1.0 / 39916800.0;
    r = r * x2 - 1.0 / 362880.0;
    r = r * x2 + 1.0 / 5040.0;
    r = r * x2 - 1.0 / 120.0;
    r = r * x2 + 1.0 / 6.0;
    r = r * x2 - 1.0;
    return -r * x;
}
__device__ __forceinline__ double cos_poly(double x) {
    const double x2 = x * x; double r = -1.0 / 265252859812191058636308480000000.0;
    r = r * x2 + 1.0 / 304888344611713860501504000000.0;
    r = r * x2 - 1.0 / 403291461126605635584000000.0;
    r = r * x2 + 1.0 / 620448401733239439360000.0;
    r = r * x2 - 1.0 / 1124000727777607680000.0;
    r = r * x2 + 1.0 / 2432902008176640000.0;
    r = r * x2 - 1.0 / 6402373705728000.0;
    r = r * x2 + 1.0 / 20922789888000.0;
    r = r * x2 - 1.0 / 87178291200.0;
    r = r * x2 + 1.0 / 479001600.0;
    r = r * x2 - 1.0 / 3628800.0;
    r = r * x2 + 1.0 / 40320.0;
    r = r * x2 - 1.0 / 720.0;
    r = r * x2 + 1.0 / 24.0;
    r = r * x2 - 0.5;
    r = r * x2 + 1.0;
    return r;
}
__device__ __forceinline__ void p0_prologue(const Ctx& C) {
    LAS float* scr = (LAS float*)(C.lds + C.wave * 16384);
    const int gw = C.vcu * NWAVES + C.wave, NGW = C.G * NWAVES, lane = C.lane;
    constexpr int I_IN = (DM / 64) * (INW / 32), I_BRA = (2048 / 64) * (DM / 32), I_SQ = (DM / 64) * (DM / 32), I_UP = (DM / 64) * (FF / 32), I_DN = (FF / 64) * (DM / 32), I_PPI = (PLE / 64) * (DM / 32);
    constexpr int NITEMS = I_IN + I_BRA + 3 * I_SQ + I_UP + I_DN + I_PPI;
    for (int it = gw; it < NITEMS; it += NGW) {
        int r = it;
        if (r < I_IN) { p0_transpose_item(C.in[I_WIN], DM, INW, C.w<bf16_t>(WS_WIN), scr, r, lane, nullptr, CK, CV, 0.0625f); continue; } r -= I_IN;
        if (r < I_BRA) { p0_transpose_item(C.in[I_WBRA], 2048, DM, C.w<bf16_t>(WS_WBRA), scr, r, lane, nullptr, 0, 0, 1.f); continue; } r -= I_BRA;
        if (r < I_SQ) { p0_transpose_item(C.in[I_WBRB], DM, DM, C.w<bf16_t>(WS_WBRB), scr, r, lane, nullptr, 0, 0, 1.f); continue; } r -= I_SQ;
        if (r < I_SQ) { p0_transpose_item(C.in[I_WO], DM, DM, C.w<bf16_t>(WS_WO), scr, r, lane, nullptr, 0, 0, 1.f); continue; } r -= I_SQ;
        if (r < I_SQ) { p0_transpose_item(C.in[I_WPG], DM, DM, C.w<bf16_t>(WS_WPG), scr, r, lane, C.in[I_GPLE], 0, 0, 1.f); continue; } r -= I_SQ;
        if (r < I_UP) { p0_transpose_item(C.in[I_WUP], DM, FF, C.w<bf16_t>(WS_WUP), scr, r, lane, C.in[I_GMLP], 0, 0, 1.f); continue; } r -= I_UP;
        if (r < I_DN) { p0_transpose_item(C.in[I_WDN], FF, DM, C.w<bf16_t>(WS_WDN), scr, r, lane, nullptr, 0, 0, 1.f); continue; } r -= I_DN;
        p0_transpose_item(C.in[I_WPP], PLE, DM, C.w<bf16_t>(WS_WPP), scr, r, lane, nullptr, 0, 0, 1.f);
    }
    const float* gm = C.in[I_GMIX];
    f32x4 gv[4];
#pragma unroll
    for (int j = 0; j < 4; ++j) gv[j] = ((const f32x4*)gm)[lane + 64 * j];
    bf16_t* XN = C.w<bf16_t>(WS_XN); bf16_t* PB = C.w<bf16_t>(WS_PB);
    for (int m = gw; m < MT; m += NGW) {
        const float* xrow = m < MP ? C.in[I_XP] + (size_t)m * DM : C.in[I_XS] + (size_t)(m - MP) * DM;
        const f32x4* xr = (const f32x4*)xrow + lane;
        f32x4 v[4]; float s = 0.f;
#pragma unroll
        for (int j = 0; j < 4; ++j) { v[j] = xr[64 * j]; s += sum4(v[j] * v[j]); }
        const float rstd = rsqrtf(wave_sum(s) * (1.f / DM) + EPS);
        u32x2* o8 = (u32x2*)(XN + (size_t)m * DM) + lane;
#pragma unroll
        for (int j = 0; j < 4; ++j) { const f32x4 y = v[j] * rstd * gv[j]; u32x2 w; w.x = pk2(y[0], y[1]); w.y = pk2(y[2], y[3]); o8[64 * j] = w; }
        const float* prow = m < MP ? C.in[I_PP] + (size_t)m * PLE : C.in[I_PS] + (size_t)(m - MP) * PLE;
        const f32x4 pv = ((const f32x4*)prow)[lane]; u32x2 pw; pw.x = pk2(pv[0], pv[1]); pw.y = pk2(pv[2], pv[3]);
        ((u32x2*)(PB + (size_t)m * PLE))[lane] = pw;
    }
    { const float* w_s = C.in[I_WS]; bf16_t* WSB = C.w<bf16_t>(WS_WSB);
      for (int e = (C.vcu * NTHR + C.tid); e < 8 * 128 * 128; e += C.G * NTHR) { const int n = (e >> 7) & 127, m = e & 127; WSB[e] = (bf16_t)f2bf(m <= n ? w_s[e] : 0.f); } }
    float* cosT = C.w<float>(WS_COS); float* sinT = C.w<float>(WS_SIN);
    for (int e = (C.vcu * NTHR + C.tid); e < NTAB * 128; e += C.G * NTHR) {
        const int ti = e >> 7, i = e & 127; const float pos = ti < 2048 ? (float)ti : (float)(16384 + ti - 2048);
        const float inv = (float)exp2(-(double)i * (13.287712379549449 / 128.0));
        const float ang = pos * inv;
        const double x = (double)ang; const double k = __builtin_rint(x * 0.15915494309189535);
        double r = __builtin_fma(-k, 6.283185307179586, x); r = __builtin_fma(-k, 2.4492935982947064e-16, r);
        cosT[e] = (float)cos_poly(r); sinT[e] = (float)sin_poly(r);
    }
}

template <class F> __device__ __forceinline__ void run_gemm(const Ctx& C, const bf16_t* A, const bf16_t* Bt, int M, int N, int K, const F& f) {
    asm volatile("" : "+s"(K));
    pg8::Gemm g{A, Bt, M, N, K}; pg8::StaticOrder S; S.init(M, N, C.G, (int)blockIdx.x);
    EpiGen<F> E{f};
    pg8::gemm_phase<EpiGen<F>, pg8::StaticOrder, true, true>((PG8_LAS unsigned char*)C.lds, g, S, E);
}

typedef short sbf16x8 __attribute__((ext_vector_type(8)));
typedef float sf32x16 __attribute__((ext_vector_type(16)));
template <class F, int KIND> __device__ __forceinline__ void small_epi(const F& f, int grow, int cA, int cB, f32x4 va0, f32x4 va1, f32x4 vb0, f32x4 vb1, int q) {
    float red[2] = {0.f, 0.f};
    const typename F::RowCtx rc = f.template row_begin<KIND>(grow);
    f.template oct<KIND>(rc, grow, cA, va0, va1, cB, vb0, vb1, red);
    if (F::template nred<KIND>() > 0) {
        red[0] += __shfl_xor(red[0], 1); red[0] += __shfl_xor(red[0], 2);
        if (F::template nred<KIND>() > 1) { red[1] += __shfl_xor(red[1], 1); red[1] += __shfl_xor(red[1], 2); }
        if (q == 0) f.template row_add<KIND>(grow, red);
    }
}
template <class F> __device__ __forceinline__ void small_gemm(const Ctx& C, const bf16_t* A, const bf16_t* Bt, int N, int K, const F& f, bool rot) {
    asm volatile("" : "+s"(K));
    const int ntile = 16 * (N / 64), Kw = K / 8;
    const int wave = C.wave, l31 = C.lane & 31, hh = C.lane >> 5, tid = C.tid;
    LAS float* red = (LAS float*)C.lds;
    for (int t = C.vcu; t < ntile; t += C.G) {
        const int rt = t & 15, ct = t >> 4;
        int cA = ct * 64, cB = cA + 32;
        if (rot && cA < CV) { cA = (ct >> 2) * 256 + (ct & 3) * 32; cB = cA + 128; }
        const int r0 = MP + 32 * rt;
        const bf16_t* pa = A + (size_t)(r0 + l31) * K + wave * Kw + 8 * hh;
        const bf16_t* pb0 = Bt + (size_t)(cA + l31) * K + wave * Kw + 8 * hh;
        const bf16_t* pb1 = Bt + (size_t)(cB + l31) * K + wave * Kw + 8 * hh;
        sf32x16 a0, a1;
#pragma unroll
        for (int i = 0; i < 16; ++i) { a0[i] = 0.f; a1[i] = 0.f; }
#pragma unroll 2
        for (int k = 0; k < Kw; k += 32) {
            const sbf16x8 fa0 = *(const sbf16x8*)(pa + k), fa1 = *(const sbf16x8*)(pa + k + 16);
            const sbf16x8 fb00 = *(const sbf16x8*)(pb0 + k), fb01 = *(const sbf16x8*)(pb0 + k + 16);
            const sbf16x8 fb10 = *(const sbf16x8*)(pb1 + k), fb11 = *(const sbf16x8*)(pb1 + k + 16);
            a0 = __builtin_amdgcn_mfma_f32_32x32x16_bf16(fa0, fb00, a0, 0, 0, 0); a1 = __builtin_amdgcn_mfma_f32_32x32x16_bf16(fa0, fb10, a1, 0, 0, 0);
            a0 = __builtin_amdgcn_mfma_f32_32x32x16_bf16(fa1, fb01, a0, 0, 0, 0); a1 = __builtin_amdgcn_mfma_f32_32x32x16_bf16(fa1, fb11, a1, 0, 0, 0);
        }
        __syncthreads();
#pragma unroll
        for (int i = 0; i < 16; ++i) { const int r = (i & 3) + 8 * (i >> 2) + 4 * hh; red[(wave * 32 + r) * 68 + l31] = a0[i]; red[(wave * 32 + r) * 68 + 32 + l31] = a1[i]; }
        __syncthreads();
        if (tid < 128) {
            const int r = tid >> 2, q = tid & 3;
            f32x4 va0 = (f32x4){0.f, 0.f, 0.f, 0.f}, va1 = va0, vb0 = va0, vb1 = va0;
#pragma unroll
            for (int w = 0; w < 8; ++w) { const LAS float* p = red + (w * 32 + r) * 68 + 8 * q;
                va0 = va0 + *(const LAS f32x4*)(p); va1 = va1 + *(const LAS f32x4*)(p + 4); vb0 = vb0 + *(const LAS f32x4*)(p + 32); vb1 = vb1 + *(const LAS f32x4*)(p + 36); }
            const int grow = r0 + r, kind = f.kind(cA), ca = cA + 8 * q, cb = cB + 8 * q;
            if (F::NK == 1) small_epi<F, 0>(f, grow, ca, cb, va0, va1, vb0, vb1, q);
            else switch (kind) {
                case 0: small_epi<F, 0>(f, grow, ca, cb, va0, va1, vb0, vb1, q); break;
                case 1: small_epi<F, (F::NK > 1 ? 1 : 0)>(f, grow, ca, cb, va0, va1, vb0, vb1, q); break;
                case 2: small_epi<F, (F::NK > 2 ? 2 : 0)>(f, grow, ca, cb, va0, va1, vb0, vb1, q); break;
                case 3: small_epi<F, (F::NK > 3 ? 3 : 0)>(f, grow, ca, cb, va0, va1, vb0, vb1, q); break;
                case 4: small_epi<F, (F::NK > 4 ? 4 : 0)>(f, grow, ca, cb, va0, va1, vb0, vb1, q); break;
                default: small_epi<F, (F::NK > 5 ? 5 : 0)>(f, grow, ca, cb, va0, va1, vb0, vb1, q); break;
            }
        }
    }
    __syncthreads();
}
template <class F> __device__ __forceinline__ void run_gemm_split(const Ctx& C, const bf16_t* A, const bf16_t* Bt, int N, int K, const F& f) {
    run_gemm(C, A, Bt, MP, N, K, f);
    small_gemm(C, A, Bt, N, K, f, false);
}
__device__ __forceinline__ void ret_simple_item(const Ctx& C, bool sample, int b, int h, int vs) {
    const int v = C.tid & 63, dg = C.wave, d0 = 32 * dg;
    const int L = sample ? 4 : 2048, row0 = sample ? MP + 4 * b : 2048 * b;
    const float gamma = 1.0f - exp2f(-5.0f - (float)h);
    float S[32];
    const size_t sbase = ((size_t)(b * 4 + h) * 256 + d0) * 512 + vs * 64 + v;
    if (sample) { const float* st = C.in[I_ST] + sbase;
#pragma unroll
        for (int j = 0; j < 32; ++j) S[j] = st[(size_t)j * 512]; }
    else {
#pragma unroll
        for (int j = 0; j < 32; ++j) S[j] = 0.f; }
    const bf16_t* Z = C.w<bf16_t>(WS_Z); bf16_t* OR = C.w<bf16_t>(WS_ORAW);
    LAS float* part = (LAS float*)C.lds;
    for (int t = 0; t < L; ++t) {
        const int row = row0 + t; const bf16_t* zr = Z + (size_t)row * INW;
        const float vv = bf2f(zr[CV + h * 512 + vs * 64 + v]);
        const u32x4* qp = (const u32x4*)(zr + CQ + h * 256 + d0); const u32x4* kp = (const u32x4*)(zr + CK + h * 256 + d0);
        float o = 0.f;
#pragma unroll
        for (int c = 0; c < 4; ++c) { const u32x4 qw = qp[c], kw = kp[c];
#pragma unroll
            for (int e = 0; e < 4; ++e) { const unsigned q2 = qw[e], k2 = kw[e]; const int j = c * 8 + e * 2;
                S[j] = gamma * S[j] + __uint_as_float(k2 << 16) * vv; o += __uint_as_float(q2 << 16) * S[j];
                S[j + 1] = gamma * S[j + 1] + __uint_as_float(k2 & 0xffff0000u) * vv; o += __uint_as_float(q2 & 0xffff0000u) * S[j + 1]; } }
        part[((t & 1) * 8 + dg) * 64 + v] = o;
        __syncthreads();
        if (dg == 0) { float ot = 0.f;
#pragma unroll
            for (int g = 0; g < 8; ++g) ot += part[((t & 1) * 8 + g) * 64 + v];
            OR[(size_t)row * 2048 + h * 512 + vs * 64 + v] = (bf16_t)f2bf(ot); }
    }
    float* so = C.out + (sample ? O_SRS : O_SRP) + sbase;
#pragma unroll
    for (int j = 0; j < 32; ++j) so[(size_t)j * 512] = S[j];
    __syncthreads();
}
typedef short bf16x8 __attribute__((ext_vector_type(8)));
typedef short s16x4 __attribute__((ext_vector_type(4)));
typedef short v4i16_t __attribute__((ext_vector_type(4)));
typedef float f32x16 __attribute__((ext_vector_type(16)));
constexpr int R_QS = 528, R_VS = 192, R_PS = 144;
constexpr int R_Q = 0, R_K = R_Q + 64 * R_QS, R_ST = R_K + 64 * R_QS, R_V = R_ST + 64 * R_QS, R_VD = R_V + 64 * R_VS, R_P = R_VD + 64 * R_VS, R_END = R_P + 64 * R_PS;
static_assert(R_END <= LDS_MISC, "retention LDS map");
__device__ __forceinline__ s16x4 vtr(const LAS unsigned char* p) { return __builtin_bit_cast(s16x4, __builtin_amdgcn_ds_read_tr16_b64_v4i16((LAS v4i16_t*)p)); }
#define MFMA32(a, b, c) __builtin_amdgcn_mfma_f32_32x32x16_bf16((a), (b), (c), 0, 0, 0)
__device__ __forceinline__ bf16x8 tr_frag(const LAS unsigned char* a, int stride) { const s16x4 lo = vtr(a), hi = vtr(a + 4 * stride); return (bf16x8){lo[0], lo[1], lo[2], lo[3], hi[0], hi[1], hi[2], hi[3]}; }
__device__ __forceinline__ void ret_mfma_item(const Ctx& C, int b, int h, int vs) {
    const int tid = C.tid, lane = C.lane, wave = C.wave, l31_ = lane & 31, hh_ = lane >> 5;
    const LAS unsigned char* lds = C.lds;
    const bf16_t* Z = C.w<bf16_t>(WS_Z); bf16_t* OR = C.w<bf16_t>(WS_ORAW);
    const float lg = log2f(1.0f - exp2f(-5.0f - (float)h));
    const int row00 = b * 2048;
    for (int e = tid; e < 64 * R_QS / 16; e += NTHR) *(LAS u32x4*)(C.lds + R_ST + e * 16) = (u32x4){0u, 0u, 0u, 0u};
    f32x16 S0, S1;
#pragma unroll
    for (int i = 0; i < 16; ++i) { S0[i] = 0.f; S1[i] = 0.f; }
    u32x4 gq[4], gk[4], gv;
    const int qrow = tid >> 5, qch = tid & 31, vrow = tid >> 3, vch = tid & 7;
    const bf16_t* zq = Z + (size_t)row00 * INW + CQ + h * 256 + qch * 8;
    const bf16_t* zk = Z + (size_t)row00 * INW + CK + h * 256 + qch * 8;
    const bf16_t* zv = Z + (size_t)row00 * INW + CV + h * 512 + vs * 64 + vch * 8;
#define RET_LOAD(ci) do { _Pragma("unroll") for (int j = 0; j < 4; ++j) { const size_t ro = (size_t)((ci) * 64 + qrow + 16 * j) * INW; gq[j] = *(const u32x4*)(zq + ro); gk[j] = *(const u32x4*)(zk + ro); } \
        gv = *(const u32x4*)(zv + (size_t)((ci) * 64 + vrow) * INW); } while (0)
    RET_LOAD(0);
    const float vdsc = exp2f((float)(63 - vrow) * lg);
    const float g64 = exp2f(64.0f * lg);
    for (int ci = 0; ci < 32; ++ci) {
        int l31 = l31_, hh = hh_; asm volatile("" : "+v"(l31), "+v"(hh));
#pragma unroll
        for (int j = 0; j < 4; ++j) { *(LAS u32x4*)(C.lds + R_Q + (qrow + 16 * j) * R_QS + qch * 16) = gq[j]; *(LAS u32x4*)(C.lds + R_K + (qrow + 16 * j) * R_QS + qch * 16) = gk[j]; }
        *(LAS u32x4*)(C.lds + R_V + vrow * R_VS + vch * 16) = gv;
        { u32x4 d;
#pragma unroll
          for (int e = 0; e < 4; ++e) { const unsigned w = gv[e]; d[e] = pk2(__uint_as_float(w << 16) * vdsc, __uint_as_float(w & 0xffff0000u) * vdsc); }
          *(LAS u32x4*)(C.lds + R_VD + vrow * R_VS + vch * 16) = d; }
        __syncthreads();
        if (ci + 1 < 32) RET_LOAD(ci + 1);
        const int rowoff = l31, koff = 16 * hh;
        const int tr_q = (l31 & 15) >> 2, tr_p = l31 & 3, tr_blk = (l31 >> 4) & 1;
        f32x16 acc;
#pragma unroll
        for (int i = 0; i < 16; ++i) acc[i] = 0.f;
        if (wave < 3) {
            const int st = wave >> 1, tt = wave == 0 ? 0 : 1;
            const LAS unsigned char* pa = lds + R_K + (32 * st + rowoff) * R_QS + koff;
            const LAS unsigned char* pb = lds + R_Q + (32 * tt + rowoff) * R_QS + koff;
#pragma unroll 4
            for (int ks = 0; ks < 16; ++ks) acc = MFMA32(*(const LAS bf16x8*)(pa + ks * 32), *(const LAS bf16x8*)(pb + ks * 32), acc);
            const int t = 32 * tt + l31;
#pragma unroll
            for (int g = 0; g < 4; ++g) { float pv[4];
#pragma unroll
                for (int e = 0; e < 4; ++e) { const int s = 32 * st + 8 * g + 4 * hh + e; pv[e] = (t >= s) ? acc[4 * g + e] * __builtin_amdgcn_exp2f((float)(t - s) * lg) : 0.f; }
                u32x2 w; w.x = cvtpk(pv[0], pv[1]); w.y = cvtpk(pv[2], pv[3]);
                *(LAS u32x2*)(C.lds + R_P + t * R_PS + (32 * st + 8 * g + 4 * hh) * 2) = w; }
        } else if (wave >= 4) {
            const int tt = (wave >> 1) & 1, vt = wave & 1;
            const LAS unsigned char* pa = lds + R_Q + (32 * tt + rowoff) * R_QS + koff;
            const LAS unsigned char* pb = lds + R_ST + (32 * vt + rowoff) * R_QS + koff;
#pragma unroll 4
            for (int ks = 0; ks < 16; ++ks) acc = MFMA32(*(const LAS bf16x8*)(pa + ks * 32), *(const LAS bf16x8*)(pb + ks * 32), acc);
#pragma unroll
            for (int i = 0; i < 16; ++i) { const int t = 32 * tt + (i & 3) + 8 * (i >> 2) + 4 * hh; acc[i] *= __builtin_amdgcn_exp2f((float)(t + 1) * lg); }
        }
        __syncthreads();
        if (wave >= 4) {
            const int tt = (wave >> 1) & 1, vt = wave & 1;
            const LAS unsigned char* pa = lds + R_P + (32 * tt + rowoff) * R_PS + koff;
            const LAS unsigned char* pb = lds + R_V + (8 * hh + tr_q) * R_VS + (32 * vt + 16 * tr_blk + 4 * tr_p) * 2;
            for (int ks = 0; ks < 2 * tt + 2; ++ks) acc = MFMA32(*(const LAS bf16x8*)(pa + ks * 32), tr_frag(pb + 16 * ks * R_VS, R_VS), acc);
            bf16_t* orow = OR + (size_t)(row00 + ci * 64 + 32 * tt) * 2048 + h * 512 + vs * 64 + 32 * vt + l31;
#pragma unroll
            for (int i = 0; i < 16; ++i) { const int tl = (i & 3) + 8 * (i >> 2) + 4 * hh; orow[(size_t)tl * 2048] = (bf16_t)f2bf(acc[i]); }
        }
        {
#pragma unroll
            for (int i = 0; i < 16; ++i) { S0[i] *= g64; S1[i] *= g64; }
            const LAS unsigned char* pa = lds + R_K + (8 * hh + tr_q) * R_QS + (32 * wave + 16 * tr_blk + 4 * tr_p) * 2;
            const LAS unsigned char* pb = lds + R_VD + (8 * hh + tr_q) * R_VS + (16 * tr_blk + 4 * tr_p) * 2;
#pragma unroll
            for (int ks = 0; ks < 4; ++ks) { const bf16x8 a = tr_frag(pa + 16 * ks * R_QS, R_QS);
                S0 = MFMA32(a, tr_frag(pb + 16 * ks * R_VS, R_VS), S0); S1 = MFMA32(a, tr_frag(pb + 16 * ks * R_VS + 64, R_VS), S1); }
#pragma unroll
            for (int g = 0; g < 4; ++g) { u32x2 w0, w1; w0.x = cvtpk(S0[4 * g], S0[4 * g + 1]); w0.y = cvtpk(S0[4 * g + 2], S0[4 * g + 3]); w1.x = cvtpk(S1[4 * g], S1[4 * g + 1]); w1.y = cvtpk(S1[4 * g + 2], S1[4 * g + 3]);
                *(LAS u32x2*)(C.lds + R_ST + l31 * R_QS + (32 * wave + 8 * g + 4 * hh) * 2) = w0;
                *(LAS u32x2*)(C.lds + R_ST + (32 + l31) * R_QS + (32 * wave + 8 * g + 4 * hh) * 2) = w1; }
        }
        __syncthreads();
    }
#undef RET_LOAD
    float* so = C.out + O_SRP + ((size_t)(b * 4 + h) * 256 + 32 * wave) * 512 + vs * 64 + l31_;
#pragma unroll
    for (int i = 0; i < 16; ++i) { const int dl = (i & 3) + 8 * (i >> 2) + 4 * hh_; so[(size_t)dl * 512] = S0[i]; so[(size_t)dl * 512 + 32] = S1[i]; }
}
__device__ __forceinline__ void p2_retention_simple(const Ctx& C) {
#ifdef RET_SIMPLE
    for (int it = C.vcu; it < 256; it += C.G) ret_simple_item(C, false, it >> 5, (it >> 3) & 3, it & 7);
#else
    for (int it = C.vcu; it < 256; it += C.G) ret_mfma_item(C, it >> 5, (it >> 3) & 3, it & 7);
    __syncthreads();
#endif
    for (int it = C.vcu; it < 4096; it += C.G) ret_simple_item(C, true, it >> 5, (it >> 3) & 3, it & 7);
}
constexpr int G_WS = 272, G_GS = 320, G_W = 0, G_G = G_W + 128 * G_WS, G_END = G_G + 128 * G_GS;
static_assert(G_END <= LDS_MISC, "gating LDS map");
__device__ __forceinline__ void p2_gating_mfma(const Ctx& C) {
    const int tid = C.tid, wave = C.wave, l31 = C.lane & 31, hh = C.lane >> 5;
    const LAS unsigned char* lds = C.lds;
    const bf16_t* Z = C.w<bf16_t>(WS_Z); const float* LNS = C.w<float>(WS_LNS); bf16_t* YB = C.w<bf16_t>(WS_YB); const bf16_t* WSB = C.w<bf16_t>(WS_WSB);
    const float* b_s = C.in[I_BS]; const float* g_gm = C.in[I_GGM];
    int g_staged = -1;
    for (int it = C.vcu; it < 1024; it += C.G) {
        const int g = it & 7, row0 = (it >> 3) * 128;
        __syncthreads();
        if (g != g_staged) { g_staged = g;
#pragma unroll
            for (int j = 0; j < 4; ++j) { const int idx = tid + NTHR * j, r = idx >> 4, c16 = idx & 15;
                *(LAS u32x4*)(C.lds + G_W + r * G_WS + c16 * 16) = *(const u32x4*)(WSB + ((size_t)g * 128 + r) * 128 + c16 * 8); } }
        { const int c16 = tid & 15; const f32x4 gg0 = *(const f32x4*)(g_gm + g * 128 + c16 * 8), gg1 = *(const f32x4*)(g_gm + g * 128 + c16 * 8 + 4);
#pragma unroll
          for (int j = 0; j < 4; ++j) { const int m = (tid >> 4) + 32 * j, row = row0 + m;
              const float mu = LNS[2 * row] * (1.f / 1024.f), var = LNS[2 * row + 1] * (1.f / 1024.f) - mu * mu, rstd = rsqrtf(var + EPS);
              const bf16_t* src = Z + (size_t)row * INW + CGV + g * 128 + c16 * 8;
              const f32x4 x0 = ld_bf4(src), x1 = ld_bf4(src + 4);
              const f32x4 y0 = (x0 - mu) * rstd * gg0, y1 = (x1 - mu) * rstd * gg1;
              u32x4 w; w.x = cvtpk(y0[0], y0[1]); w.y = cvtpk(y0[2], y0[3]); w.z = cvtpk(y1[0], y1[1]); w.w = cvtpk(y1[2], y1[3]);
              *(LAS u32x4*)(C.lds + G_G + m * G_GS + c16 * 16) = w; } }
        __syncthreads();
        const int nt = wave >> 1, ct0 = 2 * (wave & 1);
        f32x16 a0, a1;
#pragma unroll
        for (int i = 0; i < 16; ++i) { a0[i] = 0.f; a1[i] = 0.f; }
        const int tr_q = (l31 & 15) >> 2, tr_p = l31 & 3, tr_blk = (l31 >> 4) & 1;
        const LAS unsigned char* pw = lds + G_W + (32 * nt + l31) * G_WS + 16 * hh;
        const LAS unsigned char* pg = lds + G_G + (8 * hh + tr_q) * G_GS + (32 * ct0 + 16 * tr_blk + 4 * tr_p) * 2;
        for (int ks = 0; ks < 2 * nt + 2; ++ks) { const bf16x8 bw = *(const LAS bf16x8*)(pw + ks * 32);
            a0 = MFMA32(tr_frag(pg + 16 * ks * G_GS, G_GS), bw, a0); a1 = MFMA32(tr_frag(pg + 16 * ks * G_GS + 64, G_GS), bw, a1); }
        const int n = 32 * nt + l31, row = row0 + n; const float bias = b_s[g * 128 + n];
        const bf16_t* up = Z + (size_t)row * INW + CU + g * 128 + 32 * ct0 + 4 * hh; bf16_t* yp = YB + (size_t)row * DM + g * 128 + 32 * ct0 + 4 * hh;
#pragma unroll
        for (int q4 = 0; q4 < 4; ++q4) {
            const f32x4 o0 = (f32x4){a0[4 * q4], a0[4 * q4 + 1], a0[4 * q4 + 2], a0[4 * q4 + 3]} + bias, o1 = (f32x4){a1[4 * q4], a1[4 * q4 + 1], a1[4 * q4 + 2], a1[4 * q4 + 3]} + bias;
            st_bf4(yp + 8 * q4, ld_bf4(up + 8 * q4) * o0); st_bf4(yp + 32 + 8 * q4, ld_bf4(up + 32 + 8 * q4) * o1); }
    }
    __syncthreads();
}
template <int CH> __device__ __forceinline__ void gate_simple_item(const Ctx& C, int row0, float* gmv_out) {
    LAS float* gvl = (LAS float*)C.lds;
    LAS float* wl = (LAS float*)(C.lds + 65536);
    const bf16_t* Z = C.w<bf16_t>(WS_Z); const float* LNS = C.w<float>(WS_LNS); bf16_t* YB = C.w<bf16_t>(WS_YB);
    const float* w_s = C.in[I_WS]; const float* b_s = C.in[I_BS]; const float* g_gm = C.in[I_GGM];
    for (int g = 0; g < 8; ++g) {
        for (int e = C.tid; e < CH * 128; e += NTHR) { const int m = e >> 7, ch = e & 127; const int row = row0 + m;
            const float mu = LNS[2 * row] * (1.f / 1024.f), var = LNS[2 * row + 1] * (1.f / 1024.f) - mu * mu, rstd = rsqrtf(var + EPS);
            const float x = bf2f(Z[(size_t)row * INW + CGV + g * 128 + ch]); const float y = (x - mu) * rstd * g_gm[g * 128 + ch];
            gvl[e] = y; if (gmv_out) gmv_out[(size_t)m * 1024 + g * 128 + ch] = y;
            wl[e] = (ch < CH) ? w_s[((size_t)g * 128 + m) * 128 + ch] : 0.f; }
        __syncthreads();
        const int ch = C.tid & 127;
        for (int n = C.tid >> 7; n < CH; n += 4) { float acc = b_s[g * 128 + n];
            for (int m = 0; m <= n; ++m) acc += wl[n * 128 + m] * gvl[m * 128 + ch];
            const int row = row0 + n; const float u = bf2f(Z[(size_t)row * INW + CU + g * 128 + ch]);
            YB[(size_t)row * DM + g * 128 + ch] = (bf16_t)f2bf(u * acc); }
        __syncthreads();
    }
}
__device__ __forceinline__ void p2_gating_simple(const Ctx& C) {
#ifdef GATE_SIMPLE
    for (int it = C.vcu; it < 128; it += C.G) gate_simple_item<128>(C, (it >> 4) * 2048 + (it & 15) * 128, nullptr);
#else
    p2_gating_mfma(C);
#endif
    for (int it = C.vcu; it < 128; it += C.G) gate_simple_item<4>(C, MP + 4 * it, C.out + O_GMV + (size_t)it * 4 * 1024);
}
__device__ __forceinline__ void p3_finalize_ya(const Ctx& C) {
    const bf16_t* Z = C.w<bf16_t>(WS_Z); const bf16_t* OR = C.w<bf16_t>(WS_ORAW); bf16_t* YA = C.w<bf16_t>(WS_YA);
    const float* g_ret = C.in[I_GRET];
    const int gw = C.vcu * NWAVES + C.wave, NGW = C.G * NWAVES, lane = C.lane;
    for (int row = gw; row < MT; row += NGW) {
        f32x4 o[8]; float rs[4];
#pragma unroll
        for (int j = 0; j < 8; ++j) o[j] = ld_bf4(OR + (size_t)row * 2048 + 4 * lane + 256 * j);
#pragma unroll
        for (int hd = 0; hd < 4; ++hd) rs[hd] = rsqrtf(wave_sum(sum4(o[2 * hd] * o[2 * hd]) + sum4(o[2 * hd + 1] * o[2 * hd + 1])) * (1.f / 512.f) + EPS);
#pragma unroll
        for (int j = 0; j < 8; ++j) { const int c = 4 * lane + 256 * j;
            const f32x4 gz = ld_bf4(Z + (size_t)row * INW + CG + c), gr = *(const f32x4*)(g_ret + c);
            st_bf4(YA + (size_t)row * 2048 + c, gz * o[j] * rs[j >> 1] * gr); }
    }
}
__device__ __forceinline__ void p9_final_norm(const Ctx& C) {
    const bf16_t* H3 = C.w<bf16_t>(WS_H3); const float* SSQ4 = C.w<float>(WS_SSQ4); const float* gf = C.in[I_GFIN];
    const int gw = C.vcu * NWAVES + C.wave, NGW = C.G * NWAVES, lane = C.lane;
    f32x4 gv[4];
#pragma unroll
    for (int j = 0; j < 4; ++j) gv[j] = ((const f32x4*)gf)[lane + 64 * j];
    for (int row = gw; row < MT; row += NGW) {
        const float rs = rsqrtf(SSQ4[row] * (1.f / DM) + EPS);
        const bf16_t* hr = H3 + (size_t)row * DM + 4 * lane; f32x4* o = (f32x4*)(C.out + O_Y + (size_t)row * DM) + lane;
#pragma unroll
        for (int j = 0; j < 4; ++j) o[64 * j] = ld_bf4(hr + 256 * j) * rs * gv[j];
    }
}
#ifdef DBG_EXPORT
__device__ __forceinline__ void dbg_export(const Ctx& C) {
    const bf16_t* Z = C.w<bf16_t>(WS_Z); const bf16_t* YA = C.w<bf16_t>(WS_YA); const bf16_t* YB = C.w<bf16_t>(WS_YB);
    const int gw = C.vcu * NWAVES + C.wave, NGW = C.G * NWAVES, lane = C.lane;
    for (int row = gw; row < MT; row += NGW)
        for (int j = 0; j < 4; ++j) { const int c = 4 * lane + 256 * j;
            f32x4 v = (f32x4){0.f, 0.f, 0.f, 0.f};
#if DBG_EXPORT == 1
            v = ld_bf4(YB + (size_t)row * DM + c);
#elif DBG_EXPORT == 4
            v = ld_bf4(YA + (size_t)row * 2048 + c) + ld_bf4(YA + (size_t)row * 2048 + 1024 + c);
#elif DBG_EXPORT == 5
            v = ld_bf4(Z + (size_t)row * INW + CGA + c) + ld_bf4(Z + (size_t)row * INW + CGB + c);
#elif DBG_EXPORT == 6
            v = ld_bf4(C.w<bf16_t>(WS_ORAW) + (size_t)row * 2048 + c) + ld_bf4(C.w<bf16_t>(WS_ORAW) + (size_t)row * 2048 + 1024 + c);
#elif DBG_EXPORT == 7
            v = ld_bf4(Z + (size_t)row * INW + CG + c) + ld_bf4(Z + (size_t)row * INW + CG + 1024 + c);
#elif DBG_EXPORT == 8
            v = ld_bf4(Z + (size_t)row * INW + CQ + c);
#endif
            *(f32x4*)(C.out + O_Y + (size_t)row * DM + c) = v; }
}
#endif
constexpr int NPHASE = 10;
__global__ void __launch_bounds__(NTHR, 2) mk_fwd(Args args) {
    extern __shared__ __attribute__((aligned(16))) unsigned char lds_raw[];
    Ctx C;
    C.lds = (LAS unsigned char*)lds_raw; C.tid = threadIdx.x; C.lane = C.tid & 63; C.wave = __builtin_amdgcn_readfirstlane(C.tid >> 6);
    C.G = gridDim.x; { const int bx = blockIdx.x; C.vcu = (C.G % 8 == 0) ? (bx % 8) * (C.G / 8) + bx / 8 : bx; }
    C.in = args.in; C.out = args.out; C.ws = args.ws;
    const int lo = args.ph_lo, hi = args.ph_hi;
    if (C.tid < 64) ((LAS unsigned*)(C.lds + LDS_MISC))[C.tid] = 0u;
    __syncthreads();
    const XcdBarrier bar = xcd_barrier_post((unsigned*)(args.ws + WS_CTL) + 4096, (volatile LAS unsigned*)(C.lds + LDS_MISC));
#define IN(k) (lo <= (k) && (k) < hi)
#define SEAM(k) do { if (IN(k) && IN((k) + 1)) { GRID_BAR(); } } while (0)
#define GRID_BAR() do { xcd_barrier(bar); } while (0)
    if (IN(0)) { p0_prologue(C); } if (IN(0) && IN(1)) cooperative_groups::this_grid().sync();
    if (IN(1)) { F1 f{C.w<bf16_t>(WS_Z), C.w<float>(WS_COS), C.w<float>(WS_SIN), C.w<float>(WS_LNS)}; run_gemm(C, C.w<bf16_t>(WS_XN), C.w<bf16_t>(WS_WIN), MT, INW, DM, f); } SEAM(1);
    if (IN(2)) { p2_retention_simple(C); p2_gating_simple(C); } SEAM(2);
    if (IN(3)) { p3_finalize_ya(C); } SEAM(3);
    if (IN(4)) { { F2a f{C.w<bf16_t>(WS_Z), C.w<bf16_t>(WS_T)}; run_gemm_split(C, C.w<bf16_t>(WS_YA), C.w<bf16_t>(WS_WBRA), DM, 2048, f); }
                 { F2b f{C.w<bf16_t>(WS_Z), C.w<bf16_t>(WS_T), C.w<bf16_t>(WS_MG)}; run_gemm_split(C, C.w<bf16_t>(WS_YB), C.w<bf16_t>(WS_WBRB), DM, DM, f); } } SEAM(4);
    if (IN(5)) { FRes<false> f{C.in[I_XP], C.in[I_XS], nullptr, C.w<bf16_t>(WS_H1B), C.w<float>(WS_SSQ2)}; run_gemm_split(C, C.w<bf16_t>(WS_MG), C.w<bf16_t>(WS_WO), DM, DM, f); } SEAM(5);
    if (IN(6)) { F4 f{C.w<float>(WS_SSQ2), C.w<bf16_t>(WS_U)}; run_gemm_split(C, C.w<bf16_t>(WS_H1B), C.w<bf16_t>(WS_WUP), FF, DM, f); } SEAM(6);
    if (IN(7)) { FRes<true> f{nullptr, nullptr, C.w<bf16_t>(WS_H1B), C.w<bf16_t>(WS_H2B), C.w<float>(WS_SSQ3)}; run_gemm_split(C, C.w<bf16_t>(WS_U), C.w<bf16_t>(WS_WDN), DM, FF, f); } SEAM(7);
    if (IN(8)) { { F6a f{C.w<bf16_t>(WS_PE)}; run_gemm_split(C, C.w<bf16_t>(WS_PB), C.w<bf16_t>(WS_WPP), DM, PLE, f); }
                 { F6b f{C.w<float>(WS_SSQ3), C.w<bf16_t>(WS_H2B), C.w<bf16_t>(WS_PE), C.w<bf16_t>(WS_H3), C.w<float>(WS_SSQ4)}; run_gemm_split(C, C.w<bf16_t>(WS_H2B), C.w<bf16_t>(WS_WPG), DM, DM, f); } } SEAM(8);
    if (IN(9)) { p9_final_norm(C); }
#ifdef DBG_EXPORT
    if (IN(10)) { dbg_export(C); }
#endif
#undef IN
#undef SEAM
#undef GRID_BAR
}
}

extern "C" void kernel_launch(void* const* d_in, const int* in_sizes, int n_in, void* d_out, int out_size, void* d_ws, size_t ws_size, hipStream_t stream) {
    using namespace mk;
    static int grid = 0;
    if (grid == 0) {
        if (n_in != 21 || (size_t)out_size != O_END || ws_size < WS_END) { fprintf(stderr, "kernel_launch: unexpected shapes: n_in %d out %d ws %zu (need %zu)\n", n_in, out_size, ws_size, (size_t)WS_END); grid = -1; return; }
        int dev = 0, cus = 0;
        if (hipGetDevice(&dev) != hipSuccess || hipDeviceGetAttribute(&cus, hipDeviceAttributeMultiprocessorCount, dev) != hipSuccess) { grid = -1; return; }
        if (hipFuncSetAttribute((const void*)mk_fwd, hipFuncAttributeMaxDynamicSharedMemorySize, LDS_BYTES) != hipSuccess) { fprintf(stderr, "kernel_launch: hipFuncSetAttribute failed\n"); grid = -1; return; }
        int per_cu = 0;
        if (hipOccupancyMaxActiveBlocksPerMultiprocessor(&per_cu, (const void*)mk_fwd, NTHR, LDS_BYTES) != hipSuccess || per_cu < 1) { fprintf(stderr, "kernel_launch: occupancy query says %d blocks/CU\n", per_cu); (void)hipGetLastError(); grid = -1; return; }
        grid = cus;
    }
    if (grid < 0) return;
    (void)hipMemsetAsync((char*)d_ws, 0, WS_ZERO_END, stream);
    Args a{};
    for (int i = 0; i < 21; ++i) a.in[i] = (const float*)d_in[i];
    a.out = (float*)d_out; a.ws = (unsigned char*)d_ws;
#ifdef MK_MULTI
    for (int p = 0; p < NPHASE; ++p) { a.ph_lo = p; a.ph_hi = p + 1; hipLaunchKernelGGL(mk_fwd, dim3(grid), dim3(NTHR), LDS_BYTES, stream, a); }
#else
    a.ph_lo = 0; a.ph_hi = NPHASE;
    void* kargs[] = {&a};
    const hipError_t le = hipLaunchCooperativeKernel((const void*)mk_fwd, dim3(grid), dim3(NTHR), kargs, LDS_BYTES, stream);
    if (le != hipSuccess) fprintf(stderr, "kernel_launch: cooperative launch failed: %s (grid %d)\n", hipGetErrorString(le), grid);
#endif
}
```

```cpp
#include <hip/hip_runtime.h>
#include <hip/hip_cooperative_groups.h>
#include <cstdio>
#include <cstdint>
namespace pg8 {
#define PG8_LAS __attribute__((address_space(3)))
typedef unsigned short bf16_t;
typedef short bf16x8 __attribute__((ext_vector_type(8)));
typedef float f32x4 __attribute__((ext_vector_type(4)));
typedef unsigned u32x4 __attribute__((ext_vector_type(4)));
constexpr int BM = 256, BK = 64, HALF = 128, HTB = HALF * BK * 2  , STAGE_BYTES = 8 * HTB, NXCD = 8, WGM = 8;

__host__ __device__ __forceinline__ int lds_byte(int r, int c) { const int st = (r >> 4) * 2 + (c >> 5), rr = r & 15, cc = c & 31, ob = rr * 64 + cc * 2; return st * 1024 + (ob ^ (((ob >> 9) & 1) << 5)); }
__host__ __device__ __forceinline__ void stage_rc(int b, int& R, int& C) { const int st = b / 1024, sb = b % 1024, swz = sb ^ (((sb >> 9) & 1) << 5); R = (st >> 1) * 16 + swz / 64; C = (st & 1) * 32 + (swz % 64) / 2; }
__host__ __device__ __forceinline__ int perm32(int rho) { const int n = rho >> 4, i = rho & 15; return 8 * (i >> 2) + 4 * n + (i & 3); }

struct Unit { int pm, pn; };
struct Gemm { const bf16_t* A; const bf16_t* Bt; int M, N, K; };

struct StaticOrder {
    int nM, nN, nwg, G, c;
    __host__ __device__ void init(int M, int N, int G_, int c_) { nM = M / BM; nN = N / BM; nwg = nM * nN; G = G_; c = c_; }
    __host__ __device__ bool next(int i, Unit& u) const {
        const long L = (long)i * G + c; if (L >= nwg) return false;
        int wgid = (int)L; { const int q = nwg / NXCD, r = nwg % NXCD, xcd = wgid % NXCD, off = wgid / NXCD; wgid = (xcd < r ? xcd * (q + 1) : r * (q + 1) + (xcd - r) * q) + off; }
        const int nig = WGM * nN, gid = wgid / nig, fm = gid * WGM, gsz = (nM - fm) < WGM ? (nM - fm) : WGM;
        u.pm = fm + ((wgid % nig) % gsz); u.pn = (wgid % nig) / gsz; return true;
    }
    __device__ __forceinline__ void a_ready(const Unit&) const {}
    __device__ __forceinline__ void done(const Unit&) const {}
};

__device__ __forceinline__ unsigned cvt_pk_bf16(float lo, float hi) { unsigned r; asm volatile("v_cvt_pk_bf16_f32 %0, %1, %2" : "=v"(r) : "v"(lo), "v"(hi)); return r; }
typedef float f32x2 __attribute__((ext_vector_type(2)));
__device__ __forceinline__ f32x2 gelu_pk(f32x2 v) {
    const f32x2 av = __builtin_elementwise_abs(v), d = av * 0.2316418882f + 1.0f;
    f32x2 t; t.x = __builtin_amdgcn_rcpf(d.x); t.y = __builtin_amdgcn_rcpf(d.y);
    f32x2 q = t * 0.5307027145f + (-0.7265760135f); q = q * t + 0.7107068705f; q = q * t + (-0.142248368f); q = q * t + 0.127414796f; q = q * t;
    const f32x2 s = (v * v) * (-0.72134752044f);
    f32x2 e; e.x = __builtin_amdgcn_exp2f(s.x); e.y = __builtin_amdgcn_exp2f(s.y);
    const f32x2 m = v * (q * e), r = v - m;
    f32x2 o; o.x = v.x < 0.f ? m.x : r.x; o.y = v.y < 0.f ? m.y : r.y; return o;
}
template <class Epi, class Sched, bool ALIGN_EPI = false, bool SP2 = false>
__device__ __forceinline__ void gemm_phase(PG8_LAS unsigned char* lds, const Gemm g, const Sched& S, const Epi& E) {
    const int tid = threadIdx.x, wid = __builtin_amdgcn_readfirstlane(tid >> 6), lane = tid & 63, wr = wid >> 2, wc = wid & 3, fr = lane & 15, fq = lane >> 4;
    const int K = g.K, nt = K / BK;
    unsigned voffA[2], voffB[2];
#pragma unroll
    for (int i = 0; i < 2; ++i) { int R, C; stage_rc(tid * 16 + i * 8192, R, C); const int Rb = Epi::PERM ? ((R & ~31) + perm32(R & 31)) : R;
        voffA[i] = (unsigned)(R * K + C) * 2u; voffB[i] = (unsigned)(Rb * K + C) * 2u; }
    const size_t kstep = (size_t)(BK * 2);
    const size_t hstep = (size_t)HALF * K * 2;
    const size_t tstep = 2 * hstep;
    const unsigned ldsw = (unsigned)wid * 1024u;
    const int aoff = lds_byte(wr * 64 + fr, fq * 8), boff = lds_byte(wc * 32 + fr, fq * 8);
#define PG8_SA(b, h) (((b) * 2 + (h)) * HTB)
#define PG8_SB(b, h) ((4 + (b) * 2 + (h)) * HTB)
#define PG8_STAGE(bufoff, gbase, voff) do { _Pragma("unroll") for (int _i = 0; _i < 2; ++_i) \
        __builtin_amdgcn_global_load_lds((const unsigned*)((const char*)(gbase) + (voff)[_i]), (PG8_LAS unsigned*)(lds + (bufoff) + ldsw + _i * 8192), 16, 0, 0); } while (0)
#define PG8_LDA(dst, b, h) do { _Pragma("unroll") for (int m = 0; m < 4; ++m) _Pragma("unroll") for (int k = 0; k < 2; ++k) dst[m][k] = *(const PG8_LAS bf16x8*)(lds + PG8_SA(b, h) + aoff + m * 2048 + k * 1024); } while (0)
#define PG8_LDB(dst, b, h) do { _Pragma("unroll") for (int n = 0; n < 2; ++n) _Pragma("unroll") for (int k = 0; k < 2; ++k) dst[n][k] = *(const PG8_LAS bf16x8*)(lds + PG8_SB(b, h) + boff + n * 2048 + k * 1024); } while (0)
#define PG8_MMA(ai, bj, At, Bt) do { __builtin_amdgcn_s_setprio(1); _Pragma("unroll") for (int m = 0; m < 4; ++m) _Pragma("unroll") for (int n = 0; n < 2; ++n) _Pragma("unroll") for (int k = 0; k < 2; ++k) \
        acc[ai][bj][m][n] = __builtin_amdgcn_mfma_f32_16x16x32_bf16(Bt[n][k], At[m][k], acc[ai][bj][m][n], 0, 0, 0); __builtin_amdgcn_s_setprio(0); } while (0)
#define PG8_WAIT_V(n) asm volatile("s_waitcnt vmcnt(" #n ")" ::: "memory")
#define PG8_WAIT_L(n) asm volatile("s_waitcnt lgkmcnt(" #n ")" ::: "memory")
#define PG8_BAR __builtin_amdgcn_s_barrier()
#define PG8_SCHED __builtin_amdgcn_sched_barrier(0)
    Unit cur, nxt; int ui = 0;
    if (!S.next(0, cur)) return;
    f32x4 acc[2][2][4][2];
#pragma unroll
    for (int a = 0; a < 2; ++a)
#pragma unroll
        for (int b = 0; b < 2; ++b)
#pragma unroll
            for (int m = 0; m < 4; ++m)
#pragma unroll
                for (int n = 0; n < 2; ++n) acc[a][b][m][n] = (f32x4){0.f, 0.f, 0.f, 0.f};
    bf16x8 At[4][2], B0[2][2], B1[2][2];
    const char* cA = (const char*)g.A + (size_t)cur.pm * tstep; const char* cB = (const char*)g.Bt + (size_t)cur.pn * tstep;
    S.a_ready(cur);
    if constexpr (SP2) {
        PG8_STAGE(PG8_SB(0, 0), cB, voffB); PG8_STAGE(PG8_SB(0, 1), cB + hstep, voffB); PG8_STAGE(PG8_SA(0, 0), cA, voffA); PG8_STAGE(PG8_SA(0, 1), cA + hstep, voffA);
        if (wr == 1) PG8_BAR;
        PG8_WAIT_V(2); PG8_BAR;
        PG8_STAGE(PG8_SB(1, 0), cB + kstep, voffB); PG8_STAGE(PG8_SA(1, 0), cA + kstep, voffA); PG8_STAGE(PG8_SB(1, 1), cB + hstep + kstep, voffB);
        PG8_WAIT_V(6); PG8_BAR;
    } else {
        PG8_STAGE(PG8_SB(0, 0), cB, voffB); PG8_STAGE(PG8_SA(0, 0), cA, voffA); PG8_STAGE(PG8_SB(0, 1), cB + hstep, voffB); PG8_STAGE(PG8_SA(0, 1), cA + hstep, voffA);
        if (wr == 1) PG8_BAR;
        PG8_WAIT_V(4); PG8_BAR;
        PG8_STAGE(PG8_SB(1, 0), cB + kstep, voffB); PG8_STAGE(PG8_SA(1, 0), cA + kstep, voffA); PG8_STAGE(PG8_SB(1, 1), cB + hstep + kstep, voffB);
        PG8_WAIT_V(6); PG8_BAR;
    }
    for (;;) {
        const bool has_next = S.next(ui + 1, nxt);
        const char* nA = has_next ? (const char*)g.A + (size_t)nxt.pm * tstep : cA; const char* nB = has_next ? (const char*)g.Bt + (size_t)nxt.pn * tstep : cB;
        for (int t = 0; t < nt; t += 2) {
            const bool last = (t == nt - 2);
            const char* a1 = cA + (size_t)(t + 1) * kstep;
            const char* a2 = last ? nA : cA + (size_t)(t + 2) * kstep; const char* b2 = last ? nB : cB + (size_t)(t + 2) * kstep;
            const char* a3 = a2 + kstep; const char* b3 = b2 + kstep;
            if (last && has_next) S.a_ready(nxt);
            if constexpr (SP2) {
            PG8_LDB(B0, 0, 0); PG8_LDB(B1, 0, 1); PG8_SCHED; PG8_LDA(At, 0, 0); PG8_STAGE(PG8_SA(1, 1), a1 + hstep, voffA);
            PG8_WAIT_V(8); PG8_WAIT_L(0); PG8_BAR; PG8_MMA(0, 0, At, B0); PG8_MMA(0, 1, At, B1); PG8_BAR; PG8_SCHED;
            PG8_LDA(At, 0, 1); PG8_STAGE(PG8_SB(0, 0), b2, voffB); PG8_STAGE(PG8_SB(0, 1), b2 + hstep, voffB); PG8_STAGE(PG8_SA(0, 0), a2, voffA);
            PG8_WAIT_V(8); PG8_WAIT_L(0); PG8_BAR; PG8_MMA(1, 0, At, B0); PG8_MMA(1, 1, At, B1); PG8_BAR; PG8_SCHED;
            PG8_LDB(B0, 1, 0); PG8_LDB(B1, 1, 1); PG8_SCHED; PG8_LDA(At, 1, 0); PG8_STAGE(PG8_SA(0, 1), a2 + hstep, voffA);
            PG8_WAIT_V(8); PG8_WAIT_L(0); PG8_BAR; PG8_MMA(0, 0, At, B0); PG8_MMA(0, 1, At, B1); PG8_BAR; PG8_SCHED;
            PG8_LDA(At, 1, 1); PG8_STAGE(PG8_SB(1, 0), b3, voffB); PG8_STAGE(PG8_SB(1, 1), b3 + hstep, voffB); PG8_STAGE(PG8_SA(1, 0), a3, voffA);
            PG8_WAIT_V(8); PG8_WAIT_L(0); PG8_BAR; PG8_MMA(1, 0, At, B0); PG8_MMA(1, 1, At, B1); PG8_BAR; PG8_SCHED;
            } else {
            PG8_LDB(B0, 0, 0); PG8_SCHED; PG8_LDA(At, 0, 0); PG8_STAGE(PG8_SA(1, 1), a1 + hstep, voffA);
            PG8_WAIT_L(8); PG8_BAR; PG8_WAIT_L(0); PG8_MMA(0, 0, At, B0); PG8_BAR; PG8_SCHED;
            PG8_LDB(B1, 0, 1); PG8_STAGE(PG8_SB(0, 0), b2, voffB);
            PG8_BAR; PG8_WAIT_L(0); PG8_MMA(0, 1, At, B1); PG8_BAR;
            PG8_LDA(At, 0, 1); PG8_STAGE(PG8_SA(0, 0), a2, voffA);
            PG8_BAR; PG8_WAIT_L(0); PG8_MMA(1, 0, At, B0); PG8_BAR; PG8_SCHED;
            PG8_STAGE(PG8_SB(0, 1), b2 + hstep, voffB);
            PG8_WAIT_V(6); PG8_BAR; PG8_MMA(1, 1, At, B1); PG8_BAR;
            PG8_LDB(B0, 1, 0); PG8_SCHED; PG8_LDA(At, 1, 0); PG8_STAGE(PG8_SA(0, 1), a2 + hstep, voffA);
            PG8_WAIT_L(8); PG8_BAR; PG8_WAIT_L(0); PG8_MMA(0, 0, At, B0); PG8_BAR; PG8_SCHED;
            PG8_LDB(B1, 1, 1); PG8_STAGE(PG8_SB(1, 0), b3, voffB);
            PG8_BAR; PG8_WAIT_L(0); PG8_MMA(0, 1, At, B1); PG8_BAR;
            PG8_LDA(At, 1, 1); PG8_STAGE(PG8_SA(1, 0), a3, voffA);
            PG8_BAR; PG8_WAIT_L(0); PG8_MMA(1, 0, At, B0); PG8_BAR; PG8_SCHED;
            PG8_STAGE(PG8_SB(1, 1), b3 + hstep, voffB);
            PG8_WAIT_V(6); PG8_BAR; PG8_MMA(1, 1, At, B1); PG8_BAR;
            }
        }
        if constexpr (ALIGN_EPI) { if (wr == 0) PG8_BAR; }
        if constexpr (!Epi::AFTER_DRAIN) { E(acc, cur, wr, wc, fr, fq); S.done(cur); }
        if (!has_next) break;
#pragma unroll
        for (int a = 0; a < 2; ++a)
#pragma unroll
            for (int b = 0; b < 2; ++b)
#pragma unroll
                for (int m = 0; m < 4; ++m)
#pragma unroll
                    for (int n = 0; n < 2; ++n) acc[a][b][m][n] = (f32x4){0.f, 0.f, 0.f, 0.f};
        cur = nxt; cA = nA; cB = nB; ++ui;
        if constexpr (ALIGN_EPI) { if (wr == 1) PG8_BAR; }
    }
    PG8_WAIT_V(0);
    if constexpr (!ALIGN_EPI) { if (wr == 0) PG8_BAR; }
    PG8_BAR;
    if constexpr (Epi::AFTER_DRAIN) { E.fused(acc, cur, wr, wc, fr, fq, lds, wid, lane); S.done(cur); }
#undef PG8_SA
#undef PG8_SB
#undef PG8_STAGE
#undef PG8_LDA
#undef PG8_LDB
#undef PG8_MMA
#undef PG8_WAIT_V
#undef PG8_WAIT_L
#undef PG8_BAR
#undef PG8_SCHED
}
}

namespace mk {
using pg8::bf16_t; using pg8::f32x4; using pg8::f32x2; using pg8::Unit; using pg8::cvt_pk_bf16; using pg8::gelu_pk;
typedef unsigned u32x2 __attribute__((ext_vector_type(2)));
typedef unsigned u32x4 __attribute__((ext_vector_type(4)));
#define LAS __attribute__((address_space(3)))

constexpr int MP = 16384, MS = 512, MT = MP + MS, DM = 1024, INW = 10240, FF = 4096, PLE = 256;
constexpr int CQ = 0, CK = 1024, CV = 2048, CG = 4096, CU = 6144, CGV = 7168, CGA = 8192, CGB = 9216;
constexpr int NTAB = 2048 + 4;
constexpr float EPS = 1e-6f;
constexpr int NWAVES = 8, NTHR = 512;

constexpr size_t O_Y = 0;
constexpr size_t O_SRP = (size_t)MT * DM;
constexpr size_t O_SRS = O_SRP + (size_t)8 * 4 * 256 * 512;
constexpr size_t O_GMV = O_SRS + (size_t)128 * 4 * 256 * 512;
constexpr size_t O_END = O_GMV + (size_t)128 * 4 * 1024;

constexpr size_t al256(size_t x) { return (x + 255) & ~(size_t)255; }
constexpr size_t WS_CTL = 0, CTL_BYTES = 1u << 20;
constexpr size_t WS_LNS = WS_CTL + CTL_BYTES;
constexpr size_t WS_SSQO = WS_LNS + al256((size_t)MT * 2 * 4);
constexpr size_t WS_SSQ2 = WS_SSQO + al256((size_t)MT * 4 * 4);
constexpr size_t WS_SSQ3 = WS_SSQ2 + al256((size_t)MT * 4);
constexpr size_t WS_SSQ4 = WS_SSQ3 + al256((size_t)MT * 4);
constexpr size_t WS_ZERO_END = WS_SSQ4 + al256((size_t)MT * 4);
constexpr size_t WS_COS = al256(WS_ZERO_END);
constexpr size_t WS_SIN = WS_COS + al256((size_t)NTAB * 128 * 4);
constexpr size_t WS_WIN = WS_SIN + al256((size_t)NTAB * 128 * 4);
constexpr size_t WS_WBRA = WS_WIN + (size_t)INW * DM * 2;
constexpr size_t WS_WBRB = WS_WBRA + (size_t)DM * 2048 * 2;
constexpr size_t WS_WO = WS_WBRB + (size_t)DM * DM * 2;
constexpr size_t WS_WUP = WS_WO + (size_t)DM * DM * 2;
constexpr size_t WS_WDN = WS_WUP + (size_t)FF * DM * 2;
constexpr size_t WS_WPG = WS_WDN + (size_t)DM * FF * 2;
constexpr size_t WS_WPP = WS_WPG + (size_t)DM * DM * 2;
constexpr size_t WS_WSB = WS_WPP + (size_t)DM * PLE * 2;
constexpr size_t WS_XN = WS_WSB + (size_t)8 * 128 * 128 * 2;
constexpr size_t WS_PB = WS_XN + (size_t)MT * DM * 2;
constexpr size_t WS_A = WS_PB + (size_t)MT * PLE * 2;
constexpr size_t WS_Z = WS_A;
constexpr size_t WS_U = WS_A;
constexpr size_t WS_H2 = WS_U + (size_t)MT * FF * 2;
constexpr size_t WS_H2B = WS_H2 + (size_t)MT * DM * 4;
constexpr size_t WS_PE = WS_H2B + (size_t)MT * DM * 2;
constexpr size_t WS_A_END = WS_A + (size_t)MT * INW * 2;
static_assert(WS_PE + (size_t)MT * DM * 4 <= WS_A_END, "region A overlay");
constexpr size_t WS_ORAW = WS_A_END;
constexpr size_t WS_H3 = WS_ORAW;
constexpr size_t WS_YA = WS_ORAW + (size_t)MT * 2048 * 2;
constexpr size_t WS_YB = WS_YA + (size_t)MT * 2048 * 2;
constexpr size_t WS_T = WS_YB + (size_t)MT * DM * 2;
constexpr size_t WS_MG = WS_T + (size_t)MT * DM * 4;
constexpr size_t WS_H1 = WS_MG + (size_t)MT * DM * 2;
constexpr size_t WS_H1B = WS_H1 + (size_t)MT * DM * 4;
constexpr size_t WS_END = WS_H1B + (size_t)MT * DM * 2;

constexpr int LDS_RING = 131072, LDS_BYTES = 163840, LDS_MISC = LDS_BYTES - 256;

struct Args {
    const float* in[21]; float* out; unsigned char* ws; int ph_lo, ph_hi;
};

__device__ __forceinline__ float bf2f(unsigned short u) { return __uint_as_float((unsigned)u << 16); }
__device__ __forceinline__ unsigned f2bf(float f) { unsigned u = __float_as_uint(f); return (u + 0x7fffu + ((u >> 16) & 1u)) >> 16; }
__device__ __forceinline__ unsigned pk2(float lo, float hi) { return f2bf(lo) | (f2bf(hi) << 16); }
__device__ __forceinline__ f32x4 ld_bf4(const bf16_t* p) { const u32x2 w = *(const u32x2*)p; return (f32x4){__uint_as_float(w.x << 16), __uint_as_float(w.x & 0xffff0000u), __uint_as_float(w.y << 16), __uint_as_float(w.y & 0xffff0000u)}; }
typedef float f32x2_t __attribute__((ext_vector_type(2))); typedef __bf16 bf16x2_t __attribute__((ext_vector_type(2)));
__device__ __forceinline__ unsigned cvtpk(float lo, float hi) { const f32x2_t v = {lo, hi}; const bf16x2_t b = __builtin_convertvector(v, bf16x2_t); return __builtin_bit_cast(unsigned, b); }
__device__ __forceinline__ void st_bf4(bf16_t* p, f32x4 v) { u32x2 w; w.x = cvtpk(v[0], v[1]); w.y = cvtpk(v[2], v[3]); *(u32x2*)p = w; }
__device__ __forceinline__ void ld_bf8(const bf16_t* p, f32x4& a, f32x4& b) { const u32x4 w = *(const u32x4*)p;
    a = (f32x4){__uint_as_float(w.x << 16), __uint_as_float(w.x & 0xffff0000u), __uint_as_float(w.y << 16), __uint_as_float(w.y & 0xffff0000u)};
    b = (f32x4){__uint_as_float(w.z << 16), __uint_as_float(w.z & 0xffff0000u), __uint_as_float(w.w << 16), __uint_as_float(w.w & 0xffff0000u)}; }
__device__ __forceinline__ void st_bf8(bf16_t* p, f32x4 a, f32x4 b) { u32x4 w; w.x = cvtpk(a[0], a[1]); w.y = cvtpk(a[2], a[3]); w.z = cvtpk(b[0], b[1]); w.w = cvtpk(b[2], b[3]); *(u32x4*)p = w; }
__device__ __forceinline__ float sigmoidf_(float x) { return __builtin_amdgcn_rcpf(1.0f + __builtin_amdgcn_exp2f(-1.4426950408889634f * x)); }
__device__ __forceinline__ f32x4 sigmoid4(f32x4 v) { return (f32x4){sigmoidf_(v[0]), sigmoidf_(v[1]), sigmoidf_(v[2]), sigmoidf_(v[3])}; }
__device__ __forceinline__ f32x4 silu4(f32x4 v) { return v * sigmoid4(v); }
__device__ __forceinline__ f32x4 gelu4(f32x4 v) { const f32x2 a = gelu_pk((f32x2){v[0], v[1]}), b = gelu_pk((f32x2){v[2], v[3]}); return (f32x4){a.x, a.y, b.x, b.y}; }
__device__ __forceinline__ float sum4(f32x4 v) { return (v[0] + v[1]) + (v[2] + v[3]); }
__device__ __forceinline__ float wave_sum(float v) {
#pragma unroll
    for (int o = 1; o < 64; o <<= 1) v += __shfl_xor(v, o);
    return v;
}
__device__ __forceinline__ int tab_index(int row) { return row < MP ? (row & 2047) : 2048 + (row & 3); }

template <class F> struct EpiGen {
    static constexpr bool PERM = true, AFTER_DRAIN = false;
    F f;
    template <int KIND> __device__ __forceinline__ void run(const f32x4 (&acc)[2][2][4][2], int row0, int col0, int fq) const {
#pragma unroll
        for (int ai = 0; ai < 2; ++ai)
#pragma unroll
            for (int m = 0; m < 4; ++m) {
                const int row = row0 + ai * 128 + m * 16;
                float red[2] = {0.f, 0.f};
                const typename F::RowCtx rc = f.template row_begin<KIND>(row);
                f.template oct<KIND>(rc, row, col0, acc[ai][0][m][0], acc[ai][0][m][1], col0 + 128, acc[ai][1][m][0], acc[ai][1][m][1], red);
                if (F::template nred<KIND>() > 0) {
                    red[0] += __shfl_xor(red[0], 16); red[0] += __shfl_xor(red[0], 32);
                    if (F::template nred<KIND>() > 1) { red[1] += __shfl_xor(red[1], 16); red[1] += __shfl_xor(red[1], 32); }
                    if (fq == 0) f.template row_add<KIND>(row, red);
                }
                asm volatile("" ::: "memory");
            }
    }
    __device__ __forceinline__ void operator()(const f32x4 (&acc)[2][2][4][2], const Unit& u, int wr, int wc, int fr, int fq) const {
        const int row0 = u.pm * 256 + wr * 64 + fr, col0 = u.pn * 256 + wc * 32 + 8 * fq;
        const int kind = f.kind(u.pn * 256);
        if (F::NK == 1) { run<0>(acc, row0, col0, fq); return; }
        switch (kind) {
            case 0: run<0>(acc, row0, col0, fq); break;
            case 1: run<(F::NK > 1 ? 1 : 0)>(acc, row0, col0, fq); break;
            case 2: run<(F::NK > 2 ? 2 : 0)>(acc, row0, col0, fq); break;
            case 3: run<(F::NK > 3 ? 3 : 0)>(acc, row0, col0, fq); break;
            case 4: run<(F::NK > 4 ? 4 : 0)>(acc, row0, col0, fq); break;
            default: run<(F::NK > 5 ? 5 : 0)>(acc, row0, col0, fq); break;
        }
    }
};
#define F_COMMON1 static constexpr int NK = 1; __device__ __forceinline__ int kind(int) const { return 0; }

struct F1 {
    static constexpr int NK = 6; typedef int RowCtx;
    bf16_t* Z; const float* cosT; const float* sinT; float* LNS;
    __device__ __forceinline__ int kind(int cb) const { return cb < CV ? 0 : cb < CG ? 1 : cb < CU ? 2 : cb < CGV ? 3 : cb < CGA ? 4 : 5; }
    template <int K> static __device__ __forceinline__ constexpr int nred() { return K == 4 ? 2 : 0; }
    template <int K> __device__ __forceinline__ RowCtx row_begin(int row) const { return K == 0 ? tab_index(row) * 128 : 0; }
    template <int K> __device__ __forceinline__ void oct(RowCtx rc, int row, int c0, f32x4 a0, f32x4 a1, int c1, f32x4 b0, f32x4 b1, float (&red)[2]) const {
        bf16_t* zr = Z + (size_t)row * INW;
        if (K == 0) { const int i0 = c0 & 255; const f32x4 cs0 = *(const f32x4*)(cosT + rc + i0), cs1 = *(const f32x4*)(cosT + rc + i0 + 4), sn0 = *(const f32x4*)(sinT + rc + i0), sn1 = *(const f32x4*)(sinT + rc + i0 + 4);
            st_bf8(zr + c0, a0 * cs0 - b0 * sn0, a1 * cs1 - b1 * sn1); st_bf8(zr + c1, b0 * cs0 + a0 * sn0, b1 * cs1 + a1 * sn1); }
        else if (K == 1) { st_bf8(zr + c0, a0, a1); st_bf8(zr + c1, b0, b1); }
        else if (K == 2) { st_bf8(zr + c0, silu4(a0), silu4(a1)); st_bf8(zr + c1, silu4(b0), silu4(b1)); }
        else if (K == 3) { st_bf8(zr + c0, gelu4(a0), gelu4(a1)); st_bf8(zr + c1, gelu4(b0), gelu4(b1)); }
        else if (K == 4) { const f32x4 g0 = gelu4(a0), g1 = gelu4(a1), g2 = gelu4(b0), g3 = gelu4(b1); st_bf8(zr + c0, g0, g1); st_bf8(zr + c1, g2, g3);
            red[0] += (sum4(g0) + sum4(g1)) + (sum4(g2) + sum4(g3)); red[1] += (sum4(g0 * g0) + sum4(g1 * g1)) + (sum4(g2 * g2) + sum4(g3 * g3)); }
        else { st_bf8(zr + c0, sigmoid4(a0), sigmoid4(a1)); st_bf8(zr + c1, sigmoid4(b0), sigmoid4(b1)); }
    }
    template <int K> __device__ __forceinline__ void row_add(int row, const float (&red)[2]) const { atomicAdd(LNS + 2 * row, red[0]); atomicAdd(LNS + 2 * row + 1, red[1]); }
};
struct F2a {
    F_COMMON1 typedef int RowCtx;
    const bf16_t* Z; bf16_t* T;
    template <int K> static __device__ __forceinline__ constexpr int nred() { return 0; }
    template <int K> __device__ __forceinline__ RowCtx row_begin(int) const { return 0; }
    template <int K> __device__ __forceinline__ void oct(RowCtx, int row, int c0, f32x4 a0, f32x4 a1, int c1, f32x4 b0, f32x4 b1, float (&)[2]) const {
        const bf16_t* g = Z + (size_t)row * INW + CGA; bf16_t* t = T + (size_t)row * DM; f32x4 g0, g1;
        ld_bf8(g + c0, g0, g1); st_bf8(t + c0, g0 * a0, g1 * a1); ld_bf8(g + c1, g0, g1); st_bf8(t + c1, g0 * b0, g1 * b1);
    }
    template <int K> __device__ __forceinline__ void row_add(int, const float (&)[2]) const {}
};
struct F2b {
    F_COMMON1 typedef int RowCtx;
    const bf16_t* Z; const bf16_t* T; bf16_t* MG;
    template <int K> static __device__ __forceinline__ constexpr int nred() { return 0; }
    template <int K> __device__ __forceinline__ RowCtx row_begin(int) const { return 0; }
    template <int K> __device__ __forceinline__ void oct(RowCtx, int row, int c0, f32x4 a0, f32x4 a1, int c1, f32x4 b0, f32x4 b1, float (&)[2]) const {
        const bf16_t* g = Z + (size_t)row * INW + CGB; const bf16_t* t = T + (size_t)row * DM; bf16_t* o = MG + (size_t)row * DM; f32x4 g0, g1, t0, t1;
        ld_bf8(g + c0, g0, g1); ld_bf8(t + c0, t0, t1); st_bf8(o + c0, t0 + g0 * a0, t1 + g1 * a1);
        ld_bf8(g + c1, g0, g1); ld_bf8(t + c1, t0, t1); st_bf8(o + c1, t0 + g0 * b0, t1 + g1 * b1);
    }
    template <int K> __device__ __forceinline__ void row_add(int, const float (&)[2]) const {}
};
template <bool BF> struct FRes {
    F_COMMON1 typedef size_t RowCtx;
    const float* baseP; const float* baseS; const bf16_t* baseB; bf16_t* HB; float* SSQ;
    template <int K> static __device__ __forceinline__ constexpr int nred() { return 1; }
    template <int K> __device__ __forceinline__ RowCtx row_begin(int row) const { return (size_t)row * DM; }
    template <int K> __device__ __forceinline__ void oct(RowCtx ro, int row, int c0, f32x4 a0, f32x4 a1, int c1, f32x4 b0, f32x4 b1, float (&red)[2]) const {
        f32x4 x0, x1, x2, x3;
        if (BF) { ld_bf8(baseB + ro + c0, x0, x1); ld_bf8(baseB + ro + c1, x2, x3); }
        else { const float* xr = row < MP ? baseP + ro : baseS + (ro - (size_t)MP * DM); x0 = *(const f32x4*)(xr + c0); x1 = *(const f32x4*)(xr + c0 + 4); x2 = *(const f32x4*)(xr + c1); x3 = *(const f32x4*)(xr + c1 + 4); }
        const f32x4 h0 = x0 + a0, h1 = x1 + a1, h2 = x2 + b0, h3 = x3 + b1;
        st_bf8(HB + ro + c0, h0, h1); st_bf8(HB + ro + c1, h2, h3);
        red[0] += (sum4(h0 * h0) + sum4(h1 * h1)) + (sum4(h2 * h2) + sum4(h3 * h3));
    }
    template <int K> __device__ __forceinline__ void row_add(int row, const float (&red)[2]) const { atomicAdd(SSQ + row, red[0]); }
};
struct F4 {
    F_COMMON1 typedef float RowCtx;
    const float* SSQ; bf16_t* U;
    template <int K> static __device__ __forceinline__ constexpr int nred() { return 0; }
    template <int K> __device__ __forceinline__ RowCtx row_begin(int row) const { return rsqrtf(SSQ[row] * (1.0f / DM) + EPS); }
    template <int K> __device__ __forceinline__ void oct(RowCtx rs, int row, int c0, f32x4 a0, f32x4 a1, int c1, f32x4 b0, f32x4 b1, float (&)[2]) const {
        bf16_t* u = U + (size_t)row * FF; const f32x4 z = (f32x4){0.f, 0.f, 0.f, 0.f};
        a0 = __builtin_elementwise_max(a0 * rs, z); a1 = __builtin_elementwise_max(a1 * rs, z); b0 = __builtin_elementwise_max(b0 * rs, z); b1 = __builtin_elementwise_max(b1 * rs, z);
        st_bf8(u + c0, a0 * a0, a1 * a1); st_bf8(u + c1, b0 * b0, b1 * b1);
    }
    template <int K> __device__ __forceinline__ void row_add(int, const float (&)[2]) const {}
};
struct F6a {
    F_COMMON1 typedef int RowCtx;
    bf16_t* PE;
    template <int K> static __device__ __forceinline__ constexpr int nred() { return 0; }
    template <int K> __device__ __forceinline__ RowCtx row_begin(int) const { return 0; }
    template <int K> __device__ __forceinline__ void oct(RowCtx, int row, int c0, f32x4 a0, f32x4 a1, int c1, f32x4 b0, f32x4 b1, float (&)[2]) const {
        bf16_t* p = PE + (size_t)row * DM; st_bf8(p + c0, a0, a1); st_bf8(p + c1, b0, b1);
    }
    template <int K> __device__ __forceinline__ void row_add(int, const float (&)[2]) const {}
};
struct F6b {
    F_COMMON1 typedef float RowCtx;
    const float* SSQ3; const bf16_t* H2; const bf16_t* PE; bf16_t* H3; float* SSQ4;
    template <int K> static __device__ __forceinline__ constexpr int nred() { return 1; }
    template <int K> __device__ __forceinline__ RowCtx row_begin(int row) const { return rsqrtf(SSQ3[row] * (1.0f / DM) + EPS); }
    template <int K> __device__ __forceinline__ void oct(RowCtx rs, int row, int c0, f32x4 a0, f32x4 a1, int c1, f32x4 b0, f32x4 b1, float (&red)[2]) const {
        const size_t o = (size_t)row * DM; f32x4 h0, h1, p0, p1;
        ld_bf8(H2 + o + c0, h0, h1); ld_bf8(PE + o + c0, p0, p1); h0 = h0 + sigmoid4(a0 * rs) * p0; h1 = h1 + sigmoid4(a1 * rs) * p1; st_bf8(H3 + o + c0, h0, h1);
        float s = sum4(h0 * h0) + sum4(h1 * h1);
        ld_bf8(H2 + o + c1, h0, h1); ld_bf8(PE + o + c1, p0, p1); h0 = h0 + sigmoid4(b0 * rs) * p0; h1 = h1 + sigmoid4(b1 * rs) * p1; st_bf8(H3 + o + c1, h0, h1);
        red[0] += s + sum4(h0 * h0) + sum4(h1 * h1);
    }
    template <int K> __device__ __forceinline__ void row_add(int row, const float (&red)[2]) const { atomicAdd(SSQ4 + row, red[0]); }
};
#define XB_TMO      128
#define XB_XCNT(j)  (256  + 64 * (j))
#define XB_XSUB(j)  (1280 + 64 * (j))
#define XB_XGEN(j)  (2304 + 64 * (j))
#define XB_TOP      3328
#define XB_TOPGEN   3392
#define XCD_BAR_WORDS 3456
#define XB_SPIN_CAP (1u << 21)

__device__ __forceinline__ unsigned xb_ld(unsigned* p)              { return __hip_atomic_load(p, __ATOMIC_RELAXED, __HIP_MEMORY_SCOPE_AGENT); }
__device__ __forceinline__ unsigned xb_add(unsigned* p, unsigned v) { return __hip_atomic_fetch_add(p, v, __ATOMIC_RELAXED, __HIP_MEMORY_SCOPE_AGENT); }
__device__ __forceinline__ unsigned xb_xcc_id() { return (unsigned)__builtin_amdgcn_s_getreg((3 << 11) | 20) & 0xFu; }
#define XB_SPIN(cond, bar) do { unsigned _sp = 0; while (cond) { __builtin_amdgcn_s_sleep(1); \
    if ((++_sp & 255u) == 0u) { if (xb_ld(&(bar)[XB_TMO])) break; if (_sp > XB_SPIN_CAP) { atomicAdd(&(bar)[XB_TMO], 1u); break; } } } } while (0)

struct XcdBarrier {
    unsigned* bar; unsigned x;
    volatile LAS unsigned* st;
};

__device__ __forceinline__ XcdBarrier xcd_barrier_post(unsigned* bar, volatile LAS unsigned* st) {
    XcdBarrier b; b.bar = bar; b.x = xb_xcc_id(); b.st = st;
    if (threadIdx.x == 0) (void)xb_add(&bar[XB_XCNT(b.x)], 1u);
    return b;
}
__device__ __forceinline__ void xcd_barrier_complete(unsigned* bar, unsigned x, unsigned& nloc, unsigned& nx) {
    const unsigned G = gridDim.x * gridDim.y * gridDim.z;
    unsigned sum, cnt, mine, sp = 0u;
    for (;;) {
        sum = 0u; cnt = 0u; mine = 0u;
#pragma unroll
        for (unsigned j = 0; j < 16; ++j) { const unsigned c = xb_ld(&bar[XB_XCNT(j)]); sum += c; cnt += (c > 0u) ? 1u : 0u; mine = (j == x) ? c : mine; }
        if (sum == G) break;
        __builtin_amdgcn_s_sleep(1);
        if ((++sp & 255u) == 0u) { if (xb_ld(&bar[XB_TMO])) break; if (sp > XB_SPIN_CAP) { atomicAdd(&bar[XB_TMO], 1u); break; } }
    }
    nloc = mine > 0u ? mine : 1u; nx = cnt > 0u ? cnt : 1u;
}

__device__ __forceinline__ void xcd_barrier(const XcdBarrier& b) {
    asm volatile("s_waitcnt vmcnt(0)" ::: "memory");
    __syncthreads();
    if (threadIdx.x == 0) {
        unsigned* bar = b.bar;
        __builtin_amdgcn_s_waitcnt(0);
        unsigned nloc = b.st[0], nx = b.st[1];
        if (nloc == 0u) { xcd_barrier_complete(bar, b.x, nloc, nx); b.st[0] = nloc; b.st[1] = nx; }
        const unsigned old = xb_add(&bar[XB_XSUB(b.x)], 1u);
        const unsigned gen = old / nloc;
        if (old + 1u == (gen + 1u) * nloc) {
            __builtin_amdgcn_fence(__ATOMIC_RELEASE, "agent");
            asm volatile("s_waitcnt vmcnt(0)" ::: "memory");
            const unsigned og = xb_add(&bar[XB_TOP], 1u);
            const unsigned tg = og / nx;
            if (og + 1u == (tg + 1u) * nx) xb_add(&bar[XB_TOPGEN], 1u);
            else XB_SPIN(xb_ld(&bar[XB_TOPGEN]) == tg, bar);
            __builtin_amdgcn_fence(__ATOMIC_ACQUIRE, "agent");
            xb_add(&bar[XB_XGEN(b.x)], 1u);
            asm volatile("s_waitcnt vmcnt(0)" ::: "memory");
        } else {
            XB_SPIN(xb_ld(&bar[XB_XGEN(b.x)]) == gen, bar);
            __builtin_amdgcn_fence(__ATOMIC_ACQUIRE, "agent");
            asm volatile("s_waitcnt vmcnt(0)" ::: "memory");
        }
    }
    __syncthreads();
}

struct Ctx {
    LAS unsigned char* lds; int tid, lane, wave, vcu, G;
    const float* const* in; float* out; unsigned char* ws;
    template <class T> __device__ __forceinline__ T* w(size_t off) const { return (T*)(ws + off); }
};
enum { I_XP = 0, I_XS, I_PP, I_PS, I_ST, I_GMIX, I_WIN, I_GRET, I_WS, I_BS, I_GGM, I_WBRA, I_WBRB, I_WO, I_GMLP, I_WUP, I_WDN, I_GPLE, I_WPG, I_WPP, I_GFIN };

__device__ __forceinline__ void p0_transpose_item(const float* W, int K, int N, bf16_t* WT, LAS float* scr, int item, int lane, const float* rowg, int cs_lo, int cs_hi, float cs) {
    const int nblk = N / 32, kb = item / nblk, nb = item % nblk, k0 = 64 * kb, n0 = 32 * nb;
#pragma unroll 8
    for (int i = 0; i < 32; ++i) { const int kk = 2 * i + (lane >> 5); float wv = W[(size_t)(k0 + kk) * N + n0 + (lane & 31)]; if (rowg) wv *= rowg[k0 + kk]; scr[kk * 33 + (lane & 31)] = wv; }
    asm volatile("s_waitcnt lgkmcnt(0)" ::: "memory");
    const int c = lane & 7;
#pragma unroll
    for (int j = 0; j < 4; ++j) { const int n = (lane >> 3) + 8 * j; const LAS float* s = scr + (8 * c) * 33 + n; const float sc = (n0 + n >= cs_lo && n0 + n < cs_hi) ? cs : 1.0f;
        u32x4 o; o.x = pk2(s[0 * 33] * sc, s[1 * 33] * sc); o.y = pk2(s[2 * 33] * sc, s[3 * 33] * sc); o.z = pk2(s[4 * 33] * sc, s[5 * 33] * sc); o.w = pk2(s[6 * 33] * sc, s[7 * 33] * sc);
        *(u32x4*)(WT + (size_t)(n0 + n) * K + k0 + 8 * c) = o; }
    asm volatile("s_waitcnt lgkmcnt(0)" ::: "memory");
}
__device__ __forceinline__ double sin_poly(double x) {
    const double x2 = x * x; double r = -1.0 / 8841761993739701954543616000000.0;
    r = r * x2 + 1.0 / 10888869450418352160768000000.0;
    r = r * x2 - 1.0 / 15511210043330985984000000.0;
    r = r * x2 + 1.0 / 25852016738884976640000.0;
    r = r * x2 - 1.0 / 51090942171709440000.0;
    r = r * x2 + 1.0 / 121645100408832000.0;
    r = r * x2 - 1.0 / 355687428096000.0;
    r = r * x2 + 1.0 / 1307674368000.0;
    r = r * x2 - 1.0 / 6227020800.0;
    r = r * x2 + 1.0 / 39916800.0;
    r = r * x2 - 1.0 / 362880.0;
    r = r * x2 + 1.0 / 5040.0;
    r = r * x2 - 1.0 / 120.0;
    r = r * x2 + 1.0 / 6.0;
    r = r * x2 - 1.0;
    return -r * x;
}
__device__ __forceinline__ double cos_poly(double x) {
    const double x2 = x * x; double r = -1.0 / 265252859812191058636308480000000.0;
    r = r * x2 + 1.0 / 304888344611713860501504000000.0;
    r = r * x2 - 1.0 / 403291461126605635584000000.0;
    r = r * x2 + 1.0 / 620448401733239439360000.0;
    r = r * x2 - 1.0 / 1124000727777607680000.0;
    r = r * x2 + 1.0 / 2432902008176640000.0;
    r = r * x2 - 1.0 / 6402373705728000.0;
    r = r * x2 + 1.0 / 20922789888000.0;
    r = r * x2 - 1.0 / 87178291200.0;
    r = r * x2 + 1.0 / 479001600.0;
    r = r * x2 - 1.0 / 3628800.0;
    r = r * x2 + 1.0 / 40320.0;
    r = r * x2 - 1.0 / 720.0;
    r = r * x2 + 1.0 / 24.0;
    r = r * x2 - 0.5;
    r = r * x2 + 1.0;
    return r;
}
__device__ __forceinline__ void p0_prologue(const Ctx& C) {
    LAS float* scr = (LAS float*)(C.lds + C.wave * 16384);
    const int gw = C.vcu * NWAVES + C.wave, NGW = C.G * NWAVES, lane = C.lane;
    constexpr int I_IN = (DM / 64) * (INW / 32);
    for (int it = gw; it < I_IN; it += NGW) p0_transpose_item(C.in[I_WIN], DM, INW, C.w<bf16_t>(WS_WIN), scr, it, lane, nullptr, CK, CV, 0.0625f);
    const float* gm = C.in[I_GMIX];
    f32x4 gv[4];
#pragma unroll
    for (int j = 0; j < 4; ++j) gv[j] = ((const f32x4*)gm)[lane + 64 * j];
    bf16_t* XN = C.w<bf16_t>(WS_XN);
    for (int m = gw; m < MT; m += NGW) {
        const float* xrow = m < MP ? C.in[I_XP] + (size_t)m * DM : C.in[I_XS] + (size_t)(m - MP) * DM;
        const f32x4* xr = (const f32x4*)xrow + lane;
        f32x4 v[4]; float s = 0.f;
#pragma unroll
        for (int j = 0; j < 4; ++j) { v[j] = xr[64 * j]; s += sum4(v[j] * v[j]); }
        const float rstd = rsqrtf(wave_sum(s) * (1.f / DM) + EPS);
        u32x2* o8 = (u32x2*)(XN + (size_t)m * DM) + lane;
#pragma unroll
        for (int j = 0; j < 4; ++j) { const f32x4 y = v[j] * rstd * gv[j]; u32x2 w; w.x = pk2(y[0], y[1]); w.y = pk2(y[2], y[3]); o8[64 * j] = w; }
    }
    float* cosT = C.w<float>(WS_COS); float* sinT = C.w<float>(WS_SIN);
    for (int e = (C.vcu * NTHR + C.tid); e < NTAB * 128; e += C.G * NTHR) {
        const int ti = e >> 7, i = e & 127; const float pos = ti < 2048 ? (float)ti : (float)(16384 + ti - 2048);
        const float inv = (float)exp2(-(double)i * (13.287712379549449 / 128.0));
        const float ang = pos * inv;
        const double x = (double)ang; const double k = __builtin_rint(x * 0.15915494309189535);
        double r = __builtin_fma(-k, 6.283185307179586, x); r = __builtin_fma(-k, 2.4492935982947064e-16, r);
        cosT[e] = (float)cos_poly(r); sinT[e] = (float)sin_poly(r);
    }
}
__device__ __forceinline__ void p0_deferred(const Ctx& C, int sub, int nsub) {
    LAS float* scr = (LAS float*)(C.lds + C.wave * 16384);
    const int gw = sub * NWAVES + C.wave, NGW = nsub * NWAVES, lane = C.lane;
    constexpr int I_BRA = (2048 / 64) * (DM / 32), I_SQ = (DM / 64) * (DM / 32), I_UP = (DM / 64) * (FF / 32), I_DN = (FF / 64) * (DM / 32), I_PPI = (PLE / 64) * (DM / 32);
    constexpr int NITEMS = I_BRA + 3 * I_SQ + I_UP + I_DN + I_PPI;
    for (int it = gw; it < NITEMS; it += NGW) {
        int r = it;
        if (r < I_BRA) { p0_transpose_item(C.in[I_WBRA], 2048, DM, C.w<bf16_t>(WS_WBRA), scr, r, lane, nullptr, 0, 0, 1.f); continue; } r -= I_BRA;
        if (r < I_SQ) { p0_transpose_item(C.in[I_WBRB], DM, DM, C.w<bf16_t>(WS_WBRB), scr, r, lane, nullptr, 0, 0, 1.f); continue; } r -= I_SQ;
        if (r < I_SQ) { p0_transpose_item(C.in[I_WO], DM, DM, C.w<bf16_t>(WS_WO), scr, r, lane, nullptr, 0, 0, 1.f); continue; } r -= I_SQ;
        if (r < I_SQ) { p0_transpose_item(C.in[I_WPG], DM, DM, C.w<bf16_t>(WS_WPG), scr, r, lane, C.in[I_GPLE], 0, 0, 1.f); continue; } r -= I_SQ;
        if (r < I_UP) { p0_transpose_item(C.in[I_WUP], DM, FF, C.w<bf16_t>(WS_WUP), scr, r, lane, C.in[I_GMLP], 0, 0, 1.f); continue; } r -= I_UP;
        if (r < I_DN) { p0_transpose_item(C.in[I_WDN], FF, DM, C.w<bf16_t>(WS_WDN), scr, r, lane, nullptr, 0, 0, 1.f); continue; } r -= I_DN;
        p0_transpose_item(C.in[I_WPP], PLE, DM, C.w<bf16_t>(WS_WPP), scr, r, lane, nullptr, 0, 0, 1.f);
    }
    bf16_t* PB = C.w<bf16_t>(WS_PB);
    for (int m = gw; m < MT; m += NGW) {
        const float* prow = m < MP ? C.in[I_PP] + (size_t)m * PLE : C.in[I_PS] + (size_t)(m - MP) * PLE;
        const f32x4 pv = ((const f32x4*)prow)[lane]; u32x2 pw; pw.x = pk2(pv[0], pv[1]); pw.y = pk2(pv[2], pv[3]);
        ((u32x2*)(PB + (size_t)m * PLE))[lane] = pw;
    }
    { const float* w_s = C.in[I_WS]; bf16_t* WSB = C.w<bf16_t>(WS_WSB);
      for (int e = (sub * NTHR + C.tid); e < 8 * 128 * 128; e += nsub * NTHR) { const int n = (e >> 7) & 127, m = e & 127; WSB[e] = (bf16_t)f2bf(m <= n ? w_s[e] : 0.f); } }
}

template <class F> __device__ __forceinline__ void run_gemm(const Ctx& C, const bf16_t* A, const bf16_t* Bt, int M, int N, int K, const F& f) {
    asm volatile("" : "+s"(K));
    pg8::Gemm g{A, Bt, M, N, K}; pg8::StaticOrder S; S.init(M, N, C.G, (int)blockIdx.x);
    EpiGen<F> E{f};
    pg8::gemm_phase<EpiGen<F>, pg8::StaticOrder, true, true>((PG8_LAS unsigned char*)C.lds, g, S, E);
}

typedef short sbf16x8 __attribute__((ext_vector_type(8)));
typedef float sf32x16 __attribute__((ext_vector_type(16)));
template <class F, int KIND> __device__ __forceinline__ void small_epi(const F& f, int grow, int cA, int cB, f32x4 va0, f32x4 va1, f32x4 vb0, f32x4 vb1, int q) {
    float red[2] = {0.f, 0.f};
    const typename F::RowCtx rc = f.template row_begin<KIND>(grow);
    f.template oct<KIND>(rc, grow, cA, va0, va1, cB, vb0, vb1, red);
    if (F::template nred<KIND>() > 0) {
        red[0] += __shfl_xor(red[0], 1); red[0] += __shfl_xor(red[0], 2);
        if (F::template nred<KIND>() > 1) { red[1] += __shfl_xor(red[1], 1); red[1] += __shfl_xor(red[1], 2); }
        if (q == 0) f.template row_add<KIND>(grow, red);
    }
}
template <class F> __device__ __forceinline__ void small_gemm(const Ctx& C, const bf16_t* A, const bf16_t* Bt, int N, int K, const F& f, bool rot) {
    asm volatile("" : "+s"(K));
    const int ntile = 16 * (N / 64), Kw = K / 8;
    const int wave = C.wave, l31 = C.lane & 31, hh = C.lane >> 5, tid = C.tid;
    LAS float* red = (LAS float*)C.lds;
    for (int t = C.vcu; t < ntile; t += C.G) {
        const int rt = t & 15, ct = t >> 4;
        int cA = ct * 64, cB = cA + 32;
        if (rot && cA < CV) { cA = (ct >> 2) * 256 + (ct & 3) * 32; cB = cA + 128; }
        const int r0 = MP + 32 * rt;
        const bf16_t* pa = A + (size_t)(r0 + l31) * K + wave * Kw + 8 * hh;
        const bf16_t* pb0 = Bt + (size_t)(cA + l31) * K + wave * Kw + 8 * hh;
        const bf16_t* pb1 = Bt + (size_t)(cB + l31) * K + wave * Kw + 8 * hh;
        sf32x16 a0, a1;
#pragma unroll
        for (int i = 0; i < 16; ++i) { a0[i] = 0.f; a1[i] = 0.f; }
#pragma unroll 2
        for (int k = 0; k < Kw; k += 32) {
            const sbf16x8 fa0 = *(const sbf16x8*)(pa + k), fa1 = *(const sbf16x8*)(pa + k + 16);
            const sbf16x8 fb00 = *(const sbf16x8*)(pb0 + k), fb01 = *(const sbf16x8*)(pb0 + k + 16);
            const sbf16x8 fb10 = *(const sbf16x8*)(pb1 + k), fb11 = *(const sbf16x8*)(pb1 + k + 16);
            a0 = __builtin_amdgcn_mfma_f32_32x32x16_bf16(fa0, fb00, a0, 0, 0, 0); a1 = __builtin_amdgcn_mfma_f32_32x32x16_bf16(fa0, fb10, a1, 0, 0, 0);
            a0 = __builtin_amdgcn_mfma_f32_32x32x16_bf16(fa1, fb01, a0, 0, 0, 0); a1 = __builtin_amdgcn_mfma_f32_32x32x16_bf16(fa1, fb11, a1, 0, 0, 0);
        }
        __syncthreads();
#pragma unroll
        for (int i = 0; i < 16; ++i) { const int r = (i & 3) + 8 * (i >> 2) + 4 * hh; red[(wave * 32 + r) * 68 + l31] = a0[i]; red[(wave * 32 + r) * 68 + 32 + l31] = a1[i]; }
        __syncthreads();
        if (tid < 128) {
            const int r = tid >> 2, q = tid & 3;
            f32x4 va0 = (f32x4){0.f, 0.f, 0.f, 0.f}, va1 = va0, vb0 = va0, vb1 = va0;
#pragma unroll
            for (int w = 0; w < 8; ++w) { const LAS float* p = red + (w * 32 + r) * 68 + 8 * q;
                va0 = va0 + *(const LAS f32x4*)(p); va1 = va1 + *(const LAS f32x4*)(p + 4); vb0 = vb0 + *(const LAS f32x4*)(p + 32); vb1 = vb1 + *(const LAS f32x4*)(p + 36); }
            const int grow = r0 + r, kind = f.kind(cA), ca = cA + 8 * q, cb = cB + 8 * q;
            if (F::NK == 1) small_epi<F, 0>(f, grow, ca, cb, va0, va1, vb0, vb1, q);
            else switch (kind) {
                case 0: small_epi<F, 0>(f, grow, ca, cb, va0, va1, vb0, vb1, q); break;
                case 1: small_epi<F, (F::NK > 1 ? 1 : 0)>(f, grow, ca, cb, va0, va1, vb0, vb1, q); break;
                case 2: small_epi<F, (F::NK > 2 ? 2 : 0)>(f, grow, ca, cb, va0, va1, vb0, vb1, q); break;
                case 3: small_epi<F, (F::NK > 3 ? 3 : 0)>(f, grow, ca, cb, va0, va1, vb0, vb1, q); break;
                case 4: small_epi<F, (F::NK > 4 ? 4 : 0)>(f, grow, ca, cb, va0, va1, vb0, vb1, q); break;
                default: small_epi<F, (F::NK > 5 ? 5 : 0)>(f, grow, ca, cb, va0, va1, vb0, vb1, q); break;
            }
        }
    }
    __syncthreads();
}
template <class F> __device__ __forceinline__ void run_gemm_split(const Ctx& C, const bf16_t* A, const bf16_t* Bt, int N, int K, const F& f) {
    run_gemm(C, A, Bt, MP, N, K, f);
    small_gemm(C, A, Bt, N, K, f, false);
}
__device__ __forceinline__ void ret_simple_item(const Ctx& C, bool sample, int b, int h, int vs) {
    const int v = C.tid & 63, dg = C.wave, d0 = 32 * dg;
    const int L = sample ? 4 : 2048, row0 = sample ? MP + 4 * b : 2048 * b;
    const float gamma = 1.0f - exp2f(-5.0f - (float)h);
    float S[32];
    const size_t sbase = ((size_t)(b * 4 + h) * 256 + d0) * 512 + vs * 64 + v;
    if (sample) { const float* st = C.in[I_ST] + sbase;
#pragma unroll
        for (int j = 0; j < 32; ++j) S[j] = st[(size_t)j * 512]; }
    else {
#pragma unroll
        for (int j = 0; j < 32; ++j) S[j] = 0.f; }
    const bf16_t* Z = C.w<bf16_t>(WS_Z); bf16_t* OR = C.w<bf16_t>(WS_ORAW);
    LAS float* part = (LAS float*)C.lds;
    for (int t = 0; t < L; ++t) {
        const int row = row0 + t; const bf16_t* zr = Z + (size_t)row * INW;
        const float vv = bf2f(zr[CV + h * 512 + vs * 64 + v]);
        const u32x4* qp = (const u32x4*)(zr + CQ + h * 256 + d0); const u32x4* kp = (const u32x4*)(zr + CK + h * 256 + d0);
        float o = 0.f;
#pragma unroll
        for (int c = 0; c < 4; ++c) { const u32x4 qw = qp[c], kw = kp[c];
#pragma unroll
            for (int e = 0; e < 4; ++e) { const unsigned q2 = qw[e], k2 = kw[e]; const int j = c * 8 + e * 2;
                S[j] = gamma * S[j] + __uint_as_float(k2 << 16) * vv; o += __uint_as_float(q2 << 16) * S[j];
                S[j + 1] = gamma * S[j + 1] + __uint_as_float(k2 & 0xffff0000u) * vv; o += __uint_as_float(q2 & 0xffff0000u) * S[j + 1]; } }
        part[((t & 1) * 8 + dg) * 64 + v] = o;
        __syncthreads();
        if (dg == 0) { float ot = 0.f;
#pragma unroll
            for (int g = 0; g < 8; ++g) ot += part[((t & 1) * 8 + g) * 64 + v];
            OR[(size_t)row * 2048 + h * 512 + vs * 64 + v] = (bf16_t)f2bf(ot); }
    }
    float* so = C.out + (sample ? O_SRS : O_SRP) + sbase;
#pragma unroll
    for (int j = 0; j < 32; ++j) so[(size_t)j * 512] = S[j];
    __syncthreads();
}
typedef short bf16x8 __attribute__((ext_vector_type(8)));
typedef short s16x4 __attribute__((ext_vector_type(4)));
typedef short v4i16_t __attribute__((ext_vector_type(4)));
typedef float f32x16 __attribute__((ext_vector_type(16)));
constexpr int R_QS = 528, R_VS = 192, R_PS = 144;
constexpr int R_Q = 0, R_K = R_Q + 64 * R_QS, R_ST = R_K + 64 * R_QS, R_V = R_ST + 64 * R_QS, R_VD = R_V + 64 * R_VS, R_P = R_VD + 64 * R_VS, R_END = R_P + 64 * R_PS;
static_assert(R_END <= LDS_MISC, "retention LDS map");
__device__ __forceinline__ s16x4 vtr(const LAS unsigned char* p) { return __builtin_bit_cast(s16x4, __builtin_amdgcn_ds_read_tr16_b64_v4i16((LAS v4i16_t*)p)); }
#define MFMA32(a, b, c) __builtin_amdgcn_mfma_f32_32x32x16_bf16((a), (b), (c), 0, 0, 0)
__device__ __forceinline__ bf16x8 tr_frag(const LAS unsigned char* a, int stride) { const s16x4 lo = vtr(a), hi = vtr(a + 4 * stride); return (bf16x8){lo[0], lo[1], lo[2], lo[3], hi[0], hi[1], hi[2], hi[3]}; }
constexpr int R_TAB = R_END, R_OXL = R_TAB + 16384, R_RED = R_OXL + 8192, R_END2 = R_RED + 256;
static_assert(R_END2 <= LDS_MISC, "retention + stream LDS map");
template <bool STREAM> __device__ __forceinline__ void ret_mfma_item(const Ctx& C, int b, int h, int vs, int sitem0) {
    const int tid = C.tid, lane = C.lane, wave = C.wave, l31_ = lane & 31, hh_ = lane >> 5;
    const LAS unsigned char* lds = C.lds;
    const bf16_t* Z = C.w<bf16_t>(WS_Z); bf16_t* OR = C.w<bf16_t>(WS_ORAW);
    const float lg = log2f(1.0f - exp2f(-5.0f - (float)h));
    const int row00 = b * 2048;
    for (int e = tid; e < 64 * R_QS / 16; e += NTHR) *(LAS u32x4*)(C.lds + R_ST + e * 16) = (u32x4){0u, 0u, 0u, 0u};
    f32x16 S0, S1;
#pragma unroll
    for (int i = 0; i < 16; ++i) { S0[i] = 0.f; S1[i] = 0.f; }
    u32x4 gq[4], gk[4], gv;
    const int qrow = tid >> 5, qch = tid & 31, vrow = tid >> 3, vch = tid & 7;
    const bf16_t* zq = Z + (size_t)row00 * INW + CQ + h * 256 + qch * 8;
    const bf16_t* zk = Z + (size_t)row00 * INW + CK + h * 256 + qch * 8;
    const bf16_t* zv = Z + (size_t)row00 * INW + CV + h * 512 + vs * 64 + vch * 8;
#define RET_LOAD(ci) do { _Pragma("unroll") for (int j = 0; j < 4; ++j) { const size_t ro = (size_t)((ci) * 64 + qrow + 16 * j) * INW; gq[j] = *(const u32x4*)(zq + ro); gk[j] = *(const u32x4*)(zk + ro); } \
        gv = *(const u32x4*)(zv + (size_t)((ci) * 64 + vrow) * INW); } while (0)
    RET_LOAD(0);
    const float vdsc = exp2f((float)(63 - vrow) * lg);
    const float g64 = exp2f(64.0f * lg);
    f32x4 cr[4][2]; float dots[10]; u32x2 vsp[4][2]; f32x4 sl[2][2];
    const float* STin = C.in[I_ST]; float* STout = C.out + O_SRS;
#define S_ITEM(j) int si_ = sitem0 + (j); asm volatile("" : "+s"(si_)); const int bs = si_ >> 2, hs = si_ & 3, srow0 = MP + 4 * bs; const float lgs = log2f(1.0f - exp2f(-5.0f - (float)hs))
#define S_UNPK(w) (f32x4){__uint_as_float((w).x << 16), __uint_as_float((w).x & 0xffff0000u), __uint_as_float((w).y << 16), __uint_as_float((w).y & 0xffff0000u)}
#define STREAM_TABLES(j) do { S_ITEM(j); const int d = tid >> 1, wh = tid & 1; f32x4 tv; \
        _Pragma("unroll") for (int t = 0; t < 4; ++t) tv[t] = bf2f(Z[(size_t)(srow0 + t) * INW + (wh ? CK : CQ) + hs * 256 + d]) * (wh ? exp2f((float)(3 - t) * lgs) : 1.0f); \
        *(LAS f32x4*)(C.lds + R_TAB + (j) * 8192 + d * 32 + wh * 16) = tv; } while (0)
#define STREAM_BEGIN(j) do { S_ITEM(j); (void)lgs; \
        _Pragma("unroll") for (int t = 0; t < 4; ++t) { const bf16_t* vp = Z + (size_t)(srow0 + t) * INW + CV + hs * 512 + 4 * lane; vsp[t][0] = *(const u32x2*)vp; vsp[t][1] = *(const u32x2*)(vp + 256); \
            cr[t][0] = (f32x4){0.f, 0.f, 0.f, 0.f}; cr[t][1] = cr[t][0]; } \
        _Pragma("unroll") for (int e = 0; e < 10; ++e) dots[e] = 0.f; } while (0)
#define S_ROW0(c) ((((c) & 15) * 8 + wave) * 2)
#define STREAM_LOAD(c) do { S_ITEM((c) >> 4); (void)lgs; (void)srow0; \
        _Pragma("unroll") for (int r = 0; r < 2; ++r) { const float* sp = STin + ((size_t)(bs * 4 + hs) * 256 + S_ROW0(c) + r) * 512 + 4 * lane; sl[r][0] = *(const f32x4*)sp; sl[r][1] = *(const f32x4*)(sp + 256); } } while (0)
#define STREAM_CONSUME(c) do { S_ITEM((c) >> 4); (void)srow0; const float g4s = exp2f(4.0f * lgs); \
        _Pragma("unroll") for (int r = 0; r < 2; ++r) { \
            const LAS unsigned char* tp = C.lds + R_TAB + ((c) >> 4) * 8192 + (S_ROW0(c) + r) * 32; const f32x4 tq = *(const LAS f32x4*)tp, tk = *(const LAS f32x4*)(tp + 16); \
            f32x4 n0 = sl[r][0] * g4s, n1 = sl[r][1] * g4s; \
            _Pragma("unroll") for (int t = 0; t < 4; ++t) { const f32x4 va = S_UNPK(vsp[t][0]), vb = S_UNPK(vsp[t][1]); \
                n0 = n0 + va * tk[t]; n1 = n1 + vb * tk[t]; cr[t][0] = cr[t][0] + sl[r][0] * tq[t]; cr[t][1] = cr[t][1] + sl[r][1] * tq[t]; } \
            float* op = STout + ((size_t)(bs * 4 + hs) * 256 + S_ROW0(c) + r) * 512 + 4 * lane; *(f32x4*)op = n0; *(f32x4*)(op + 256) = n1; \
            dots[0] += tq[0] * tk[0]; dots[1] += tq[1] * tk[0]; dots[2] += tq[1] * tk[1]; dots[3] += tq[2] * tk[0]; dots[4] += tq[2] * tk[1]; dots[5] += tq[2] * tk[2]; \
            dots[6] += tq[3] * tk[0]; dots[7] += tq[3] * tk[1]; dots[8] += tq[3] * tk[2]; dots[9] += tq[3] * tk[3]; } } while (0)
#define STREAM_FINISH(j) do { S_ITEM(j); \
        _Pragma("unroll") for (int t = 0; t < 4; ++t) { const float gc = exp2f((float)(t + 1) * lgs), gi = exp2f((float)(t - 3) * lgs); \
            f32x4 oa = cr[t][0] * gc, ob = cr[t][1] * gc; \
            _Pragma("unroll") for (int s = 0; s <= t; ++s) { const float w = dots[t * (t + 1) / 2 + s] * gi; oa = oa + S_UNPK(vsp[s][0]) * w; ob = ob + S_UNPK(vsp[s][1]) * w; } \
            LAS float* ox = (LAS float*)(C.lds + R_OXL) + t * 512 + 4 * lane; \
            _Pragma("unroll") for (int c = 0; c < 4; ++c) { __hip_atomic_fetch_add(ox + c, oa[c], __ATOMIC_RELAXED, __HIP_MEMORY_SCOPE_WORKGROUP); __hip_atomic_fetch_add(ox + 256 + c, ob[c], __ATOMIC_RELAXED, __HIP_MEMORY_SCOPE_WORKGROUP); } } \
        __syncthreads(); \
        { const int t = tid >> 7, jq = tid & 127; LAS f32x4* oxp = (LAS f32x4*)(C.lds + R_OXL + (t * 512 + 4 * jq) * 4); const f32x4 o4 = *oxp; *oxp = (f32x4){0.f, 0.f, 0.f, 0.f}; \
          const float ss = wave_sum(sum4(o4 * o4)); if (lane == 0) ((LAS float*)(C.lds + R_RED))[(j) * 8 + wave] = ss; \
          __syncthreads(); \
          const float rs = rsqrtf((((LAS float*)(C.lds + R_RED))[(j) * 8 + 2 * t] + ((LAS float*)(C.lds + R_RED))[(j) * 8 + 2 * t + 1]) * (1.f / 512.f) + EPS); \
          const int col = hs * 512 + 4 * jq; const f32x4 gz = ld_bf4(Z + (size_t)(srow0 + t) * INW + CG + col), gr = *(const f32x4*)(C.in[I_GRET] + col); \
          st_bf4(C.w<bf16_t>(WS_YA) + (size_t)(srow0 + t) * 2048 + col, gz * o4 * rs * gr); } } while (0)
    if (STREAM) { STREAM_TABLES(0); STREAM_BEGIN(0); *(LAS f32x4*)(C.lds + R_OXL + tid * 16) = (f32x4){0.f, 0.f, 0.f, 0.f}; }
    for (int ci = 0; ci < 32; ++ci) {
        int l31 = l31_, hh = hh_; asm volatile("" : "+v"(l31), "+v"(hh));
#pragma unroll
        for (int j = 0; j < 4; ++j) { *(LAS u32x4*)(C.lds + R_Q + (qrow + 16 * j) * R_QS + qch * 16) = gq[j]; *(LAS u32x4*)(C.lds + R_K + (qrow + 16 * j) * R_QS + qch * 16) = gk[j]; }
        *(LAS u32x4*)(C.lds + R_V + vrow * R_VS + vch * 16) = gv;
        { u32x4 d;
#pragma unroll
          for (int e = 0; e < 4; ++e) { const unsigned w = gv[e]; d[e] = pk2(__uint_as_float(w << 16) * vdsc, __uint_as_float(w & 0xffff0000u) * vdsc); }
          *(LAS u32x4*)(C.lds + R_VD + vrow * R_VS + vch * 16) = d; }
        if (STREAM && ci == 16) STREAM_TABLES(1);
        __syncthreads();
        if (STREAM) {
            if (ci > 0) STREAM_CONSUME(ci - 1);
            if (ci == 16) { STREAM_FINISH(0); STREAM_BEGIN(1); }
            STREAM_LOAD(ci);
        }
        if (ci + 1 < 32) RET_LOAD(ci + 1);
        const int rowoff = l31, koff = 16 * hh;
        const int tr_q = (l31 & 15) >> 2, tr_p = l31 & 3, tr_blk = (l31 >> 4) & 1;
        f32x16 acc;
#pragma unroll
        for (int i = 0; i < 16; ++i) acc[i] = 0.f;
        if (wave < 3) {
            const int st = wave >> 1, tt = wave == 0 ? 0 : 1;
            const LAS unsigned char* pa = lds + R_K + (32 * st + rowoff) * R_QS + koff;
            const LAS unsigned char* pb = lds + R_Q + (32 * tt + rowoff) * R_QS + koff;
#pragma unroll 4
            for (int ks = 0; ks < 16; ++ks) acc = MFMA32(*(const LAS bf16x8*)(pa + ks * 32), *(const LAS bf16x8*)(pb + ks * 32), acc);
            const int t = 32 * tt + l31;
#pragma unroll
            for (int g = 0; g < 4; ++g) { float pv[4];
#pragma unroll
                for (int e = 0; e < 4; ++e) { const int s = 32 * st + 8 * g + 4 * hh + e; pv[e] = (t >= s) ? acc[4 * g + e] * __builtin_amdgcn_exp2f((float)(t - s) * lg) : 0.f; }
                u32x2 w; w.x = cvtpk(pv[0], pv[1]); w.y = cvtpk(pv[2], pv[3]);
                *(LAS u32x2*)(C.lds + R_P + t * R_PS + (32 * st + 8 * g + 4 * hh) * 2) = w; }
        } else if (wave >= 4) {
            const int tt = (wave >> 1) & 1, vt = wave & 1;
            const LAS unsigned char* pa = lds + R_Q + (32 * tt + rowoff) * R_QS + koff;
            const LAS unsigned char* pb = lds + R_ST + (32 * vt + rowoff) * R_QS + koff;
#pragma unroll 4
            for (int ks = 0; ks < 16; ++ks) acc = MFMA32(*(const LAS bf16x8*)(pa + ks * 32), *(const LAS bf16x8*)(pb + ks * 32), acc);
#pragma unroll
            for (int i = 0; i < 16; ++i) { const int t = 32 * tt + (i & 3) + 8 * (i >> 2) + 4 * hh; acc[i] *= __builtin_amdgcn_exp2f((float)(t + 1) * lg); }
        }
        __syncthreads();
        if (wave >= 4) {
            const int tt = (wave >> 1) & 1, vt = wave & 1;
            const LAS unsigned char* pa = lds + R_P + (32 * tt + rowoff) * R_PS + koff;
            const LAS unsigned char* pb = lds + R_V + (8 * hh + tr_q) * R_VS + (32 * vt + 16 * tr_blk + 4 * tr_p) * 2;
            for (int ks = 0; ks < 2 * tt + 2; ++ks) acc = MFMA32(*(const LAS bf16x8*)(pa + ks * 32), tr_frag(pb + 16 * ks * R_VS, R_VS), acc);
            bf16_t* orow = OR + (size_t)(row00 + ci * 64 + 32 * tt) * 2048 + h * 512 + vs * 64 + 32 * vt + l31;
#pragma unroll
            for (int i = 0; i < 16; ++i) { const int tl = (i & 3) + 8 * (i >> 2) + 4 * hh; orow[(size_t)tl * 2048] = (bf16_t)f2bf(acc[i]); }
        }
        {
#pragma unroll
            for (int i = 0; i < 16; ++i) { S0[i] *= g64; S1[i] *= g64; }
            const LAS unsigned char* pa = lds + R_K + (8 * hh + tr_q) * R_QS + (32 * wave + 16 * tr_blk + 4 * tr_p) * 2;
            const LAS unsigned char* pb = lds + R_VD + (8 * hh + tr_q) * R_VS + (16 * tr_blk + 4 * tr_p) * 2;
#pragma unroll
            for (int ks = 0; ks < 4; ++ks) { const bf16x8 a = tr_frag(pa + 16 * ks * R_QS, R_QS);
                S0 = MFMA32(a, tr_frag(pb + 16 * ks * R_VS, R_VS), S0); S1 = MFMA32(a, tr_frag(pb + 16 * ks * R_VS + 64, R_VS), S1); }
#pragma unroll
            for (int g = 0; g < 4; ++g) { u32x2 w0, w1; w0.x = cvtpk(S0[4 * g], S0[4 * g + 1]); w0.y = cvtpk(S0[4 * g + 2], S0[4 * g + 3]); w1.x = cvtpk(S1[4 * g], S1[4 * g + 1]); w1.y = cvtpk(S1[4 * g + 2], S1[4 * g + 3]);
                *(LAS u32x2*)(C.lds + R_ST + l31 * R_QS + (32 * wave + 8 * g + 4 * hh) * 2) = w0;
                *(LAS u32x2*)(C.lds + R_ST + (32 + l31) * R_QS + (32 * wave + 8 * g + 4 * hh) * 2) = w1; }
        }
        __syncthreads();
    }
    if (STREAM) { STREAM_CONSUME(31); STREAM_FINISH(1); }
#undef RET_LOAD
#undef S_ITEM
#undef S_UNPK
#undef STREAM_TABLES
#undef STREAM_BEGIN
#undef S_ROW0
#undef STREAM_LOAD
#undef STREAM_CONSUME
#undef STREAM_FINISH
    float* so = C.out + O_SRP + ((size_t)(b * 4 + h) * 256 + 32 * wave) * 512 + vs * 64 + l31_;
#pragma unroll
    for (int i = 0; i < 16; ++i) { const int dl = (i & 3) + 8 * (i >> 2) + 4 * hh_; so[(size_t)dl * 512] = S0[i]; so[(size_t)dl * 512 + 32] = S1[i]; }
}
__device__ __forceinline__ void p2_retention_simple(const Ctx& C) {
#ifdef RET_SIMPLE
    for (int it = C.vcu; it < 256; it += C.G) ret_simple_item(C, false, it >> 5, (it >> 3) & 3, it & 7);
#else
    if (C.G == 256) { const int it = C.vcu; ret_mfma_item<true>(C, it >> 5, (it >> 3) & 3, it & 7, 2 * it); __syncthreads(); return; }
    for (int it = C.vcu; it < 256; it += C.G) ret_mfma_item<false>(C, it >> 5, (it >> 3) & 3, it & 7, 0);
    __syncthreads();
#endif
    for (int it = C.vcu; it < 4096; it += C.G) ret_simple_item(C, true, it >> 5, (it >> 3) & 3, it & 7);
}
constexpr int G_WS = 272, G_GS = 320, G_W = 0, G_G = G_W + 128 * G_WS, G_END = G_G + 128 * G_GS;
static_assert(G_END <= LDS_MISC, "gating LDS map");
__device__ __forceinline__ void p2_gating_mfma(const Ctx& C) {
    const int tid = C.tid, wave = C.wave, l31 = C.lane & 31, hh = C.lane >> 5;
    const LAS unsigned char* lds = C.lds;
    const bf16_t* Z = C.w<bf16_t>(WS_Z); const float* LNS = C.w<float>(WS_LNS); bf16_t* YB = C.w<bf16_t>(WS_YB); const bf16_t* WSB = C.w<bf16_t>(WS_WSB);
    const float* b_s = C.in[I_BS]; const float* g_gm = C.in[I_GGM];
    int g_staged = -1;
    for (int it = C.vcu; it < 1024; it += C.G) {
        const int g = it & 7, row0 = (it >> 3) * 128;
        __syncthreads();
        if (g != g_staged) { g_staged = g;
#pragma unroll
            for (int j = 0; j < 4; ++j) { const int idx = tid + NTHR * j, r = idx >> 4, c16 = idx & 15;
                *(LAS u32x4*)(C.lds + G_W + r * G_WS + c16 * 16) = *(const u32x4*)(WSB + ((size_t)g * 128 + r) * 128 + c16 * 8); } }
        { const int c16 = tid & 15; const f32x4 gg0 = *(const f32x4*)(g_gm + g * 128 + c16 * 8), gg1 = *(const f32x4*)(g_gm + g * 128 + c16 * 8 + 4);
#pragma unroll
          for (int j = 0; j < 4; ++j) { const int m = (tid >> 4) + 32 * j, row = row0 + m;
              const float mu = LNS[2 * row] * (1.f / 1024.f), var = LNS[2 * row + 1] * (1.f / 1024.f) - mu * mu, rstd = rsqrtf(var + EPS);
              const bf16_t* src = Z + (size_t)row * INW + CGV + g * 128 + c16 * 8;
              const f32x4 x0 = ld_bf4(src), x1 = ld_bf4(src + 4);
              const f32x4 y0 = (x0 - mu) * rstd * gg0, y1 = (x1 - mu) * rstd * gg1;
              u32x4 w; w.x = cvtpk(y0[0], y0[1]); w.y = cvtpk(y0[2], y0[3]); w.z = cvtpk(y1[0], y1[1]); w.w = cvtpk(y1[2], y1[3]);
              *(LAS u32x4*)(C.lds + G_G + m * G_GS + c16 * 16) = w; } }
        __syncthreads();
        const int nt = wave >> 1, ct0 = 2 * (wave & 1);
        f32x16 a0, a1;
#pragma unroll
        for (int i = 0; i < 16; ++i) { a0[i] = 0.f; a1[i] = 0.f; }
        const int tr_q = (l31 & 15) >> 2, tr_p = l31 & 3, tr_blk = (l31 >> 4) & 1;
        const LAS unsigned char* pw = lds + G_W + (32 * nt + l31) * G_WS + 16 * hh;
        const LAS unsigned char* pg = lds + G_G + (8 * hh + tr_q) * G_GS + (32 * ct0 + 16 * tr_blk + 4 * tr_p) * 2;
        for (int ks = 0; ks < 2 * nt + 2; ++ks) { const bf16x8 bw = *(const LAS bf16x8*)(pw + ks * 32);
            a0 = MFMA32(tr_frag(pg + 16 * ks * G_GS, G_GS), bw, a0); a1 = MFMA32(tr_frag(pg + 16 * ks * G_GS + 64, G_GS), bw, a1); }
        const int n = 32 * nt + l31, row = row0 + n; const float bias = b_s[g * 128 + n];
        const bf16_t* up = Z + (size_t)row * INW + CU + g * 128 + 32 * ct0 + 4 * hh; bf16_t* yp = YB + (size_t)row * DM + g * 128 + 32 * ct0 + 4 * hh;
#pragma unroll
        for (int q4 = 0; q4 < 4; ++q4) {
            const f32x4 o0 = (f32x4){a0[4 * q4], a0[4 * q4 + 1], a0[4 * q4 + 2], a0[4 * q4 + 3]} + bias, o1 = (f32x4){a1[4 * q4], a1[4 * q4 + 1], a1[4 * q4 + 2], a1[4 * q4 + 3]} + bias;
            st_bf4(yp + 8 * q4, ld_bf4(up + 8 * q4) * o0); st_bf4(yp + 32 + 8 * q4, ld_bf4(up + 32 + 8 * q4) * o1); }
    }
    __syncthreads();
}
template <int CH> __device__ __forceinline__ void gate_simple_item(const Ctx& C, int row0, float* gmv_out) {
    LAS float* gvl = (LAS float*)C.lds;
    LAS float* wl = (LAS float*)(C.lds + 65536);
    const bf16_t* Z = C.w<bf16_t>(WS_Z); const float* LNS = C.w<float>(WS_LNS); bf16_t* YB = C.w<bf16_t>(WS_YB);
    const float* w_s = C.in[I_WS]; const float* b_s = C.in[I_BS]; const float* g_gm = C.in[I_GGM];
    for (int g = 0; g < 8; ++g) {
        for (int e = C.tid; e < CH * 128; e += NTHR) { const int m = e >> 7, ch = e & 127; const int row = row0 + m;
            const float mu = LNS[2 * row] * (1.f / 1024.f), var = LNS[2 * row + 1] * (1.f / 1024.f) - mu * mu, rstd = rsqrtf(var + EPS);
            const float x = bf2f(Z[(size_t)row * INW + CGV + g * 128 + ch]); const float y = (x - mu) * rstd * g_gm[g * 128 + ch];
            gvl[e] = y; if (gmv_out) gmv_out[(size_t)m * 1024 + g * 128 + ch] = y;
            wl[e] = (ch < CH) ? w_s[((size_t)g * 128 + m) * 128 + ch] : 0.f; }
        __syncthreads();
        const int ch = C.tid & 127;
        for (int n = C.tid >> 7; n < CH; n += 4) { float acc = b_s[g * 128 + n];
            for (int m = 0; m <= n; ++m) acc += wl[n * 128 + m] * gvl[m * 128 + ch];
            const int row = row0 + n; const float u = bf2f(Z[(size_t)row * INW + CU + g * 128 + ch]);
            YB[(size_t)row * DM + g * 128 + ch] = (bf16_t)f2bf(u * acc); }
        __syncthreads();
    }
}
__device__ __forceinline__ void p2_gating_simple(const Ctx& C) {
#ifdef GATE_SIMPLE
    for (int it = C.vcu; it < 128; it += C.G) gate_simple_item<128>(C, (it >> 4) * 2048 + (it & 15) * 128, nullptr);
#else
    p2_gating_mfma(C);
#endif
    for (int it = C.vcu; it < 128; it += C.G) gate_simple_item<4>(C, MP + 4 * it, C.out + O_GMV + (size_t)it * 4 * 1024);
}
__device__ __forceinline__ void p3_finalize_ya(const Ctx& C) {
    const bf16_t* Z = C.w<bf16_t>(WS_Z); const bf16_t* OR = C.w<bf16_t>(WS_ORAW); bf16_t* YA = C.w<bf16_t>(WS_YA);
    const float* g_ret = C.in[I_GRET];
    const int gw = C.vcu * NWAVES + C.wave, NGW = C.G * NWAVES, lane = C.lane;
    const int mend = (C.G == 256) ? MP : MT;
    for (int row = gw; row < mend; row += NGW) {
        f32x4 o[8]; float rs[4];
#pragma unroll
        for (int j = 0; j < 8; ++j) o[j] = ld_bf4(OR + (size_t)row * 2048 + 4 * lane + 256 * j);
#pragma unroll
        for (int hd = 0; hd < 4; ++hd) rs[hd] = rsqrtf(wave_sum(sum4(o[2 * hd] * o[2 * hd]) + sum4(o[2 * hd + 1] * o[2 * hd + 1])) * (1.f / 512.f) + EPS);
#pragma unroll
        for (int j = 0; j < 8; ++j) { const int c = 4 * lane + 256 * j;
            const f32x4 gz = ld_bf4(Z + (size_t)row * INW + CG + c), gr = *(const f32x4*)(g_ret + c);
            st_bf4(YA + (size_t)row * 2048 + c, gz * o[j] * rs[j >> 1] * gr); }
    }
}
__device__ __forceinline__ void p9_final_norm(const Ctx& C) {
    const bf16_t* H3 = C.w<bf16_t>(WS_H3); const float* SSQ4 = C.w<float>(WS_SSQ4); const float* gf = C.in[I_GFIN];
    const int gw = C.vcu * NWAVES + C.wave, NGW = C.G * NWAVES, lane = C.lane;
    f32x4 gv[4];
#pragma unroll
    for (int j = 0; j < 4; ++j) gv[j] = ((const f32x4*)gf)[lane + 64 * j];
    for (int row = gw; row < MT; row += NGW) {
        const float rs = rsqrtf(SSQ4[row] * (1.f / DM) + EPS);
        const bf16_t* hr = H3 + (size_t)row * DM + 4 * lane; f32x4* o = (f32x4*)(C.out + O_Y + (size_t)row * DM) + lane;
#pragma unroll
        for (int j = 0; j < 4; ++j) o[64 * j] = ld_bf4(hr + 256 * j) * rs * gv[j];
    }
}
#ifdef DBG_EXPORT
__device__ __forceinline__ void dbg_export(const Ctx& C) {
    const bf16_t* Z = C.w<bf16_t>(WS_Z); const bf16_t* YA = C.w<bf16_t>(WS_YA); const bf16_t* YB = C.w<bf16_t>(WS_YB);
    const int gw = C.vcu * NWAVES + C.wave, NGW = C.G * NWAVES, lane = C.lane;
    for (int row = gw; row < MT; row += NGW)
        for (int j = 0; j < 4; ++j) { const int c = 4 * lane + 256 * j;
            f32x4 v = (f32x4){0.f, 0.f, 0.f, 0.f};
#if DBG_EXPORT == 1
            v = ld_bf4(YB + (size_t)row * DM + c);
#elif DBG_EXPORT == 4
            v = ld_bf4(YA + (size_t)row * 2048 + c) + ld_bf4(YA + (size_t)row * 2048 + 1024 + c);
#elif DBG_EXPORT == 5
            v = ld_bf4(Z + (size_t)row * INW + CGA + c) + ld_bf4(Z + (size_t)row * INW + CGB + c);
#elif DBG_EXPORT == 6
            v = ld_bf4(C.w<bf16_t>(WS_ORAW) + (size_t)row * 2048 + c) + ld_bf4(C.w<bf16_t>(WS_ORAW) + (size_t)row * 2048 + 1024 + c);
#elif DBG_EXPORT == 7
            v = ld_bf4(Z + (size_t)row * INW + CG + c) + ld_bf4(Z + (size_t)row * INW + CG + 1024 + c);
#elif DBG_EXPORT == 8
            v = ld_bf4(Z + (size_t)row * INW + CQ + c);
#endif
            *(f32x4*)(C.out + O_Y + (size_t)row * DM + c) = v; }
}
#endif
constexpr int NPHASE = 10;
__global__ void __launch_bounds__(NTHR, 2) mk_fwd(Args args) {
    extern __shared__ __attribute__((aligned(16))) unsigned char lds_raw[];
    Ctx C;
    C.lds = (LAS unsigned char*)lds_raw; C.tid = threadIdx.x; C.lane = C.tid & 63; C.wave = __builtin_amdgcn_readfirstlane(C.tid >> 6);
    C.G = gridDim.x; { const int bx = blockIdx.x; C.vcu = (C.G % 8 == 0) ? (bx % 8) * (C.G / 8) + bx / 8 : bx; }
    C.in = args.in; C.out = args.out; C.ws = args.ws;
    const int lo = args.ph_lo, hi = args.ph_hi;
    if (C.tid < 64) ((LAS unsigned*)(C.lds + LDS_MISC))[C.tid] = 0u;
    __syncthreads();
    const XcdBarrier bar = xcd_barrier_post((unsigned*)(args.ws + WS_CTL) + 4096, (volatile LAS unsigned*)(C.lds + LDS_MISC));
#define IN(k) (lo <= (k) && (k) < hi)
#define SEAM(k) do { if (IN(k) && IN((k) + 1)) { GRID_BAR(); } } while (0)
#define GRID_BAR() do { xcd_barrier(bar); } while (0)
    if (IN(0)) { p0_prologue(C); } if (IN(0) && IN(1)) cooperative_groups::this_grid().sync();
    if (IN(1)) { F1 f{C.w<bf16_t>(WS_Z), C.w<float>(WS_COS), C.w<float>(WS_SIN), C.w<float>(WS_LNS)}; run_gemm(C, C.w<bf16_t>(WS_XN), C.w<bf16_t>(WS_WIN), MT, INW, DM, f);
                 { constexpr int NU = (MT / 256) * (INW / 256); const int rem = NU % C.G;
                   if (rem == 0) p0_deferred(C, (int)blockIdx.x, C.G); else if ((int)blockIdx.x >= rem) p0_deferred(C, (int)blockIdx.x - rem, C.G - rem); } } SEAM(1);
    if (IN(2)) { p2_retention_simple(C); p2_gating_simple(C); } SEAM(2);
    if (IN(3)) { p3_finalize_ya(C); } SEAM(3);
    if (IN(4)) { { F2a f{C.w<bf16_t>(WS_Z), C.w<bf16_t>(WS_T)}; run_gemm_split(C, C.w<bf16_t>(WS_YA), C.w<bf16_t>(WS_WBRA), DM, 2048, f); }
                 { F2b f{C.w<bf16_t>(WS_Z), C.w<bf16_t>(WS_T), C.w<bf16_t>(WS_MG)}; run_gemm_split(C, C.w<bf16_t>(WS_YB), C.w<bf16_t>(WS_WBRB), DM, DM, f); } } SEAM(4);
    if (IN(5)) { FRes<false> f{C.in[I_XP], C.in[I_XS], nullptr, C.w<bf16_t>(WS_H1B), C.w<float>(WS_SSQ2)}; run_gemm_split(C, C.w<bf16_t>(WS_MG), C.w<bf16_t>(WS_WO), DM, DM, f); } SEAM(5);
    if (IN(6)) { F4 f{C.w<float>(WS_SSQ2), C.w<bf16_t>(WS_U)}; run_gemm_split(C, C.w<bf16_t>(WS_H1B), C.w<bf16_t>(WS_WUP), FF, DM, f); } SEAM(6);
    if (IN(7)) { FRes<true> f{nullptr, nullptr, C.w<bf16_t>(WS_H1B), C.w<bf16_t>(WS_H2B), C.w<float>(WS_SSQ3)}; run_gemm_split(C, C.w<bf16_t>(WS_U), C.w<bf16_t>(WS_WDN), DM, FF, f); } SEAM(7);
    if (IN(8)) { { F6a f{C.w<bf16_t>(WS_PE)}; run_gemm_split(C, C.w<bf16_t>(WS_PB), C.w<bf16_t>(WS_WPP), DM, PLE, f); }
                 { F6b f{C.w<float>(WS_SSQ3), C.w<bf16_t>(WS_H2B), C.w<bf16_t>(WS_PE), C.w<bf16_t>(WS_H3), C.w<float>(WS_SSQ4)}; run_gemm_split(C, C.w<bf16_t>(WS_H2B), C.w<bf16_t>(WS_WPG), DM, DM, f); } } SEAM(8);
    if (IN(9)) { p9_final_norm(C); }
#ifdef DBG_EXPORT
    if (IN(10)) { dbg_export(C); }
#endif
#undef IN
#undef SEAM
#undef GRID_BAR
}
}

extern "C" void kernel_launch(void* const* d_in, const int* in_sizes, int n_in, void* d_out, int out_size, void* d_ws, size_t ws_size, hipStream_t stream) {
    using namespace mk;
    static int grid = 0;
    if (grid == 0) {
        if (n_in != 21 || (size_t)out_size != O_END || ws_size < WS_END) { fprintf(stderr, "kernel_launch: unexpected shapes: n_in %d out %d ws %zu (need %zu)\n", n_in, out_size, ws_size, (size_t)WS_END); grid = -1; return; }
        int dev = 0, cus = 0;
        if (hipGetDevice(&dev) != hipSuccess || hipDeviceGetAttribute(&cus, hipDeviceAttributeMultiprocessorCount, dev) != hipSuccess) { grid = -1; return; }
        if (hipFuncSetAttribute((const void*)mk_fwd, hipFuncAttributeMaxDynamicSharedMemorySize, LDS_BYTES) != hipSuccess) { fprintf(stderr, "kernel_launch: hipFuncSetAttribute failed\n"); grid = -1; return; }
        int per_cu = 0;
        if (hipOccupancyMaxActiveBlocksPerMultiprocessor(&per_cu, (const void*)mk_fwd, NTHR, LDS_BYTES) != hipSuccess || per_cu < 1) { fprintf(stderr, "kernel_launch: occupancy query says %d blocks/CU\n", per_cu); (void)hipGetLastError(); grid = -1; return; }
        grid = cus;
    }
    if (grid < 0) return;
    (void)hipMemsetAsync((char*)d_ws, 0, WS_ZERO_END, stream);
    Args a{};
    for (int i = 0; i < 21; ++i) a.in[i] = (const float*)d_in[i];
    a.out = (float*)d_out; a.ws = (unsigned char*)d_ws;
#ifdef MK_MULTI
    for (int p = 0; p < NPHASE; ++p) { a.ph_lo = p; a.ph_hi = p + 1; hipLaunchKernelGGL(mk_fwd, dim3(grid), dim3(NTHR), LDS_BYTES, stream, a); }
#else
    a.ph_lo = 0; a.ph_hi = NPHASE;
    void* kargs[] = {&a};
    const hipError_t le = hipLaunchCooperativeKernel((const void*)mk_fwd, dim3(grid), dim3(NTHR), kargs, LDS_BYTES, stream);
    if (le != hipSuccess) fprintf(stderr, "kernel_launch: cooperative launch failed: %s (grid %d)\n", hipGetErrorString(le), grid);
#endif
}
```

```cpp
#include <hip/hip_runtime.h>
#include <hip/hip_cooperative_groups.h>
#include <cstdio>
#include <cstdint>
namespace pg8 {
#define PG8_LAS __attribute__((address_space(3)))
typedef unsigned short bf16_t;
typedef short bf16x8 __attribute__((ext_vector_type(8)));
typedef float f32x4 __attribute__((ext_vector_type(4)));
typedef unsigned u32x4 __attribute__((ext_vector_type(4)));
constexpr int BM = 256, BK = 64, HALF = 128, HTB = HALF * BK * 2  , STAGE_BYTES = 8 * HTB, NXCD = 8, WGM = 4;

__host__ __device__ __forceinline__ int lds_byte(int r, int c) { const int st = (r >> 4) * 2 + (c >> 5), rr = r & 15, cc = c & 31, ob = rr * 64 + cc * 2; return st * 1024 + (ob ^ (((ob >> 9) & 1) << 5)); }
__host__ __device__ __forceinline__ void stage_rc(int b, int& R, int& C) { const int st = b / 1024, sb = b % 1024, swz = sb ^ (((sb >> 9) & 1) << 5); R = (st >> 1) * 16 + swz / 64; C = (st & 1) * 32 + (swz % 64) / 2; }
__host__ __device__ __forceinline__ int perm32(int rho) { const int n = rho >> 4, i = rho & 15; return 8 * (i >> 2) + 4 * n + (i & 3); }

struct Unit { int pm, pn; };
struct Gemm { const bf16_t* A; const bf16_t* Bt; int M, N, K; };

struct StaticOrder {
    int nM, nN, nwg, G, c;
    __host__ __device__ void init(int M, int N, int G_, int c_) { nM = M / BM; nN = N / BM; nwg = nM * nN; G = G_; c = c_; }
    __host__ __device__ bool next(int i, Unit& u) const {
        const long L = (long)i * G + c; if (L >= nwg) return false;
        int wgid = (int)L; { const int q = nwg / NXCD, r = nwg % NXCD, xcd = wgid % NXCD, off = wgid / NXCD; wgid = (xcd < r ? xcd * (q + 1) : r * (q + 1) + (xcd - r) * q) + off; }
        const int nig = WGM * nN, gid = wgid / nig, fm = gid * WGM, gsz = (nM - fm) < WGM ? (nM - fm) : WGM;
        u.pm = fm + ((wgid % nig) % gsz); u.pn = (wgid % nig) / gsz; return true;
    }
    __device__ __forceinline__ void a_ready(const Unit&) const {}
    __device__ __forceinline__ void done(const Unit&) const {}
};

__device__ __forceinline__ unsigned cvt_pk_bf16(float lo, float hi) { unsigned r; asm volatile("v_cvt_pk_bf16_f32 %0, %1, %2" : "=v"(r) : "v"(lo), "v"(hi)); return r; }
typedef float f32x2 __attribute__((ext_vector_type(2)));
__device__ __forceinline__ f32x2 gelu_pk(f32x2 v) {
    const f32x2 av = __builtin_elementwise_abs(v), d = av * 0.2316418882f + 1.0f;
    f32x2 t; t.x = __builtin_amdgcn_rcpf(d.x); t.y = __builtin_amdgcn_rcpf(d.y);
    f32x2 q = t * 0.5307027145f + (-0.7265760135f); q = q * t + 0.7107068705f; q = q * t + (-0.142248368f); q = q * t + 0.127414796f; q = q * t;
    const f32x2 s = (v * v) * (-0.72134752044f);
    f32x2 e; e.x = __builtin_amdgcn_exp2f(s.x); e.y = __builtin_amdgcn_exp2f(s.y);
    const f32x2 m = v * (q * e), r = v - m;
    f32x2 o; o.x = v.x < 0.f ? m.x : r.x; o.y = v.y < 0.f ? m.y : r.y; return o;
}
template <class Epi, class Sched, bool ALIGN_EPI = false, bool SP2 = false>
__device__ __forceinline__ void gemm_phase(PG8_LAS unsigned char* lds, const Gemm g, const Sched& S, const Epi& E) {
    const int tid = threadIdx.x, wid = __builtin_amdgcn_readfirstlane(tid >> 6), lane = tid & 63, wr = wid >> 2, wc = wid & 3, fr = lane & 15, fq = lane >> 4;
    const int K = g.K, nt = K / BK;
    unsigned voffA[2], voffB[2];
#pragma unroll
    for (int i = 0; i < 2; ++i) { int R, C; stage_rc(tid * 16 + i * 8192, R, C); const int Rb = Epi::PERM ? ((R & ~31) + perm32(R & 31)) : R;
        voffA[i] = (unsigned)(R * K + C) * 2u; voffB[i] = (unsigned)(Rb * K + C) * 2u; }
    const size_t kstep = (size_t)(BK * 2);
    const size_t hstep = (size_t)HALF * K * 2;
    const size_t tstep = 2 * hstep;
    const unsigned ldsw = (unsigned)wid * 1024u;
    const int aoff = lds_byte(wr * 64 + fr, fq * 8), boff = lds_byte(wc * 32 + fr, fq * 8);
#define PG8_SA(b, h) (((b) * 2 + (h)) * HTB)
#define PG8_SB(b, h) ((4 + (b) * 2 + (h)) * HTB)
#define PG8_STAGE(bufoff, gbase, voff) do { _Pragma("unroll") for (int _i = 0; _i < 2; ++_i) \
        __builtin_amdgcn_global_load_lds((const unsigned*)((const char*)(gbase) + (voff)[_i]), (PG8_LAS unsigned*)(lds + (bufoff) + ldsw + _i * 8192), 16, 0, 0); } while (0)
#define PG8_LDA(dst, b, h) do { _Pragma("unroll") for (int m = 0; m < 4; ++m) _Pragma("unroll") for (int k = 0; k < 2; ++k) dst[m][k] = *(const PG8_LAS bf16x8*)(lds + PG8_SA(b, h) + aoff + m * 2048 + k * 1024); } while (0)
#define PG8_LDB(dst, b, h) do { _Pragma("unroll") for (int n = 0; n < 2; ++n) _Pragma("unroll") for (int k = 0; k < 2; ++k) dst[n][k] = *(const PG8_LAS bf16x8*)(lds + PG8_SB(b, h) + boff + n * 2048 + k * 1024); } while (0)
#define PG8_MMA(ai, bj, At, Bt) do { __builtin_amdgcn_s_setprio(1); _Pragma("unroll") for (int m = 0; m < 4; ++m) _Pragma("unroll") for (int n = 0; n < 2; ++n) _Pragma("unroll") for (int k = 0; k < 2; ++k) \
        acc[ai][bj][m][n] = __builtin_amdgcn_mfma_f32_16x16x32_bf16(Bt[n][k], At[m][k], acc[ai][bj][m][n], 0, 0, 0); __builtin_amdgcn_s_setprio(0); } while (0)
#define PG8_WAIT_V(n) asm volatile("s_waitcnt vmcnt(" #n ")" ::: "memory")
#define PG8_WAIT_L(n) asm volatile("s_waitcnt lgkmcnt(" #n ")" ::: "memory")
#define PG8_BAR __builtin_amdgcn_s_barrier()
#define PG8_SCHED __builtin_amdgcn_sched_barrier(0)
    Unit cur, nxt; int ui = 0;
    if (!S.next(0, cur)) return;
    f32x4 acc[2][2][4][2];
#pragma unroll
    for (int a = 0; a < 2; ++a)
#pragma unroll
        for (int b = 0; b < 2; ++b)
#pragma unroll
            for (int m = 0; m < 4; ++m)
#pragma unroll
                for (int n = 0; n < 2; ++n) acc[a][b][m][n] = (f32x4){0.f, 0.f, 0.f, 0.f};
    bf16x8 At[4][2], B0[2][2], B1[2][2];
    const char* cA = (const char*)g.A + (size_t)cur.pm * tstep; const char* cB = (const char*)g.Bt + (size_t)cur.pn * tstep;
    S.a_ready(cur);
    if constexpr (SP2) {
        PG8_STAGE(PG8_SB(0, 0), cB, voffB); PG8_STAGE(PG8_SB(0, 1), cB + hstep, voffB); PG8_STAGE(PG8_SA(0, 0), cA, voffA); PG8_STAGE(PG8_SA(0, 1), cA + hstep, voffA);
        if (wr == 1) PG8_BAR;
        PG8_WAIT_V(2); PG8_BAR;
        PG8_STAGE(PG8_SB(1, 0), cB + kstep, voffB); PG8_STAGE(PG8_SA(1, 0), cA + kstep, voffA); PG8_STAGE(PG8_SB(1, 1), cB + hstep + kstep, voffB);
        PG8_WAIT_V(6); PG8_BAR;
    } else {
        PG8_STAGE(PG8_SB(0, 0), cB, voffB); PG8_STAGE(PG8_SA(0, 0), cA, voffA); PG8_STAGE(PG8_SB(0, 1), cB + hstep, voffB); PG8_STAGE(PG8_SA(0, 1), cA + hstep, voffA);
        if (wr == 1) PG8_BAR;
        PG8_WAIT_V(4); PG8_BAR;
        PG8_STAGE(PG8_SB(1, 0), cB + kstep, voffB); PG8_STAGE(PG8_SA(1, 0), cA + kstep, voffA); PG8_STAGE(PG8_SB(1, 1), cB + hstep + kstep, voffB);
        PG8_WAIT_V(6); PG8_BAR;
    }
    for (;;) {
        const bool has_next = S.next(ui + 1, nxt);
        const char* nA = has_next ? (const char*)g.A + (size_t)nxt.pm * tstep : cA; const char* nB = has_next ? (const char*)g.Bt + (size_t)nxt.pn * tstep : cB;
        for (int t = 0; t < nt; t += 2) {
            if constexpr (Epi::HOOK) { if ((t & 7) == 0) E.khook(acc, cur, t, wr, wc, fr, fq); }
            const bool last = (t == nt - 2);
            const char* a1 = cA + (size_t)(t + 1) * kstep;
            const char* a2 = last ? nA : cA + (size_t)(t + 2) * kstep; const char* b2 = last ? nB : cB + (size_t)(t + 2) * kstep;
            const char* a3 = a2 + kstep; const char* b3 = b2 + kstep;
            if (last && has_next) S.a_ready(nxt);
            if constexpr (SP2) {
            PG8_LDB(B0, 0, 0); PG8_LDB(B1, 0, 1); PG8_SCHED; PG8_LDA(At, 0, 0); PG8_STAGE(PG8_SA(1, 1), a1 + hstep, voffA);
            PG8_WAIT_V(8); PG8_WAIT_L(0); PG8_BAR; PG8_MMA(0, 0, At, B0); PG8_MMA(0, 1, At, B1); PG8_BAR; PG8_SCHED;
            PG8_LDA(At, 0, 1); PG8_STAGE(PG8_SB(0, 0), b2, voffB); PG8_STAGE(PG8_SB(0, 1), b2 + hstep, voffB); PG8_STAGE(PG8_SA(0, 0), a2, voffA);
            PG8_WAIT_V(8); PG8_WAIT_L(0); PG8_BAR; PG8_MMA(1, 0, At, B0); PG8_MMA(1, 1, At, B1); PG8_BAR; PG8_SCHED;
            PG8_LDB(B0, 1, 0); PG8_LDB(B1, 1, 1); PG8_SCHED; PG8_LDA(At, 1, 0); PG8_STAGE(PG8_SA(0, 1), a2 + hstep, voffA);
            PG8_WAIT_V(8); PG8_WAIT_L(0); PG8_BAR; PG8_MMA(0, 0, At, B0); PG8_MMA(0, 1, At, B1); PG8_BAR; PG8_SCHED;
            PG8_LDA(At, 1, 1); PG8_STAGE(PG8_SB(1, 0), b3, voffB); PG8_STAGE(PG8_SB(1, 1), b3 + hstep, voffB); PG8_STAGE(PG8_SA(1, 0), a3, voffA);
            PG8_WAIT_V(8); PG8_WAIT_L(0); PG8_BAR; PG8_MMA(1, 0, At, B0); PG8_MMA(1, 1, At, B1); PG8_BAR; PG8_SCHED;
            } else {
            PG8_LDB(B0, 0, 0); PG8_SCHED; PG8_LDA(At, 0, 0); PG8_STAGE(PG8_SA(1, 1), a1 + hstep, voffA);
            PG8_WAIT_L(8); PG8_BAR; PG8_WAIT_L(0); PG8_MMA(0, 0, At, B0); PG8_BAR; PG8_SCHED;
            PG8_LDB(B1, 0, 1); PG8_STAGE(PG8_SB(0, 0), b2, voffB);
            PG8_BAR; PG8_WAIT_L(0); PG8_MMA(0, 1, At, B1); PG8_BAR;
            PG8_LDA(At, 0, 1); PG8_STAGE(PG8_SA(0, 0), a2, voffA);
            PG8_BAR; PG8_WAIT_L(0); PG8_MMA(1, 0, At, B0); PG8_BAR; PG8_SCHED;
            PG8_STAGE(PG8_SB(0, 1), b2 + hstep, voffB);
            PG8_WAIT_V(6); PG8_BAR; PG8_MMA(1, 1, At, B1); PG8_BAR;
            PG8_LDB(B0, 1, 0); PG8_SCHED; PG8_LDA(At, 1, 0); PG8_STAGE(PG8_SA(0, 1), a2 + hstep, voffA);
            PG8_WAIT_L(8); PG8_BAR; PG8_WAIT_L(0); PG8_MMA(0, 0, At, B0); PG8_BAR; PG8_SCHED;
            PG8_LDB(B1, 1, 1); PG8_STAGE(PG8_SB(1, 0), b3, voffB);
            PG8_BAR; PG8_WAIT_L(0); PG8_MMA(0, 1, At, B1); PG8_BAR;
            PG8_LDA(At, 1, 1); PG8_STAGE(PG8_SA(1, 0), a3, voffA);
            PG8_BAR; PG8_WAIT_L(0); PG8_MMA(1, 0, At, B0); PG8_BAR; PG8_SCHED;
            PG8_STAGE(PG8_SB(1, 1), b3 + hstep, voffB);
            PG8_WAIT_V(6); PG8_BAR; PG8_MMA(1, 1, At, B1); PG8_BAR;
            }
        }
        if constexpr (ALIGN_EPI) { if (wr == 0) PG8_BAR; }
        if constexpr (!Epi::AFTER_DRAIN) { E(acc, cur, wr, wc, fr, fq); S.done(cur); }
        if (!has_next) break;
#pragma unroll
        for (int a = 0; a < 2; ++a)
#pragma unroll
            for (int b = 0; b < 2; ++b)
#pragma unroll
                for (int m = 0; m < 4; ++m)
#pragma unroll
                    for (int n = 0; n < 2; ++n) acc[a][b][m][n] = (f32x4){0.f, 0.f, 0.f, 0.f};
        cur = nxt; cA = nA; cB = nB; ++ui;
        if constexpr (ALIGN_EPI) { if (wr == 1) PG8_BAR; }
    }
    PG8_WAIT_V(0);
    if constexpr (!ALIGN_EPI) { if (wr == 0) PG8_BAR; }
    PG8_BAR;
    if constexpr (Epi::AFTER_DRAIN) { E.fused(acc, cur, wr, wc, fr, fq, lds, wid, lane); S.done(cur); }
#undef PG8_SA
#undef PG8_SB
#undef PG8_STAGE
#undef PG8_LDA
#undef PG8_LDB
#undef PG8_MMA
#undef PG8_WAIT_V
#undef PG8_WAIT_L
#undef PG8_BAR
#undef PG8_SCHED
}
}

namespace mk {
using pg8::bf16_t; using pg8::f32x4; using pg8::f32x2; using pg8::Unit; using pg8::cvt_pk_bf16; using pg8::gelu_pk;
typedef unsigned u32x2 __attribute__((ext_vector_type(2)));
typedef unsigned u32x4 __attribute__((ext_vector_type(4)));
#define LAS __attribute__((address_space(3)))

constexpr int MP = 16384, MS = 512, MT = MP + MS, DM = 1024, INW = 10240, FF = 4096, PLE = 256;
constexpr int ZLD = INW + 128;
constexpr int CQ = 0, CK = 1024, CV = 2048, CG = 4096, CU = 6144, CGV = 7168, CGA = 8192, CGB = 9216;
constexpr int NTAB = 2048 + 4;
constexpr float EPS = 1e-6f;
constexpr int NWAVES = 8, NTHR = 512;

constexpr size_t O_Y = 0;
constexpr size_t O_SRP = (size_t)MT * DM;
constexpr size_t O_SRS = O_SRP + (size_t)8 * 4 * 256 * 512;
constexpr size_t O_GMV = O_SRS + (size_t)128 * 4 * 256 * 512;
constexpr size_t O_END = O_GMV + (size_t)128 * 4 * 1024;

constexpr size_t al256(size_t x) { return (x + 255) & ~(size_t)255; }
constexpr size_t WS_CTL = 0, CTL_BYTES = 1u << 20;
constexpr size_t WS_LNS = WS_CTL + CTL_BYTES;
constexpr size_t WS_SSQO = WS_LNS + al256((size_t)MT * 2 * 4);
constexpr size_t WS_SSQ2 = WS_SSQO + al256((size_t)MT * 4 * 4);
constexpr size_t WS_SSQ3 = WS_SSQ2 + al256((size_t)MT * 4);
constexpr size_t WS_SSQ4 = WS_SSQ3 + al256((size_t)MT * 4);
constexpr size_t WS_ZERO_END = WS_SSQ4 + al256((size_t)MT * 4);
constexpr size_t WS_COS = al256(WS_ZERO_END);
constexpr size_t WS_SIN = WS_COS + al256((size_t)NTAB * 128 * 4);
constexpr size_t WS_WIN = WS_SIN + al256((size_t)NTAB * 128 * 4);
constexpr size_t WS_WBRA = WS_WIN + (size_t)INW * DM * 2;
constexpr size_t WS_WBRB = WS_WBRA + (size_t)DM * 2048 * 2;
constexpr size_t WS_WO = WS_WBRB + (size_t)DM * DM * 2;
constexpr size_t WS_WUP = WS_WO + (size_t)DM * DM * 2;
constexpr size_t WS_WDN = WS_WUP + (size_t)FF * DM * 2;
constexpr size_t WS_WPG = WS_WDN + (size_t)DM * FF * 2;
constexpr size_t WS_WPP = WS_WPG + (size_t)DM * DM * 2;
constexpr size_t WS_WSB = WS_WPP + (size_t)DM * PLE * 2;
constexpr size_t WS_XN = WS_WSB + (size_t)8 * 128 * 128 * 2;
constexpr size_t WS_PB = WS_XN + (size_t)MT * DM * 2;
constexpr size_t WS_A = WS_PB + (size_t)MT * PLE * 2;
constexpr size_t WS_Z = WS_A;
constexpr size_t WS_U = WS_A;
constexpr size_t WS_H2 = WS_U + (size_t)MT * FF * 2;
constexpr size_t WS_H2B = WS_H2 + (size_t)MT * DM * 4;
constexpr size_t WS_PE = WS_H2B + (size_t)MT * DM * 2;
constexpr size_t WS_A_END = WS_A + (size_t)MT * ZLD * 2;
static_assert(WS_PE + (size_t)MT * DM * 4 <= WS_A_END, "region A overlay");
constexpr size_t WS_ORAW = WS_A_END;
constexpr size_t WS_H3 = WS_ORAW;
constexpr size_t WS_YA = WS_ORAW + (size_t)MT * 2048 * 2;
constexpr size_t WS_YB = WS_YA + (size_t)MT * 2048 * 2;
constexpr size_t WS_T = WS_YB + (size_t)MT * DM * 2;
constexpr size_t WS_MG = WS_T + (size_t)MT * DM * 4;
constexpr size_t WS_H1 = WS_MG + (size_t)MT * DM * 2;
constexpr size_t WS_H1B = WS_H1 + (size_t)MT * DM * 4;
constexpr size_t WS_END = WS_H1B + (size_t)MT * DM * 2;

constexpr int LDS_RING = 131072, LDS_BYTES = 163840, LDS_MISC = LDS_BYTES - 256;

struct Args {
    const float* in[21]; float* out; unsigned char* ws; int ph_lo, ph_hi;
};

__device__ __forceinline__ float bf2f(unsigned short u) { return __uint_as_float((unsigned)u << 16); }
__device__ __forceinline__ unsigned f2bf(float f) { unsigned u = __float_as_uint(f); return (u + 0x7fffu + ((u >> 16) & 1u)) >> 16; }
__device__ __forceinline__ unsigned pk2(float lo, float hi) { return f2bf(lo) | (f2bf(hi) << 16); }
__device__ __forceinline__ f32x4 ld_bf4(const bf16_t* p) { const u32x2 w = *(const u32x2*)p; return (f32x4){__uint_as_float(w.x << 16), __uint_as_float(w.x & 0xffff0000u), __uint_as_float(w.y << 16), __uint_as_float(w.y & 0xffff0000u)}; }
typedef float f32x2_t __attribute__((ext_vector_type(2))); typedef __bf16 bf16x2_t __attribute__((ext_vector_type(2)));
__device__ __forceinline__ unsigned cvtpk(float lo, float hi) { const f32x2_t v = {lo, hi}; const bf16x2_t b = __builtin_convertvector(v, bf16x2_t); return __builtin_bit_cast(unsigned, b); }
__device__ __forceinline__ void st_bf4(bf16_t* p, f32x4 v) { u32x2 w; w.x = cvtpk(v[0], v[1]); w.y = cvtpk(v[2], v[3]); *(u32x2*)p = w; }
__device__ __forceinline__ void ld_bf8(const bf16_t* p, f32x4& a, f32x4& b) { const u32x4 w = *(const u32x4*)p;
    a = (f32x4){__uint_as_float(w.x << 16), __uint_as_float(w.x & 0xffff0000u), __uint_as_float(w.y << 16), __uint_as_float(w.y & 0xffff0000u)};
    b = (f32x4){__uint_as_float(w.z << 16), __uint_as_float(w.z & 0xffff0000u), __uint_as_float(w.w << 16), __uint_as_float(w.w & 0xffff0000u)}; }
__device__ __forceinline__ void st_bf8(bf16_t* p, f32x4 a, f32x4 b) { u32x4 w; w.x = cvtpk(a[0], a[1]); w.y = cvtpk(a[2], a[3]); w.z = cvtpk(b[0], b[1]); w.w = cvtpk(b[2], b[3]); *(u32x4*)p = w; }
__device__ __forceinline__ float sigmoidf_(float x) { return __builtin_amdgcn_rcpf(1.0f + __builtin_amdgcn_exp2f(-1.4426950408889634f * x)); }
__device__ __forceinline__ f32x4 sigmoid4(f32x4 v) { return (f32x4){sigmoidf_(v[0]), sigmoidf_(v[1]), sigmoidf_(v[2]), sigmoidf_(v[3])}; }
__device__ __forceinline__ f32x4 silu4(f32x4 v) { return v * sigmoid4(v); }
__device__ __forceinline__ f32x4 gelu4(f32x4 v) { const f32x2 a = gelu_pk((f32x2){v[0], v[1]}), b = gelu_pk((f32x2){v[2], v[3]}); return (f32x4){a.x, a.y, b.x, b.y}; }
__device__ __forceinline__ float sum4(f32x4 v) { return (v[0] + v[1]) + (v[2] + v[3]); }
__device__ __forceinline__ float wave_sum(float v) {
#pragma unroll
    for (int o = 1; o < 64; o <<= 1) v += __shfl_xor(v, o);
    return v;
}
__device__ __forceinline__ int tab_index(int row) { return row < MP ? (row & 2047) : 2048 + (row & 3); }

template <class F> struct EpiGen {
    static constexpr bool PERM = true, AFTER_DRAIN = false, HOOK = F::HOOK;
    F f;
    __device__ __forceinline__ void khook(f32x4 (&acc)[2][2][4][2], const Unit& u, int t, int wr, int wc, int fr, int fq) const { f.khook(acc, u.pm * 256 + wr * 64 + fr, t); }
    template <int KIND> __device__ __forceinline__ void run(const f32x4 (&acc)[2][2][4][2], int row0, int col0, int fq) const {
#pragma unroll
        for (int ai = 0; ai < 2; ++ai)
#pragma unroll
            for (int m = 0; m < 4; ++m) {
                const int row = row0 + ai * 128 + m * 16;
                float red[2] = {0.f, 0.f};
                const typename F::RowCtx rc = f.template row_begin<KIND>(row);
                f.template oct<KIND>(rc, row, col0, acc[ai][0][m][0], acc[ai][0][m][1], col0 + 128, acc[ai][1][m][0], acc[ai][1][m][1], red);
                if (F::template nred<KIND>() > 0) {
                    red[0] += __shfl_xor(red[0], 16); red[0] += __shfl_xor(red[0], 32);
                    if (F::template nred<KIND>() > 1) { red[1] += __shfl_xor(red[1], 16); red[1] += __shfl_xor(red[1], 32); }
                    if (fq == 0) f.template row_add<KIND>(row, red);
                }
                asm volatile("" ::: "memory");
            }
    }
    __device__ __forceinline__ void operator()(const f32x4 (&acc)[2][2][4][2], const Unit& u, int wr, int wc, int fr, int fq) const {
        const int row0 = u.pm * 256 + wr * 64 + fr, col0 = u.pn * 256 + wc * 32 + 8 * fq;
        const int kind = f.kind(u.pn * 256);
        if (F::NK == 1) { run<0>(acc, row0, col0, fq); return; }
        switch (kind) {
            case 0: run<0>(acc, row0, col0, fq); break;
            case 1: run<(F::NK > 1 ? 1 : 0)>(acc, row0, col0, fq); break;
            case 2: run<(F::NK > 2 ? 2 : 0)>(acc, row0, col0, fq); break;
            case 3: run<(F::NK > 3 ? 3 : 0)>(acc, row0, col0, fq); break;
            case 4: run<(F::NK > 4 ? 4 : 0)>(acc, row0, col0, fq); break;
            default: run<(F::NK > 5 ? 5 : 0)>(acc, row0, col0, fq); break;
        }
    }
};
#define F_NOHOOK static constexpr bool HOOK = false; __device__ __forceinline__ void khook(f32x4 (&)[2][2][4][2], int, int) const {}
#define F_COMMON1 static constexpr int NK = 1; __device__ __forceinline__ int kind(int) const { return 0; }

struct F1 {
    F_NOHOOK static constexpr int NK = 6; typedef int RowCtx;
    bf16_t* Z; const float* cosT; const float* sinT; float* LNS;
    __device__ __forceinline__ int kind(int cb) const { return cb < CV ? 0 : cb < CG ? 1 : cb < CU ? 2 : cb < CGV ? 3 : cb < CGA ? 4 : 5; }
    template <int K> static __device__ __forceinline__ constexpr int nred() { return K == 4 ? 2 : 0; }
    template <int K> __device__ __forceinline__ RowCtx row_begin(int row) const { return K == 0 ? tab_index(row) * 128 : 0; }
    template <int K> __device__ __forceinline__ void oct(RowCtx rc, int row, int c0, f32x4 a0, f32x4 a1, int c1, f32x4 b0, f32x4 b1, float (&red)[2]) const {
        bf16_t* zr = Z + (size_t)row * ZLD;
        if (K == 0) { const int i0 = c0 & 255; const f32x4 cs0 = *(const f32x4*)(cosT + rc + i0), cs1 = *(const f32x4*)(cosT + rc + i0 + 4), sn0 = *(const f32x4*)(sinT + rc + i0), sn1 = *(const f32x4*)(sinT + rc + i0 + 4);
            st_bf8(zr + c0, a0 * cs0 - b0 * sn0, a1 * cs1 - b1 * sn1); st_bf8(zr + c1, b0 * cs0 + a0 * sn0, b1 * cs1 + a1 * sn1); }
        else if (K == 1) { st_bf8(zr + c0, a0, a1); st_bf8(zr + c1, b0, b1); }
        else if (K == 2 || K == 3) { st_bf8(zr + c0, a0, a1); st_bf8(zr + c1, b0, b1); }
        else if (K == 4) { const f32x4 g0 = gelu4(a0), g1 = gelu4(a1), g2 = gelu4(b0), g3 = gelu4(b1); st_bf8(zr + c0, g0, g1); st_bf8(zr + c1, g2, g3);
            red[0] += (sum4(g0) + sum4(g1)) + (sum4(g2) + sum4(g3)); red[1] += (sum4(g0 * g0) + sum4(g1 * g1)) + (sum4(g2 * g2) + sum4(g3 * g3)); }
        else { st_bf8(zr + c0, sigmoid4(a0), sigmoid4(a1)); st_bf8(zr + c1, sigmoid4(b0), sigmoid4(b1)); }
    }
    template <int K> __device__ __forceinline__ void row_add(int row, const float (&red)[2]) const { atomicAdd(LNS + 2 * row, red[0]); atomicAdd(LNS + 2 * row + 1, red[1]); }
};
struct F2a {
    static constexpr bool HOOK = true; F_COMMON1 typedef float RowCtx;
    const bf16_t* Z; bf16_t* T; const float* SSQO;
    __device__ __forceinline__ void khook(f32x4 (&acc)[2][2][4][2], int row0, int t) const {
        int h = t >> 3; asm volatile("" : "+s"(h));
        if (h == 0) return;
        const float* p = SSQO + (size_t)row0 * 4 + (h - 1);
        float s0[8], s1[8];
#pragma unroll
        for (int g = 0; g < 8; ++g) { s0[g] = p[((g >> 2) * 128 + (g & 3) * 16) * 4]; s1[g] = p[((g >> 2) * 128 + (g & 3) * 16) * 4 + 1]; }
#pragma unroll
        for (int g = 0; g < 8; ++g) { const float ratio = sqrtf((s1[g] * (1.f / 512.f) + EPS) / (s0[g] * (1.f / 512.f) + EPS));
#pragma unroll
            for (int bj = 0; bj < 2; ++bj)
#pragma unroll
                for (int n = 0; n < 2; ++n) acc[g >> 2][bj][g & 3][n] = acc[g >> 2][bj][g & 3][n] * ratio; }
    }
    template <int K> static __device__ __forceinline__ constexpr int nred() { return 0; }
    template <int K> __device__ __forceinline__ RowCtx row_begin(int row) const { return row < MP ? rsqrtf(SSQO[row * 4 + 3] * (1.f / 512.f) + EPS) : 1.0f; }
    template <int K> __device__ __forceinline__ void oct(RowCtx rs, int row, int c0, f32x4 a0, f32x4 a1, int c1, f32x4 b0, f32x4 b1, float (&)[2]) const {
        const bf16_t* g = Z + (size_t)row * ZLD + CGA; bf16_t* t = T + (size_t)row * DM; f32x4 g0, g1;
        ld_bf8(g + c0, g0, g1); st_bf8(t + c0, g0 * a0 * rs, g1 * a1 * rs); ld_bf8(g + c1, g0, g1); st_bf8(t + c1, g0 * b0 * rs, g1 * b1 * rs);
    }
    template <int K> __device__ __forceinline__ void row_add(int, const float (&)[2]) const {}
};
struct F2b {
    F_NOHOOK F_COMMON1 typedef int RowCtx;
    const bf16_t* Z; const bf16_t* T; bf16_t* MG;
    template <int K> static __device__ __forceinline__ constexpr int nred() { return 0; }
    template <int K> __device__ __forceinline__ RowCtx row_begin(int) const { return 0; }
    template <int K> __device__ __forceinline__ void oct(RowCtx, int row, int c0, f32x4 a0, f32x4 a1, int c1, f32x4 b0, f32x4 b1, float (&)[2]) const {
        const bf16_t* g = Z + (size_t)row * ZLD + CGB; const bf16_t* t = T + (size_t)row * DM; bf16_t* o = MG + (size_t)row * DM; f32x4 g0, g1, t0, t1;
        ld_bf8(g + c0, g0, g1); ld_bf8(t + c0, t0, t1); st_bf8(o + c0, t0 + g0 * a0, t1 + g1 * a1);
        ld_bf8(g + c1, g0, g1); ld_bf8(t + c1, t0, t1); st_bf8(o + c1, t0 + g0 * b0, t1 + g1 * b1);
    }
    template <int K> __device__ __forceinline__ void row_add(int, const float (&)[2]) const {}
};
template <bool BF> struct FRes {
    F_NOHOOK F_COMMON1 typedef size_t RowCtx;
    const float* baseP; const float* baseS; const bf16_t* baseB; bf16_t* HB; float* SSQ;
    template <int K> static __device__ __forceinline__ constexpr int nred() { return 1; }
    template <int K> __device__ __forceinline__ RowCtx row_begin(int row) const { return (size_t)row * DM; }
    template <int K> __device__ __forceinline__ void oct(RowCtx ro, int row, int c0, f32x4 a0, f32x4 a1, int c1, f32x4 b0, f32x4 b1, float (&red)[2]) const {
        f32x4 x0, x1, x2, x3;
        if (BF) { ld_bf8(baseB + ro + c0, x0, x1); ld_bf8(baseB + ro + c1, x2, x3); }
        else { const float* xr = row < MP ? baseP + ro : baseS + (ro - (size_t)MP * DM); x0 = *(const f32x4*)(xr + c0); x1 = *(const f32x4*)(xr + c0 + 4); x2 = *(const f32x4*)(xr + c1); x3 = *(const f32x4*)(xr + c1 + 4); }
        const f32x4 h0 = x0 + a0, h1 = x1 + a1, h2 = x2 + b0, h3 = x3 + b1;
        st_bf8(HB + ro + c0, h0, h1); st_bf8(HB + ro + c1, h2, h3);
        red[0] += (sum4(h0 * h0) + sum4(h1 * h1)) + (sum4(h2 * h2) + sum4(h3 * h3));
    }
    template <int K> __device__ __forceinline__ void row_add(int row, const float (&red)[2]) const { atomicAdd(SSQ + row, red[0]); }
};
struct F4 {
    F_NOHOOK F_COMMON1 typedef float RowCtx;
    const float* SSQ; bf16_t* U;
    template <int K> static __device__ __forceinline__ constexpr int nred() { return 0; }
    template <int K> __device__ __forceinline__ RowCtx row_begin(int row) const { return rsqrtf(SSQ[row] * (1.0f / DM) + EPS); }
    template <int K> __device__ __forceinline__ void oct(RowCtx rs, int row, int c0, f32x4 a0, f32x4 a1, int c1, f32x4 b0, f32x4 b1, float (&)[2]) const {
        bf16_t* u = U + (size_t)row * FF; const f32x4 z = (f32x4){0.f, 0.f, 0.f, 0.f};
        a0 = __builtin_elementwise_max(a0 * rs, z); a1 = __builtin_elementwise_max(a1 * rs, z); b0 = __builtin_elementwise_max(b0 * rs, z); b1 = __builtin_elementwise_max(b1 * rs, z);
        st_bf8(u + c0, a0 * a0, a1 * a1); st_bf8(u + c1, b0 * b0, b1 * b1);
    }
    template <int K> __device__ __forceinline__ void row_add(int, const float (&)[2]) const {}
};
struct F6a {
    F_NOHOOK F_COMMON1 typedef int RowCtx;
    bf16_t* PE;
    template <int K> static __device__ __forceinline__ constexpr int nred() { return 0; }
    template <int K> __device__ __forceinline__ RowCtx row_begin(int) const { return 0; }
    template <int K> __device__ __forceinline__ void oct(RowCtx, int row, int c0, f32x4 a0, f32x4 a1, int c1, f32x4 b0, f32x4 b1, float (&)[2]) const {
        bf16_t* p = PE + (size_t)row * DM; st_bf8(p + c0, a0, a1); st_bf8(p + c1, b0, b1);
    }
    template <int K> __device__ __forceinline__ void row_add(int, const float (&)[2]) const {}
};
struct F6b {
    F_NOHOOK F_COMMON1 typedef float RowCtx;
    const float* SSQ3; const bf16_t* H2; const bf16_t* PE; bf16_t* H3; float* SSQ4;
    template <int K> static __device__ __forceinline__ constexpr int nred() { return 1; }
    template <int K> __device__ __forceinline__ RowCtx row_begin(int row) const { return rsqrtf(SSQ3[row] * (1.0f / DM) + EPS); }
    template <int K> __device__ __forceinline__ void oct(RowCtx rs, int row, int c0, f32x4 a0, f32x4 a1, int c1, f32x4 b0, f32x4 b1, float (&red)[2]) const {
        const size_t o = (size_t)row * DM; f32x4 h0, h1, p0, p1;
        ld_bf8(H2 + o + c0, h0, h1); ld_bf8(PE + o + c0, p0, p1); h0 = h0 + sigmoid4(a0 * rs) * p0; h1 = h1 + sigmoid4(a1 * rs) * p1; st_bf8(H3 + o + c0, h0, h1);
        float s = sum4(h0 * h0) + sum4(h1 * h1);
        ld_bf8(H2 + o + c1, h0, h1); ld_bf8(PE + o + c1, p0, p1); h0 = h0 + sigmoid4(b0 * rs) * p0; h1 = h1 + sigmoid4(b1 * rs) * p1; st_bf8(H3 + o + c1, h0, h1);
        red[0] += s + sum4(h0 * h0) + sum4(h1 * h1);
    }
    template <int K> __device__ __forceinline__ void row_add(int row, const float (&red)[2]) const { atomicAdd(SSQ4 + row, red[0]); }
};
#define XB_TMO      128
#define XB_XCNT(j)  (256  + 64 * (j))
#define XB_XSUB(j)  (1280 + 64 * (j))
#define XB_XGEN(j)  (2304 + 64 * (j))
#define XB_TOP      3328
#define XB_TOPGEN   3392
#define XCD_BAR_WORDS 3456
#define XB_SPIN_CAP (1u << 21)

__device__ __forceinline__ unsigned xb_ld(unsigned* p)              { return __hip_atomic_load(p, __ATOMIC_RELAXED, __HIP_MEMORY_SCOPE_AGENT); }
__device__ __forceinline__ unsigned xb_add(unsigned* p, unsigned v) { return __hip_atomic_fetch_add(p, v, __ATOMIC_RELAXED, __HIP_MEMORY_SCOPE_AGENT); }
__device__ __forceinline__ unsigned xb_xcc_id() { return (unsigned)__builtin_amdgcn_s_getreg((3 << 11) | 20) & 0xFu; }
#define XB_SPIN(cond, bar) do { unsigned _sp = 0; while (cond) { __builtin_amdgcn_s_sleep(1); \
    if ((++_sp & 255u) == 0u) { if (xb_ld(&(bar)[XB_TMO])) break; if (_sp > XB_SPIN_CAP) { atomicAdd(&(bar)[XB_TMO], 1u); break; } } } } while (0)

struct XcdBarrier {
    unsigned* bar; unsigned x;
    volatile LAS unsigned* st;
};

__device__ __forceinline__ XcdBarrier xcd_barrier_post(unsigned* bar, volatile LAS unsigned* st) {
    XcdBarrier b; b.bar = bar; b.x = xb_xcc_id(); b.st = st;
    if (threadIdx.x == 0) (void)xb_add(&bar[XB_XCNT(b.x)], 1u);
    return b;
}
__device__ __forceinline__ void xcd_barrier_complete(unsigned* bar, unsigned x, unsigned& nloc, unsigned& nx) {
    const unsigned G = gridDim.x * gridDim.y * gridDim.z;
    unsigned sum, cnt, mine, sp = 0u;
    for (;;) {
        sum = 0u; cnt = 0u; mine = 0u;
#pragma unroll
        for (unsigned j = 0; j < 16; ++j) { const unsigned c = xb_ld(&bar[XB_XCNT(j)]); sum += c; cnt += (c > 0u) ? 1u : 0u; mine = (j == x) ? c : mine; }
        if (sum == G) break;
        __builtin_amdgcn_s_sleep(1);
        if ((++sp & 255u) == 0u) { if (xb_ld(&bar[XB_TMO])) break; if (sp > XB_SPIN_CAP) { atomicAdd(&bar[XB_TMO], 1u); break; } }
    }
    nloc = mine > 0u ? mine : 1u; nx = cnt > 0u ? cnt : 1u;
}

__device__ __forceinline__ void xcd_barrier(const XcdBarrier& b) {
    asm volatile("s_waitcnt vmcnt(0)" ::: "memory");
    __syncthreads();
    if (threadIdx.x == 0) {
        unsigned* bar = b.bar;
        __builtin_amdgcn_s_waitcnt(0);
        unsigned nloc = b.st[0], nx = b.st[1];
        if (nloc == 0u) { xcd_barrier_complete(bar, b.x, nloc, nx); b.st[0] = nloc; b.st[1] = nx; }
        const unsigned old = xb_add(&bar[XB_XSUB(b.x)], 1u);
        const unsigned gen = old / nloc;
        if (old + 1u == (gen + 1u) * nloc) {
            __builtin_amdgcn_fence(__ATOMIC_RELEASE, "agent");
            asm volatile("s_waitcnt vmcnt(0)" ::: "memory");
            const unsigned og = xb_add(&bar[XB_TOP], 1u);
            const unsigned tg = og / nx;
            if (og + 1u == (tg + 1u) * nx) xb_add(&bar[XB_TOPGEN], 1u);
            else XB_SPIN(xb_ld(&bar[XB_TOPGEN]) == tg, bar);
            __builtin_amdgcn_fence(__ATOMIC_ACQUIRE, "agent");
            xb_add(&bar[XB_XGEN(b.x)], 1u);
            asm volatile("s_waitcnt vmcnt(0)" ::: "memory");
        } else {
            XB_SPIN(xb_ld(&bar[XB_XGEN(b.x)]) == gen, bar);
            __builtin_amdgcn_fence(__ATOMIC_ACQUIRE, "agent");
            asm volatile("s_waitcnt vmcnt(0)" ::: "memory");
        }
    }
    __syncthreads();
}

struct Ctx {
    LAS unsigned char* lds; int tid, lane, wave, vcu, G;
    const float* const* in; float* out; unsigned char* ws;
    template <class T> __device__ __forceinline__ T* w(size_t off) const { return (T*)(ws + off); }
};
enum { I_XP = 0, I_XS, I_PP, I_PS, I_ST, I_GMIX, I_WIN, I_GRET, I_WS, I_BS, I_GGM, I_WBRA, I_WBRB, I_WO, I_GMLP, I_WUP, I_WDN, I_GPLE, I_WPG, I_WPP, I_GFIN };

__device__ __forceinline__ void p0_transpose_item(const float* W, int K, int N, bf16_t* WT, LAS float* scr, int item, int lane, const float* rowg, int cs_lo, int cs_hi, float cs) {
    const int nblk = N / 32, kb = item / nblk, nb = item % nblk, k0 = 64 * kb, n0 = 32 * nb;
    { const int kr = lane >> 3, n4 = (lane & 7) * 4;
#pragma unroll
      for (int i = 0; i < 8; ++i) { const int kk = 8 * i + kr; f32x4 wv = *(const f32x4*)(W + (size_t)(k0 + kk) * N + n0 + n4); if (rowg) wv = wv * rowg[k0 + kk];
          scr[kk * 33 + n4] = wv[0]; scr[kk * 33 + n4 + 1] = wv[1]; scr[kk * 33 + n4 + 2] = wv[2]; scr[kk * 33 + n4 + 3] = wv[3]; } }
    asm volatile("s_waitcnt lgkmcnt(0)" ::: "memory");
    const int c = lane & 7;
#pragma unroll
    for (int j = 0; j < 4; ++j) { const int n = (lane >> 3) + 8 * j; const LAS float* s = scr + (8 * c) * 33 + n; const float sc = (n0 + n >= cs_lo && n0 + n < cs_hi) ? cs : 1.0f;
        u32x4 o; o.x = pk2(s[0 * 33] * sc, s[1 * 33] * sc); o.y = pk2(s[2 * 33] * sc, s[3 * 33] * sc); o.z = pk2(s[4 * 33] * sc, s[5 * 33] * sc); o.w = pk2(s[6 * 33] * sc, s[7 * 33] * sc);
        *(u32x4*)(WT + (size_t)(n0 + n) * K + k0 + 8 * c) = o; }
    asm volatile("s_waitcnt lgkmcnt(0)" ::: "memory");
}
__device__ __forceinline__ double sin_poly(double x) {
    const double x2 = x * x; double r = -1.0 / 8841761993739701954543616000000.0;
    r = r * x2 + 1.0 / 10888869450418352160768000000.0;
    r = r * x2 - 1.0 / 15511210043330985984000000.0;
    r = r * x2 + 1.0 / 25852016738884976640000.0;
    r = r * x2 - 1.0 / 51090942171709440000.0;
    r = r * x2 + 1.0 / 121645100408832000.0;
    r = r * x2 - 1.0 / 355687428096000.0;
    r = r * x2 + 1.0 / 1307674368000.0;
    r = r * x2 - 1.0 / 6227020800.0;
    r = r * x2 + 1.0 / 39916800.0;
    r = r * x2 - 1.0 / 362880.0;
    r = r * x2 + 1.0 / 5040.0;
    r = r * x2 - 1.0 / 120.0;
    r = r * x2 + 1.0 / 6.0;
    r = r * x2 - 1.0;
    return -r * x;
}
__device__ __forceinline__ double cos_poly(double x) {
    const double x2 = x * x; double r = -1.0 / 265252859812191058636308480000000.0;
    r = r * x2 + 1.0 / 304888344611713860501504000000.0;
    r = r * x2 - 1.0 / 403291461126605635584000000.0;
    r = r * x2 + 1.0 / 620448401733239439360000.0;
    r = r * x2 - 1.0 / 1124000727777607680000.0;
    r = r * x2 + 1.0 / 2432902008176640000.0;
    r = r * x2 - 1.0 / 6402373705728000.0;
    r = r * x2 + 1.0 / 20922789888000.0;
    r = r * x2 - 1.0 / 87178291200.0;
    r = r * x2 + 1.0 / 479001600.0;
    r = r * x2 - 1.0 / 3628800.0;
    r = r * x2 + 1.0 / 40320.0;
    r = r * x2 - 1.0 / 720.0;
    r = r * x2 + 1.0 / 24.0;
    r = r * x2 - 0.5;
    r = r * x2 + 1.0;
    return r;
}
__device__ __forceinline__ void p0_prologue(const Ctx& C) {
    LAS float* scr = (LAS float*)(C.lds + C.wave * 16384);
    const int gw = C.vcu * NWAVES + C.wave, NGW = C.G * NWAVES, lane = C.lane;
    constexpr int I_IN = (DM / 64) * (INW / 32);
    for (int it = gw; it < I_IN; it += NGW) p0_transpose_item(C.in[I_WIN], DM, INW, C.w<bf16_t>(WS_WIN), scr, it, lane, nullptr, CK, CV, 0.0625f);
    const float* gm = C.in[I_GMIX];
    f32x4 gv[4];
#pragma unroll
    for (int j = 0; j < 4; ++j) gv[j] = ((const f32x4*)gm)[lane + 64 * j];
    bf16_t* XN = C.w<bf16_t>(WS_XN);
    for (int m0 = gw; m0 < MT; m0 += 2 * NGW) {
        f32x4 v[2][4];
#pragma unroll
        for (int r = 0; r < 2; ++r) { const int m = m0 + r * NGW; if (m < MT) { const f32x4* xr = (const f32x4*)(m < MP ? C.in[I_XP] + (size_t)m * DM : C.in[I_XS] + (size_t)(m - MP) * DM) + lane;
#pragma unroll
            for (int j = 0; j < 4; ++j) v[r][j] = xr[64 * j]; } }
#pragma unroll
        for (int r = 0; r < 2; ++r) { const int m = m0 + r * NGW; if (m < MT) { float s = 0.f;
#pragma unroll
            for (int j = 0; j < 4; ++j) s += sum4(v[r][j] * v[r][j]);
            const float rstd = rsqrtf(wave_sum(s) * (1.f / DM) + EPS);
            u32x2* o8 = (u32x2*)(XN + (size_t)m * DM) + lane;
#pragma unroll
            for (int j = 0; j < 4; ++j) { const f32x4 y = v[r][j] * rstd * gv[j]; u32x2 w; w.x = pk2(y[0], y[1]); w.y = pk2(y[2], y[3]); o8[64 * j] = w; } } }
    }
    float* cosT = C.w<float>(WS_COS); float* sinT = C.w<float>(WS_SIN);
    for (int e = (C.vcu * NTHR + C.tid); e < NTAB * 128; e += C.G * NTHR) {
        const int ti = e >> 7, i = e & 127; const float pos = ti < 2048 ? (float)ti : (float)(16384 + ti - 2048);
        const float inv = (float)exp2(-(double)i * (13.287712379549449 / 128.0));
        const float ang = pos * inv;
        const double x = (double)ang; const double k = __builtin_rint(x * 0.15915494309189535);
        double r = __builtin_fma(-k, 6.283185307179586, x); r = __builtin_fma(-k, 2.4492935982947064e-16, r);
        cosT[e] = (float)cos_poly(r); sinT[e] = (float)sin_poly(r);
    }
}
__device__ __forceinline__ void p0_deferred(const Ctx& C, int sub, int nsub) {
    LAS float* scr = (LAS float*)(C.lds + C.wave * 16384);
    const int gw = sub * NWAVES + C.wave, NGW = nsub * NWAVES, lane = C.lane;
    constexpr int I_BRA = (2048 / 64) * (DM / 32), I_SQ = (DM / 64) * (DM / 32), I_UP = (DM / 64) * (FF / 32), I_DN = (FF / 64) * (DM / 32), I_PPI = (PLE / 64) * (DM / 32);
    constexpr int NITEMS = I_BRA + 3 * I_SQ + I_UP + I_DN + I_PPI;
    for (int it = gw; it < NITEMS; it += NGW) {
        int r = it;
        if (r < I_BRA) { p0_transpose_item(C.in[I_WBRA], 2048, DM, C.w<bf16_t>(WS_WBRA), scr, r, lane, nullptr, 0, 0, 1.f); continue; } r -= I_BRA;
        if (r < I_SQ) { p0_transpose_item(C.in[I_WBRB], DM, DM, C.w<bf16_t>(WS_WBRB), scr, r, lane, nullptr, 0, 0, 1.f); continue; } r -= I_SQ;
        if (r < I_SQ) { p0_transpose_item(C.in[I_WO], DM, DM, C.w<bf16_t>(WS_WO), scr, r, lane, nullptr, 0, 0, 1.f); continue; } r -= I_SQ;
        if (r < I_SQ) { p0_transpose_item(C.in[I_WPG], DM, DM, C.w<bf16_t>(WS_WPG), scr, r, lane, C.in[I_GPLE], 0, 0, 1.f); continue; } r -= I_SQ;
        if (r < I_UP) { p0_transpose_item(C.in[I_WUP], DM, FF, C.w<bf16_t>(WS_WUP), scr, r, lane, C.in[I_GMLP], 0, 0, 1.f); continue; } r -= I_UP;
        if (r < I_DN) { p0_transpose_item(C.in[I_WDN], FF, DM, C.w<bf16_t>(WS_WDN), scr, r, lane, nullptr, 0, 0, 1.f); continue; } r -= I_DN;
        p0_transpose_item(C.in[I_WPP], PLE, DM, C.w<bf16_t>(WS_WPP), scr, r, lane, nullptr, 0, 0, 1.f);
    }
    bf16_t* PB = C.w<bf16_t>(WS_PB);
    for (int m = gw; m < MT; m += NGW) {
        const float* prow = m < MP ? C.in[I_PP] + (size_t)m * PLE : C.in[I_PS] + (size_t)(m - MP) * PLE;
        const f32x4 pv = ((const f32x4*)prow)[lane]; u32x2 pw; pw.x = pk2(pv[0], pv[1]); pw.y = pk2(pv[2], pv[3]);
        ((u32x2*)(PB + (size_t)m * PLE))[lane] = pw;
    }
    { const float* w_s = C.in[I_WS]; bf16_t* WSB = C.w<bf16_t>(WS_WSB);
      for (int e = (sub * NTHR + C.tid); e < 8 * 128 * 128; e += nsub * NTHR) { const int n = (e >> 7) & 127, m = e & 127; WSB[e] = (bf16_t)f2bf(m <= n ? w_s[e] : 0.f); } }
}

template <class F> __device__ __forceinline__ void run_gemm(const Ctx& C, const bf16_t* A, const bf16_t* Bt, int M, int N, int K, const F& f) {
    asm volatile("" : "+s"(K));
    pg8::Gemm g{A, Bt, M, N, K}; pg8::StaticOrder S; S.init(M, N, C.G, (int)blockIdx.x);
    EpiGen<F> E{f};
    pg8::gemm_phase<EpiGen<F>, pg8::StaticOrder, true, true>((PG8_LAS unsigned char*)C.lds, g, S, E);
}

typedef short sbf16x8 __attribute__((ext_vector_type(8)));
typedef float sf32x16 __attribute__((ext_vector_type(16)));
template <class F, int KIND> __device__ __forceinline__ void small_epi(const F& f, int grow, int cA, int cB, f32x4 va0, f32x4 va1, f32x4 vb0, f32x4 vb1, int q) {
    float red[2] = {0.f, 0.f};
    const typename F::RowCtx rc = f.template row_begin<KIND>(grow);
    f.template oct<KIND>(rc, grow, cA, va0, va1, cB, vb0, vb1, red);
    if (F::template nred<KIND>() > 0) {
        red[0] += __shfl_xor(red[0], 1); red[0] += __shfl_xor(red[0], 2);
        if (F::template nred<KIND>() > 1) { red[1] += __shfl_xor(red[1], 1); red[1] += __shfl_xor(red[1], 2); }
        if (q == 0) f.template row_add<KIND>(grow, red);
    }
}
template <class F> __device__ __forceinline__ void small_gemm(const Ctx& C, const bf16_t* A, const bf16_t* Bt, int N, int K, const F& f, bool rot) {
    asm volatile("" : "+s"(K));
    const int ntile = 16 * (N / 64), Kw = K / 8;
    const int wave = C.wave, l31 = C.lane & 31, hh = C.lane >> 5, tid = C.tid;
    LAS float* red = (LAS float*)C.lds;
    for (int t = C.vcu; t < ntile; t += C.G) {
        const int rt = t & 15, ct = t >> 4;
        int cA = ct * 64, cB = cA + 32;
        if (rot && cA < CV) { cA = (ct >> 2) * 256 + (ct & 3) * 32; cB = cA + 128; }
        const int r0 = MP + 32 * rt;
        const bf16_t* pa = A + (size_t)(r0 + l31) * K + wave * Kw + 8 * hh;
        const bf16_t* pb0 = Bt + (size_t)(cA + l31) * K + wave * Kw + 8 * hh;
        const bf16_t* pb1 = Bt + (size_t)(cB + l31) * K + wave * Kw + 8 * hh;
        sf32x16 a0, a1;
#pragma unroll
        for (int i = 0; i < 16; ++i) { a0[i] = 0.f; a1[i] = 0.f; }
#pragma unroll 4
        for (int k = 0; k < Kw; k += 32) {
            const sbf16x8 fa0 = *(const sbf16x8*)(pa + k), fa1 = *(const sbf16x8*)(pa + k + 16);
            const sbf16x8 fb00 = *(const sbf16x8*)(pb0 + k), fb01 = *(const sbf16x8*)(pb0 + k + 16);
            const sbf16x8 fb10 = *(const sbf16x8*)(pb1 + k), fb11 = *(const sbf16x8*)(pb1 + k + 16);
            a0 = __builtin_amdgcn_mfma_f32_32x32x16_bf16(fa0, fb00, a0, 0, 0, 0); a1 = __builtin_amdgcn_mfma_f32_32x32x16_bf16(fa0, fb10, a1, 0, 0, 0);
            a0 = __builtin_amdgcn_mfma_f32_32x32x16_bf16(fa1, fb01, a0, 0, 0, 0); a1 = __builtin_amdgcn_mfma_f32_32x32x16_bf16(fa1, fb11, a1, 0, 0, 0);
        }
        __syncthreads();
#pragma unroll
        for (int i = 0; i < 16; ++i) { const int r = (i & 3) + 8 * (i >> 2) + 4 * hh; red[(wave * 32 + r) * 68 + l31] = a0[i]; red[(wave * 32 + r) * 68 + 32 + l31] = a1[i]; }
        __syncthreads();
        if (tid < 128) {
            const int r = tid >> 2, q = tid & 3;
            f32x4 va0 = (f32x4){0.f, 0.f, 0.f, 0.f}, va1 = va0, vb0 = va0, vb1 = va0;
#pragma unroll
            for (int w = 0; w < 8; ++w) { const LAS float* p = red + (w * 32 + r) * 68 + 8 * q;
                va0 = va0 + *(const LAS f32x4*)(p); va1 = va1 + *(const LAS f32x4*)(p + 4); vb0 = vb0 + *(const LAS f32x4*)(p + 32); vb1 = vb1 + *(const LAS f32x4*)(p + 36); }
            const int grow = r0 + r, kind = f.kind(cA), ca = cA + 8 * q, cb = cB + 8 * q;
            if (F::NK == 1) small_epi<F, 0>(f, grow, ca, cb, va0, va1, vb0, vb1, q);
            else switch (kind) {
                case 0: small_epi<F, 0>(f, grow, ca, cb, va0, va1, vb0, vb1, q); break;
                case 1: small_epi<F, (F::NK > 1 ? 1 : 0)>(f, grow, ca, cb, va0, va1, vb0, vb1, q); break;
                case 2: small_epi<F, (F::NK > 2 ? 2 : 0)>(f, grow, ca, cb, va0, va1, vb0, vb1, q); break;
                case 3: small_epi<F, (F::NK > 3 ? 3 : 0)>(f, grow, ca, cb, va0, va1, vb0, vb1, q); break;
                case 4: small_epi<F, (F::NK > 4 ? 4 : 0)>(f, grow, ca, cb, va0, va1, vb0, vb1, q); break;
                default: small_epi<F, (F::NK > 5 ? 5 : 0)>(f, grow, ca, cb, va0, va1, vb0, vb1, q); break;
            }
        }
    }
    __syncthreads();
}
constexpr int SG3_WAVE = 12288;
static_assert(8 * SG3_WAVE <= LDS_MISC && 8 * 32 * 68 * 4 <= LDS_MISC, "small path LDS map");
template <class F> __device__ __forceinline__ void small_gemm3(const Ctx& C, const bf16_t* A, const bf16_t* Bt, int N, int K, const F& f) {
    asm volatile("" : "+s"(K));
    static_assert(F::NK == 1, "small_gemm3: single-kind epilogues only");
    const int ntile = 16 * (N / 64), Kw = K / 8, lnb = (Kw >= 512) ? 2 : ((Kw >= 256) ? 1 : 0);
    const int wave = C.wave, tid = C.tid;
    LAS float* red = (LAS float*)C.lds;
    const int ntl = (ntile - C.vcu + C.G - 1) / C.G, S = ntl << lnb;
    if (S <= 0) return;
    int lane = C.lane; asm volatile("" : "+v"(lane));
    const int lr = lane >> 3, lc = lane & 7, m31 = lane & 31, hh = lane >> 5;
    LAS unsigned char* wl = C.lds + wave * SG3_WAVE;
    LAS unsigned char* wst = wl + lr * 128 + ((lc ^ lr) * 16);
    const LAS unsigned char* wld = wl + m31 * 128;
    sbf16x8 g[24];
    sf32x16 a0, a1;
#pragma unroll
    for (int i = 0; i < 16; ++i) { a0[i] = 0.f; a1[i] = 0.f; }
#define SG3_ISSUE(half, sidx) do { int s_ = (sidx); asm volatile("" : "+s"(s_)); \
        const int tl_ = s_ >> lnb, t_ = C.vcu + tl_ * C.G; const size_t ko_ = (size_t)(wave * Kw + (s_ - (tl_ << lnb)) * 128 + (half) * 64 + 8 * lc); \
        const bf16_t* pa_ = A + (size_t)(MP + 32 * (t_ & 15) + lr) * K + ko_; const bf16_t* pb_ = Bt + (size_t)((t_ >> 4) * 64 + lr) * K + ko_; \
        _Pragma("unroll") for (int i = 0; i < 4; ++i) { g[(half) * 12 + i] = *(const sbf16x8*)(pa_ + (size_t)(8 * i) * K); g[(half) * 12 + 4 + i] = *(const sbf16x8*)(pb_ + (size_t)(8 * i) * K); \
            g[(half) * 12 + 8 + i] = *(const sbf16x8*)(pb_ + (size_t)(32 + 8 * i) * K); } } while (0)
#define SG3_WRITE(half) do { _Pragma("unroll") for (int i = 0; i < 4; ++i) { *(LAS sbf16x8*)(wst + i * 1024) = g[(half) * 12 + i]; *(LAS sbf16x8*)(wst + 4096 + i * 1024) = g[(half) * 12 + 4 + i]; \
        *(LAS sbf16x8*)(wst + 8192 + i * 1024) = g[(half) * 12 + 8 + i]; } } while (0)
#define SG3_MMA() do { _Pragma("unroll") for (int j = 0; j < 4; ++j) { const int po_ = ((2 * j + hh) ^ (m31 & 7)) * 16; \
        const sbf16x8 fa_ = *(const LAS sbf16x8*)(wld + po_), fb_ = *(const LAS sbf16x8*)(wld + 4096 + po_), fc_ = *(const LAS sbf16x8*)(wld + 8192 + po_); \
        a0 = __builtin_amdgcn_mfma_f32_32x32x16_bf16(fa_, fb_, a0, 0, 0, 0); a1 = __builtin_amdgcn_mfma_f32_32x32x16_bf16(fa_, fc_, a1, 0, 0, 0); } } while (0)
    SG3_ISSUE(0, 0); SG3_ISSUE(1, 0);
#pragma unroll 1
    for (int s = 0; s < S; ++s) {
        SG3_WRITE(0); asm volatile("" ::: "memory");
        if (s + 1 < S) SG3_ISSUE(0, s + 1);
        asm volatile("" ::: "memory");
        SG3_MMA(); asm volatile("" ::: "memory");
        SG3_WRITE(1); asm volatile("" ::: "memory");
        if (s + 1 < S) SG3_ISSUE(1, s + 1);
        asm volatile("" ::: "memory");
        SG3_MMA(); asm volatile("" ::: "memory");
        if (((s + 1) & ((1 << lnb) - 1)) == 0) {
            const int t_ = C.vcu + (s >> lnb) * C.G;
            __syncthreads();
#pragma unroll
            for (int i = 0; i < 16; ++i) { const int r = (i & 3) + 8 * (i >> 2) + 4 * hh; red[(wave * 32 + r) * 68 + m31] = a0[i]; red[(wave * 32 + r) * 68 + 32 + m31] = a1[i]; a0[i] = 0.f; a1[i] = 0.f; }
            __syncthreads();
            if (tid < 128) { const int r = tid >> 2, q = tid & 3;
                f32x4 va0 = (f32x4){0.f, 0.f, 0.f, 0.f}, va1 = va0, vb0 = va0, vb1 = va0;
#pragma unroll
                for (int w = 0; w < 8; ++w) { const LAS float* p = red + (w * 32 + r) * 68 + 8 * q;
                    va0 = va0 + *(const LAS f32x4*)(p); va1 = va1 + *(const LAS f32x4*)(p + 4); vb0 = vb0 + *(const LAS f32x4*)(p + 32); vb1 = vb1 + *(const LAS f32x4*)(p + 36); }
                small_epi<F, 0>(f, MP + 32 * (t_ & 15) + r, (t_ >> 4) * 64 + 8 * q, (t_ >> 4) * 64 + 32 + 8 * q, va0, va1, vb0, vb1, q); }
            __syncthreads();
        }
    }
#undef SG3_ISSUE
#undef SG3_WRITE
#undef SG3_MMA
}
template <class F> __device__ __forceinline__ void run_gemm_split(const Ctx& C, const bf16_t* A, const bf16_t* Bt, int N, int K, const F& f) {
    run_gemm(C, A, Bt, MP, N, K, f);
    if (K >= 1024) small_gemm3(C, A, Bt, N, K, f); else small_gemm(C, A, Bt, N, K, f, false);
}
__device__ __forceinline__ void ret_simple_item(const Ctx& C, bool sample, int b, int h, int vs) {
    const int v = C.tid & 63, dg = C.wave, d0 = 32 * dg;
    const int L = sample ? 4 : 2048, row0 = sample ? MP + 4 * b : 2048 * b;
    const float gamma = 1.0f - exp2f(-5.0f - (float)h);
    float S[32];
    const size_t sbase = ((size_t)(b * 4 + h) * 256 + d0) * 512 + vs * 64 + v;
    if (sample) { const float* st = C.in[I_ST] + sbase;
#pragma unroll
        for (int j = 0; j < 32; ++j) S[j] = st[(size_t)j * 512]; }
    else {
#pragma unroll
        for (int j = 0; j < 32; ++j) S[j] = 0.f; }
    const bf16_t* Z = C.w<bf16_t>(WS_Z); bf16_t* OR = C.w<bf16_t>(WS_ORAW);
    LAS float* part = (LAS float*)C.lds;
    for (int t = 0; t < L; ++t) {
        const int row = row0 + t; const bf16_t* zr = Z + (size_t)row * ZLD;
        const float vv = bf2f(zr[CV + h * 512 + vs * 64 + v]);
        const u32x4* qp = (const u32x4*)(zr + CQ + h * 256 + d0); const u32x4* kp = (const u32x4*)(zr + CK + h * 256 + d0);
        float o = 0.f;
#pragma unroll
        for (int c = 0; c < 4; ++c) { const u32x4 qw = qp[c], kw = kp[c];
#pragma unroll
            for (int e = 0; e < 4; ++e) { const unsigned q2 = qw[e], k2 = kw[e]; const int j = c * 8 + e * 2;
                S[j] = gamma * S[j] + __uint_as_float(k2 << 16) * vv; o += __uint_as_float(q2 << 16) * S[j];
                S[j + 1] = gamma * S[j + 1] + __uint_as_float(k2 & 0xffff0000u) * vv; o += __uint_as_float(q2 & 0xffff0000u) * S[j + 1]; } }
        part[((t & 1) * 8 + dg) * 64 + v] = o;
        __syncthreads();
        if (dg == 0) { float ot = 0.f;
#pragma unroll
            for (int g = 0; g < 8; ++g) ot += part[((t & 1) * 8 + g) * 64 + v];
            OR[(size_t)row * 2048 + h * 512 + vs * 64 + v] = (bf16_t)f2bf(ot); }
    }
    float* so = C.out + (sample ? O_SRS : O_SRP) + sbase;
#pragma unroll
    for (int j = 0; j < 32; ++j) so[(size_t)j * 512] = S[j];
    __syncthreads();
}
typedef short bf16x8 __attribute__((ext_vector_type(8)));
typedef short s16x4 __attribute__((ext_vector_type(4)));
typedef short v4i16_t __attribute__((ext_vector_type(4)));
typedef float f32x16 __attribute__((ext_vector_type(16)));
constexpr int R_QS = 528, R_VS = 192, R_PS = 144;
constexpr int R_Q = 0, R_K = R_Q + 64 * R_QS, R_ST = R_K + 64 * R_QS, R_V = R_ST + 64 * R_QS, R_VD = R_V + 64 * R_VS, R_P = R_VD + 64 * R_VS, R_END = R_P + 64 * R_PS;
static_assert(R_END <= LDS_MISC, "retention LDS map");
__device__ __forceinline__ s16x4 vtr(const LAS unsigned char* p) { return __builtin_bit_cast(s16x4, __builtin_amdgcn_ds_read_tr16_b64_v4i16((LAS v4i16_t*)p)); }
#define MFMA32(a, b, c) __builtin_amdgcn_mfma_f32_32x32x16_bf16((a), (b), (c), 0, 0, 0)
__device__ __forceinline__ bf16x8 tr_frag(const LAS unsigned char* a, int stride) { const s16x4 lo = vtr(a), hi = vtr(a + 4 * stride); return (bf16x8){lo[0], lo[1], lo[2], lo[3], hi[0], hi[1], hi[2], hi[3]}; }
constexpr int R_ZG = R_END  , R_TAB = R_END, R_OXL = R_TAB + 16384, R_RED = R_OXL + 8192, R_GR = R_RED + 256, R_END2 = R_GR + 256;
static_assert(R_END2 <= LDS_MISC, "retention + stream LDS map");
template <bool STREAM> __device__ __forceinline__ void ret_mfma_item(const Ctx& C, int b, int h, int vs, int sitem0) {
    const int tid = C.tid, lane = C.lane, wave = C.wave, l31_ = lane & 31, hh_ = lane >> 5;
    const LAS unsigned char* lds = C.lds;
    const bf16_t* Z = C.w<bf16_t>(WS_Z); bf16_t* OR = C.w<bf16_t>(WS_ORAW);
    const float lg = log2f(1.0f - exp2f(-5.0f - (float)h));
    const int row00 = b * 2048;
    if (tid < 64) ((LAS float*)(C.lds + R_GR))[tid] = C.in[I_GRET][h * 512 + vs * 64 + tid];
    for (int e = tid; e < 64 * R_QS / 16; e += NTHR) *(LAS u32x4*)(C.lds + R_ST + e * 16) = (u32x4){0u, 0u, 0u, 0u};
    f32x16 S0, S1;
#pragma unroll
    for (int i = 0; i < 16; ++i) { S0[i] = 0.f; S1[i] = 0.f; }
    u32x4 gq[4], gk[4], gv, gz;
    const int qrow = tid >> 5, qch = tid & 31, vrow = tid >> 3, vch = tid & 7;
    const bf16_t* zq = Z + (size_t)row00 * ZLD + CQ + h * 256 + qch * 8;
    const bf16_t* zk = Z + (size_t)row00 * ZLD + CK + h * 256 + qch * 8;
    const bf16_t* zv = Z + (size_t)row00 * ZLD + CV + h * 512 + vs * 64 + vch * 8;
    const bf16_t* zz = Z + (size_t)row00 * ZLD + CG + h * 512 + vs * 64 + vch * 8;
#define RET_LOAD(ci) do { _Pragma("unroll") for (int j = 0; j < 4; ++j) { const size_t ro = (size_t)((ci) * 64 + qrow + 16 * j) * ZLD; gq[j] = *(const u32x4*)(zq + ro); gk[j] = *(const u32x4*)(zk + ro); } \
        gv = *(const u32x4*)(zv + (size_t)((ci) * 64 + vrow) * ZLD); if (!STREAM) gz = *(const u32x4*)(zz + (size_t)((ci) * 64 + vrow) * ZLD); } while (0)
    RET_LOAD(0);
    const float vdsc = exp2f((float)(63 - vrow) * lg);
    const float g64 = exp2f(64.0f * lg);
    f32x4 cr[4][2]; float dots[10]; u32x2 vsp[4][2]; f32x4 sl[2][2];
    const float* STin = C.in[I_ST]; float* STout = C.out + O_SRS;
#define S_ITEM(j) int si_ = sitem0 + (j); asm volatile("" : "+s"(si_)); const int bs = si_ >> 2, hs = si_ & 3, srow0 = MP + 4 * bs; const float lgs = log2f(1.0f - exp2f(-5.0f - (float)hs))
#define S_UNPK(w) (f32x4){__uint_as_float((w).x << 16), __uint_as_float((w).x & 0xffff0000u), __uint_as_float((w).y << 16), __uint_as_float((w).y & 0xffff0000u)}
#define STREAM_TABLES(j) do { S_ITEM(j); const int d = tid >> 1, wh = tid & 1; f32x4 tv; \
        _Pragma("unroll") for (int t = 0; t < 4; ++t) tv[t] = bf2f(Z[(size_t)(srow0 + t) * ZLD + (wh ? CK : CQ) + hs * 256 + d]) * (wh ? exp2f((float)(3 - t) * lgs) : 1.0f); \
        *(LAS f32x4*)(C.lds + R_TAB + (j) * 8192 + d * 32 + wh * 16) = tv; } while (0)
#define STREAM_BEGIN(j) do { S_ITEM(j); (void)lgs; \
        _Pragma("unroll") for (int t = 0; t < 4; ++t) { const bf16_t* vp = Z + (size_t)(srow0 + t) * ZLD + CV + hs * 512 + 4 * lane; vsp[t][0] = *(const u32x2*)vp; vsp[t][1] = *(const u32x2*)(vp + 256); \
            cr[t][0] = (f32x4){0.f, 0.f, 0.f, 0.f}; cr[t][1] = cr[t][0]; } \
        _Pragma("unroll") for (int e = 0; e < 10; ++e) dots[e] = 0.f; } while (0)
#define S_ROW0(c) ((((c) & 15) * 8 + wave) * 2)
#define STREAM_LOAD(c) do { S_ITEM((c) >> 4); (void)lgs; (void)srow0; \
        _Pragma("unroll") for (int r = 0; r < 2; ++r) { const float* sp = STin + ((size_t)(bs * 4 + hs) * 256 + S_ROW0(c) + r) * 512 + 4 * lane; sl[r][0] = *(const f32x4*)sp; sl[r][1] = *(const f32x4*)(sp + 256); } } while (0)
#define STREAM_CONSUME(c) do { S_ITEM((c) >> 4); (void)srow0; const float g4s = exp2f(4.0f * lgs); \
        _Pragma("unroll") for (int r = 0; r < 2; ++r) { \
            const LAS unsigned char* tp = C.lds + R_TAB + ((c) >> 4) * 8192 + (S_ROW0(c) + r) * 32; const f32x4 tq = *(const LAS f32x4*)tp, tk = *(const LAS f32x4*)(tp + 16); \
            f32x4 n0 = sl[r][0] * g4s, n1 = sl[r][1] * g4s; \
            _Pragma("unroll") for (int t = 0; t < 4; ++t) { const f32x4 va = S_UNPK(vsp[t][0]), vb = S_UNPK(vsp[t][1]); \
                n0 = n0 + va * tk[t]; n1 = n1 + vb * tk[t]; cr[t][0] = cr[t][0] + sl[r][0] * tq[t]; cr[t][1] = cr[t][1] + sl[r][1] * tq[t]; } \
            float* op = STout + ((size_t)(bs * 4 + hs) * 256 + S_ROW0(c) + r) * 512 + 4 * lane; *(f32x4*)op = n0; *(f32x4*)(op + 256) = n1; \
            dots[0] += tq[0] * tk[0]; dots[1] += tq[1] * tk[0]; dots[2] += tq[1] * tk[1]; dots[3] += tq[2] * tk[0]; dots[4] += tq[2] * tk[1]; dots[5] += tq[2] * tk[2]; \
            dots[6] += tq[3] * tk[0]; dots[7] += tq[3] * tk[1]; dots[8] += tq[3] * tk[2]; dots[9] += tq[3] * tk[3]; } } while (0)
#define STREAM_FINISH(j) do { S_ITEM(j); \
        _Pragma("unroll") for (int t = 0; t < 4; ++t) { const float gc = exp2f((float)(t + 1) * lgs), gi = exp2f((float)(t - 3) * lgs); \
            f32x4 oa = cr[t][0] * gc, ob = cr[t][1] * gc; \
            _Pragma("unroll") for (int s = 0; s <= t; ++s) { const float w = dots[t * (t + 1) / 2 + s] * gi; oa = oa + S_UNPK(vsp[s][0]) * w; ob = ob + S_UNPK(vsp[s][1]) * w; } \
            LAS float* ox = (LAS float*)(C.lds + R_OXL) + t * 512 + 4 * lane; \
            _Pragma("unroll") for (int c = 0; c < 4; ++c) { __hip_atomic_fetch_add(ox + c, oa[c], __ATOMIC_RELAXED, __HIP_MEMORY_SCOPE_WORKGROUP); __hip_atomic_fetch_add(ox + 256 + c, ob[c], __ATOMIC_RELAXED, __HIP_MEMORY_SCOPE_WORKGROUP); } } \
        __syncthreads(); \
        { const int t = tid >> 7, jq = tid & 127; LAS f32x4* oxp = (LAS f32x4*)(C.lds + R_OXL + (t * 512 + 4 * jq) * 4); const f32x4 o4 = *oxp; *oxp = (f32x4){0.f, 0.f, 0.f, 0.f}; \
          const float ss = wave_sum(sum4(o4 * o4)); if (lane == 0) ((LAS float*)(C.lds + R_RED))[(j) * 8 + wave] = ss; \
          __syncthreads(); \
          const float rs = rsqrtf((((LAS float*)(C.lds + R_RED))[(j) * 8 + 2 * t] + ((LAS float*)(C.lds + R_RED))[(j) * 8 + 2 * t + 1]) * (1.f / 512.f) + EPS); \
          const int col = hs * 512 + 4 * jq; const f32x4 gz = silu4(ld_bf4(Z + (size_t)(srow0 + t) * ZLD + CG + col)), gr = *(const f32x4*)(C.in[I_GRET] + col); \
          st_bf4(C.w<bf16_t>(WS_YA) + (size_t)(srow0 + t) * 2048 + col, gz * o4 * rs * gr); } } while (0)
    if (STREAM) { STREAM_TABLES(0); STREAM_BEGIN(0); *(LAS f32x4*)(C.lds + R_OXL + tid * 16) = (f32x4){0.f, 0.f, 0.f, 0.f}; }
#ifdef PROBE_ST
    unsigned long long ts0 = 0, ts1 = 0, ts2 = 0, ts3 = 0, ts4 = 0, tl = __builtin_amdgcn_s_memrealtime();
#define ST_MARK(acc_) do { const unsigned long long tn_ = __builtin_amdgcn_s_memrealtime(); acc_ += tn_ - tl; tl = tn_; } while (0)
#else
#define ST_MARK(acc_) do { } while (0)
#endif
    u32x2 yap[4]; float ssp = 0.f;
#define RET_FLUSH(c) do { if (wave >= 4) { const int tt_ = (wave >> 1) & 1, vt_ = wave & 1, row_ = row00 + (c) * 64 + 32 * tt_ + l31; \
        if (hh == 0) atomicAdd(C.w<float>(WS_SSQO) + row_ * 4 + h, ssp); \
        bf16_t* ya_ = C.w<bf16_t>(WS_YA) + (size_t)row_ * 2048 + h * 512 + vs * 64 + 32 * vt_ + 4 * hh; \
        _Pragma("unroll") for (int g = 0; g < 4; ++g) *(u32x2*)(ya_ + 8 * g) = yap[g]; } } while (0)
    for (int ci = 0; ci < 32; ++ci) {
        int l31 = l31_, hh = hh_; asm volatile("" : "+v"(l31), "+v"(hh));
#pragma unroll
        for (int j = 0; j < 4; ++j) { *(LAS u32x4*)(C.lds + R_Q + (qrow + 16 * j) * R_QS + qch * 16) = gq[j]; *(LAS u32x4*)(C.lds + R_K + (qrow + 16 * j) * R_QS + qch * 16) = gk[j]; }
        *(LAS u32x4*)(C.lds + R_V + vrow * R_VS + vch * 16) = gv;
        if (!STREAM) *(LAS u32x4*)(C.lds + R_ZG + vrow * R_PS + vch * 16) = gz;
        { u32x4 d;
#pragma unroll
          for (int e = 0; e < 4; ++e) { const unsigned w = gv[e]; d[e] = pk2(__uint_as_float(w << 16) * vdsc, __uint_as_float(w & 0xffff0000u) * vdsc); }
          *(LAS u32x4*)(C.lds + R_VD + vrow * R_VS + vch * 16) = d; }
        if (STREAM && ci == 16) STREAM_TABLES(1);
        __syncthreads();
        ST_MARK(ts0);
        if (ci > 0) RET_FLUSH(ci - 1);
        if (STREAM) {
            if (ci > 0) STREAM_CONSUME(ci - 1);
            if (ci == 16) { STREAM_FINISH(0); STREAM_BEGIN(1); }
            STREAM_LOAD(ci);
        }
#ifdef PROBE_SAMEROWS
        if (ci + 1 < 32) RET_LOAD(0);
#else
        if (ci + 1 < 32) RET_LOAD(ci + 1);
#endif
        ST_MARK(ts4);
        const int rowoff = l31, koff = 16 * hh;
        const int tr_q = (l31 & 15) >> 2, tr_p = l31 & 3, tr_blk = (l31 >> 4) & 1;
        f32x16 acc;
#pragma unroll
        for (int i = 0; i < 16; ++i) acc[i] = 0.f;
        if (wave < 3) {
            const int st = wave >> 1, tt = wave == 0 ? 0 : 1;
            const LAS unsigned char* pa = lds + R_K + (32 * st + rowoff) * R_QS + koff;
            const LAS unsigned char* pb = lds + R_Q + (32 * tt + rowoff) * R_QS + koff;
            { bf16x8 fa = *(const LAS bf16x8*)pa, fb = *(const LAS bf16x8*)pb;
#pragma unroll
              for (int ks = 0; ks < 16; ++ks) { bf16x8 na = fa, nb = fb; if (ks + 1 < 16) { na = *(const LAS bf16x8*)(pa + (ks + 1) * 32); nb = *(const LAS bf16x8*)(pb + (ks + 1) * 32); }
                  acc = MFMA32(fa, fb, acc); fa = na; fb = nb; } }
            const int t = 32 * tt + l31;
#pragma unroll
            for (int g = 0; g < 4; ++g) { float pv[4];
#pragma unroll
                for (int e = 0; e < 4; ++e) { const int s = 32 * st + 8 * g + 4 * hh + e; pv[e] = (t >= s) ? acc[4 * g + e] * __builtin_amdgcn_exp2f((float)(t - s) * lg) : 0.f; }
                u32x2 w; w.x = cvtpk(pv[0], pv[1]); w.y = cvtpk(pv[2], pv[3]);
                *(LAS u32x2*)(C.lds + R_P + t * R_PS + (32 * st + 8 * g + 4 * hh) * 2) = w; }
        } else if (wave >= 4) {
            const int tt = (wave >> 1) & 1, vt = wave & 1;
            const LAS unsigned char* pa = lds + R_ST + (32 * vt + rowoff) * R_QS + koff;
            const LAS unsigned char* pb = lds + R_Q + (32 * tt + rowoff) * R_QS + koff;
            { bf16x8 fa = *(const LAS bf16x8*)pa, fb = *(const LAS bf16x8*)pb;
#pragma unroll
              for (int ks = 0; ks < 16; ++ks) { bf16x8 na = fa, nb = fb; if (ks + 1 < 16) { na = *(const LAS bf16x8*)(pa + (ks + 1) * 32); nb = *(const LAS bf16x8*)(pb + (ks + 1) * 32); }
                  acc = MFMA32(fa, fb, acc); fa = na; fb = nb; } }
            const float dc = __builtin_amdgcn_exp2f((float)(32 * tt + l31 + 1) * lg);
#pragma unroll
            for (int i = 0; i < 16; ++i) acc[i] *= dc;
        }
        ST_MARK(ts1);
        __syncthreads();
        ST_MARK(ts3);
        if (wave >= 4) {
            const int tt = (wave >> 1) & 1, vt = wave & 1;
            const LAS unsigned char* pa = lds + R_V + (8 * hh + tr_q) * R_VS + (32 * vt + 16 * tr_blk + 4 * tr_p) * 2;
            const LAS unsigned char* pb = lds + R_P + (32 * tt + rowoff) * R_PS + koff;
            for (int ks = 0; ks < 2 * tt + 2; ++ks) acc = MFMA32(tr_frag(pa + 16 * ks * R_VS, R_VS), *(const LAS bf16x8*)(pb + ks * 32), acc);
            float ss = 0.f;
#pragma unroll
            for (int i = 0; i < 16; ++i) ss += acc[i] * acc[i];
            ssp = ss + __shfl_xor(ss, 32);
            const LAS float* gr = (const LAS float*)(C.lds + R_GR) + 32 * vt + 4 * hh;
#pragma unroll
            for (int g = 0; g < 4; ++g) { const u32x2 zw = STREAM ? *(const u32x2*)(Z + (size_t)(row00 + ci * 64 + 32 * tt + l31) * ZLD + CG + h * 512 + vs * 64 + 32 * vt + 4 * hh + 8 * g)
                                                            : *(const LAS u32x2*)(C.lds + R_ZG + (32 * tt + l31) * R_PS + (32 * vt + 4 * hh + 8 * g) * 2);
                const f32x4 y = silu4((f32x4){__uint_as_float(zw.x << 16), __uint_as_float(zw.x & 0xffff0000u), __uint_as_float(zw.y << 16), __uint_as_float(zw.y & 0xffff0000u)})
                    * (f32x4){acc[4 * g], acc[4 * g + 1], acc[4 * g + 2], acc[4 * g + 3]} * *(const LAS f32x4*)(gr + 8 * g);
                yap[g].x = cvtpk(y[0], y[1]); yap[g].y = cvtpk(y[2], y[3]); }
        }
        {
#pragma unroll
            for (int i = 0; i < 16; ++i) { S0[i] *= g64; S1[i] *= g64; }
            const LAS unsigned char* pa = lds + R_K + (8 * hh + tr_q) * R_QS + (32 * wave + 16 * tr_blk + 4 * tr_p) * 2;
            const LAS unsigned char* pb = lds + R_VD + (8 * hh + tr_q) * R_VS + (16 * tr_blk + 4 * tr_p) * 2;
#pragma unroll
            for (int ks = 0; ks < 4; ++ks) { const bf16x8 a = tr_frag(pa + 16 * ks * R_QS, R_QS);
                S0 = MFMA32(a, tr_frag(pb + 16 * ks * R_VS, R_VS), S0); S1 = MFMA32(a, tr_frag(pb + 16 * ks * R_VS + 64, R_VS), S1); }
#pragma unroll
            for (int g = 0; g < 4; ++g) { u32x2 w0, w1; w0.x = cvtpk(S0[4 * g], S0[4 * g + 1]); w0.y = cvtpk(S0[4 * g + 2], S0[4 * g + 3]); w1.x = cvtpk(S1[4 * g], S1[4 * g + 1]); w1.y = cvtpk(S1[4 * g + 2], S1[4 * g + 3]);
                *(LAS u32x2*)(C.lds + R_ST + l31 * R_QS + (32 * wave + 8 * g + 4 * hh) * 2) = w0;
                *(LAS u32x2*)(C.lds + R_ST + (32 + l31) * R_QS + (32 * wave + 8 * g + 4 * hh) * 2) = w1; }
        }
        __syncthreads();
        ST_MARK(ts2);
    }
#ifdef PROBE_ST
    if (blockIdx.x == 0 && tid == PROBE_ST_TID) { float* dbg = C.w<float>(WS_CTL) + 65536; dbg[0] = (float)ts0 * 0.01f; dbg[1] = (float)ts1 * 0.01f; dbg[2] = (float)ts2 * 0.01f; dbg[3] = (float)ts3 * 0.01f; dbg[4] = (float)ts4 * 0.01f; }
#endif
    { const int l31 = l31_, hh = hh_; RET_FLUSH(31); }
    if (STREAM) { STREAM_CONSUME(31); STREAM_FINISH(1); }
#undef RET_LOAD
#undef RET_FLUSH
#undef S_ITEM
#undef S_UNPK
#undef STREAM_TABLES
#undef STREAM_BEGIN
#undef S_ROW0
#undef STREAM_LOAD
#undef STREAM_CONSUME
#undef STREAM_FINISH
    float* so = C.out + O_SRP + ((size_t)(b * 4 + h) * 256 + 32 * wave) * 512 + vs * 64 + l31_;
#pragma unroll
    for (int i = 0; i < 16; ++i) { const int dl = (i & 3) + 8 * (i >> 2) + 4 * hh_; so[(size_t)dl * 512] = S0[i]; so[(size_t)dl * 512 + 32] = S1[i]; }
}
constexpr int T_TAB = 0, T_OXL = T_TAB + 8192, T_RED = T_OXL + 8192;
__device__ __forceinline__ void stream_item(const Ctx& C, int si) {
    const int tid = C.tid, lane = C.lane, wave = C.wave;
    const int bs = si >> 2, hs = si & 3, srow0 = MP + 4 * bs; const float lgs = log2f(1.0f - exp2f(-5.0f - (float)hs));
    const bf16_t* Z = C.w<bf16_t>(WS_Z);
    { const int d = tid >> 1, wh = tid & 1; f32x4 tv;
#pragma unroll
      for (int t = 0; t < 4; ++t) tv[t] = bf2f(Z[(size_t)(srow0 + t) * ZLD + (wh ? CK : CQ) + hs * 256 + d]) * (wh ? exp2f((float)(3 - t) * lgs) : 1.0f);
      *(LAS f32x4*)(C.lds + T_TAB + d * 32 + wh * 16) = tv;
      *(LAS f32x4*)(C.lds + T_OXL + tid * 16) = (f32x4){0.f, 0.f, 0.f, 0.f}; }
    f32x4 va[4], vb[4], cra[4], crb[4]; float dots[10];
#pragma unroll
    for (int t = 0; t < 4; ++t) { const bf16_t* vp = Z + (size_t)(srow0 + t) * ZLD + CV + hs * 512 + 4 * lane; va[t] = ld_bf4(vp); vb[t] = ld_bf4(vp + 256);
        cra[t] = (f32x4){0.f, 0.f, 0.f, 0.f}; crb[t] = cra[t]; }
#pragma unroll
    for (int e = 0; e < 10; ++e) dots[e] = 0.f;
    const float g4s = exp2f(4.0f * lgs);
    const float* sp = C.in[I_ST] + ((size_t)(bs * 4 + hs) * 256 + 32 * wave) * 512 + 4 * lane;
    float* op = C.out + O_SRS + ((size_t)(bs * 4 + hs) * 256 + 32 * wave) * 512 + 4 * lane;
    __syncthreads();
    f32x4 ba[4][2], bb[4][2];
#define ST_LOAD(buf, g) do { _Pragma("unroll") for (int r = 0; r < 4; ++r) { buf[r][0] = *(const f32x4*)(sp + (size_t)((g) * 4 + r) * 512); buf[r][1] = *(const f32x4*)(sp + (size_t)((g) * 4 + r) * 512 + 256); } } while (0)
#define ST_USE(buf, g) do { _Pragma("unroll") for (int r = 0; r < 4; ++r) { const int d = 32 * wave + (g) * 4 + r; \
        const f32x4 tq = *(const LAS f32x4*)(C.lds + T_TAB + d * 32), tk = *(const LAS f32x4*)(C.lds + T_TAB + d * 32 + 16); \
        f32x4 n0 = buf[r][0] * g4s, n1 = buf[r][1] * g4s; \
        _Pragma("unroll") for (int t = 0; t < 4; ++t) { n0 = n0 + va[t] * tk[t]; n1 = n1 + vb[t] * tk[t]; cra[t] = cra[t] + buf[r][0] * tq[t]; crb[t] = crb[t] + buf[r][1] * tq[t]; } \
        *(f32x4*)(op + (size_t)((g) * 4 + r) * 512) = n0; *(f32x4*)(op + (size_t)((g) * 4 + r) * 512 + 256) = n1; \
        dots[0] += tq[0] * tk[0]; dots[1] += tq[1] * tk[0]; dots[2] += tq[1] * tk[1]; dots[3] += tq[2] * tk[0]; dots[4] += tq[2] * tk[1]; dots[5] += tq[2] * tk[2]; \
        dots[6] += tq[3] * tk[0]; dots[7] += tq[3] * tk[1]; dots[8] += tq[3] * tk[2]; dots[9] += tq[3] * tk[3]; } } while (0)
    ST_LOAD(ba, 0);
#pragma unroll 1
    for (int g = 0; g < 8; g += 2) { ST_LOAD(bb, g + 1); ST_USE(ba, g); if (g + 2 < 8) ST_LOAD(ba, g + 2); ST_USE(bb, g + 1); }
#undef ST_LOAD
#undef ST_USE
#pragma unroll
    for (int t = 0; t < 4; ++t) { const float gc = exp2f((float)(t + 1) * lgs), gi = exp2f((float)(t - 3) * lgs);
        f32x4 oa = cra[t] * gc, ob = crb[t] * gc;
#pragma unroll
        for (int s = 0; s <= t; ++s) { const float w = dots[t * (t + 1) / 2 + s] * gi; oa = oa + va[s] * w; ob = ob + vb[s] * w; }
        LAS float* ox = (LAS float*)(C.lds + T_OXL) + t * 512 + 4 * lane;
#pragma unroll
        for (int c = 0; c < 4; ++c) { __hip_atomic_fetch_add(ox + c, oa[c], __ATOMIC_RELAXED, __HIP_MEMORY_SCOPE_WORKGROUP); __hip_atomic_fetch_add(ox + 256 + c, ob[c], __ATOMIC_RELAXED, __HIP_MEMORY_SCOPE_WORKGROUP); } }
    __syncthreads();
    { const int t = tid >> 7, jq = tid & 127; const f32x4 o4 = *(const LAS f32x4*)(C.lds + T_OXL + (t * 512 + 4 * jq) * 4);
      const float ss = wave_sum(sum4(o4 * o4)); if (lane == 0) ((LAS float*)(C.lds + T_RED))[wave] = ss;
      __syncthreads();
      const float rs = rsqrtf((((LAS float*)(C.lds + T_RED))[2 * t] + ((LAS float*)(C.lds + T_RED))[2 * t + 1]) * (1.f / 512.f) + EPS);
      const int col = hs * 512 + 4 * jq; const f32x4 gz = silu4(ld_bf4(Z + (size_t)(srow0 + t) * ZLD + CG + col)), gr = *(const f32x4*)(C.in[I_GRET] + col);
      st_bf4(C.w<bf16_t>(WS_YA) + (size_t)(srow0 + t) * 2048 + col, gz * o4 * rs * gr); }
    __syncthreads();
}
__device__ __forceinline__ void stream_pair(const Ctx& C, int si0) {
    const int wave = C.wave, ch = wave & 1, rq = wave >> 1;
    const bf16_t* Z = C.w<bf16_t>(WS_Z);
    int lane0 = C.lane; asm volatile("" : "+v"(lane0), "+s"(si0));
    const float* sp = C.in[I_ST] + ((size_t)si0 * 256 + 64 * rq) * 512 + ch * 256 + 4 * lane0;
    float* op = C.out + O_SRS + ((size_t)si0 * 256 + 64 * rq) * 512 + ch * 256 + 4 * lane0;
    f32x4 rg[8][4];
#define SP_OFF(G) ((size_t)((((G) >> 4) * 256) + (((G) & 15) * 4)) * 512)
#define SP_LOAD(slot, G) do { const float* p_ = sp + SP_OFF(G); rg[slot][0] = *(const f32x4*)p_; rg[slot][1] = *(const f32x4*)(p_ + 512); rg[slot][2] = *(const f32x4*)(p_ + 1024); rg[slot][3] = *(const f32x4*)(p_ + 1536); } while (0)
#pragma unroll
    for (int s = 0; s < 7; ++s) SP_LOAD(s, s);
#pragma unroll 1
    for (int item = 0; item < 2; ++item) {
        int si = si0 + item; asm volatile("" : "+s"(si));
        int tid = C.tid, lane = C.lane; asm volatile("" : "+v"(tid), "+v"(lane));
        const int bs = si >> 2, hs = si & 3, srow0 = MP + 4 * bs; const float lgs = log2f(1.0f - exp2f(-5.0f - (float)hs));
        { const int d = tid >> 1, wh = tid & 1; f32x4 tv;
#pragma unroll
          for (int t = 0; t < 4; ++t) tv[t] = bf2f(Z[(size_t)(srow0 + t) * ZLD + (wh ? CK : CQ) + hs * 256 + d]) * (wh ? exp2f((float)(3 - t) * lgs) : 1.0f);
          *(LAS f32x4*)(C.lds + T_TAB + d * 32 + wh * 16) = tv;
          *(LAS f32x4*)(C.lds + T_OXL + tid * 16) = (f32x4){0.f, 0.f, 0.f, 0.f}; }
        f32x4 va[4], cra[4];
#pragma unroll
        for (int t = 0; t < 4; ++t) { va[t] = ld_bf4(Z + (size_t)(srow0 + t) * ZLD + CV + hs * 512 + ch * 256 + 4 * lane); cra[t] = (f32x4){0.f, 0.f, 0.f, 0.f}; }
        const float g4s = exp2f(4.0f * lgs);
        __syncthreads();
#pragma unroll 1
        for (int half = 0; half < 2; ++half) {
#pragma unroll
            for (int j = 0; j < 8; ++j) { const int G = item * 16 + half * 8 + j;
                SP_LOAD((j + 7) & 7, (G + 7 < 32 ? G + 7 : 0));
                float* o_ = op + SP_OFF(G);
#pragma unroll
                for (int r = 0; r < 4; ++r) { const int d = 64 * rq + (half * 8 + j) * 4 + r;
                    const f32x4 tq = *(const LAS f32x4*)(C.lds + T_TAB + d * 32), tk = *(const LAS f32x4*)(C.lds + T_TAB + d * 32 + 16);
                    const f32x4 s0 = rg[j][r];
                    f32x4 n0 = s0 * g4s;
#pragma unroll
                    for (int t = 0; t < 4; ++t) { n0 = n0 + va[t] * tk[t]; cra[t] = cra[t] + s0 * tq[t]; }
                    *(f32x4*)(o_ + r * 512) = n0; }
                asm volatile("" ::: "memory"); }
        }
        int hse = hs; asm volatile("" : "+s"(hse)); const float lge = log2f(1.0f - exp2f(-5.0f - (float)hse));
        float dots[10];
#pragma unroll
        for (int e = 0; e < 10; ++e) dots[e] = 0.f;
#pragma unroll
        for (int i = 0; i < 4; ++i) { const int d = lane * 4 + i; const f32x4 tq = *(const LAS f32x4*)(C.lds + T_TAB + d * 32), tk = *(const LAS f32x4*)(C.lds + T_TAB + d * 32 + 16);
            dots[0] += tq[0] * tk[0]; dots[1] += tq[1] * tk[0]; dots[2] += tq[1] * tk[1]; dots[3] += tq[2] * tk[0]; dots[4] += tq[2] * tk[1]; dots[5] += tq[2] * tk[2];
            dots[6] += tq[3] * tk[0]; dots[7] += tq[3] * tk[1]; dots[8] += tq[3] * tk[2]; dots[9] += tq[3] * tk[3]; }
#pragma unroll
        for (int e = 0; e < 10; ++e) dots[e] = (rq == 0) ? wave_sum(dots[e]) : 0.f;
#pragma unroll
        for (int t = 0; t < 4; ++t) { const float gc = exp2f((float)(t + 1) * lge), gi = exp2f((float)(t - 3) * lge);
            f32x4 oa = cra[t] * gc;
#pragma unroll
            for (int s = 0; s <= t; ++s) { const float w = dots[t * (t + 1) / 2 + s] * gi; oa = oa + va[s] * w; }
            LAS float* ox = (LAS float*)(C.lds + T_OXL) + t * 512 + ch * 256 + 4 * lane;
#pragma unroll
            for (int c = 0; c < 4; ++c) __hip_atomic_fetch_add(ox + c, oa[c], __ATOMIC_RELAXED, __HIP_MEMORY_SCOPE_WORKGROUP); }
        __syncthreads();
        { const int t = tid >> 7, jq = tid & 127; const f32x4 o4 = *(const LAS f32x4*)(C.lds + T_OXL + (t * 512 + 4 * jq) * 4);
          const float ss = wave_sum(sum4(o4 * o4)); if (lane == 0) ((LAS float*)(C.lds + T_RED))[wave] = ss;
          __syncthreads();
          const float rs = rsqrtf((((LAS float*)(C.lds + T_RED))[2 * t] + ((LAS float*)(C.lds + T_RED))[2 * t + 1]) * (1.f / 512.f) + EPS);
          const int col = hs * 512 + 4 * jq; const f32x4 gz = silu4(ld_bf4(Z + (size_t)(srow0 + t) * ZLD + CG + col)), gr = *(const f32x4*)(C.in[I_GRET] + col);
          st_bf4(C.w<bf16_t>(WS_YA) + (size_t)(srow0 + t) * 2048 + col, gz * o4 * rs * gr); }
        __syncthreads();
    }
#undef SP_LOAD
#undef SP_OFF
}
__device__ __forceinline__ void p2_retention_simple(const Ctx& C) {
#ifdef RET_SIMPLE
    for (int it = C.vcu; it < 256; it += C.G) ret_simple_item(C, false, it >> 5, (it >> 3) & 3, it & 7);
#else
    if (C.G == 256) { const int it = C.vcu;
#ifdef RET_INTERLEAVED
        ret_mfma_item<true>(C, it >> 5, (it >> 3) & 3, it & 7, 2 * it); __syncthreads();
#else
#ifdef PROBE_RS
        const unsigned long long t0_ = __builtin_amdgcn_s_memrealtime();
        ret_mfma_item<false>(C, it >> 5, (it >> 3) & 3, it & 7, 0); __syncthreads();
        const unsigned long long t1_ = __builtin_amdgcn_s_memrealtime();
        stream_item(C, 2 * it); stream_item(C, 2 * it + 1);
        const unsigned long long t2_ = __builtin_amdgcn_s_memrealtime();
        if (blockIdx.x == 0 && C.tid == 0) { float* dbg = C.w<float>(WS_CTL) + 65536; dbg[0] = (float)(t1_ - t0_) * 0.01f; dbg[1] = (float)(t2_ - t1_) * 0.01f; }
#else
        const bool sfirst = (((int)blockIdx.x >> 3) & 1) != 0;
        if (sfirst) { stream_pair(C, 2 * it); __syncthreads(); ret_mfma_item<false>(C, it >> 5, (it >> 3) & 3, it & 7, 0); __syncthreads(); }
        else { ret_mfma_item<false>(C, it >> 5, (it >> 3) & 3, it & 7, 0); __syncthreads(); stream_pair(C, 2 * it); }
#endif
#endif
        return; }
    for (int it = C.vcu; it < 256; it += C.G) ret_mfma_item<false>(C, it >> 5, (it >> 3) & 3, it & 7, 0);
    __syncthreads();
#endif
    for (int it = C.vcu; it < 4096; it += C.G) ret_simple_item(C, true, it >> 5, (it >> 3) & 3, it & 7);
}
__device__ __forceinline__ void unpk8(u32x4 w, f32x4& a, f32x4& b) {
    a = (f32x4){__uint_as_float(w.x << 16), __uint_as_float(w.x & 0xffff0000u), __uint_as_float(w.y << 16), __uint_as_float(w.y & 0xffff0000u)};
    b = (f32x4){__uint_as_float(w.z << 16), __uint_as_float(w.z & 0xffff0000u), __uint_as_float(w.w << 16), __uint_as_float(w.w & 0xffff0000u)}; }
constexpr int G_WS = 272, G_GS = 320, G_W = 0, G_G = G_W + 128 * G_WS, G_END = G_G + 128 * G_GS;
static_assert(G_END <= LDS_MISC, "gating LDS map");
__device__ __forceinline__ void p2_gating_mfma(const Ctx& C) {
    const int tid = C.tid, wave = C.wave, l31 = C.lane & 31, hh = C.lane >> 5;
    const LAS unsigned char* lds = C.lds;
    const bf16_t* Z = C.w<bf16_t>(WS_Z); const float* LNS = C.w<float>(WS_LNS); bf16_t* YB = C.w<bf16_t>(WS_YB); const bf16_t* WSB = C.w<bf16_t>(WS_WSB);
    const float* b_s = C.in[I_BS]; const float* g_gm = C.in[I_GGM];
    int g_staged = -1;
    const int c16 = tid & 15, mrow = tid >> 4;
    u32x4 gvr[4]; f32x2_t lnr[4];
#define GT_LOAD(itx) do { const int g_ = (itx) & 7, r0_ = ((itx) >> 3) * 128; _Pragma("unroll") for (int j = 0; j < 4; ++j) { const int row_ = r0_ + mrow + 32 * j; \
        gvr[j] = *(const u32x4*)(Z + (size_t)row_ * ZLD + CGV + g_ * 128 + c16 * 8); lnr[j] = *(const f32x2_t*)(LNS + 2 * row_); } } while (0)
    if (C.vcu < 1024) GT_LOAD(C.vcu);
#pragma unroll 1
    for (int it = C.vcu; it < 1024; it += C.G) {
        const int g = it & 7, row0 = (it >> 3) * 128;
        __syncthreads();
        if (g != g_staged) { g_staged = g;
#pragma unroll
            for (int j = 0; j < 4; ++j) { const int idx = tid + NTHR * j, r = idx >> 4, cw = idx & 15;
                *(LAS u32x4*)(C.lds + G_W + r * G_WS + cw * 16) = *(const u32x4*)(WSB + ((size_t)g * 128 + r) * 128 + cw * 8); } }
        { const f32x4 gg0 = *(const f32x4*)(g_gm + g * 128 + c16 * 8), gg1 = *(const f32x4*)(g_gm + g * 128 + c16 * 8 + 4);
#pragma unroll
          for (int j = 0; j < 4; ++j) { const int m = mrow + 32 * j;
              const float mu = lnr[j][0] * (1.f / 1024.f), var = lnr[j][1] * (1.f / 1024.f) - mu * mu, rstd = rsqrtf(var + EPS);
              f32x4 x0, x1; unpk8(gvr[j], x0, x1);
              const f32x4 y0 = (x0 - mu) * rstd * gg0, y1 = (x1 - mu) * rstd * gg1;
              u32x4 w; w.x = cvtpk(y0[0], y0[1]); w.y = cvtpk(y0[2], y0[3]); w.z = cvtpk(y1[0], y1[1]); w.w = cvtpk(y1[2], y1[3]);
              *(LAS u32x4*)(C.lds + G_G + m * G_GS + c16 * 16) = w; } }
        const int nt = wave >> 1, ct0 = 2 * (wave & 1);
        const int n = 32 * nt + l31, row = row0 + n;
        const bf16_t* up = Z + (size_t)row * ZLD + CU + g * 128 + 32 * ct0 + 4 * hh;
        u32x2 ur[8];
#pragma unroll
        for (int q4 = 0; q4 < 4; ++q4) { ur[2 * q4] = *(const u32x2*)(up + 8 * q4); ur[2 * q4 + 1] = *(const u32x2*)(up + 32 + 8 * q4); }
        asm volatile("" ::: "memory");
        if (it + C.G < 1024) GT_LOAD(it + C.G);
        asm volatile("" ::: "memory");
        __syncthreads();
        f32x16 a0, a1;
#pragma unroll
        for (int i = 0; i < 16; ++i) { a0[i] = 0.f; a1[i] = 0.f; }
        const int tr_q = (l31 & 15) >> 2, tr_p = l31 & 3, tr_blk = (l31 >> 4) & 1;
        const LAS unsigned char* pw = lds + G_W + (32 * nt + l31) * G_WS + 16 * hh;
        const LAS unsigned char* pg = lds + G_G + (8 * hh + tr_q) * G_GS + (32 * ct0 + 16 * tr_blk + 4 * tr_p) * 2;
        for (int ks = 0; ks < 2 * nt + 2; ++ks) { const bf16x8 bw = *(const LAS bf16x8*)(pw + ks * 32);
            a0 = MFMA32(tr_frag(pg + 16 * ks * G_GS, G_GS), bw, a0); a1 = MFMA32(tr_frag(pg + 16 * ks * G_GS + 64, G_GS), bw, a1); }
        const float bias = b_s[g * 128 + n];
        bf16_t* yp = YB + (size_t)row * DM + g * 128 + 32 * ct0 + 4 * hh;
#define G_UNPK(w) (f32x4){__uint_as_float((w).x << 16), __uint_as_float((w).x & 0xffff0000u), __uint_as_float((w).y << 16), __uint_as_float((w).y & 0xffff0000u)}
#pragma unroll
        for (int q4 = 0; q4 < 4; ++q4) {
            const f32x4 o0 = (f32x4){a0[4 * q4], a0[4 * q4 + 1], a0[4 * q4 + 2], a0[4 * q4 + 3]} + bias, o1 = (f32x4){a1[4 * q4], a1[4 * q4 + 1], a1[4 * q4 + 2], a1[4 * q4 + 3]} + bias;
            st_bf4(yp + 8 * q4, gelu4(G_UNPK(ur[2 * q4])) * o0); st_bf4(yp + 32 + 8 * q4, gelu4(G_UNPK(ur[2 * q4 + 1])) * o1); }
#undef G_UNPK
    }
#undef GT_LOAD
    __syncthreads();
}
template <int CH> __device__ __forceinline__ void gate_simple_item(const Ctx& C, int row0, float* gmv_out) {
    LAS float* gvl = (LAS float*)C.lds;
    LAS float* wl = (LAS float*)(C.lds + 65536);
    const bf16_t* Z = C.w<bf16_t>(WS_Z); const float* LNS = C.w<float>(WS_LNS); bf16_t* YB = C.w<bf16_t>(WS_YB);
    const float* w_s = C.in[I_WS]; const float* b_s = C.in[I_BS]; const float* g_gm = C.in[I_GGM];
    for (int g = 0; g < 8; ++g) {
        for (int e = C.tid; e < CH * 128; e += NTHR) { const int m = e >> 7, ch = e & 127; const int row = row0 + m;
            const float mu = LNS[2 * row] * (1.f / 1024.f), var = LNS[2 * row + 1] * (1.f / 1024.f) - mu * mu, rstd = rsqrtf(var + EPS);
            const float x = bf2f(Z[(size_t)row * ZLD + CGV + g * 128 + ch]); const float y = (x - mu) * rstd * g_gm[g * 128 + ch];
            gvl[e] = y; if (gmv_out) gmv_out[(size_t)m * 1024 + g * 128 + ch] = y;
            wl[e] = (ch < CH) ? w_s[((size_t)g * 128 + m) * 128 + ch] : 0.f; }
        __syncthreads();
        const int ch = C.tid & 127;
        for (int n = C.tid >> 7; n < CH; n += 4) { float acc = b_s[g * 128 + n];
            for (int m = 0; m <= n; ++m) acc += wl[n * 128 + m] * gvl[m * 128 + ch];
            const int row = row0 + n; const f32x2 uu = gelu_pk((f32x2){bf2f(Z[(size_t)row * ZLD + CU + g * 128 + ch]), 0.f}); const float u = uu.x;
            YB[(size_t)row * DM + g * 128 + ch] = (bf16_t)f2bf(u * acc); }
        __syncthreads();
    }
}
__device__ __forceinline__ void gate_sample_item(const Ctx& C, int b) {
    const bf16_t* Z = C.w<bf16_t>(WS_Z); const float* LNS = C.w<float>(WS_LNS); bf16_t* YB = C.w<bf16_t>(WS_YB);
    const float* w_s = C.in[I_WS]; const float* b_s = C.in[I_BS]; const float* g_gm = C.in[I_GGM];
    const int row0 = MP + 4 * b; float* gmv = C.out + O_GMV + (size_t)b * 4 * 1024;
    float mu[4], rstd[4];
#pragma unroll
    for (int m = 0; m < 4; ++m) { mu[m] = LNS[2 * (row0 + m)] * (1.f / 1024.f); const float var = LNS[2 * (row0 + m) + 1] * (1.f / 1024.f) - mu[m] * mu[m]; rstd[m] = rsqrtf(var + EPS); }
#pragma unroll
    for (int j = 0; j < 2; ++j) { const int c = C.tid + NTHR * j, g = c >> 7; const float gg = g_gm[c];
        float gv[4];
#pragma unroll
        for (int m = 0; m < 4; ++m) { gv[m] = (bf2f(Z[(size_t)(row0 + m) * ZLD + CGV + c]) - mu[m]) * rstd[m] * gg; gmv[(size_t)m * 1024 + c] = gv[m]; }
#pragma unroll
        for (int n = 0; n < 4; ++n) { float acc = b_s[g * 128 + n];
#pragma unroll
            for (int m = 0; m <= n; ++m) acc += w_s[((size_t)g * 128 + n) * 128 + m] * gv[m];
            const f32x2 uu = gelu_pk((f32x2){bf2f(Z[(size_t)(row0 + n) * ZLD + CU + c]), 0.f});
            YB[(size_t)(row0 + n) * DM + c] = (bf16_t)f2bf(uu.x * acc); } }
}
__device__ __forceinline__ void p2_gating_simple(const Ctx& C) {
#ifdef GATE_SIMPLE
    for (int it = C.vcu; it < 128; it += C.G) gate_simple_item<128>(C, (it >> 4) * 2048 + (it & 15) * 128, nullptr);
#else
    p2_gating_mfma(C);
#endif
    for (int it = C.vcu; it < 128; it += C.G) gate_sample_item(C, it);
}
__device__ __forceinline__ void p3_finalize_ya(const Ctx& C) {
    const bf16_t* Z = C.w<bf16_t>(WS_Z); const bf16_t* OR = C.w<bf16_t>(WS_ORAW); bf16_t* YA = C.w<bf16_t>(WS_YA);
    const float* g_ret = C.in[I_GRET];
    const int gw = C.vcu * NWAVES + C.wave, NGW = C.G * NWAVES, lane = C.lane;
    const int mend = (C.G == 256) ? MP : MT;
    for (int row = gw; row < mend; row += NGW) {
        f32x4 o[8]; float rs[4];
#pragma unroll
        for (int j = 0; j < 8; ++j) o[j] = ld_bf4(OR + (size_t)row * 2048 + 4 * lane + 256 * j);
#pragma unroll
        for (int hd = 0; hd < 4; ++hd) rs[hd] = rsqrtf(wave_sum(sum4(o[2 * hd] * o[2 * hd]) + sum4(o[2 * hd + 1] * o[2 * hd + 1])) * (1.f / 512.f) + EPS);
#pragma unroll
        for (int j = 0; j < 8; ++j) { const int c = 4 * lane + 256 * j;
            const f32x4 gz = silu4(ld_bf4(Z + (size_t)row * ZLD + CG + c)), gr = *(const f32x4*)(g_ret + c);
            st_bf4(YA + (size_t)row * 2048 + c, gz * o[j] * rs[j >> 1] * gr); }
    }
}
__device__ __forceinline__ void p9_final_norm(const Ctx& C) {
    const bf16_t* H3 = C.w<bf16_t>(WS_H3); const float* SSQ4 = C.w<float>(WS_SSQ4); const float* gf = C.in[I_GFIN];
    const int gw = C.vcu * NWAVES + C.wave, NGW = C.G * NWAVES, lane = C.lane;
    f32x4 gv[4];
#pragma unroll
    for (int j = 0; j < 4; ++j) gv[j] = ((const f32x4*)gf)[lane + 64 * j];
    for (int row0 = gw; row0 < MT; row0 += 4 * NGW) {
        u32x2 hv[4][4]; float rs[4];
#pragma unroll
        for (int r = 0; r < 4; ++r) { const int row = row0 + r * NGW; if (row < MT) { rs[r] = SSQ4[row];
#pragma unroll
            for (int j = 0; j < 4; ++j) hv[r][j] = *(const u32x2*)(H3 + (size_t)row * DM + 4 * lane + 256 * j); } }
#pragma unroll
        for (int r = 0; r < 4; ++r) { const int row = row0 + r * NGW; if (row < MT) { const float s = rsqrtf(rs[r] * (1.f / DM) + EPS);
            f32x4* o = (f32x4*)(C.out + O_Y + (size_t)row * DM) + lane;
#pragma unroll
            for (int j = 0; j < 4; ++j) o[64 * j] = (f32x4){__uint_as_float(hv[r][j].x << 16), __uint_as_float(hv[r][j].x & 0xffff0000u), __uint_as_float(hv[r][j].y << 16), __uint_as_float(hv[r][j].y & 0xffff0000u)} * s * gv[j]; } }
    }
}
#ifdef DBG_EXPORT
__device__ __forceinline__ void dbg_export(const Ctx& C) {
    const bf16_t* Z = C.w<bf16_t>(WS_Z); const bf16_t* YA = C.w<bf16_t>(WS_YA); const bf16_t* YB = C.w<bf16_t>(WS_YB);
    const int gw = C.vcu * NWAVES + C.wave, NGW = C.G * NWAVES, lane = C.lane;
    for (int row = gw; row < MT; row += NGW)
        for (int j = 0; j < 4; ++j) { const int c = 4 * lane + 256 * j;
            f32x4 v = (f32x4){0.f, 0.f, 0.f, 0.f};
#if DBG_EXPORT == 1
            v = ld_bf4(YB + (size_t)row * DM + c);
#elif DBG_EXPORT == 4
            v = ld_bf4(YA + (size_t)row * 2048 + c) + ld_bf4(YA + (size_t)row * 2048 + 1024 + c);
#elif DBG_EXPORT == 5
            v = ld_bf4(Z + (size_t)row * ZLD + CGA + c) + ld_bf4(Z + (size_t)row * ZLD + CGB + c);
#elif DBG_EXPORT == 6
            v = ld_bf4(C.w<bf16_t>(WS_ORAW) + (size_t)row * 2048 + c) + ld_bf4(C.w<bf16_t>(WS_ORAW) + (size_t)row * 2048 + 1024 + c);
#elif DBG_EXPORT == 7
            v = ld_bf4(Z + (size_t)row * ZLD + CG + c) + ld_bf4(Z + (size_t)row * ZLD + CG + 1024 + c);
#elif DBG_EXPORT == 8
            v = ld_bf4(Z + (size_t)row * ZLD + CQ + c);
#endif
            *(f32x4*)(C.out + O_Y + (size_t)row * DM + c) = v; }
}
#endif
constexpr int NPHASE = 10;
__global__ void __launch_bounds__(NTHR, 2) mk_fwd(Args args) {
    extern __shared__ __attribute__((aligned(16))) unsigned char lds_raw[];
    Ctx C;
    C.lds = (LAS unsigned char*)lds_raw; C.tid = threadIdx.x; C.lane = C.tid & 63; C.wave = __builtin_amdgcn_readfirstlane(C.tid >> 6);
    C.G = gridDim.x; { const int bx = blockIdx.x; C.vcu = (C.G % 8 == 0) ? (bx % 8) * (C.G / 8) + bx / 8 : bx; }
    C.in = args.in; C.out = args.out; C.ws = args.ws;
    const int lo = args.ph_lo, hi = args.ph_hi;
    if (C.tid < 64) ((LAS unsigned*)(C.lds + LDS_MISC))[C.tid] = 0u;
    __syncthreads();
    const XcdBarrier bar = xcd_barrier_post((unsigned*)(args.ws + WS_CTL) + 4096, (volatile LAS unsigned*)(C.lds + LDS_MISC));
#define IN(k) (lo <= (k) && (k) < hi)
#ifndef PROBE_BSCALE
#define PROBE_BSCALE 0.1f
#endif
#ifdef PROBE_A
    unsigned long long tA0 = 0, tA1 = 0, tB0 = 0, tB1 = 0;
#define PSTAMP(k, which) do { if ((k) == PROBE_A) { if (which) tA1 = __builtin_amdgcn_s_memrealtime(); else tA0 = __builtin_amdgcn_s_memrealtime(); } if ((k) == PROBE_B) { if (which) tB1 = __builtin_amdgcn_s_memrealtime(); else tB0 = __builtin_amdgcn_s_memrealtime(); } } while (0)
#else
#define PSTAMP(k, which) do { } while (0)
#endif
#define SEAM(k) do { if (IN(k) && IN((k) + 1)) { GRID_BAR(); } } while (0)
#define GRID_BAR() do { xcd_barrier(bar); } while (0)
    PSTAMP(0, 0);
    if (IN(0)) { p0_prologue(C); } SEAM(0);
    if (lo < 0) cooperative_groups::this_grid().sync();
    PSTAMP(0, 1);
    PSTAMP(1, 0);
    if (IN(1)) { F1 f{C.w<bf16_t>(WS_Z), C.w<float>(WS_COS), C.w<float>(WS_SIN), C.w<float>(WS_LNS)}; run_gemm(C, C.w<bf16_t>(WS_XN), C.w<bf16_t>(WS_WIN), MT, INW, DM, f);
                 { constexpr int NU = (MT / 256) * (INW / 256); const int rem = NU % C.G;
                   if (rem == 0) p0_deferred(C, (int)blockIdx.x, C.G); else if ((int)blockIdx.x >= rem) p0_deferred(C, (int)blockIdx.x - rem, C.G - rem); } } SEAM(1);
    PSTAMP(1, 1);
    PSTAMP(2, 0);
#ifdef PROBE_P2
    if (IN(2)) { tA0 = __builtin_amdgcn_s_memrealtime(); p2_retention_simple(C); tA1 = __builtin_amdgcn_s_memrealtime(); tB0 = tA1; p2_gating_simple(C); tB1 = __builtin_amdgcn_s_memrealtime(); }
#else
    if (IN(2)) { p2_retention_simple(C); p2_gating_simple(C); }
#endif
    if (IN(2) && IN(4)) { GRID_BAR(); }
    PSTAMP(2, 1);
    PSTAMP(3, 0);
    PSTAMP(3, 1);
    PSTAMP(4, 0);
    if (IN(4)) { { F2a f{C.w<bf16_t>(WS_Z), C.w<bf16_t>(WS_T), C.w<float>(WS_SSQO)}; run_gemm_split(C, C.w<bf16_t>(WS_YA), C.w<bf16_t>(WS_WBRA), DM, 2048, f); }
                 { F2b f{C.w<bf16_t>(WS_Z), C.w<bf16_t>(WS_T), C.w<bf16_t>(WS_MG)}; run_gemm_split(C, C.w<bf16_t>(WS_YB), C.w<bf16_t>(WS_WBRB), DM, DM, f); } } SEAM(4);
    PSTAMP(4, 1);
    PSTAMP(5, 0);
    if (IN(5)) { FRes<false> f{C.in[I_XP], C.in[I_XS], nullptr, C.w<bf16_t>(WS_H1B), C.w<float>(WS_SSQ2)}; run_gemm_split(C, C.w<bf16_t>(WS_MG), C.w<bf16_t>(WS_WO), DM, DM, f); } SEAM(5);
    PSTAMP(5, 1);
    PSTAMP(6, 0);
    if (IN(6)) { F4 f{C.w<float>(WS_SSQ2), C.w<bf16_t>(WS_U)}; run_gemm_split(C, C.w<bf16_t>(WS_H1B), C.w<bf16_t>(WS_WUP), FF, DM, f); } SEAM(6);
    PSTAMP(6, 1);
    PSTAMP(7, 0);
    if (IN(7)) { FRes<true> f{nullptr, nullptr, C.w<bf16_t>(WS_H1B), C.w<bf16_t>(WS_H2B), C.w<float>(WS_SSQ3)}; run_gemm_split(C, C.w<bf16_t>(WS_U), C.w<bf16_t>(WS_WDN), DM, FF, f); } SEAM(7);
    PSTAMP(7, 1);
    PSTAMP(8, 0);
    if (IN(8)) { { F6a f{C.w<bf16_t>(WS_PE)}; run_gemm_split(C, C.w<bf16_t>(WS_PB), C.w<bf16_t>(WS_WPP), DM, PLE, f); }
                 { F6b f{C.w<float>(WS_SSQ3), C.w<bf16_t>(WS_H2B), C.w<bf16_t>(WS_PE), C.w<bf16_t>(WS_H3), C.w<float>(WS_SSQ4)}; run_gemm_split(C, C.w<bf16_t>(WS_H2B), C.w<bf16_t>(WS_WPG), DM, DM, f); } } SEAM(8);
    PSTAMP(8, 1);
    PSTAMP(9, 0);
    if (IN(9)) { p9_final_norm(C); }
    PSTAMP(9, 1);
#ifdef PROBE_A
    GRID_BAR();
    if (blockIdx.x == 0 && C.tid == 0) { float dA = (float)(tA1 - tA0) * 0.01f, dB = (float)(tB1 - tB0) * 0.01f;
#ifdef PROBE_RS
        dA = C.w<float>(WS_CTL)[65536]; dB = C.w<float>(WS_CTL)[65537];
#endif
#ifdef PROBE_ST
        dA = C.w<float>(WS_CTL)[65536 + PROBE_ST_X]; dB = C.w<float>(WS_CTL)[65536 + PROBE_ST_Y];
#endif
        C.out[0] = 0.1f * dA; C.out[O_Y + (size_t)MP * DM] = PROBE_BSCALE * dB; }
#endif
#undef IN
#undef SEAM
#undef GRID_BAR
}
}

extern "C" void kernel_launch(void* const* d_in, const int* in_sizes, int n_in, void* d_out, int out_size, void* d_ws, size_t ws_size, hipStream_t stream) {
    using namespace mk;
    static int grid = 0;
    if (grid == 0) {
        if (n_in != 21 || (size_t)out_size != O_END || ws_size < WS_END) { fprintf(stderr, "kernel_launch: unexpected shapes: n_in %d out %d ws %zu (need %zu)\n", n_in, out_size, ws_size, (size_t)WS_END); grid = -1; return; }
        int dev = 0, cus = 0;
        if (hipGetDevice(&dev) != hipSuccess || hipDeviceGetAttribute(&cus, hipDeviceAttributeMultiprocessorCount, dev) != hipSuccess) { grid = -1; return; }
        if (hipFuncSetAttribute((const void*)mk_fwd, hipFuncAttributeMaxDynamicSharedMemorySize, LDS_BYTES) != hipSuccess) { fprintf(stderr, "kernel_launch: hipFuncSetAttribute failed\n"); grid = -1; return; }
        int per_cu = 0;
        if (hipOccupancyMaxActiveBlocksPerMultiprocessor(&per_cu, (const void*)mk_fwd, NTHR, LDS_BYTES) != hipSuccess || per_cu < 1) { fprintf(stderr, "kernel_launch: occupancy query says %d blocks/CU\n", per_cu); (void)hipGetLastError(); grid = -1; return; }
        if (cus != 256) { fprintf(stderr, "kernel_launch: built for a 256-CU device (the retention phase deals exactly one prompt item and two sample items per workgroup); found %d CUs\n", cus); grid = -1; return; }
        grid = cus;
    }
    if (grid < 0) return;
    (void)hipMemsetAsync((char*)d_ws, 0, WS_ZERO_END, stream);
    Args a{};
    for (int i = 0; i < 21; ++i) a.in[i] = (const float*)d_in[i];
    a.out = (float*)d_out; a.ws = (unsigned char*)d_ws;
#ifdef MK_MULTI
    for (int p = 0; p < NPHASE; ++p) { a.ph_lo = p; a.ph_hi = p + 1; hipLaunchKernelGGL(mk_fwd, dim3(grid), dim3(NTHR), LDS_BYTES, stream, a); }
#else
    a.ph_lo = 0; a.ph_hi = NPHASE;
    void* kargs[] = {&a};
    const hipError_t le = hipLaunchCooperativeKernel((const void*)mk_fwd, dim3(grid), dim3(NTHR), kargs, LDS_BYTES, stream);
    if (le != hipSuccess) fprintf(stderr, "kernel_launch: cooperative launch failed: %s (grid %d)\n", hipGetErrorString(le), grid);
#endif
}
```

```cpp
#include <hip/hip_runtime.h>
#include <hip/hip_cooperative_groups.h>
#include <cstdio>
#include <cstdint>
namespace pg8 {
#define PG8_LAS __attribute__((address_space(3)))
typedef unsigned short bf16_t;
typedef short bf16x8 __attribute__((ext_vector_type(8)));
typedef float f32x4 __attribute__((ext_vector_type(4)));
typedef unsigned u32x4 __attribute__((ext_vector_type(4)));
constexpr int BM = 256, BK = 64, HALF = 128, HTB = HALF * BK * 2  , STAGE_BYTES = 8 * HTB, NXCD = 8, WGM = 4;

__host__ __device__ __forceinline__ int lds_byte(int r, int c) { const int st = (r >> 4) * 2 + (c >> 5), rr = r & 15, cc = c & 31, ob = rr * 64 + cc * 2; return st * 1024 + (ob ^ (((ob >> 9) & 1) << 5)); }
__host__ __device__ __forceinline__ void stage_rc(int b, int& R, int& C) { const int st = b / 1024, sb = b % 1024, swz = sb ^ (((sb >> 9) & 1) << 5); R = (st >> 1) * 16 + swz / 64; C = (st & 1) * 32 + (swz % 64) / 2; }
__host__ __device__ __forceinline__ int perm32(int rho) { const int n = rho >> 4, i = rho & 15; return 8 * (i >> 2) + 4 * n + (i & 3); }

struct Unit { int pm, pn; };
struct Gemm { const bf16_t* A; const bf16_t* Bt; int M, N, K; };

struct StaticOrder {
    int nM, nN, nwg, G, c;
    __host__ __device__ void init(int M, int N, int G_, int c_) { nM = M / BM; nN = N / BM; nwg = nM * nN; G = G_; c = c_; }
    __host__ __device__ bool next(int i, Unit& u) const {
        const long L = (long)i * G + c; if (L >= nwg) return false;
        int wgid = (int)L; { const int q = nwg / NXCD, r = nwg % NXCD, xcd = wgid % NXCD, off = wgid / NXCD; wgid = (xcd < r ? xcd * (q + 1) : r * (q + 1) + (xcd - r) * q) + off; }
        const int nig = WGM * nN, gid = wgid / nig, fm = gid * WGM, gsz = (nM - fm) < WGM ? (nM - fm) : WGM;
        u.pm = fm + ((wgid % nig) % gsz); u.pn = (wgid % nig) / gsz; return true;
    }
    __device__ __forceinline__ void a_ready(const Unit&) const {}
    __device__ __forceinline__ void done(const Unit&) const {}
};

__device__ __forceinline__ unsigned cvt_pk_bf16(float lo, float hi) { unsigned r; asm volatile("v_cvt_pk_bf16_f32 %0, %1, %2" : "=v"(r) : "v"(lo), "v"(hi)); return r; }
typedef float f32x2 __attribute__((ext_vector_type(2)));
__device__ __forceinline__ f32x2 gelu_pk(f32x2 v) {
    const f32x2 av = __builtin_elementwise_abs(v), d = av * 0.2316418882f + 1.0f;
    f32x2 t; t.x = __builtin_amdgcn_rcpf(d.x); t.y = __builtin_amdgcn_rcpf(d.y);
    f32x2 q = t * 0.5307027145f + (-0.7265760135f); q = q * t + 0.7107068705f; q = q * t + (-0.142248368f); q = q * t + 0.127414796f; q = q * t;
    const f32x2 s = (v * v) * (-0.72134752044f);
    f32x2 e; e.x = __builtin_amdgcn_exp2f(s.x); e.y = __builtin_amdgcn_exp2f(s.y);
    const f32x2 m = v * (q * e), r = v - m;
    f32x2 o; o.x = v.x < 0.f ? m.x : r.x; o.y = v.y < 0.f ? m.y : r.y; return o;
}
template <class Epi, class Sched, bool ALIGN_EPI = false, bool SP2 = false>
__device__ __forceinline__ void gemm_phase(PG8_LAS unsigned char* lds, const Gemm g, const Sched& S, const Epi& E) {
    const int tid = threadIdx.x, wid = __builtin_amdgcn_readfirstlane(tid >> 6), lane = tid & 63, wr = wid >> 2, wc = wid & 3, fr = lane & 15, fq = lane >> 4;
    const int K = g.K, nt = K / BK;
    unsigned voffA[2], voffB[2];
#pragma unroll
    for (int i = 0; i < 2; ++i) { int R, C; stage_rc(tid * 16 + i * 8192, R, C); const int Rb = Epi::PERM ? ((R & ~31) + perm32(R & 31)) : R;
        voffA[i] = (unsigned)(R * K + C) * 2u; voffB[i] = (unsigned)(Rb * K + C) * 2u; }
    const size_t kstep = (size_t)(BK * 2);
    const size_t hstep = (size_t)HALF * K * 2;
    const size_t tstep = 2 * hstep;
    const unsigned ldsw = (unsigned)wid * 1024u;
    const int aoff = lds_byte(wr * 64 + fr, fq * 8), boff = lds_byte(wc * 32 + fr, fq * 8);
#define PG8_SA(b, h) (((b) * 2 + (h)) * HTB)
#define PG8_SB(b, h) ((4 + (b) * 2 + (h)) * HTB)
#define PG8_STAGE(bufoff, gbase, voff) do { _Pragma("unroll") for (int _i = 0; _i < 2; ++_i) \
        __builtin_amdgcn_global_load_lds((const unsigned*)((const char*)(gbase) + (voff)[_i]), (PG8_LAS unsigned*)(lds + (bufoff) + ldsw + _i * 8192), 16, 0, 0); } while (0)
#define PG8_LDA(dst, b, h) do { _Pragma("unroll") for (int m = 0; m < 4; ++m) _Pragma("unroll") for (int k = 0; k < 2; ++k) dst[m][k] = *(const PG8_LAS bf16x8*)(lds + PG8_SA(b, h) + aoff + m * 2048 + k * 1024); } while (0)
#define PG8_LDB(dst, b, h) do { _Pragma("unroll") for (int n = 0; n < 2; ++n) _Pragma("unroll") for (int k = 0; k < 2; ++k) dst[n][k] = *(const PG8_LAS bf16x8*)(lds + PG8_SB(b, h) + boff + n * 2048 + k * 1024); } while (0)
#define PG8_MMA(ai, bj, At, Bt) do { __builtin_amdgcn_s_setprio(1); _Pragma("unroll") for (int m = 0; m < 4; ++m) _Pragma("unroll") for (int n = 0; n < 2; ++n) _Pragma("unroll") for (int k = 0; k < 2; ++k) \
        acc[ai][bj][m][n] = __builtin_amdgcn_mfma_f32_16x16x32_bf16(Bt[n][k], At[m][k], acc[ai][bj][m][n], 0, 0, 0); __builtin_amdgcn_s_setprio(0); } while (0)
#define PG8_WAIT_V(n) asm volatile("s_waitcnt vmcnt(" #n ")" ::: "memory")
#define PG8_WAIT_L(n) asm volatile("s_waitcnt lgkmcnt(" #n ")" ::: "memory")
#define PG8_BAR __builtin_amdgcn_s_barrier()
#define PG8_SCHED __builtin_amdgcn_sched_barrier(0)
    Unit cur, nxt; int ui = 0;
    if (!S.next(0, cur)) return;
    f32x4 acc[2][2][4][2];
#pragma unroll
    for (int a = 0; a < 2; ++a)
#pragma unroll
        for (int b = 0; b < 2; ++b)
#pragma unroll
            for (int m = 0; m < 4; ++m)
#pragma unroll
                for (int n = 0; n < 2; ++n) acc[a][b][m][n] = (f32x4){0.f, 0.f, 0.f, 0.f};
    bf16x8 At[4][2], B0[2][2], B1[2][2];
    const char* cA = (const char*)g.A + (size_t)cur.pm * tstep; const char* cB = (const char*)g.Bt + (size_t)cur.pn * tstep;
    S.a_ready(cur);
    if constexpr (SP2) {
        PG8_STAGE(PG8_SB(0, 0), cB, voffB); PG8_STAGE(PG8_SB(0, 1), cB + hstep, voffB); PG8_STAGE(PG8_SA(0, 0), cA, voffA); PG8_STAGE(PG8_SA(0, 1), cA + hstep, voffA);
        if (wr == 1) PG8_BAR;
        PG8_WAIT_V(2); PG8_BAR;
        PG8_STAGE(PG8_SB(1, 0), cB + kstep, voffB); PG8_STAGE(PG8_SA(1, 0), cA + kstep, voffA); PG8_STAGE(PG8_SB(1, 1), cB + hstep + kstep, voffB);
        PG8_WAIT_V(6); PG8_BAR;
    } else {
        PG8_STAGE(PG8_SB(0, 0), cB, voffB); PG8_STAGE(PG8_SA(0, 0), cA, voffA); PG8_STAGE(PG8_SB(0, 1), cB + hstep, voffB); PG8_STAGE(PG8_SA(0, 1), cA + hstep, voffA);
        if (wr == 1) PG8_BAR;
        PG8_WAIT_V(4); PG8_BAR;
        PG8_STAGE(PG8_SB(1, 0), cB + kstep, voffB); PG8_STAGE(PG8_SA(1, 0), cA + kstep, voffA); PG8_STAGE(PG8_SB(1, 1), cB + hstep + kstep, voffB);
        PG8_WAIT_V(6); PG8_BAR;
    }
    for (;;) {
        const bool has_next = S.next(ui + 1, nxt);
        const char* nA = has_next ? (const char*)g.A + (size_t)nxt.pm * tstep : cA; const char* nB = has_next ? (const char*)g.Bt + (size_t)nxt.pn * tstep : cB;
        for (int t = 0; t < nt; t += 2) {
            if constexpr (Epi::HOOK) { if ((t & 7) == 0) E.khook(acc, cur, t, wr, wc, fr, fq); }
            const bool last = (t == nt - 2);
            const char* a1 = cA + (size_t)(t + 1) * kstep;
            const char* a2 = last ? nA : cA + (size_t)(t + 2) * kstep; const char* b2 = last ? nB : cB + (size_t)(t + 2) * kstep;
            const char* a3 = a2 + kstep; const char* b3 = b2 + kstep;
            if (last && has_next) S.a_ready(nxt);
            if constexpr (SP2) {
            PG8_LDB(B0, 0, 0); PG8_LDB(B1, 0, 1); PG8_SCHED; PG8_LDA(At, 0, 0); PG8_STAGE(PG8_SA(1, 1), a1 + hstep, voffA);
            PG8_WAIT_V(8); PG8_WAIT_L(0); PG8_BAR; PG8_MMA(0, 0, At, B0); PG8_MMA(0, 1, At, B1); PG8_BAR; PG8_SCHED;
            PG8_LDA(At, 0, 1); PG8_STAGE(PG8_SB(0, 0), b2, voffB); PG8_STAGE(PG8_SB(0, 1), b2 + hstep, voffB); PG8_STAGE(PG8_SA(0, 0), a2, voffA);
            PG8_WAIT_V(8); PG8_WAIT_L(0); PG8_BAR; PG8_MMA(1, 0, At, B0); PG8_MMA(1, 1, At, B1); PG8_BAR; PG8_SCHED;
            PG8_LDB(B0, 1, 0); PG8_LDB(B1, 1, 1); PG8_SCHED; PG8_LDA(At, 1, 0); PG8_STAGE(PG8_SA(0, 1), a2 + hstep, voffA);
            PG8_WAIT_V(8); PG8_WAIT_L(0); PG8_BAR; PG8_MMA(0, 0, At, B0); PG8_MMA(0, 1, At, B1); PG8_BAR; PG8_SCHED;
            PG8_LDA(At, 1, 1); PG8_STAGE(PG8_SB(1, 0), b3, voffB); PG8_STAGE(PG8_SB(1, 1), b3 + hstep, voffB); PG8_STAGE(PG8_SA(1, 0), a3, voffA);
            PG8_WAIT_V(8); PG8_WAIT_L(0); PG8_BAR; PG8_MMA(1, 0, At, B0); PG8_MMA(1, 1, At, B1); PG8_BAR; PG8_SCHED;
            } else {
            PG8_LDB(B0, 0, 0); PG8_SCHED; PG8_LDA(At, 0, 0); PG8_STAGE(PG8_SA(1, 1), a1 + hstep, voffA);
            PG8_WAIT_L(8); PG8_BAR; PG8_WAIT_L(0); PG8_MMA(0, 0, At, B0); PG8_BAR; PG8_SCHED;
            PG8_LDB(B1, 0, 1); PG8_STAGE(PG8_SB(0, 0), b2, voffB);
            PG8_BAR; PG8_WAIT_L(0); PG8_MMA(0, 1, At, B1); PG8_BAR;
            PG8_LDA(At, 0, 1); PG8_STAGE(PG8_SA(0, 0), a2, voffA);
            PG8_BAR; PG8_WAIT_L(0); PG8_MMA(1, 0, At, B0); PG8_BAR; PG8_SCHED;
            PG8_STAGE(PG8_SB(0, 1), b2 + hstep, voffB);
            PG8_WAIT_V(6); PG8_BAR; PG8_MMA(1, 1, At, B1); PG8_BAR;
            PG8_LDB(B0, 1, 0); PG8_SCHED; PG8_LDA(At, 1, 0); PG8_STAGE(PG8_SA(0, 1), a2 + hstep, voffA);
            PG8_WAIT_L(8); PG8_BAR; PG8_WAIT_L(0); PG8_MMA(0, 0, At, B0); PG8_BAR; PG8_SCHED;
            PG8_LDB(B1, 1, 1); PG8_STAGE(PG8_SB(1, 0), b3, voffB);
            PG8_BAR; PG8_WAIT_L(0); PG8_MMA(0, 1, At, B1); PG8_BAR;
            PG8_LDA(At, 1, 1); PG8_STAGE(PG8_SA(1, 0), a3, voffA);
            PG8_BAR; PG8_WAIT_L(0); PG8_MMA(1, 0, At, B0); PG8_BAR; PG8_SCHED;
            PG8_STAGE(PG8_SB(1, 1), b3 + hstep, voffB);
            PG8_WAIT_V(6); PG8_BAR; PG8_MMA(1, 1, At, B1); PG8_BAR;
            }
        }
        if constexpr (ALIGN_EPI) { if (wr == 0) PG8_BAR; }
        if constexpr (!Epi::AFTER_DRAIN) { E(acc, cur, wr, wc, fr, fq); S.done(cur); }
        if (!has_next) break;
#pragma unroll
        for (int a = 0; a < 2; ++a)
#pragma unroll
            for (int b = 0; b < 2; ++b)
#pragma unroll
                for (int m = 0; m < 4; ++m)
#pragma unroll
                    for (int n = 0; n < 2; ++n) acc[a][b][m][n] = (f32x4){0.f, 0.f, 0.f, 0.f};
        cur = nxt; cA = nA; cB = nB; ++ui;
        if constexpr (ALIGN_EPI) { if (wr == 1) PG8_BAR; }
    }
    PG8_WAIT_V(0);
    if constexpr (!ALIGN_EPI) { if (wr == 0) PG8_BAR; }
    PG8_BAR;
    if constexpr (Epi::AFTER_DRAIN) { E.fused(acc, cur, wr, wc, fr, fq, lds, wid, lane); S.done(cur); }
#undef PG8_SA
#undef PG8_SB
#undef PG8_STAGE
#undef PG8_LDA
#undef PG8_LDB
#undef PG8_MMA
#undef PG8_WAIT_V
#undef PG8_WAIT_L
#undef PG8_BAR
#undef PG8_SCHED
}
}

namespace mk {
using pg8::bf16_t; using pg8::f32x4; using pg8::f32x2; using pg8::Unit; using pg8::cvt_pk_bf16; using pg8::gelu_pk;
typedef unsigned u32x2 __attribute__((ext_vector_type(2)));
typedef unsigned u32x4 __attribute__((ext_vector_type(4)));
#define LAS __attribute__((address_space(3)))

constexpr int MP = 16384, MS = 512, MT = MP + MS, DM = 1024, INW = 10240, FF = 4096, PLE = 256;
constexpr int ZLD = INW + 128;
constexpr int CQ = 0, CK = 1024, CV = 2048, CG = 4096, CU = 6144, CGV = 7168, CGA = 8192, CGB = 9216;
constexpr int NTAB = 2048 + 4;
constexpr float EPS = 1e-6f;
constexpr int NWAVES = 8, NTHR = 512;

constexpr size_t O_Y = 0;
constexpr size_t O_SRP = (size_t)MT * DM;
constexpr size_t O_SRS = O_SRP + (size_t)8 * 4 * 256 * 512;
constexpr size_t O_GMV = O_SRS + (size_t)128 * 4 * 256 * 512;
constexpr size_t O_END = O_GMV + (size_t)128 * 4 * 1024;

constexpr size_t al256(size_t x) { return (x + 255) & ~(size_t)255; }
constexpr size_t WS_CTL = 0, CTL_BYTES = 1u << 20;
constexpr size_t WS_LNS = WS_CTL + CTL_BYTES;
constexpr size_t WS_SSQO = WS_LNS + al256((size_t)MT * 2 * 4);
constexpr size_t WS_SSQ2 = WS_SSQO + al256((size_t)MT * 4 * 4);
constexpr size_t WS_SSQ3 = WS_SSQ2 + al256((size_t)MT * 4);
constexpr size_t WS_SSQ4 = WS_SSQ3 + al256((size_t)MT * 4);
constexpr size_t WS_ZERO_END = WS_SSQ4 + al256((size_t)MT * 4);
constexpr size_t WS_COS = al256(WS_ZERO_END);
constexpr size_t WS_SIN = WS_COS + al256((size_t)NTAB * 128 * 4);
constexpr size_t WS_WIN = WS_SIN + al256((size_t)NTAB * 128 * 4);
constexpr size_t WS_WBRA = WS_WIN + (size_t)INW * DM * 2;
constexpr size_t WS_WBRB = WS_WBRA + (size_t)DM * 2048 * 2;
constexpr size_t WS_WO = WS_WBRB + (size_t)DM * DM * 2;
constexpr size_t WS_WUP = WS_WO + (size_t)DM * DM * 2;
constexpr size_t WS_WDN = WS_WUP + (size_t)FF * DM * 2;
constexpr size_t WS_WPG = WS_WDN + (size_t)DM * FF * 2;
constexpr size_t WS_WPP = WS_WPG + (size_t)DM * DM * 2;
constexpr size_t WS_WSB = WS_WPP + (size_t)DM * PLE * 2;
constexpr size_t WS_XN = WS_WSB + (size_t)8 * 128 * 128 * 2;
constexpr size_t WS_PB = WS_XN + (size_t)MT * DM * 2;
constexpr size_t WS_A = WS_PB + (size_t)MT * PLE * 2;
constexpr size_t WS_Z = WS_A;
constexpr size_t WS_U = WS_A;
constexpr size_t WS_H2 = WS_U + (size_t)MT * FF * 2;
constexpr size_t WS_H2B = WS_H2 + (size_t)MT * DM * 4;
constexpr size_t WS_PE = WS_H2B + (size_t)MT * DM * 2;
constexpr size_t WS_A_END = WS_A + (size_t)MT * ZLD * 2;
static_assert(WS_PE + (size_t)MT * DM * 4 <= WS_A_END, "region A overlay");
constexpr size_t WS_ORAW = WS_A_END;
constexpr size_t WS_H3 = WS_ORAW;
constexpr size_t WS_YA = WS_ORAW + (size_t)MT * 2048 * 2;
constexpr size_t WS_YB = WS_YA + (size_t)MT * 2048 * 2;
constexpr size_t WS_T = WS_YB + (size_t)MT * DM * 2;
constexpr size_t WS_MG = WS_T + (size_t)MT * DM * 4;
constexpr size_t WS_H1 = WS_MG + (size_t)MT * DM * 2;
constexpr size_t WS_H1B = WS_H1 + (size_t)MT * DM * 4;
constexpr size_t WS_END = WS_H1B + (size_t)MT * DM * 2;

constexpr int LDS_RING = 131072, LDS_BYTES = 163840, LDS_MISC = LDS_BYTES - 256;

struct Args {
    const float* in[21]; float* out; unsigned char* ws; int ph_lo, ph_hi;
};

__device__ __forceinline__ float bf2f(unsigned short u) { return __uint_as_float((unsigned)u << 16); }
__device__ __forceinline__ unsigned f2bf(float f) { unsigned u = __float_as_uint(f); return (u + 0x7fffu + ((u >> 16) & 1u)) >> 16; }
__device__ __forceinline__ unsigned pk2(float lo, float hi) { return f2bf(lo) | (f2bf(hi) << 16); }
__device__ __forceinline__ f32x4 ld_bf4(const bf16_t* p) { const u32x2 w = *(const u32x2*)p; return (f32x4){__uint_as_float(w.x << 16), __uint_as_float(w.x & 0xffff0000u), __uint_as_float(w.y << 16), __uint_as_float(w.y & 0xffff0000u)}; }
typedef float f32x2_t __attribute__((ext_vector_type(2))); typedef __bf16 bf16x2_t __attribute__((ext_vector_type(2)));
__device__ __forceinline__ unsigned cvtpk(float lo, float hi) { const f32x2_t v = {lo, hi}; const bf16x2_t b = __builtin_convertvector(v, bf16x2_t); return __builtin_bit_cast(unsigned, b); }
__device__ __forceinline__ void st_bf4(bf16_t* p, f32x4 v) { u32x2 w; w.x = cvtpk(v[0], v[1]); w.y = cvtpk(v[2], v[3]); *(u32x2*)p = w; }
__device__ __forceinline__ void ld_bf8(const bf16_t* p, f32x4& a, f32x4& b) { const u32x4 w = *(const u32x4*)p;
    a = (f32x4){__uint_as_float(w.x << 16), __uint_as_float(w.x & 0xffff0000u), __uint_as_float(w.y << 16), __uint_as_float(w.y & 0xffff0000u)};
    b = (f32x4){__uint_as_float(w.z << 16), __uint_as_float(w.z & 0xffff0000u), __uint_as_float(w.w << 16), __uint_as_float(w.w & 0xffff0000u)}; }
__device__ __forceinline__ void st_bf8(bf16_t* p, f32x4 a, f32x4 b) { u32x4 w; w.x = cvtpk(a[0], a[1]); w.y = cvtpk(a[2], a[3]); w.z = cvtpk(b[0], b[1]); w.w = cvtpk(b[2], b[3]); *(u32x4*)p = w; }
__device__ __forceinline__ float sigmoidf_(float x) { return __builtin_amdgcn_rcpf(1.0f + __builtin_amdgcn_exp2f(-1.4426950408889634f * x)); }
__device__ __forceinline__ f32x4 sigmoid4(f32x4 v) { return (f32x4){sigmoidf_(v[0]), sigmoidf_(v[1]), sigmoidf_(v[2]), sigmoidf_(v[3])}; }
__device__ __forceinline__ f32x4 silu4(f32x4 v) { return v * sigmoid4(v); }
__device__ __forceinline__ f32x4 gelu4(f32x4 v) { const f32x2 a = gelu_pk((f32x2){v[0], v[1]}), b = gelu_pk((f32x2){v[2], v[3]}); return (f32x4){a.x, a.y, b.x, b.y}; }
__device__ __forceinline__ float sum4(f32x4 v) { return (v[0] + v[1]) + (v[2] + v[3]); }
__device__ __forceinline__ float wave_sum(float v) {
#pragma unroll
    for (int o = 1; o < 64; o <<= 1) v += __shfl_xor(v, o);
    return v;
}
__device__ __forceinline__ int tab_index(int row) { return row < MP ? (row & 2047) : 2048 + (row & 3); }

template <class F> struct EpiGen {
    static constexpr bool PERM = true, AFTER_DRAIN = false, HOOK = F::HOOK;
    F f;
    __device__ __forceinline__ void khook(f32x4 (&acc)[2][2][4][2], const Unit& u, int t, int wr, int wc, int fr, int fq) const { f.khook(acc, u.pm * 256 + wr * 64 + fr, t); }
    template <int KIND> __device__ __forceinline__ void run(const f32x4 (&acc)[2][2][4][2], int row0, int col0, int fq) const {
#pragma unroll
        for (int ai = 0; ai < 2; ++ai)
#pragma unroll
            for (int m = 0; m < 4; ++m) {
                const int row = row0 + ai * 128 + m * 16;
                float red[2] = {0.f, 0.f};
                const typename F::RowCtx rc = f.template row_begin<KIND>(row);
                f.template oct<KIND>(rc, row, col0, acc[ai][0][m][0], acc[ai][0][m][1], col0 + 128, acc[ai][1][m][0], acc[ai][1][m][1], red);
                if (F::template nred<KIND>() > 0) {
                    red[0] += __shfl_xor(red[0], 16); red[0] += __shfl_xor(red[0], 32);
                    if (F::template nred<KIND>() > 1) { red[1] += __shfl_xor(red[1], 16); red[1] += __shfl_xor(red[1], 32); }
                    if (fq == 0) f.template row_add<KIND>(row, red);
                }
                asm volatile("" ::: "memory");
            }
    }
    __device__ __forceinline__ void operator()(const f32x4 (&acc)[2][2][4][2], const Unit& u, int wr, int wc, int fr, int fq) const {
        const int row0 = u.pm * 256 + wr * 64 + fr, col0 = u.pn * 256 + wc * 32 + 8 * fq;
        const int kind = f.kind(u.pn * 256);
        if (F::NK == 1) { run<0>(acc, row0, col0, fq); return; }
        switch (kind) {
            case 0: run<0>(acc, row0, col0, fq); break;
            case 1: run<(F::NK > 1 ? 1 : 0)>(acc, row0, col0, fq); break;
            case 2: run<(F::NK > 2 ? 2 : 0)>(acc, row0, col0, fq); break;
            case 3: run<(F::NK > 3 ? 3 : 0)>(acc, row0, col0, fq); break;
            case 4: run<(F::NK > 4 ? 4 : 0)>(acc, row0, col0, fq); break;
            default: run<(F::NK > 5 ? 5 : 0)>(acc, row0, col0, fq); break;
        }
    }
};
#define F_NOHOOK static constexpr bool HOOK = false; __device__ __forceinline__ void khook(f32x4 (&)[2][2][4][2], int, int) const {}
#define F_COMMON1 static constexpr int NK = 1; __device__ __forceinline__ int kind(int) const { return 0; }

struct F1 {
    F_NOHOOK static constexpr int NK = 6; typedef int RowCtx;
    bf16_t* Z; const float* cosT; const float* sinT; float* LNS;
    __device__ __forceinline__ int kind(int cb) const { return cb < CV ? 0 : cb < CG ? 1 : cb < CU ? 2 : cb < CGV ? 3 : cb < CGA ? 4 : 5; }
    template <int K> static __device__ __forceinline__ constexpr int nred() { return K == 4 ? 2 : 0; }
    template <int K> __device__ __forceinline__ RowCtx row_begin(int row) const { return K == 0 ? tab_index(row) * 128 : 0; }
    template <int K> __device__ __forceinline__ void oct(RowCtx rc, int row, int c0, f32x4 a0, f32x4 a1, int c1, f32x4 b0, f32x4 b1, float (&red)[2]) const {
        bf16_t* zr = Z + (size_t)row * ZLD;
        if (K == 0) { const int i0 = c0 & 255; const f32x4 cs0 = *(const f32x4*)(cosT + rc + i0), cs1 = *(const f32x4*)(cosT + rc + i0 + 4), sn0 = *(const f32x4*)(sinT + rc + i0), sn1 = *(const f32x4*)(sinT + rc + i0 + 4);
            st_bf8(zr + c0, a0 * cs0 - b0 * sn0, a1 * cs1 - b1 * sn1); st_bf8(zr + c1, b0 * cs0 + a0 * sn0, b1 * cs1 + a1 * sn1); }
        else if (K == 1) { st_bf8(zr + c0, a0, a1); st_bf8(zr + c1, b0, b1); }
        else if (K == 2 || K == 3) { st_bf8(zr + c0, a0, a1); st_bf8(zr + c1, b0, b1); }
        else if (K == 4) { const f32x4 g0 = gelu4(a0), g1 = gelu4(a1), g2 = gelu4(b0), g3 = gelu4(b1); st_bf8(zr + c0, g0, g1); st_bf8(zr + c1, g2, g3);
            red[0] += (sum4(g0) + sum4(g1)) + (sum4(g2) + sum4(g3)); red[1] += (sum4(g0 * g0) + sum4(g1 * g1)) + (sum4(g2 * g2) + sum4(g3 * g3)); }
        else { st_bf8(zr + c0, sigmoid4(a0), sigmoid4(a1)); st_bf8(zr + c1, sigmoid4(b0), sigmoid4(b1)); }
    }
    template <int K> __device__ __forceinline__ void row_add(int row, const float (&red)[2]) const { atomicAdd(LNS + 2 * row, red[0]); atomicAdd(LNS + 2 * row + 1, red[1]); }
};
struct F2a {
    static constexpr bool HOOK = true; F_COMMON1 typedef float RowCtx;
    const bf16_t* Z; bf16_t* T; const float* SSQO;
    __device__ __forceinline__ void khook(f32x4 (&acc)[2][2][4][2], int row0, int t) const {
        int h = t >> 3; asm volatile("" : "+s"(h));
        if (h == 0) return;
        const float* p = SSQO + (size_t)row0 * 4 + (h - 1);
        float s0[8], s1[8];
#pragma unroll
        for (int g = 0; g < 8; ++g) { s0[g] = p[((g >> 2) * 128 + (g & 3) * 16) * 4]; s1[g] = p[((g >> 2) * 128 + (g & 3) * 16) * 4 + 1]; }
#pragma unroll
        for (int g = 0; g < 8; ++g) { const float ratio = sqrtf((s1[g] * (1.f / 512.f) + EPS) / (s0[g] * (1.f / 512.f) + EPS));
#pragma unroll
            for (int bj = 0; bj < 2; ++bj)
#pragma unroll
                for (int n = 0; n < 2; ++n) acc[g >> 2][bj][g & 3][n] = acc[g >> 2][bj][g & 3][n] * ratio; }
    }
    template <int K> static __device__ __forceinline__ constexpr int nred() { return 0; }
    template <int K> __device__ __forceinline__ RowCtx row_begin(int row) const { return row < MP ? rsqrtf(SSQO[row * 4 + 3] * (1.f / 512.f) + EPS) : 1.0f; }
    template <int K> __device__ __forceinline__ void oct(RowCtx rs, int row, int c0, f32x4 a0, f32x4 a1, int c1, f32x4 b0, f32x4 b1, float (&)[2]) const {
        const bf16_t* g = Z + (size_t)row * ZLD + CGA; bf16_t* t = T + (size_t)row * DM; f32x4 g0, g1;
        ld_bf8(g + c0, g0, g1); st_bf8(t + c0, g0 * a0 * rs, g1 * a1 * rs); ld_bf8(g + c1, g0, g1); st_bf8(t + c1, g0 * b0 * rs, g1 * b1 * rs);
    }
    template <int K> __device__ __forceinline__ void row_add(int, const float (&)[2]) const {}
};
struct F2b {
    F_NOHOOK F_COMMON1 typedef int RowCtx;
    const bf16_t* Z; const bf16_t* T; bf16_t* MG;
    template <int K> static __device__ __forceinline__ constexpr int nred() { return 0; }
    template <int K> __device__ __forceinline__ RowCtx row_begin(int) const { return 0; }
    template <int K> __device__ __forceinline__ void oct(RowCtx, int row, int c0, f32x4 a0, f32x4 a1, int c1, f32x4 b0, f32x4 b1, float (&)[2]) const {
        const bf16_t* g = Z + (size_t)row * ZLD + CGB; const bf16_t* t = T + (size_t)row * DM; bf16_t* o = MG + (size_t)row * DM; f32x4 g0, g1, t0, t1;
        ld_bf8(g + c0, g0, g1); ld_bf8(t + c0, t0, t1); st_bf8(o + c0, t0 + g0 * a0, t1 + g1 * a1);
        ld_bf8(g + c1, g0, g1); ld_bf8(t + c1, t0, t1); st_bf8(o + c1, t0 + g0 * b0, t1 + g1 * b1);
    }
    template <int K> __device__ __forceinline__ void row_add(int, const float (&)[2]) const {}
};
template <bool BF> struct FRes {
    F_NOHOOK F_COMMON1 typedef size_t RowCtx;
    const float* baseP; const float* baseS; const bf16_t* baseB; bf16_t* HB; float* SSQ;
    template <int K> static __device__ __forceinline__ constexpr int nred() { return 1; }
    template <int K> __device__ __forceinline__ RowCtx row_begin(int row) const { return (size_t)row * DM; }
    template <int K> __device__ __forceinline__ void oct(RowCtx ro, int row, int c0, f32x4 a0, f32x4 a1, int c1, f32x4 b0, f32x4 b1, float (&red)[2]) const {
        f32x4 x0, x1, x2, x3;
        if (BF) { ld_bf8(baseB + ro + c0, x0, x1); ld_bf8(baseB + ro + c1, x2, x3); }
        else { const float* xr = row < MP ? baseP + ro : baseS + (ro - (size_t)MP * DM); x0 = *(const f32x4*)(xr + c0); x1 = *(const f32x4*)(xr + c0 + 4); x2 = *(const f32x4*)(xr + c1); x3 = *(const f32x4*)(xr + c1 + 4); }
        const f32x4 h0 = x0 + a0, h1 = x1 + a1, h2 = x2 + b0, h3 = x3 + b1;
        st_bf8(HB + ro + c0, h0, h1); st_bf8(HB + ro + c1, h2, h3);
        red[0] += (sum4(h0 * h0) + sum4(h1 * h1)) + (sum4(h2 * h2) + sum4(h3 * h3));
    }
    template <int K> __device__ __forceinline__ void row_add(int row, const float (&red)[2]) const { atomicAdd(SSQ + row, red[0]); }
};
struct F4 {
    F_NOHOOK F_COMMON1 typedef float RowCtx;
    const float* SSQ; bf16_t* U;
    template <int K> static __device__ __forceinline__ constexpr int nred() { return 0; }
    template <int K> __device__ __forceinline__ RowCtx row_begin(int row) const { return rsqrtf(SSQ[row] * (1.0f / DM) + EPS); }
    template <int K> __device__ __forceinline__ void oct(RowCtx rs, int row, int c0, f32x4 a0, f32x4 a1, int c1, f32x4 b0, f32x4 b1, float (&)[2]) const {
        bf16_t* u = U + (size_t)row * FF; const f32x4 z = (f32x4){0.f, 0.f, 0.f, 0.f};
        a0 = __builtin_elementwise_max(a0 * rs, z); a1 = __builtin_elementwise_max(a1 * rs, z); b0 = __builtin_elementwise_max(b0 * rs, z); b1 = __builtin_elementwise_max(b1 * rs, z);
        st_bf8(u + c0, a0 * a0, a1 * a1); st_bf8(u + c1, b0 * b0, b1 * b1);
    }
    template <int K> __device__ __forceinline__ void row_add(int, const float (&)[2]) const {}
};
struct F6a {
    F_NOHOOK F_COMMON1 typedef int RowCtx;
    bf16_t* PE;
    template <int K> static __device__ __forceinline__ constexpr int nred() { return 0; }
    template <int K> __device__ __forceinline__ RowCtx row_begin(int) const { return 0; }
    template <int K> __device__ __forceinline__ void oct(RowCtx, int row, int c0, f32x4 a0, f32x4 a1, int c1, f32x4 b0, f32x4 b1, float (&)[2]) const {
        bf16_t* p = PE + (size_t)row * DM; st_bf8(p + c0, a0, a1); st_bf8(p + c1, b0, b1);
    }
    template <int K> __device__ __forceinline__ void row_add(int, const float (&)[2]) const {}
};
struct F6b {
    F_NOHOOK F_COMMON1 typedef float RowCtx;
    const float* SSQ3; const bf16_t* H2; const bf16_t* PE; bf16_t* H3; float* SSQ4;
    template <int K> static __device__ __forceinline__ constexpr int nred() { return 1; }
    template <int K> __device__ __forceinline__ RowCtx row_begin(int row) const { return rsqrtf(SSQ3[row] * (1.0f / DM) + EPS); }
    template <int K> __device__ __forceinline__ void oct(RowCtx rs, int row, int c0, f32x4 a0, f32x4 a1, int c1, f32x4 b0, f32x4 b1, float (&red)[2]) const {
        const size_t o = (size_t)row * DM; f32x4 h0, h1, p0, p1;
        ld_bf8(H2 + o + c0, h0, h1); ld_bf8(PE + o + c0, p0, p1); h0 = h0 + sigmoid4(a0 * rs) * p0; h1 = h1 + sigmoid4(a1 * rs) * p1; st_bf8(H3 + o + c0, h0, h1);
        float s = sum4(h0 * h0) + sum4(h1 * h1);
        ld_bf8(H2 + o + c1, h0, h1); ld_bf8(PE + o + c1, p0, p1); h0 = h0 + sigmoid4(b0 * rs) * p0; h1 = h1 + sigmoid4(b1 * rs) * p1; st_bf8(H3 + o + c1, h0, h1);
        red[0] += s + sum4(h0 * h0) + sum4(h1 * h1);
    }
    template <int K> __device__ __forceinline__ void row_add(int row, const float (&red)[2]) const { atomicAdd(SSQ4 + row, red[0]); }
};
#define XB_TMO      128
#define XB_XCNT(j)  (256  + 64 * (j))
#define XB_XSUB(j)  (1280 + 64 * (j))
#define XB_XGEN(j)  (2304 + 64 * (j))
#define XB_TOP      3328
#define XB_TOPGEN   3392
#define XCD_BAR_WORDS 3456
#define XB_SPIN_CAP (1u << 21)

__device__ __forceinline__ unsigned xb_ld(unsigned* p)              { return __hip_atomic_load(p, __ATOMIC_RELAXED, __HIP_MEMORY_SCOPE_AGENT); }
__device__ __forceinline__ unsigned xb_add(unsigned* p, unsigned v) { return __hip_atomic_fetch_add(p, v, __ATOMIC_RELAXED, __HIP_MEMORY_SCOPE_AGENT); }
__device__ __forceinline__ unsigned xb_xcc_id() { return (unsigned)__builtin_amdgcn_s_getreg((3 << 11) | 20) & 0xFu; }
#define XB_SPIN(cond, bar) do { unsigned _sp = 0; while (cond) { __builtin_amdgcn_s_sleep(1); \
    if ((++_sp & 255u) == 0u) { if (xb_ld(&(bar)[XB_TMO])) break; if (_sp > XB_SPIN_CAP) { atomicAdd(&(bar)[XB_TMO], 1u); break; } } } } while (0)

struct XcdBarrier {
    unsigned* bar; unsigned x;
    volatile LAS unsigned* st;
};

__device__ __forceinline__ XcdBarrier xcd_barrier_post(unsigned* bar, volatile LAS unsigned* st) {
    XcdBarrier b; b.bar = bar; b.x = xb_xcc_id(); b.st = st;
    if (threadIdx.x == 0) (void)xb_add(&bar[XB_XCNT(b.x)], 1u);
    return b;
}
__device__ __forceinline__ void xcd_barrier_complete(unsigned* bar, unsigned x, unsigned& nloc, unsigned& nx) {
    const unsigned G = gridDim.x * gridDim.y * gridDim.z;
    unsigned sum, cnt, mine, sp = 0u;
    for (;;) {
        sum = 0u; cnt = 0u; mine = 0u;
#pragma unroll
        for (unsigned j = 0; j < 16; ++j) { const unsigned c = xb_ld(&bar[XB_XCNT(j)]); sum += c; cnt += (c > 0u) ? 1u : 0u; mine = (j == x) ? c : mine; }
        if (sum == G) break;
        __builtin_amdgcn_s_sleep(1);
        if ((++sp & 255u) == 0u) { if (xb_ld(&bar[XB_TMO])) break; if (sp > XB_SPIN_CAP) { atomicAdd(&bar[XB_TMO], 1u); break; } }
    }
    nloc = mine > 0u ? mine : 1u; nx = cnt > 0u ? cnt : 1u;
}

__device__ __forceinline__ void xcd_barrier(const XcdBarrier& b) {
    asm volatile("s_waitcnt vmcnt(0)" ::: "memory");
    __syncthreads();
    if (threadIdx.x == 0) {
        unsigned* bar = b.bar;
        __builtin_amdgcn_s_waitcnt(0);
        unsigned nloc = b.st[0], nx = b.st[1];
        if (nloc == 0u) { xcd_barrier_complete(bar, b.x, nloc, nx); b.st[0] = nloc; b.st[1] = nx; }
        const unsigned old = xb_add(&bar[XB_XSUB(b.x)], 1u);
        const unsigned gen = old / nloc;
        if (old + 1u == (gen + 1u) * nloc) {
            __builtin_amdgcn_fence(__ATOMIC_RELEASE, "agent");
            asm volatile("s_waitcnt vmcnt(0)" ::: "memory");
            const unsigned og = xb_add(&bar[XB_TOP], 1u);
            const unsigned tg = og / nx;
            if (og + 1u == (tg + 1u) * nx) xb_add(&bar[XB_TOPGEN], 1u);
            else XB_SPIN(xb_ld(&bar[XB_TOPGEN]) == tg, bar);
            __builtin_amdgcn_fence(__ATOMIC_ACQUIRE, "agent");
            xb_add(&bar[XB_XGEN(b.x)], 1u);
            asm volatile("s_waitcnt vmcnt(0)" ::: "memory");
        } else {
            XB_SPIN(xb_ld(&bar[XB_XGEN(b.x)]) == gen, bar);
            __builtin_amdgcn_fence(__ATOMIC_ACQUIRE, "agent");
            asm volatile("s_waitcnt vmcnt(0)" ::: "memory");
        }
    }
    __syncthreads();
}

struct Ctx {
    LAS unsigned char* lds; int tid, lane, wave, vcu, G;
    const float* const* in; float* out; unsigned char* ws;
    template <class T> __device__ __forceinline__ T* w(size_t off) const { return (T*)(ws + off); }
};
enum { I_XP = 0, I_XS, I_PP, I_PS, I_ST, I_GMIX, I_WIN, I_GRET, I_WS, I_BS, I_GGM, I_WBRA, I_WBRB, I_WO, I_GMLP, I_WUP, I_WDN, I_GPLE, I_WPG, I_WPP, I_GFIN };

__device__ __forceinline__ void p0_transpose_item(const float* W, int K, int N, bf16_t* WT, LAS float* scr, int item, int lane, const float* rowg, int cs_lo, int cs_hi, float cs) {
    const int nblk = N / 32, kb = item / nblk, nb = item % nblk, k0 = 64 * kb, n0 = 32 * nb;
    { const int kr = lane >> 3, n4 = (lane & 7) * 4;
#pragma unroll
      for (int i = 0; i < 8; ++i) { const int kk = 8 * i + kr; f32x4 wv = *(const f32x4*)(W + (size_t)(k0 + kk) * N + n0 + n4); if (rowg) wv = wv * rowg[k0 + kk];
          scr[kk * 33 + n4] = wv[0]; scr[kk * 33 + n4 + 1] = wv[1]; scr[kk * 33 + n4 + 2] = wv[2]; scr[kk * 33 + n4 + 3] = wv[3]; } }
    asm volatile("s_waitcnt lgkmcnt(0)" ::: "memory");
    const int c = lane & 7;
#pragma unroll
    for (int j = 0; j < 4; ++j) { const int n = (lane >> 3) + 8 * j; const LAS float* s = scr + (8 * c) * 33 + n; const float sc = (n0 + n >= cs_lo && n0 + n < cs_hi) ? cs : 1.0f;
        u32x4 o; o.x = pk2(s[0 * 33] * sc, s[1 * 33] * sc); o.y = pk2(s[2 * 33] * sc, s[3 * 33] * sc); o.z = pk2(s[4 * 33] * sc, s[5 * 33] * sc); o.w = pk2(s[6 * 33] * sc, s[7 * 33] * sc);
        *(u32x4*)(WT + (size_t)(n0 + n) * K + k0 + 8 * c) = o; }
    asm volatile("s_waitcnt lgkmcnt(0)" ::: "memory");
}
__device__ __forceinline__ double sin_poly(double x) {
    const double x2 = x * x; double r = -1.0 / 8841761993739701954543616000000.0;
    r = r * x2 + 1.0 / 10888869450418352160768000000.0;
    r = r * x2 - 1.0 / 15511210043330985984000000.0;
    r = r * x2 + 1.0 / 25852016738884976640000.0;
    r = r * x2 - 1.0 / 51090942171709440000.0;
    r = r * x2 + 1.0 / 121645100408832000.0;
    r = r * x2 - 1.0 / 355687428096000.0;
    r = r * x2 + 1.0 / 1307674368000.0;
    r = r * x2 - 1.0 / 6227020800.0;
    r = r * x2 + 1.0 / 39916800.0;
    r = r * x2 - 1.0 / 362880.0;
    r = r * x2 + 1.0 / 5040.0;
    r = r * x2 - 1.0 / 120.0;
    r = r * x2 + 1.0 / 6.0;
    r = r * x2 - 1.0;
    return -r * x;
}
__device__ __forceinline__ double cos_poly(double x) {
    const double x2 = x * x; double r = -1.0 / 265252859812191058636308480000000.0;
    r = r * x2 + 1.0 / 304888344611713860501504000000.0;
    r = r * x2 - 1.0 / 403291461126605635584000000.0;
    r = r * x2 + 1.0 / 620448401733239439360000.0;
    r = r * x2 - 1.0 / 1124000727777607680000.0;
    r = r * x2 + 1.0 / 2432902008176640000.0;
    r = r * x2 - 1.0 / 6402373705728000.0;
    r = r * x2 + 1.0 / 20922789888000.0;
    r = r * x2 - 1.0 / 87178291200.0;
    r = r * x2 + 1.0 / 479001600.0;
    r = r * x2 - 1.0 / 3628800.0;
    r = r * x2 + 1.0 / 40320.0;
    r = r * x2 - 1.0 / 720.0;
    r = r * x2 + 1.0 / 24.0;
    r = r * x2 - 0.5;
    r = r * x2 + 1.0;
    return r;
}
__device__ __forceinline__ void p0_prologue(const Ctx& C) {
    LAS float* scr = (LAS float*)(C.lds + C.wave * 16384);
    const int gw = C.vcu * NWAVES + C.wave, NGW = C.G * NWAVES, lane = C.lane;
    constexpr int I_IN = (DM / 64) * (INW / 32);
    for (int it = gw; it < I_IN; it += NGW) p0_transpose_item(C.in[I_WIN], DM, INW, C.w<bf16_t>(WS_WIN), scr, it, lane, nullptr, CK, CV, 0.0625f);
    const float* gm = C.in[I_GMIX];
    f32x4 gv[4];
#pragma unroll
    for (int j = 0; j < 4; ++j) gv[j] = ((const f32x4*)gm)[lane + 64 * j];
    bf16_t* XN = C.w<bf16_t>(WS_XN);
    for (int m0 = gw; m0 < MT; m0 += 2 * NGW) {
        f32x4 v[2][4];
#pragma unroll
        for (int r = 0; r < 2; ++r) { const int m = m0 + r * NGW; if (m < MT) { const f32x4* xr = (const f32x4*)(m < MP ? C.in[I_XP] + (size_t)m * DM : C.in[I_XS] + (size_t)(m - MP) * DM) + lane;
#pragma unroll
            for (int j = 0; j < 4; ++j) v[r][j] = xr[64 * j]; } }
#pragma unroll
        for (int r = 0; r < 2; ++r) { const int m = m0 + r * NGW; if (m < MT) { float s = 0.f;
#pragma unroll
            for (int j = 0; j < 4; ++j) s += sum4(v[r][j] * v[r][j]);
            const float rstd = rsqrtf(wave_sum(s) * (1.f / DM) + EPS);
            u32x2* o8 = (u32x2*)(XN + (size_t)m * DM) + lane;
#pragma unroll
            for (int j = 0; j < 4; ++j) { const f32x4 y = v[r][j] * rstd * gv[j]; u32x2 w; w.x = pk2(y[0], y[1]); w.y = pk2(y[2], y[3]); o8[64 * j] = w; } } }
    }
    float* cosT = C.w<float>(WS_COS); float* sinT = C.w<float>(WS_SIN);
    for (int e = (C.vcu * NTHR + C.tid); e < NTAB * 128; e += C.G * NTHR) {
        const int ti = e >> 7, i = e & 127; const float pos = ti < 2048 ? (float)ti : (float)(16384 + ti - 2048);
        const float inv = (float)exp2(-(double)i * (13.287712379549449 / 128.0));
        const float ang = pos * inv;
        const double x = (double)ang; const double k = __builtin_rint(x * 0.15915494309189535);
        double r = __builtin_fma(-k, 6.283185307179586, x); r = __builtin_fma(-k, 2.4492935982947064e-16, r);
        cosT[e] = (float)cos_poly(r); sinT[e] = (float)sin_poly(r);
    }
}
__device__ __forceinline__ void p0_deferred(const Ctx& C, int sub, int nsub) {
    LAS float* scr = (LAS float*)(C.lds + C.wave * 16384);
    const int gw = sub * NWAVES + C.wave, NGW = nsub * NWAVES, lane = C.lane;
    constexpr int I_BRA = (2048 / 64) * (DM / 32), I_SQ = (DM / 64) * (DM / 32), I_UP = (DM / 64) * (FF / 32), I_DN = (FF / 64) * (DM / 32), I_PPI = (PLE / 64) * (DM / 32);
    constexpr int NITEMS = I_BRA + 3 * I_SQ + I_UP + I_DN + I_PPI;
    for (int it = gw; it < NITEMS; it += NGW) {
        int r = it;
        if (r < I_BRA) { p0_transpose_item(C.in[I_WBRA], 2048, DM, C.w<bf16_t>(WS_WBRA), scr, r, lane, nullptr, 0, 0, 1.f); continue; } r -= I_BRA;
        if (r < I_SQ) { p0_transpose_item(C.in[I_WBRB], DM, DM, C.w<bf16_t>(WS_WBRB), scr, r, lane, nullptr, 0, 0, 1.f); continue; } r -= I_SQ;
        if (r < I_SQ) { p0_transpose_item(C.in[I_WO], DM, DM, C.w<bf16_t>(WS_WO), scr, r, lane, nullptr, 0, 0, 1.f); continue; } r -= I_SQ;
        if (r < I_SQ) { p0_transpose_item(C.in[I_WPG], DM, DM, C.w<bf16_t>(WS_WPG), scr, r, lane, C.in[I_GPLE], 0, 0, 1.f); continue; } r -= I_SQ;
        if (r < I_UP) { p0_transpose_item(C.in[I_WUP], DM, FF, C.w<bf16_t>(WS_WUP), scr, r, lane, C.in[I_GMLP], 0, 0, 1.f); continue; } r -= I_UP;
        if (r < I_DN) { p0_transpose_item(C.in[I_WDN], FF, DM, C.w<bf16_t>(WS_WDN), scr, r, lane, nullptr, 0, 0, 1.f); continue; } r -= I_DN;
        p0_transpose_item(C.in[I_WPP], PLE, DM, C.w<bf16_t>(WS_WPP), scr, r, lane, nullptr, 0, 0, 1.f);
    }
    bf16_t* PB = C.w<bf16_t>(WS_PB);
    for (int m = gw; m < MT; m += NGW) {
        const float* prow = m < MP ? C.in[I_PP] + (size_t)m * PLE : C.in[I_PS] + (size_t)(m - MP) * PLE;
        const f32x4 pv = ((const f32x4*)prow)[lane]; u32x2 pw; pw.x = pk2(pv[0], pv[1]); pw.y = pk2(pv[2], pv[3]);
        ((u32x2*)(PB + (size_t)m * PLE))[lane] = pw;
    }
    { const float* w_s = C.in[I_WS]; bf16_t* WSB = C.w<bf16_t>(WS_WSB);
      for (int e = (sub * NTHR + C.tid); e < 8 * 128 * 128; e += nsub * NTHR) { const int n = (e >> 7) & 127, m = e & 127; WSB[e] = (bf16_t)f2bf(m <= n ? w_s[e] : 0.f); } }
}

template <class F> __device__ __forceinline__ void run_gemm(const Ctx& C, const bf16_t* A, const bf16_t* Bt, int M, int N, int K, const F& f) {
    asm volatile("" : "+s"(K));
    pg8::Gemm g{A, Bt, M, N, K}; pg8::StaticOrder S; S.init(M, N, C.G, (int)blockIdx.x);
    EpiGen<F> E{f};
    pg8::gemm_phase<EpiGen<F>, pg8::StaticOrder, true, true>((PG8_LAS unsigned char*)C.lds, g, S, E);
}

typedef short sbf16x8 __attribute__((ext_vector_type(8)));
typedef float sf32x16 __attribute__((ext_vector_type(16)));
template <class F, int KIND> __device__ __forceinline__ void small_epi(const F& f, int grow, int cA, int cB, f32x4 va0, f32x4 va1, f32x4 vb0, f32x4 vb1, int q) {
    float red[2] = {0.f, 0.f};
    const typename F::RowCtx rc = f.template row_begin<KIND>(grow);
    f.template oct<KIND>(rc, grow, cA, va0, va1, cB, vb0, vb1, red);
    if (F::template nred<KIND>() > 0) {
        red[0] += __shfl_xor(red[0], 1); red[0] += __shfl_xor(red[0], 2);
        if (F::template nred<KIND>() > 1) { red[1] += __shfl_xor(red[1], 1); red[1] += __shfl_xor(red[1], 2); }
        if (q == 0) f.template row_add<KIND>(grow, red);
    }
}
template <class F> __device__ __forceinline__ void small_gemm(const Ctx& C, const bf16_t* A, const bf16_t* Bt, int N, int K, const F& f, bool rot) {
    asm volatile("" : "+s"(K));
    const int ntile = 16 * (N / 64), Kw = K / 8;
    const int wave = C.wave, l31 = C.lane & 31, hh = C.lane >> 5, tid = C.tid;
    LAS float* red = (LAS float*)C.lds;
    for (int t = C.vcu; t < ntile; t += C.G) {
        const int rt = t & 15, ct = t >> 4;
        int cA = ct * 64, cB = cA + 32;
        if (rot && cA < CV) { cA = (ct >> 2) * 256 + (ct & 3) * 32; cB = cA + 128; }
        const int r0 = MP + 32 * rt;
        const bf16_t* pa = A + (size_t)(r0 + l31) * K + wave * Kw + 8 * hh;
        const bf16_t* pb0 = Bt + (size_t)(cA + l31) * K + wave * Kw + 8 * hh;
        const bf16_t* pb1 = Bt + (size_t)(cB + l31) * K + wave * Kw + 8 * hh;
        sf32x16 a0, a1;
#pragma unroll
        for (int i = 0; i < 16; ++i) { a0[i] = 0.f; a1[i] = 0.f; }
#pragma unroll 4
        for (int k = 0; k < Kw; k += 32) {
            const sbf16x8 fa0 = *(const sbf16x8*)(pa + k), fa1 = *(const sbf16x8*)(pa + k + 16);
            const sbf16x8 fb00 = *(const sbf16x8*)(pb0 + k), fb01 = *(const sbf16x8*)(pb0 + k + 16);
            const sbf16x8 fb10 = *(const sbf16x8*)(pb1 + k), fb11 = *(const sbf16x8*)(pb1 + k + 16);
            a0 = __builtin_amdgcn_mfma_f32_32x32x16_bf16(fa0, fb00, a0, 0, 0, 0); a1 = __builtin_amdgcn_mfma_f32_32x32x16_bf16(fa0, fb10, a1, 0, 0, 0);
            a0 = __builtin_amdgcn_mfma_f32_32x32x16_bf16(fa1, fb01, a0, 0, 0, 0); a1 = __builtin_amdgcn_mfma_f32_32x32x16_bf16(fa1, fb11, a1, 0, 0, 0);
        }
        __syncthreads();
#pragma unroll
        for (int i = 0; i < 16; ++i) { const int r = (i & 3) + 8 * (i >> 2) + 4 * hh; red[(wave * 32 + r) * 68 + l31] = a0[i]; red[(wave * 32 + r) * 68 + 32 + l31] = a1[i]; }
        __syncthreads();
        if (tid < 128) {
            const int r = tid >> 2, q = tid & 3;
            f32x4 va0 = (f32x4){0.f, 0.f, 0.f, 0.f}, va1 = va0, vb0 = va0, vb1 = va0;
#pragma unroll
            for (int w = 0; w < 8; ++w) { const LAS float* p = red + (w * 32 + r) * 68 + 8 * q;
                va0 = va0 + *(const LAS f32x4*)(p); va1 = va1 + *(const LAS f32x4*)(p + 4); vb0 = vb0 + *(const LAS f32x4*)(p + 32); vb1 = vb1 + *(const LAS f32x4*)(p + 36); }
            const int grow = r0 + r, kind = f.kind(cA), ca = cA + 8 * q, cb = cB + 8 * q;
            if (F::NK == 1) small_epi<F, 0>(f, grow, ca, cb, va0, va1, vb0, vb1, q);
            else switch (kind) {
                case 0: small_epi<F, 0>(f, grow, ca, cb, va0, va1, vb0, vb1, q); break;
                case 1: small_epi<F, (F::NK > 1 ? 1 : 0)>(f, grow, ca, cb, va0, va1, vb0, vb1, q); break;
                case 2: small_epi<F, (F::NK > 2 ? 2 : 0)>(f, grow, ca, cb, va0, va1, vb0, vb1, q); break;
                case 3: small_epi<F, (F::NK > 3 ? 3 : 0)>(f, grow, ca, cb, va0, va1, vb0, vb1, q); break;
                case 4: small_epi<F, (F::NK > 4 ? 4 : 0)>(f, grow, ca, cb, va0, va1, vb0, vb1, q); break;
                default: small_epi<F, (F::NK > 5 ? 5 : 0)>(f, grow, ca, cb, va0, va1, vb0, vb1, q); break;
            }
        }
    }
    __syncthreads();
}
constexpr int SG3_WAVE = 12288;
static_assert(8 * SG3_WAVE <= LDS_MISC && 8 * 32 * 68 * 4 <= LDS_MISC, "small path LDS map");
template <class F> __device__ __forceinline__ void small_gemm3(const Ctx& C, const bf16_t* A, const bf16_t* Bt, int N, int K, const F& f) {
    asm volatile("" : "+s"(K));
    static_assert(F::NK == 1, "small_gemm3: single-kind epilogues only");
    const int ntile = 16 * (N / 64), Kw = K / 8, lnb = (Kw >= 512) ? 2 : ((Kw >= 256) ? 1 : 0);
    const int wave = C.wave, tid = C.tid;
    LAS float* red = (LAS float*)C.lds;
    const int ntl = (ntile - C.vcu + C.G - 1) / C.G, S = ntl << lnb;
    if (S <= 0) return;
    int lane = C.lane; asm volatile("" : "+v"(lane));
    const int lr = lane >> 3, lc = lane & 7, m31 = lane & 31, hh = lane >> 5;
    LAS unsigned char* wl = C.lds + wave * SG3_WAVE;
    LAS unsigned char* wst = wl + lr * 128 + ((lc ^ lr) * 16);
    const LAS unsigned char* wld = wl + m31 * 128;
    sbf16x8 g[24];
    sf32x16 a0, a1;
#pragma unroll
    for (int i = 0; i < 16; ++i) { a0[i] = 0.f; a1[i] = 0.f; }
#define SG3_ISSUE(half, sidx) do { int s_ = (sidx); asm volatile("" : "+s"(s_)); \
        const int tl_ = s_ >> lnb, t_ = C.vcu + tl_ * C.G; const size_t ko_ = (size_t)(wave * Kw + (s_ - (tl_ << lnb)) * 128 + (half) * 64 + 8 * lc); \
        const bf16_t* pa_ = A + (size_t)(MP + 32 * (t_ & 15) + lr) * K + ko_; const bf16_t* pb_ = Bt + (size_t)((t_ >> 4) * 64 + lr) * K + ko_; \
        _Pragma("unroll") for (int i = 0; i < 4; ++i) { g[(half) * 12 + i] = *(const sbf16x8*)(pa_ + (size_t)(8 * i) * K); g[(half) * 12 + 4 + i] = *(const sbf16x8*)(pb_ + (size_t)(8 * i) * K); \
            g[(half) * 12 + 8 + i] = *(const sbf16x8*)(pb_ + (size_t)(32 + 8 * i) * K); } } while (0)
#define SG3_WRITE(half) do { _Pragma("unroll") for (int i = 0; i < 4; ++i) { *(LAS sbf16x8*)(wst + i * 1024) = g[(half) * 12 + i]; *(LAS sbf16x8*)(wst + 4096 + i * 1024) = g[(half) * 12 + 4 + i]; \
        *(LAS sbf16x8*)(wst + 8192 + i * 1024) = g[(half) * 12 + 8 + i]; } } while (0)
#define SG3_MMA() do { _Pragma("unroll") for (int j = 0; j < 4; ++j) { const int po_ = ((2 * j + hh) ^ (m31 & 7)) * 16; \
        const sbf16x8 fa_ = *(const LAS sbf16x8*)(wld + po_), fb_ = *(const LAS sbf16x8*)(wld + 4096 + po_), fc_ = *(const LAS sbf16x8*)(wld + 8192 + po_); \
        a0 = __builtin_amdgcn_mfma_f32_32x32x16_bf16(fa_, fb_, a0, 0, 0, 0); a1 = __builtin_amdgcn_mfma_f32_32x32x16_bf16(fa_, fc_, a1, 0, 0, 0); } } while (0)
    SG3_ISSUE(0, 0); SG3_ISSUE(1, 0);
#pragma unroll 1
    for (int s = 0; s < S; ++s) {
        SG3_WRITE(0); asm volatile("" ::: "memory");
        if (s + 1 < S) SG3_ISSUE(0, s + 1);
        asm volatile("" ::: "memory");
        SG3_MMA(); asm volatile("" ::: "memory");
        SG3_WRITE(1); asm volatile("" ::: "memory");
        if (s + 1 < S) SG3_ISSUE(1, s + 1);
        asm volatile("" ::: "memory");
        SG3_MMA(); asm volatile("" ::: "memory");
        if (((s + 1) & ((1 << lnb) - 1)) == 0) {
            const int t_ = C.vcu + (s >> lnb) * C.G;
            __syncthreads();
#pragma unroll
            for (int i = 0; i < 16; ++i) { const int r = (i & 3) + 8 * (i >> 2) + 4 * hh; red[(wave * 32 + r) * 68 + m31] = a0[i]; red[(wave * 32 + r) * 68 + 32 + m31] = a1[i]; a0[i] = 0.f; a1[i] = 0.f; }
            __syncthreads();
            if (tid < 128) { const int r = tid >> 2, q = tid & 3;
                f32x4 va0 = (f32x4){0.f, 0.f, 0.f, 0.f}, va1 = va0, vb0 = va0, vb1 = va0;
#pragma unroll
                for (int w = 0; w < 8; ++w) { const LAS float* p = red + (w * 32 + r) * 68 + 8 * q;
                    va0 = va0 + *(const LAS f32x4*)(p); va1 = va1 + *(const LAS f32x4*)(p + 4); vb0 = vb0 + *(const LAS f32x4*)(p + 32); vb1 = vb1 + *(const LAS f32x4*)(p + 36); }
                small_epi<F, 0>(f, MP + 32 * (t_ & 15) + r, (t_ >> 4) * 64 + 8 * q, (t_ >> 4) * 64 + 32 + 8 * q, va0, va1, vb0, vb1, q); }
            __syncthreads();
        }
    }
#undef SG3_ISSUE
#undef SG3_WRITE
#undef SG3_MMA
}
template <class F> __device__ __forceinline__ void run_gemm_split(const Ctx& C, const bf16_t* A, const bf16_t* Bt, int N, int K, const F& f) {
    run_gemm(C, A, Bt, MP, N, K, f);
    if (K >= 1024) small_gemm3(C, A, Bt, N, K, f); else small_gemm(C, A, Bt, N, K, f, false);
}
__device__ __forceinline__ void ret_simple_item(const Ctx& C, bool sample, int b, int h, int vs) {
    const int v = C.tid & 63, dg = C.wave, d0 = 32 * dg;
    const int L = sample ? 4 : 2048, row0 = sample ? MP + 4 * b : 2048 * b;
    const float gamma = 1.0f - exp2f(-5.0f - (float)h);
    float S[32];
    const size_t sbase = ((size_t)(b * 4 + h) * 256 + d0) * 512 + vs * 64 + v;
    if (sample) { const float* st = C.in[I_ST] + sbase;
#pragma unroll
        for (int j = 0; j < 32; ++j) S[j] = st[(size_t)j * 512]; }
    else {
#pragma unroll
        for (int j = 0; j < 32; ++j) S[j] = 0.f; }
    const bf16_t* Z = C.w<bf16_t>(WS_Z); bf16_t* OR = C.w<bf16_t>(WS_ORAW);
    LAS float* part = (LAS float*)C.lds;
    for (int t = 0; t < L; ++t) {
        const int row = row0 + t; const bf16_t* zr = Z + (size_t)row * ZLD;
        const float vv = bf2f(zr[CV + h * 512 + vs * 64 + v]);
        const u32x4* qp = (const u32x4*)(zr + CQ + h * 256 + d0); const u32x4* kp = (const u32x4*)(zr + CK + h * 256 + d0);
        float o = 0.f;
#pragma unroll
        for (int c = 0; c < 4; ++c) { const u32x4 qw = qp[c], kw = kp[c];
#pragma unroll
            for (int e = 0; e < 4; ++e) { const unsigned q2 = qw[e], k2 = kw[e]; const int j = c * 8 + e * 2;
                S[j] = gamma * S[j] + __uint_as_float(k2 << 16) * vv; o += __uint_as_float(q2 << 16) * S[j];
                S[j + 1] = gamma * S[j + 1] + __uint_as_float(k2 & 0xffff0000u) * vv; o += __uint_as_float(q2 & 0xffff0000u) * S[j + 1]; } }
        part[((t & 1) * 8 + dg) * 64 + v] = o;
        __syncthreads();
        if (dg == 0) { float ot = 0.f;
#pragma unroll
            for (int g = 0; g < 8; ++g) ot += part[((t & 1) * 8 + g) * 64 + v];
            OR[(size_t)row * 2048 + h * 512 + vs * 64 + v] = (bf16_t)f2bf(ot); }
    }
    float* so = C.out + (sample ? O_SRS : O_SRP) + sbase;
#pragma unroll
    for (int j = 0; j < 32; ++j) so[(size_t)j * 512] = S[j];
    __syncthreads();
}
typedef short bf16x8 __attribute__((ext_vector_type(8)));
typedef short s16x4 __attribute__((ext_vector_type(4)));
typedef short v4i16_t __attribute__((ext_vector_type(4)));
typedef float f32x16 __attribute__((ext_vector_type(16)));
constexpr int R_QS = 528, R_VS = 192, R_PS = 144;
constexpr int R_Q = 0, R_K = R_Q + 64 * R_QS, R_ST = R_K + 64 * R_QS, R_V = R_ST + 64 * R_QS, R_VD = R_V + 64 * R_VS, R_P = R_VD + 64 * R_VS, R_END = R_P + 64 * R_PS;
static_assert(R_END <= LDS_MISC, "retention LDS map");
__device__ __forceinline__ s16x4 vtr(const LAS unsigned char* p) { return __builtin_bit_cast(s16x4, __builtin_amdgcn_ds_read_tr16_b64_v4i16((LAS v4i16_t*)p)); }
#define MFMA32(a, b, c) __builtin_amdgcn_mfma_f32_32x32x16_bf16((a), (b), (c), 0, 0, 0)
__device__ __forceinline__ bf16x8 tr_frag(const LAS unsigned char* a, int stride) { const s16x4 lo = vtr(a), hi = vtr(a + 4 * stride); return (bf16x8){lo[0], lo[1], lo[2], lo[3], hi[0], hi[1], hi[2], hi[3]}; }
constexpr int R_ZG = R_END  , R_TAB = R_END, R_OXL = R_TAB + 16384, R_RED = R_OXL + 8192, R_GR = R_RED + 256, R_END2 = R_GR + 256;
static_assert(R_END2 <= LDS_MISC, "retention + stream LDS map");
template <bool STREAM> __device__ __forceinline__ void ret_mfma_item(const Ctx& C, int b, int h, int vs, int sitem0) {
    const int tid = C.tid, lane = C.lane, wave = C.wave, l31_ = lane & 31, hh_ = lane >> 5;
    const LAS unsigned char* lds = C.lds;
    const bf16_t* Z = C.w<bf16_t>(WS_Z); bf16_t* OR = C.w<bf16_t>(WS_ORAW);
    const float lg = log2f(1.0f - exp2f(-5.0f - (float)h));
    const int row00 = b * 2048;
    if (tid < 64) ((LAS float*)(C.lds + R_GR))[tid] = C.in[I_GRET][h * 512 + vs * 64 + tid];
    for (int e = tid; e < 64 * R_QS / 16; e += NTHR) *(LAS u32x4*)(C.lds + R_ST + e * 16) = (u32x4){0u, 0u, 0u, 0u};
    f32x16 S0, S1;
#pragma unroll
    for (int i = 0; i < 16; ++i) { S0[i] = 0.f; S1[i] = 0.f; }
    u32x4 gq[4], gk[4], gv, gz;
    const int qrow = tid >> 5, qch = tid & 31, vrow = tid >> 3, vch = tid & 7;
    const bf16_t* zq = Z + (size_t)row00 * ZLD + CQ + h * 256 + qch * 8;
    const bf16_t* zk = Z + (size_t)row00 * ZLD + CK + h * 256 + qch * 8;
    const bf16_t* zv = Z + (size_t)row00 * ZLD + CV + h * 512 + vs * 64 + vch * 8;
    const bf16_t* zz = Z + (size_t)row00 * ZLD + CG + h * 512 + vs * 64 + vch * 8;
#define RET_LOAD(ci) do { _Pragma("unroll") for (int j = 0; j < 4; ++j) { const size_t ro = (size_t)((ci) * 64 + qrow + 16 * j) * ZLD; gq[j] = *(const u32x4*)(zq + ro); gk[j] = *(const u32x4*)(zk + ro); } \
        gv = *(const u32x4*)(zv + (size_t)((ci) * 64 + vrow) * ZLD); if (!STREAM) gz = *(const u32x4*)(zz + (size_t)((ci) * 64 + vrow) * ZLD); } while (0)
    RET_LOAD(0);
    const float vdsc = exp2f((float)(63 - vrow) * lg);
    const float g64 = exp2f(64.0f * lg);
    f32x4 cr[4][2]; float dots[10]; u32x2 vsp[4][2]; f32x4 sl[2][2];
    const float* STin = C.in[I_ST]; float* STout = C.out + O_SRS;
#define S_ITEM(j) int si_ = sitem0 + (j); asm volatile("" : "+s"(si_)); const int bs = si_ >> 2, hs = si_ & 3, srow0 = MP + 4 * bs; const float lgs = log2f(1.0f - exp2f(-5.0f - (float)hs))
#define S_UNPK(w) (f32x4){__uint_as_float((w).x << 16), __uint_as_float((w).x & 0xffff0000u), __uint_as_float((w).y << 16), __uint_as_float((w).y & 0xffff0000u)}
#define STREAM_TABLES(j) do { S_ITEM(j); const int d = tid >> 1, wh = tid & 1; f32x4 tv; \
        _Pragma("unroll") for (int t = 0; t < 4; ++t) tv[t] = bf2f(Z[(size_t)(srow0 + t) * ZLD + (wh ? CK : CQ) + hs * 256 + d]) * (wh ? exp2f((float)(3 - t) * lgs) : 1.0f); \
        *(LAS f32x4*)(C.lds + R_TAB + (j) * 8192 + d * 32 + wh * 16) = tv; } while (0)
#define STREAM_BEGIN(j) do { S_ITEM(j); (void)lgs; \
        _Pragma("unroll") for (int t = 0; t < 4; ++t) { const bf16_t* vp = Z + (size_t)(srow0 + t) * ZLD + CV + hs * 512 + 4 * lane; vsp[t][0] = *(const u32x2*)vp; vsp[t][1] = *(const u32x2*)(vp + 256); \
            cr[t][0] = (f32x4){0.f, 0.f, 0.f, 0.f}; cr[t][1] = cr[t][0]; } \
        _Pragma("unroll") for (int e = 0; e < 10; ++e) dots[e] = 0.f; } while (0)
#define S_ROW0(c) ((((c) & 15) * 8 + wave) * 2)
#define STREAM_LOAD(c) do { S_ITEM((c) >> 4); (void)lgs; (void)srow0; \
        _Pragma("unroll") for (int r = 0; r < 2; ++r) { const float* sp = STin + ((size_t)(bs * 4 + hs) * 256 + S_ROW0(c) + r) * 512 + 4 * lane; sl[r][0] = *(const f32x4*)sp; sl[r][1] = *(const f32x4*)(sp + 256); } } while (0)
#define STREAM_CONSUME(c) do { S_ITEM((c) >> 4); (void)srow0; const float g4s = exp2f(4.0f * lgs); \
        _Pragma("unroll") for (int r = 0; r < 2; ++r) { \
            const LAS unsigned char* tp = C.lds + R_TAB + ((c) >> 4) * 8192 + (S_ROW0(c) + r) * 32; const f32x4 tq = *(const LAS f32x4*)tp, tk = *(const LAS f32x4*)(tp + 16); \
            f32x4 n0 = sl[r][0] * g4s, n1 = sl[r][1] * g4s; \
            _Pragma("unroll") for (int t = 0; t < 4; ++t) { const f32x4 va = S_UNPK(vsp[t][0]), vb = S_UNPK(vsp[t][1]); \
                n0 = n0 + va * tk[t]; n1 = n1 + vb * tk[t]; cr[t][0] = cr[t][0] + sl[r][0] * tq[t]; cr[t][1] = cr[t][1] + sl[r][1] * tq[t]; } \
            float* op = STout + ((size_t)(bs * 4 + hs) * 256 + S_ROW0(c) + r) * 512 + 4 * lane; *(f32x4*)op = n0; *(f32x4*)(op + 256) = n1; \
            dots[0] += tq[0] * tk[0]; dots[1] += tq[1] * tk[0]; dots[2] += tq[1] * tk[1]; dots[3] += tq[2] * tk[0]; dots[4] += tq[2] * tk[1]; dots[5] += tq[2] * tk[2]; \
            dots[6] += tq[3] * tk[0]; dots[7] += tq[3] * tk[1]; dots[8] += tq[3] * tk[2]; dots[9] += tq[3] * tk[3]; } } while (0)
#define STREAM_FINISH(j) do { S_ITEM(j); \
        _Pragma("unroll") for (int t = 0; t < 4; ++t) { const float gc = exp2f((float)(t + 1) * lgs), gi = exp2f((float)(t - 3) * lgs); \
            f32x4 oa = cr[t][0] * gc, ob = cr[t][1] * gc; \
            _Pragma("unroll") for (int s = 0; s <= t; ++s) { const float w = dots[t * (t + 1) / 2 + s] * gi; oa = oa + S_UNPK(vsp[s][0]) * w; ob = ob + S_UNPK(vsp[s][1]) * w; } \
            LAS float* ox = (LAS float*)(C.lds + R_OXL) + t * 512 + 4 * lane; \
            _Pragma("unroll") for (int c = 0; c < 4; ++c) { __hip_atomic_fetch_add(ox + c, oa[c], __ATOMIC_RELAXED, __HIP_MEMORY_SCOPE_WORKGROUP); __hip_atomic_fetch_add(ox + 256 + c, ob[c], __ATOMIC_RELAXED, __HIP_MEMORY_SCOPE_WORKGROUP); } } \
        __syncthreads(); \
        { const int t = tid >> 7, jq = tid & 127; LAS f32x4* oxp = (LAS f32x4*)(C.lds + R_OXL + (t * 512 + 4 * jq) * 4); const f32x4 o4 = *oxp; *oxp = (f32x4){0.f, 0.f, 0.f, 0.f}; \
          const float ss = wave_sum(sum4(o4 * o4)); if (lane == 0) ((LAS float*)(C.lds + R_RED))[(j) * 8 + wave] = ss; \
          __syncthreads(); \
          const float rs = rsqrtf((((LAS float*)(C.lds + R_RED))[(j) * 8 + 2 * t] + ((LAS float*)(C.lds + R_RED))[(j) * 8 + 2 * t + 1]) * (1.f / 512.f) + EPS); \
          const int col = hs * 512 + 4 * jq; const f32x4 gz = silu4(ld_bf4(Z + (size_t)(srow0 + t) * ZLD + CG + col)), gr = *(const f32x4*)(C.in[I_GRET] + col); \
          st_bf4(C.w<bf16_t>(WS_YA) + (size_t)(srow0 + t) * 2048 + col, gz * o4 * rs * gr); } } while (0)
    if (STREAM) { STREAM_TABLES(0); STREAM_BEGIN(0); *(LAS f32x4*)(C.lds + R_OXL + tid * 16) = (f32x4){0.f, 0.f, 0.f, 0.f}; }
#ifdef PROBE_ST
    unsigned long long ts0 = 0, ts1 = 0, ts2 = 0, ts3 = 0, ts4 = 0, tl = __builtin_amdgcn_s_memrealtime();
#define ST_MARK(acc_) do { const unsigned long long tn_ = __builtin_amdgcn_s_memrealtime(); acc_ += tn_ - tl; tl = tn_; } while (0)
#else
#define ST_MARK(acc_) do { } while (0)
#endif
    u32x2 yap[4]; float ssp = 0.f;
#define RET_FLUSH(c) do { if (wave >= 4) { const int tt_ = (wave >> 1) & 1, vt_ = wave & 1, row_ = row00 + (c) * 64 + 32 * tt_ + l31; \
        if (hh == 0) atomicAdd(C.w<float>(WS_SSQO) + row_ * 4 + h, ssp); \
        bf16_t* ya_ = C.w<bf16_t>(WS_YA) + (size_t)row_ * 2048 + h * 512 + vs * 64 + 32 * vt_ + 4 * hh; \
        _Pragma("unroll") for (int g = 0; g < 4; ++g) *(u32x2*)(ya_ + 8 * g) = yap[g]; } } while (0)
    for (int ci = 0; ci < 32; ++ci) {
        int l31 = l31_, hh = hh_; asm volatile("" : "+v"(l31), "+v"(hh));
#pragma unroll
        for (int j = 0; j < 4; ++j) { *(LAS u32x4*)(C.lds + R_Q + (qrow + 16 * j) * R_QS + qch * 16) = gq[j]; *(LAS u32x4*)(C.lds + R_K + (qrow + 16 * j) * R_QS + qch * 16) = gk[j]; }
        *(LAS u32x4*)(C.lds + R_V + vrow * R_VS + vch * 16) = gv;
        if (!STREAM) *(LAS u32x4*)(C.lds + R_ZG + vrow * R_PS + vch * 16) = gz;
        { u32x4 d;
#pragma unroll
          for (int e = 0; e < 4; ++e) { const unsigned w = gv[e]; d[e] = pk2(__uint_as_float(w << 16) * vdsc, __uint_as_float(w & 0xffff0000u) * vdsc); }
          *(LAS u32x4*)(C.lds + R_VD + vrow * R_VS + vch * 16) = d; }
        if (STREAM && ci == 16) STREAM_TABLES(1);
        __syncthreads();
        ST_MARK(ts0);
        if (ci > 0) RET_FLUSH(ci - 1);
        if (STREAM) {
            if (ci > 0) STREAM_CONSUME(ci - 1);
            if (ci == 16) { STREAM_FINISH(0); STREAM_BEGIN(1); }
            STREAM_LOAD(ci);
        }
#ifdef PROBE_SAMEROWS
        if (ci + 1 < 32) RET_LOAD(0);
#else
        if (ci + 1 < 32) RET_LOAD(ci + 1);
#endif
        ST_MARK(ts4);
        const int rowoff = l31, koff = 16 * hh;
        const int tr_q = (l31 & 15) >> 2, tr_p = l31 & 3, tr_blk = (l31 >> 4) & 1;
        f32x16 acc;
#pragma unroll
        for (int i = 0; i < 16; ++i) acc[i] = 0.f;
        if (wave < 3) {
            const int st = wave >> 1, tt = wave == 0 ? 0 : 1;
            const LAS unsigned char* pa = lds + R_K + (32 * st + rowoff) * R_QS + koff;
            const LAS unsigned char* pb = lds + R_Q + (32 * tt + rowoff) * R_QS + koff;
            { bf16x8 fa = *(const LAS bf16x8*)pa, fb = *(const LAS bf16x8*)pb;
#pragma unroll
              for (int ks = 0; ks < 16; ++ks) { bf16x8 na = fa, nb = fb; if (ks + 1 < 16) { na = *(const LAS bf16x8*)(pa + (ks + 1) * 32); nb = *(const LAS bf16x8*)(pb + (ks + 1) * 32); }
                  acc = MFMA32(fa, fb, acc); fa = na; fb = nb; } }
            const int t = 32 * tt + l31;
#pragma unroll
            for (int g = 0; g < 4; ++g) { float pv[4];
#pragma unroll
                for (int e = 0; e < 4; ++e) { const int s = 32 * st + 8 * g + 4 * hh + e; pv[e] = (t >= s) ? acc[4 * g + e] * __builtin_amdgcn_exp2f((float)(t - s) * lg) : 0.f; }
                u32x2 w; w.x = cvtpk(pv[0], pv[1]); w.y = cvtpk(pv[2], pv[3]);
                *(LAS u32x2*)(C.lds + R_P + t * R_PS + (32 * st + 8 * g + 4 * hh) * 2) = w; }
        } else if (wave >= 4) {
            const int tt = (wave >> 1) & 1, vt = wave & 1;
            const LAS unsigned char* pa = lds + R_ST + (32 * vt + rowoff) * R_QS + koff;
            const LAS unsigned char* pb = lds + R_Q + (32 * tt + rowoff) * R_QS + koff;
            { bf16x8 fa = *(const LAS bf16x8*)pa, fb = *(const LAS bf16x8*)pb;
#pragma unroll
              for (int ks = 0; ks < 16; ++ks) { bf16x8 na = fa, nb = fb; if (ks + 1 < 16) { na = *(const LAS bf16x8*)(pa + (ks + 1) * 32); nb = *(const LAS bf16x8*)(pb + (ks + 1) * 32); }
                  acc = MFMA32(fa, fb, acc); fa = na; fb = nb; } }
            const float dc = __builtin_amdgcn_exp2f((float)(32 * tt + l31 + 1) * lg);
#pragma unroll
            for (int i = 0; i < 16; ++i) acc[i] *= dc;
        }
        ST_MARK(ts1);
        __syncthreads();
        ST_MARK(ts3);
        if (wave >= 4) {
            const int tt = (wave >> 1) & 1, vt = wave & 1;
            const LAS unsigned char* pa = lds + R_V + (8 * hh + tr_q) * R_VS + (32 * vt + 16 * tr_blk + 4 * tr_p) * 2;
            const LAS unsigned char* pb = lds + R_P + (32 * tt + rowoff) * R_PS + koff;
            for (int ks = 0; ks < 2 * tt + 2; ++ks) acc = MFMA32(tr_frag(pa + 16 * ks * R_VS, R_VS), *(const LAS bf16x8*)(pb + ks * 32), acc);
            float ss = 0.f;
#pragma unroll
            for (int i = 0; i < 16; ++i) ss += acc[i] * acc[i];
            ssp = ss + __shfl_xor(ss, 32);
            const LAS float* gr = (const LAS float*)(C.lds + R_GR) + 32 * vt + 4 * hh;
#pragma unroll
            for (int g = 0; g < 4; ++g) { const u32x2 zw = STREAM ? *(const u32x2*)(Z + (size_t)(row00 + ci * 64 + 32 * tt + l31) * ZLD + CG + h * 512 + vs * 64 + 32 * vt + 4 * hh + 8 * g)
                                                            : *(const LAS u32x2*)(C.lds + R_ZG + (32 * tt + l31) * R_PS + (32 * vt + 4 * hh + 8 * g) * 2);
                const f32x4 y = silu4((f32x4){__uint_as_float(zw.x << 16), __uint_as_float(zw.x & 0xffff0000u), __uint_as_float(zw.y << 16), __uint_as_float(zw.y & 0xffff0000u)})
                    * (f32x4){acc[4 * g], acc[4 * g + 1], acc[4 * g + 2], acc[4 * g + 3]} * *(const LAS f32x4*)(gr + 8 * g);
                yap[g].x = cvtpk(y[0], y[1]); yap[g].y = cvtpk(y[2], y[3]); }
        }
        {
#pragma unroll
            for (int i = 0; i < 16; ++i) { S0[i] *= g64; S1[i] *= g64; }
            const LAS unsigned char* pa = lds + R_K + (8 * hh + tr_q) * R_QS + (32 * wave + 16 * tr_blk + 4 * tr_p) * 2;
            const LAS unsigned char* pb = lds + R_VD + (8 * hh + tr_q) * R_VS + (16 * tr_blk + 4 * tr_p) * 2;
#pragma unroll
            for (int ks = 0; ks < 4; ++ks) { const bf16x8 a = tr_frag(pa + 16 * ks * R_QS, R_QS);
                S0 = MFMA32(a, tr_frag(pb + 16 * ks * R_VS, R_VS), S0); S1 = MFMA32(a, tr_frag(pb + 16 * ks * R_VS + 64, R_VS), S1); }
#pragma unroll
            for (int g = 0; g < 4; ++g) { u32x2 w0, w1; w0.x = cvtpk(S0[4 * g], S0[4 * g + 1]); w0.y = cvtpk(S0[4 * g + 2], S0[4 * g + 3]); w1.x = cvtpk(S1[4 * g], S1[4 * g + 1]); w1.y = cvtpk(S1[4 * g + 2], S1[4 * g + 3]);
                *(LAS u32x2*)(C.lds + R_ST + l31 * R_QS + (32 * wave + 8 * g + 4 * hh) * 2) = w0;
                *(LAS u32x2*)(C.lds + R_ST + (32 + l31) * R_QS + (32 * wave + 8 * g + 4 * hh) * 2) = w1; }
        }
        __syncthreads();
        ST_MARK(ts2);
    }
#ifdef PROBE_ST
    if (blockIdx.x == 0 && tid == PROBE_ST_TID) { float* dbg = C.w<float>(WS_CTL) + 65536; dbg[0] = (float)ts0 * 0.01f; dbg[1] = (float)ts1 * 0.01f; dbg[2] = (float)ts2 * 0.01f; dbg[3] = (float)ts3 * 0.01f; dbg[4] = (float)ts4 * 0.01f; }
#endif
    { const int l31 = l31_, hh = hh_; RET_FLUSH(31); }
    if (STREAM) { STREAM_CONSUME(31); STREAM_FINISH(1); }
#undef RET_LOAD
#undef RET_FLUSH
#undef S_ITEM
#undef S_UNPK
#undef STREAM_TABLES
#undef STREAM_BEGIN
#undef S_ROW0
#undef STREAM_LOAD
#undef STREAM_CONSUME
#undef STREAM_FINISH
    float* so = C.out + O_SRP + ((size_t)(b * 4 + h) * 256 + 32 * wave) * 512 + vs * 64 + l31_;
#pragma unroll
    for (int i = 0; i < 16; ++i) { const int dl = (i & 3) + 8 * (i >> 2) + 4 * hh_; so[(size_t)dl * 512] = S0[i]; so[(size_t)dl * 512 + 32] = S1[i]; }
}
constexpr int T_TAB = 0, T_OXL = T_TAB + 8192, T_RED = T_OXL + 8192;
__device__ __forceinline__ void stream_item(const Ctx& C, int si) {
    const int tid = C.tid, lane = C.lane, wave = C.wave;
    const int bs = si >> 2, hs = si & 3, srow0 = MP + 4 * bs; const float lgs = log2f(1.0f - exp2f(-5.0f - (float)hs));
    const bf16_t* Z = C.w<bf16_t>(WS_Z);
    { const int d = tid >> 1, wh = tid & 1; f32x4 tv;
#pragma unroll
      for (int t = 0; t < 4; ++t) tv[t] = bf2f(Z[(size_t)(srow0 + t) * ZLD + (wh ? CK : CQ) + hs * 256 + d]) * (wh ? exp2f((float)(3 - t) * lgs) : 1.0f);
      *(LAS f32x4*)(C.lds + T_TAB + d * 32 + wh * 16) = tv;
      *(LAS f32x4*)(C.lds + T_OXL + tid * 16) = (f32x4){0.f, 0.f, 0.f, 0.f}; }
    f32x4 va[4], vb[4], cra[4], crb[4]; float dots[10];
#pragma unroll
    for (int t = 0; t < 4; ++t) { const bf16_t* vp = Z + (size_t)(srow0 + t) * ZLD + CV + hs * 512 + 4 * lane; va[t] = ld_bf4(vp); vb[t] = ld_bf4(vp + 256);
        cra[t] = (f32x4){0.f, 0.f, 0.f, 0.f}; crb[t] = cra[t]; }
#pragma unroll
    for (int e = 0; e < 10; ++e) dots[e] = 0.f;
    const float g4s = exp2f(4.0f * lgs);
    const float* sp = C.in[I_ST] + ((size_t)(bs * 4 + hs) * 256 + 32 * wave) * 512 + 4 * lane;
    float* op = C.out + O_SRS + ((size_t)(bs * 4 + hs) * 256 + 32 * wave) * 512 + 4 * lane;
    __syncthreads();
    f32x4 ba[4][2], bb[4][2];
#define ST_LOAD(buf, g) do { _Pragma("unroll") for (int r = 0; r < 4; ++r) { buf[r][0] = *(const f32x4*)(sp + (size_t)((g) * 4 + r) * 512); buf[r][1] = *(const f32x4*)(sp + (size_t)((g) * 4 + r) * 512 + 256); } } while (0)
#define ST_USE(buf, g) do { _Pragma("unroll") for (int r = 0; r < 4; ++r) { const int d = 32 * wave + (g) * 4 + r; \
        const f32x4 tq = *(const LAS f32x4*)(C.lds + T_TAB + d * 32), tk = *(const LAS f32x4*)(C.lds + T_TAB + d * 32 + 16); \
        f32x4 n0 = buf[r][0] * g4s, n1 = buf[r][1] * g4s; \
        _Pragma("unroll") for (int t = 0; t < 4; ++t) { n0 = n0 + va[t] * tk[t]; n1 = n1 + vb[t] * tk[t]; cra[t] = cra[t] + buf[r][0] * tq[t]; crb[t] = crb[t] + buf[r][1] * tq[t]; } \
        *(f32x4*)(op + (size_t)((g) * 4 + r) * 512) = n0; *(f32x4*)(op + (size_t)((g) * 4 + r) * 512 + 256) = n1; \
        dots[0] += tq[0] * tk[0]; dots[1] += tq[1] * tk[0]; dots[2] += tq[1] * tk[1]; dots[3] += tq[2] * tk[0]; dots[4] += tq[2] * tk[1]; dots[5] += tq[2] * tk[2]; \
        dots[6] += tq[3] * tk[0]; dots[7] += tq[3] * tk[1]; dots[8] += tq[3] * tk[2]; dots[9] += tq[3] * tk[3]; } } while (0)
    ST_LOAD(ba, 0);
#pragma unroll 1
    for (int g = 0; g < 8; g += 2) { ST_LOAD(bb, g + 1); ST_USE(ba, g); if (g + 2 < 8) ST_LOAD(ba, g + 2); ST_USE(bb, g + 1); }
#undef ST_LOAD
#undef ST_USE
#pragma unroll
    for (int t = 0; t < 4; ++t) { const float gc = exp2f((float)(t + 1) * lgs), gi = exp2f((float)(t - 3) * lgs);
        f32x4 oa = cra[t] * gc, ob = crb[t] * gc;
#pragma unroll
        for (int s = 0; s <= t; ++s) { const float w = dots[t * (t + 1) / 2 + s] * gi; oa = oa + va[s] * w; ob = ob + vb[s] * w; }
        LAS float* ox = (LAS float*)(C.lds + T_OXL) + t * 512 + 4 * lane;
#pragma unroll
        for (int c = 0; c < 4; ++c) { __hip_atomic_fetch_add(ox + c, oa[c], __ATOMIC_RELAXED, __HIP_MEMORY_SCOPE_WORKGROUP); __hip_atomic_fetch_add(ox + 256 + c, ob[c], __ATOMIC_RELAXED, __HIP_MEMORY_SCOPE_WORKGROUP); } }
    __syncthreads();
    { const int t = tid >> 7, jq = tid & 127; const f32x4 o4 = *(const LAS f32x4*)(C.lds + T_OXL + (t * 512 + 4 * jq) * 4);
      const float ss = wave_sum(sum4(o4 * o4)); if (lane == 0) ((LAS float*)(C.lds + T_RED))[wave] = ss;
      __syncthreads();
      const float rs = rsqrtf((((LAS float*)(C.lds + T_RED))[2 * t] + ((LAS float*)(C.lds + T_RED))[2 * t + 1]) * (1.f / 512.f) + EPS);
      const int col = hs * 512 + 4 * jq; const f32x4 gz = silu4(ld_bf4(Z + (size_t)(srow0 + t) * ZLD + CG + col)), gr = *(const f32x4*)(C.in[I_GRET] + col);
      st_bf4(C.w<bf16_t>(WS_YA) + (size_t)(srow0 + t) * 2048 + col, gz * o4 * rs * gr); }
    __syncthreads();
}
__device__ __forceinline__ void stream_pair(const Ctx& C, int si0) {
    const int wave = C.wave, ch = wave & 1, rq = wave >> 1;
    const bf16_t* Z = C.w<bf16_t>(WS_Z);
    int lane0 = C.lane; asm volatile("" : "+v"(lane0), "+s"(si0));
    const float* sp = C.in[I_ST] + ((size_t)si0 * 256 + 64 * rq) * 512 + ch * 256 + 4 * lane0;
    float* op = C.out + O_SRS + ((size_t)si0 * 256 + 64 * rq) * 512 + ch * 256 + 4 * lane0;
    f32x4 rg[8][4];
#define SP_OFF(G) ((size_t)((((G) >> 4) * 256) + (((G) & 15) * 4)) * 512)
#define SP_LOAD(slot, G) do { const float* p_ = sp + SP_OFF(G); rg[slot][0] = *(const f32x4*)p_; rg[slot][1] = *(const f32x4*)(p_ + 512); rg[slot][2] = *(const f32x4*)(p_ + 1024); rg[slot][3] = *(const f32x4*)(p_ + 1536); } while (0)
#pragma unroll
    for (int s = 0; s < 7; ++s) SP_LOAD(s, s);
#pragma unroll 1
    for (int item = 0; item < 2; ++item) {
        int si = si0 + item; asm volatile("" : "+s"(si));
        int tid = C.tid, lane = C.lane; asm volatile("" : "+v"(tid), "+v"(lane));
        const int bs = si >> 2, hs = si & 3, srow0 = MP + 4 * bs; const float lgs = log2f(1.0f - exp2f(-5.0f - (float)hs));
        { const int d = tid >> 1, wh = tid & 1; f32x4 tv;
#pragma unroll
          for (int t = 0; t < 4; ++t) tv[t] = bf2f(Z[(size_t)(srow0 + t) * ZLD + (wh ? CK : CQ) + hs * 256 + d]) * (wh ? exp2f((float)(3 - t) * lgs) : 1.0f);
          *(LAS f32x4*)(C.lds + T_TAB + d * 32 + wh * 16) = tv;
          *(LAS f32x4*)(C.lds + T_OXL + tid * 16) = (f32x4){0.f, 0.f, 0.f, 0.f}; }
        f32x4 va[4], cra[4];
#pragma unroll
        for (int t = 0; t < 4; ++t) { va[t] = ld_bf4(Z + (size_t)(srow0 + t) * ZLD + CV + hs * 512 + ch * 256 + 4 * lane); cra[t] = (f32x4){0.f, 0.f, 0.f, 0.f}; }
        const float g4s = exp2f(4.0f * lgs);
        __syncthreads();
#pragma unroll 1
        for (int half = 0; half < 2; ++half) {
#pragma unroll
            for (int j = 0; j < 8; ++j) { const int G = item * 16 + half * 8 + j;
                SP_LOAD((j + 7) & 7, (G + 7 < 32 ? G + 7 : 0));
                float* o_ = op + SP_OFF(G);
#pragma unroll
                for (int r = 0; r < 4; ++r) { const int d = 64 * rq + (half * 8 + j) * 4 + r;
                    const f32x4 tq = *(const LAS f32x4*)(C.lds + T_TAB + d * 32), tk = *(const LAS f32x4*)(C.lds + T_TAB + d * 32 + 16);
                    const f32x4 s0 = rg[j][r];
                    f32x4 n0 = s0 * g4s;
#pragma unroll
                    for (int t = 0; t < 4; ++t) { n0 = n0 + va[t] * tk[t]; cra[t] = cra[t] + s0 * tq[t]; }
                    *(f32x4*)(o_ + r * 512) = n0; }
                asm volatile("" ::: "memory"); }
        }
        int hse = hs; asm volatile("" : "+s"(hse)); const float lge = log2f(1.0f - exp2f(-5.0f - (float)hse));
        float dots[10];
#pragma unroll
        for (int e = 0; e < 10; ++e) dots[e] = 0.f;
#pragma unroll
        for (int i = 0; i < 4; ++i) { const int d = lane * 4 + i; const f32x4 tq = *(const LAS f32x4*)(C.lds + T_TAB + d * 32), tk = *(const LAS f32x4*)(C.lds + T_TAB + d * 32 + 16);
            dots[0] += tq[0] * tk[0]; dots[1] += tq[1] * tk[0]; dots[2] += tq[1] * tk[1]; dots[3] += tq[2] * tk[0]; dots[4] += tq[2] * tk[1]; dots[5] += tq[2] * tk[2];
            dots[6] += tq[3] * tk[0]; dots[7] += tq[3] * tk[1]; dots[8] += tq[3] * tk[2]; dots[9] += tq[3] * tk[3]; }
#pragma unroll
        for (int e = 0; e < 10; ++e) dots[e] = (rq == 0) ? wave_sum(dots[e]) : 0.f;
#pragma unroll
        for (int t = 0; t < 4; ++t) { const float gc = exp2f((float)(t + 1) * lge), gi = exp2f((float)(t - 3) * lge);
            f32x4 oa = cra[t] * gc;
#pragma unroll
            for (int s = 0; s <= t; ++s) { const float w = dots[t * (t + 1) / 2 + s] * gi; oa = oa + va[s] * w; }
            LAS float* ox = (LAS float*)(C.lds + T_OXL) + t * 512 + ch * 256 + 4 * lane;
#pragma unroll
            for (int c = 0; c < 4; ++c) __hip_atomic_fetch_add(ox + c, oa[c], __ATOMIC_RELAXED, __HIP_MEMORY_SCOPE_WORKGROUP); }
        __syncthreads();
        { const int t = tid >> 7, jq = tid & 127; const f32x4 o4 = *(const LAS f32x4*)(C.lds + T_OXL + (t * 512 + 4 * jq) * 4);
          const float ss = wave_sum(sum4(o4 * o4)); if (lane == 0) ((LAS float*)(C.lds + T_RED))[wave] = ss;
          __syncthreads();
          const float rs = rsqrtf((((LAS float*)(C.lds + T_RED))[2 * t] + ((LAS float*)(C.lds + T_RED))[2 * t + 1]) * (1.f / 512.f) + EPS);
          const int col = hs * 512 + 4 * jq; const f32x4 gz = silu4(ld_bf4(Z + (size_t)(srow0 + t) * ZLD + CG + col)), gr = *(const f32x4*)(C.in[I_GRET] + col);
          st_bf4(C.w<bf16_t>(WS_YA) + (size_t)(srow0 + t) * 2048 + col, gz * o4 * rs * gr); }
        __syncthreads();
    }
#undef SP_LOAD
#undef SP_OFF
}
__device__ __forceinline__ void p2_gating_simple(const Ctx& C);
__device__ __forceinline__ void p2_retention_simple(const Ctx& C) {
#ifdef RET_SIMPLE
    for (int it = C.vcu; it < 256; it += C.G) ret_simple_item(C, false, it >> 5, (it >> 3) & 3, it & 7);
#else
    if (C.G == 256) { const int it = C.vcu;
#ifdef RET_INTERLEAVED
        ret_mfma_item<true>(C, it >> 5, (it >> 3) & 3, it & 7, 2 * it); __syncthreads();
#else
#ifdef PROBE_RS
        const unsigned long long t0_ = __builtin_amdgcn_s_memrealtime();
        ret_mfma_item<false>(C, it >> 5, (it >> 3) & 3, it & 7, 0); __syncthreads();
        const unsigned long long t1_ = __builtin_amdgcn_s_memrealtime();
        stream_item(C, 2 * it); stream_item(C, 2 * it + 1);
        const unsigned long long t2_ = __builtin_amdgcn_s_memrealtime();
        if (blockIdx.x == 0 && C.tid == 0) { float* dbg = C.w<float>(WS_CTL) + 65536; dbg[0] = (float)(t1_ - t0_) * 0.01f; dbg[1] = (float)(t2_ - t1_) * 0.01f; }
#else
        const bool sfirst = (((int)blockIdx.x >> 3) & 1) != 0;
        if (sfirst) { stream_pair(C, 2 * it); __syncthreads(); p2_gating_simple(C); __syncthreads(); ret_mfma_item<false>(C, it >> 5, (it >> 3) & 3, it & 7, 0); __syncthreads(); }
        else { ret_mfma_item<false>(C, it >> 5, (it >> 3) & 3, it & 7, 0); __syncthreads(); stream_pair(C, 2 * it); __syncthreads(); p2_gating_simple(C); }
#endif
#endif
        return; }
    for (int it = C.vcu; it < 256; it += C.G) ret_mfma_item<false>(C, it >> 5, (it >> 3) & 3, it & 7, 0);
    __syncthreads();
#endif
    for (int it = C.vcu; it < 4096; it += C.G) ret_simple_item(C, true, it >> 5, (it >> 3) & 3, it & 7);
}
__device__ __forceinline__ void unpk8(u32x4 w, f32x4& a, f32x4& b) {
    a = (f32x4){__uint_as_float(w.x << 16), __uint_as_float(w.x & 0xffff0000u), __uint_as_float(w.y << 16), __uint_as_float(w.y & 0xffff0000u)};
    b = (f32x4){__uint_as_float(w.z << 16), __uint_as_float(w.z & 0xffff0000u), __uint_as_float(w.w << 16), __uint_as_float(w.w & 0xffff0000u)}; }
constexpr int G_WS = 272, G_GS = 320, G_W = 0, G_G = G_W + 128 * G_WS, G_END = G_G + 128 * G_GS;
static_assert(G_END <= LDS_MISC, "gating LDS map");
__device__ __forceinline__ void p2_gating_mfma(const Ctx& C) {
    const int tid = C.tid, wave = C.wave, l31 = C.lane & 31, hh = C.lane >> 5;
    const LAS unsigned char* lds = C.lds;
    const bf16_t* Z = C.w<bf16_t>(WS_Z); const float* LNS = C.w<float>(WS_LNS); bf16_t* YB = C.w<bf16_t>(WS_YB); const bf16_t* WSB = C.w<bf16_t>(WS_WSB);
    const float* b_s = C.in[I_BS]; const float* g_gm = C.in[I_GGM];
    int g_staged = -1;
    const int c16 = tid & 15, mrow = tid >> 4;
    u32x4 gvr[4]; f32x2_t lnr[4];
#define GT_LOAD(itx) do { const int g_ = (itx) & 7, r0_ = ((itx) >> 3) * 128; _Pragma("unroll") for (int j = 0; j < 4; ++j) { const int row_ = r0_ + mrow + 32 * j; \
        gvr[j] = *(const u32x4*)(Z + (size_t)row_ * ZLD + CGV + g_ * 128 + c16 * 8); lnr[j] = *(const f32x2_t*)(LNS + 2 * row_); } } while (0)
    if (C.vcu < 1024) GT_LOAD(C.vcu);
#pragma unroll 1
    for (int it = C.vcu; it < 1024; it += C.G) {
        const int g = it & 7, row0 = (it >> 3) * 128;
        __syncthreads();
        if (g != g_staged) { g_staged = g;
#pragma unroll
            for (int j = 0; j < 4; ++j) { const int idx = tid + NTHR * j, r = idx >> 4, cw = idx & 15;
                *(LAS u32x4*)(C.lds + G_W + r * G_WS + cw * 16) = *(const u32x4*)(WSB + ((size_t)g * 128 + r) * 128 + cw * 8); } }
        { const f32x4 gg0 = *(const f32x4*)(g_gm + g * 128 + c16 * 8), gg1 = *(const f32x4*)(g_gm + g * 128 + c16 * 8 + 4);
#pragma unroll
          for (int j = 0; j < 4; ++j) { const int m = mrow + 32 * j;
              const float mu = lnr[j][0] * (1.f / 1024.f), var = lnr[j][1] * (1.f / 1024.f) - mu * mu, rstd = rsqrtf(var + EPS);
              f32x4 x0, x1; unpk8(gvr[j], x0, x1);
              const f32x4 y0 = (x0 - mu) * rstd * gg0, y1 = (x1 - mu) * rstd * gg1;
              u32x4 w; w.x = cvtpk(y0[0], y0[1]); w.y = cvtpk(y0[2], y0[3]); w.z = cvtpk(y1[0], y1[1]); w.w = cvtpk(y1[2], y1[3]);
              *(LAS u32x4*)(C.lds + G_G + m * G_GS + c16 * 16) = w; } }
        const int nt = wave >> 1, ct0 = 2 * (wave & 1);
        const int n = 32 * nt + l31, row = row0 + n;
        const bf16_t* up = Z + (size_t)row * ZLD + CU + g * 128 + 32 * ct0 + 4 * hh;
        u32x2 ur[8];
#pragma unroll
        for (int q4 = 0; q4 < 4; ++q4) { ur[2 * q4] = *(const u32x2*)(up + 8 * q4); ur[2 * q4 + 1] = *(const u32x2*)(up + 32 + 8 * q4); }
        asm volatile("" ::: "memory");
        if (it + C.G < 1024) GT_LOAD(it + C.G);
        asm volatile("" ::: "memory");
        __syncthreads();
        f32x16 a0, a1;
#pragma unroll
        for (int i = 0; i < 16; ++i) { a0[i] = 0.f; a1[i] = 0.f; }
        const int tr_q = (l31 & 15) >> 2, tr_p = l31 & 3, tr_blk = (l31 >> 4) & 1;
        const LAS unsigned char* pw = lds + G_W + (32 * nt + l31) * G_WS + 16 * hh;
        const LAS unsigned char* pg = lds + G_G + (8 * hh + tr_q) * G_GS + (32 * ct0 + 16 * tr_blk + 4 * tr_p) * 2;
        for (int ks = 0; ks < 2 * nt + 2; ++ks) { const bf16x8 bw = *(const LAS bf16x8*)(pw + ks * 32);
            a0 = MFMA32(tr_frag(pg + 16 * ks * G_GS, G_GS), bw, a0); a1 = MFMA32(tr_frag(pg + 16 * ks * G_GS + 64, G_GS), bw, a1); }
        const float bias = b_s[g * 128 + n];
        bf16_t* yp = YB + (size_t)row * DM + g * 128 + 32 * ct0 + 4 * hh;
#define G_UNPK(w) (f32x4){__uint_as_float((w).x << 16), __uint_as_float((w).x & 0xffff0000u), __uint_as_float((w).y << 16), __uint_as_float((w).y & 0xffff0000u)}
#pragma unroll
        for (int q4 = 0; q4 < 4; ++q4) {
            const f32x4 o0 = (f32x4){a0[4 * q4], a0[4 * q4 + 1], a0[4 * q4 + 2], a0[4 * q4 + 3]} + bias, o1 = (f32x4){a1[4 * q4], a1[4 * q4 + 1], a1[4 * q4 + 2], a1[4 * q4 + 3]} + bias;
            st_bf4(yp + 8 * q4, gelu4(G_UNPK(ur[2 * q4])) * o0); st_bf4(yp + 32 + 8 * q4, gelu4(G_UNPK(ur[2 * q4 + 1])) * o1); }
#undef G_UNPK
    }
#undef GT_LOAD
    __syncthreads();
}
template <int CH> __device__ __forceinline__ void gate_simple_item(const Ctx& C, int row0, float* gmv_out) {
    LAS float* gvl = (LAS float*)C.lds;
    LAS float* wl = (LAS float*)(C.lds + 65536);
    const bf16_t* Z = C.w<bf16_t>(WS_Z); const float* LNS = C.w<float>(WS_LNS); bf16_t* YB = C.w<bf16_t>(WS_YB);
    const float* w_s = C.in[I_WS]; const float* b_s = C.in[I_BS]; const float* g_gm = C.in[I_GGM];
    for (int g = 0; g < 8; ++g) {
        for (int e = C.tid; e < CH * 128; e += NTHR) { const int m = e >> 7, ch = e & 127; const int row = row0 + m;
            const float mu = LNS[2 * row] * (1.f / 1024.f), var = LNS[2 * row + 1] * (1.f / 1024.f) - mu * mu, rstd = rsqrtf(var + EPS);
            const float x = bf2f(Z[(size_t)row * ZLD + CGV + g * 128 + ch]); const float y = (x - mu) * rstd * g_gm[g * 128 + ch];
            gvl[e] = y; if (gmv_out) gmv_out[(size_t)m * 1024 + g * 128 + ch] = y;
            wl[e] = (ch < CH) ? w_s[((size_t)g * 128 + m) * 128 + ch] : 0.f; }
        __syncthreads();
        const int ch = C.tid & 127;
        for (int n = C.tid >> 7; n < CH; n += 4) { float acc = b_s[g * 128 + n];
            for (int m = 0; m <= n; ++m) acc += wl[n * 128 + m] * gvl[m * 128 + ch];
            const int row = row0 + n; const f32x2 uu = gelu_pk((f32x2){bf2f(Z[(size_t)row * ZLD + CU + g * 128 + ch]), 0.f}); const float u = uu.x;
            YB[(size_t)row * DM + g * 128 + ch] = (bf16_t)f2bf(u * acc); }
        __syncthreads();
    }
}
__device__ __forceinline__ void gate_sample_item(const Ctx& C, int b) {
    const bf16_t* Z = C.w<bf16_t>(WS_Z); const float* LNS = C.w<float>(WS_LNS); bf16_t* YB = C.w<bf16_t>(WS_YB);
    const float* w_s = C.in[I_WS]; const float* b_s = C.in[I_BS]; const float* g_gm = C.in[I_GGM];
    const int row0 = MP + 4 * b; float* gmv = C.out + O_GMV + (size_t)b * 4 * 1024;
    float mu[4], rstd[4];
#pragma unroll
    for (int m = 0; m < 4; ++m) { mu[m] = LNS[2 * (row0 + m)] * (1.f / 1024.f); const float var = LNS[2 * (row0 + m) + 1] * (1.f / 1024.f) - mu[m] * mu[m]; rstd[m] = rsqrtf(var + EPS); }
#pragma unroll
    for (int j = 0; j < 2; ++j) { const int c = C.tid + NTHR * j, g = c >> 7; const float gg = g_gm[c];
        float gv[4];
#pragma unroll
        for (int m = 0; m < 4; ++m) { gv[m] = (bf2f(Z[(size_t)(row0 + m) * ZLD + CGV + c]) - mu[m]) * rstd[m] * gg; gmv[(size_t)m * 1024 + c] = gv[m]; }
#pragma unroll
        for (int n = 0; n < 4; ++n) { float acc = b_s[g * 128 + n];
#pragma unroll
            for (int m = 0; m <= n; ++m) acc += w_s[((size_t)g * 128 + n) * 128 + m] * gv[m];
            const f32x2 uu = gelu_pk((f32x2){bf2f(Z[(size_t)(row0 + n) * ZLD + CU + c]), 0.f});
            YB[(size_t)(row0 + n) * DM + c] = (bf16_t)f2bf(uu.x * acc); } }
}
__device__ __forceinline__ void p2_gating_simple(const Ctx& C) {
#ifdef GATE_SIMPLE
    for (int it = C.vcu; it < 128; it += C.G) gate_simple_item<128>(C, (it >> 4) * 2048 + (it & 15) * 128, nullptr);
#else
    p2_gating_mfma(C);
#endif
    for (int it = C.vcu; it < 128; it += C.G) gate_sample_item(C, it);
}
__device__ __forceinline__ void p3_finalize_ya(const Ctx& C) {
    const bf16_t* Z = C.w<bf16_t>(WS_Z); const bf16_t* OR = C.w<bf16_t>(WS_ORAW); bf16_t* YA = C.w<bf16_t>(WS_YA);
    const float* g_ret = C.in[I_GRET];
    const int gw = C.vcu * NWAVES + C.wave, NGW = C.G * NWAVES, lane = C.lane;
    const int mend = (C.G == 256) ? MP : MT;
    for (int row = gw; row < mend; row += NGW) {
        f32x4 o[8]; float rs[4];
#pragma unroll
        for (int j = 0; j < 8; ++j) o[j] = ld_bf4(OR + (size_t)row * 2048 + 4 * lane + 256 * j);
#pragma unroll
        for (int hd = 0; hd < 4; ++hd) rs[hd] = rsqrtf(wave_sum(sum4(o[2 * hd] * o[2 * hd]) + sum4(o[2 * hd + 1] * o[2 * hd + 1])) * (1.f / 512.f) + EPS);
#pragma unroll
        for (int j = 0; j < 8; ++j) { const int c = 4 * lane + 256 * j;
            const f32x4 gz = silu4(ld_bf4(Z + (size_t)row * ZLD + CG + c)), gr = *(const f32x4*)(g_ret + c);
            st_bf4(YA + (size_t)row * 2048 + c, gz * o[j] * rs[j >> 1] * gr); }
    }
}
__device__ __forceinline__ void p9_final_norm(const Ctx& C) {
    const bf16_t* H3 = C.w<bf16_t>(WS_H3); const float* SSQ4 = C.w<float>(WS_SSQ4); const float* gf = C.in[I_GFIN];
    const int gw = C.vcu * NWAVES + C.wave, NGW = C.G * NWAVES, lane = C.lane;
    f32x4 gv[4];
#pragma unroll
    for (int j = 0; j < 4; ++j) gv[j] = ((const f32x4*)gf)[lane + 64 * j];
    for (int row0 = gw; row0 < MT; row0 += 4 * NGW) {
        u32x2 hv[4][4]; float rs[4];
#pragma unroll
        for (int r = 0; r < 4; ++r) { const int row = row0 + r * NGW; if (row < MT) { rs[r] = SSQ4[row];
#pragma unroll
            for (int j = 0; j < 4; ++j) hv[r][j] = *(const u32x2*)(H3 + (size_t)row * DM + 4 * lane + 256 * j); } }
#pragma unroll
        for (int r = 0; r < 4; ++r) { const int row = row0 + r * NGW; if (row < MT) { const float s = rsqrtf(rs[r] * (1.f / DM) + EPS);
            f32x4* o = (f32x4*)(C.out + O_Y + (size_t)row * DM) + lane;
#pragma unroll
            for (int j = 0; j < 4; ++j) o[64 * j] = (f32x4){__uint_as_float(hv[r][j].x << 16), __uint_as_float(hv[r][j].x & 0xffff0000u), __uint_as_float(hv[r][j].y << 16), __uint_as_float(hv[r][j].y & 0xffff0000u)} * s * gv[j]; } }
    }
}
#ifdef DBG_EXPORT
__device__ __forceinline__ void dbg_export(const Ctx& C) {
    const bf16_t* Z = C.w<bf16_t>(WS_Z); const bf16_t* YA = C.w<bf16_t>(WS_YA); const bf16_t* YB = C.w<bf16_t>(WS_YB);
    const int gw = C.vcu * NWAVES + C.wave, NGW = C.G * NWAVES, lane = C.lane;
    for (int row = gw; row < MT; row += NGW)
        for (int j = 0; j < 4; ++j) { const int c = 4 * lane + 256 * j;
            f32x4 v = (f32x4){0.f, 0.f, 0.f, 0.f};
#if DBG_EXPORT == 1
            v = ld_bf4(YB + (size_t)row * DM + c);
#elif DBG_EXPORT == 4
            v = ld_bf4(YA + (size_t)row * 2048 + c) + ld_bf4(YA + (size_t)row * 2048 + 1024 + c);
#elif DBG_EXPORT == 5
            v = ld_bf4(Z + (size_t)row * ZLD + CGA + c) + ld_bf4(Z + (size_t)row * ZLD + CGB + c);
#elif DBG_EXPORT == 6
            v = ld_bf4(C.w<bf16_t>(WS_ORAW) + (size_t)row * 2048 + c) + ld_bf4(C.w<bf16_t>(WS_ORAW) + (size_t)row * 2048 + 1024 + c);
#elif DBG_EXPORT == 7
            v = ld_bf4(Z + (size_t)row * ZLD + CG + c) + ld_bf4(Z + (size_t)row * ZLD + CG + 1024 + c);
#elif DBG_EXPORT == 8
            v = ld_bf4(Z + (size_t)row * ZLD + CQ + c);
#endif
            *(f32x4*)(C.out + O_Y + (size_t)row * DM + c) = v; }
}
#endif
constexpr int NPHASE = 10;
__global__ void __launch_bounds__(NTHR, 2) mk_fwd(Args args) {
    extern __shared__ __attribute__((aligned(16))) unsigned char lds_raw[];
    Ctx C;
    C.lds = (LAS unsigned char*)lds_raw; C.tid = threadIdx.x; C.lane = C.tid & 63; C.wave = __builtin_amdgcn_readfirstlane(C.tid >> 6);
    C.G = gridDim.x; { const int bx = blockIdx.x; C.vcu = (C.G % 8 == 0) ? (bx % 8) * (C.G / 8) + bx / 8 : bx; }
    C.in = args.in; C.out = args.out; C.ws = args.ws;
    const int lo = args.ph_lo, hi = args.ph_hi;
    if (C.tid < 64) ((LAS unsigned*)(C.lds + LDS_MISC))[C.tid] = 0u;
    __syncthreads();
    const XcdBarrier bar = xcd_barrier_post((unsigned*)(args.ws + WS_CTL) + 4096, (volatile LAS unsigned*)(C.lds + LDS_MISC));
#define IN(k) (lo <= (k) && (k) < hi)
#ifndef PROBE_BSCALE
#define PROBE_BSCALE 0.1f
#endif
#ifdef PROBE_A
    unsigned long long tA0 = 0, tA1 = 0, tB0 = 0, tB1 = 0;
#define PSTAMP(k, which) do { if ((k) == PROBE_A) { if (which) tA1 = __builtin_amdgcn_s_memrealtime(); else tA0 = __builtin_amdgcn_s_memrealtime(); } if ((k) == PROBE_B) { if (which) tB1 = __builtin_amdgcn_s_memrealtime(); else tB0 = __builtin_amdgcn_s_memrealtime(); } } while (0)
#else
#define PSTAMP(k, which) do { } while (0)
#endif
#define SEAM(k) do { if (IN(k) && IN((k) + 1)) { GRID_BAR(); } } while (0)
#define GRID_BAR() do { xcd_barrier(bar); } while (0)
    PSTAMP(0, 0);
    if (IN(0)) { p0_prologue(C); } SEAM(0);
    if (lo < 0) cooperative_groups::this_grid().sync();
    PSTAMP(0, 1);
    PSTAMP(1, 0);
    if (IN(1)) { F1 f{C.w<bf16_t>(WS_Z), C.w<float>(WS_COS), C.w<float>(WS_SIN), C.w<float>(WS_LNS)}; run_gemm(C, C.w<bf16_t>(WS_XN), C.w<bf16_t>(WS_WIN), MT, INW, DM, f);
                 { constexpr int NU = (MT / 256) * (INW / 256); const int rem = NU % C.G;
                   if (rem == 0) p0_deferred(C, (int)blockIdx.x, C.G); else if ((int)blockIdx.x >= rem) p0_deferred(C, (int)blockIdx.x - rem, C.G - rem); } } SEAM(1);
    PSTAMP(1, 1);
    PSTAMP(2, 0);
#ifdef PROBE_P2
    if (IN(2)) { tA0 = __builtin_amdgcn_s_memrealtime(); p2_retention_simple(C); tA1 = __builtin_amdgcn_s_memrealtime(); tB0 = tA1; p2_gating_simple(C); tB1 = __builtin_amdgcn_s_memrealtime(); }
#else
    if (IN(2)) { p2_retention_simple(C); if (C.G != 256) p2_gating_simple(C); }
#endif
    if (IN(2) && IN(4)) { GRID_BAR(); }
    PSTAMP(2, 1);
    PSTAMP(3, 0);
    PSTAMP(3, 1);
    PSTAMP(4, 0);
    if (IN(4)) { { F2a f{C.w<bf16_t>(WS_Z), C.w<bf16_t>(WS_T), C.w<float>(WS_SSQO)}; run_gemm_split(C, C.w<bf16_t>(WS_YA), C.w<bf16_t>(WS_WBRA), DM, 2048, f); }
                 { F2b f{C.w<bf16_t>(WS_Z), C.w<bf16_t>(WS_T), C.w<bf16_t>(WS_MG)}; run_gemm_split(C, C.w<bf16_t>(WS_YB), C.w<bf16_t>(WS_WBRB), DM, DM, f); } } SEAM(4);
    PSTAMP(4, 1);
    PSTAMP(5, 0);
    if (IN(5)) { FRes<false> f{C.in[I_XP], C.in[I_XS], nullptr, C.w<bf16_t>(WS_H1B), C.w<float>(WS_SSQ2)}; run_gemm_split(C, C.w<bf16_t>(WS_MG), C.w<bf16_t>(WS_WO), DM, DM, f); } SEAM(5);
    PSTAMP(5, 1);
    PSTAMP(6, 0);
    if (IN(6)) { F4 f{C.w<float>(WS_SSQ2), C.w<bf16_t>(WS_U)}; run_gemm_split(C, C.w<bf16_t>(WS_H1B), C.w<bf16_t>(WS_WUP), FF, DM, f); } SEAM(6);
    PSTAMP(6, 1);
    PSTAMP(7, 0);
    if (IN(7)) { FRes<true> f{nullptr, nullptr, C.w<bf16_t>(WS_H1B), C.w<bf16_t>(WS_H2B), C.w<float>(WS_SSQ3)}; run_gemm_split(C, C.w<bf16_t>(WS_U), C.w<bf16_t>(WS_WDN), DM, FF, f); } SEAM(7);
    PSTAMP(7, 1);
    PSTAMP(8, 0);
    if (IN(8)) { { F6a f{C.w<bf16_t>(WS_PE)}; run_gemm_split(C, C.w<bf16_t>(WS_PB), C.w<bf16_t>(WS_WPP), DM, PLE, f); }
                 { F6b f{C.w<float>(WS_SSQ3), C.w<bf16_t>(WS_H2B), C.w<bf16_t>(WS_PE), C.w<bf16_t>(WS_H3), C.w<float>(WS_SSQ4)}; run_gemm_split(C, C.w<bf16_t>(WS_H2B), C.w<bf16_t>(WS_WPG), DM, DM, f); } } SEAM(8);
    PSTAMP(8, 1);
    PSTAMP(9, 0);
    if (IN(9)) { p9_final_norm(C); }
    PSTAMP(9, 1);
#ifdef PROBE_A
    GRID_BAR();
    if (blockIdx.x == 0 && C.tid == 0) { float dA = (float)(tA1 - tA0) * 0.01f, dB = (float)(tB1 - tB0) * 0.01f;
#ifdef PROBE_RS
        dA = C.w<float>(WS_CTL)[65536]; dB = C.w<float>(WS_CTL)[65537];
#endif
#ifdef PROBE_ST
        dA = C.w<float>(WS_CTL)[65536 + PROBE_ST_X]; dB = C.w<float>(WS_CTL)[65536 + PROBE_ST_Y];
#endif
        C.out[0] = 0.1f * dA; C.out[O_Y + (size_t)MP * DM] = PROBE_BSCALE * dB; }
#endif
#undef IN
#undef SEAM
#undef GRID_BAR
}
}

extern "C" void kernel_launch(void* const* d_in, const int* in_sizes, int n_in, void* d_out, int out_size, void* d_ws, size_t ws_size, hipStream_t stream) {
    using namespace mk;
    static int grid = 0;
    if (grid == 0) {
        if (n_in != 21 || (size_t)out_size != O_END || ws_size < WS_END) { fprintf(stderr, "kernel_launch: unexpected shapes: n_in %d out %d ws %zu (need %zu)\n", n_in, out_size, ws_size, (size_t)WS_END); grid = -1; return; }
        int dev = 0, cus = 0;
        if (hipGetDevice(&dev) != hipSuccess || hipDeviceGetAttribute(&cus, hipDeviceAttributeMultiprocessorCount, dev) != hipSuccess) { grid = -1; return; }
        if (hipFuncSetAttribute((const void*)mk_fwd, hipFuncAttributeMaxDynamicSharedMemorySize, LDS_BYTES) != hipSuccess) { fprintf(stderr, "kernel_launch: hipFuncSetAttribute failed\n"); grid = -1; return; }
        int per_cu = 0;
        if (hipOccupancyMaxActiveBlocksPerMultiprocessor(&per_cu, (const void*)mk_fwd, NTHR, LDS_BYTES) != hipSuccess || per_cu < 1) { fprintf(stderr, "kernel_launch: occupancy query says %d blocks/CU\n", per_cu); (void)hipGetLastError(); grid = -1; return; }
        if (cus != 256) { fprintf(stderr, "kernel_launch: built for a 256-CU device (the retention phase deals exactly one prompt item and two sample items per workgroup); found %d CUs\n", cus); grid = -1; return; }
        grid = cus;
    }
    if (grid < 0) return;
    (void)hipMemsetAsync((char*)d_ws, 0, WS_ZERO_END, stream);
    Args a{};
    for (int i = 0; i < 21; ++i) a.in[i] = (const float*)d_in[i];
    a.out = (float*)d_out; a.ws = (unsigned char*)d_ws;
#ifdef MK_MULTI
    for (int p = 0; p < NPHASE; ++p) { a.ph_lo = p; a.ph_hi = p + 1; hipLaunchKernelGGL(mk_fwd, dim3(grid), dim3(NTHR), LDS_BYTES, stream, a); }
#else
    a.ph_lo = 0; a.ph_hi = NPHASE;
    void* kargs[] = {&a};
    const hipError_t le = hipLaunchCooperativeKernel((const void*)mk_fwd, dim3(grid), dim3(NTHR), kargs, LDS_BYTES, stream);
    if (le != hipSuccess) fprintf(stderr, "kernel_launch: cooperative launch failed: %s (grid %d)\n", hipGetErrorString(le), grid);
#endif
}
```

```cpp
#include <hip/hip_runtime.h>
#include <hip/hip_cooperative_groups.h>
#include <cstdio>
#include <cstdint>
namespace pg8 {
#define PG8_LAS __attribute__((address_space(3)))
typedef unsigned short bf16_t;
typedef short bf16x8 __attribute__((ext_vector_type(8)));
typedef float f32x4 __attribute__((ext_vector_type(4)));
typedef unsigned u32x4 __attribute__((ext_vector_type(4)));
constexpr int BM = 256, BK = 64, HALF = 128, HTB = HALF * BK * 2  , STAGE_BYTES = 8 * HTB, NXCD = 8, WGM = 4;

__host__ __device__ __forceinline__ int lds_byte(int r, int c) { const int st = (r >> 4) * 2 + (c >> 5), rr = r & 15, cc = c & 31, ob = rr * 64 + cc * 2; return st * 1024 + (ob ^ (((ob >> 9) & 1) << 5)); }
__host__ __device__ __forceinline__ void stage_rc(int b, int& R, int& C) { const int st = b / 1024, sb = b % 1024, swz = sb ^ (((sb >> 9) & 1) << 5); R = (st >> 1) * 16 + swz / 64; C = (st & 1) * 32 + (swz % 64) / 2; }
__host__ __device__ __forceinline__ int perm32(int rho) { const int n = rho >> 4, i = rho & 15; return 8 * (i >> 2) + 4 * n + (i & 3); }

struct Unit { int pm, pn; };
struct Gemm { const bf16_t* A; const bf16_t* Bt; int M, N, K; };

struct StaticOrder {
    int nM, nN, nwg, G, c;
    __host__ __device__ void init(int M, int N, int G_, int c_) { nM = M / BM; nN = N / BM; nwg = nM * nN; G = G_; c = c_; }
    __host__ __device__ bool next(int i, Unit& u) const {
        const long L = (long)i * G + c; if (L >= nwg) return false;
        int wgid = (int)L; { const int q = nwg / NXCD, r = nwg % NXCD, xcd = wgid % NXCD, off = wgid / NXCD; wgid = (xcd < r ? xcd * (q + 1) : r * (q + 1) + (xcd - r) * q) + off; }
        const int nig = WGM * nN, gid = wgid / nig, fm = gid * WGM, gsz = (nM - fm) < WGM ? (nM - fm) : WGM;
        u.pm = fm + ((wgid % nig) % gsz); u.pn = (wgid % nig) / gsz; return true;
    }
    __device__ __forceinline__ void a_ready(const Unit&) const {}
    __device__ __forceinline__ void done(const Unit&) const {}
};

__device__ __forceinline__ unsigned cvt_pk_bf16(float lo, float hi) { unsigned r; asm volatile("v_cvt_pk_bf16_f32 %0, %1, %2" : "=v"(r) : "v"(lo), "v"(hi)); return r; }
typedef float f32x2 __attribute__((ext_vector_type(2)));
__device__ __forceinline__ f32x2 gelu_pk(f32x2 v) {
    const f32x2 av = __builtin_elementwise_abs(v), d = av * 0.2316418882f + 1.0f;
    f32x2 t; t.x = __builtin_amdgcn_rcpf(d.x); t.y = __builtin_amdgcn_rcpf(d.y);
    f32x2 q = t * 0.5307027145f + (-0.7265760135f); q = q * t + 0.7107068705f; q = q * t + (-0.142248368f); q = q * t + 0.127414796f; q = q * t;
    const f32x2 s = (v * v) * (-0.72134752044f);
    f32x2 e; e.x = __builtin_amdgcn_exp2f(s.x); e.y = __builtin_amdgcn_exp2f(s.y);
    const f32x2 m = v * (q * e), r = v - m;
    f32x2 o; o.x = v.x < 0.f ? m.x : r.x; o.y = v.y < 0.f ? m.y : r.y; return o;
}
template <class Epi, class Sched, bool ALIGN_EPI = false, bool SP2 = false>
__device__ __forceinline__ void gemm_phase(PG8_LAS unsigned char* lds, const Gemm g, const Sched& S, const Epi& E) {
    const int tid = threadIdx.x, wid = __builtin_amdgcn_readfirstlane(tid >> 6), lane = tid & 63, wr = wid >> 2, wc = wid & 3, fr = lane & 15, fq = lane >> 4;
    const int K = g.K, nt = K / BK;
    unsigned voffA[2], voffB[2];
#pragma unroll
    for (int i = 0; i < 2; ++i) { int R, C; stage_rc(tid * 16 + i * 8192, R, C); const int Rb = Epi::PERM ? ((R & ~31) + perm32(R & 31)) : R;
        voffA[i] = (unsigned)(R * K + C) * 2u; voffB[i] = (unsigned)(Rb * K + C) * 2u; }
    const size_t kstep = (size_t)(BK * 2);
    const size_t hstep = (size_t)HALF * K * 2;
    const size_t tstep = 2 * hstep;
    const unsigned ldsw = (unsigned)wid * 1024u;
    const int aoff = lds_byte(wr * 64 + fr, fq * 8), boff = lds_byte(wc * 32 + fr, fq * 8);
#define PG8_SA(b, h) (((b) * 2 + (h)) * HTB)
#define PG8_SB(b, h) ((4 + (b) * 2 + (h)) * HTB)
#define PG8_STAGE(bufoff, gbase, voff) do { _Pragma("unroll") for (int _i = 0; _i < 2; ++_i) \
        __builtin_amdgcn_global_load_lds((const unsigned*)((const char*)(gbase) + (voff)[_i]), (PG8_LAS unsigned*)(lds + (bufoff) + ldsw + _i * 8192), 16, 0, 0); } while (0)
#define PG8_LDA(dst, b, h) do { _Pragma("unroll") for (int m = 0; m < 4; ++m) _Pragma("unroll") for (int k = 0; k < 2; ++k) dst[m][k] = *(const PG8_LAS bf16x8*)(lds + PG8_SA(b, h) + aoff + m * 2048 + k * 1024); } while (0)
#define PG8_LDB(dst, b, h) do { _Pragma("unroll") for (int n = 0; n < 2; ++n) _Pragma("unroll") for (int k = 0; k < 2; ++k) dst[n][k] = *(const PG8_LAS bf16x8*)(lds + PG8_SB(b, h) + boff + n * 2048 + k * 1024); } while (0)
#define PG8_MMA(ai, bj, At, Bt) do { __builtin_amdgcn_s_setprio(1); _Pragma("unroll") for (int m = 0; m < 4; ++m) _Pragma("unroll") for (int n = 0; n < 2; ++n) _Pragma("unroll") for (int k = 0; k < 2; ++k) \
        acc[ai][bj][m][n] = __builtin_amdgcn_mfma_f32_16x16x32_bf16(Bt[n][k], At[m][k], acc[ai][bj][m][n], 0, 0, 0); __builtin_amdgcn_s_setprio(0); } while (0)
#define PG8_WAIT_V(n) asm volatile("s_waitcnt vmcnt(" #n ")" ::: "memory")
#define PG8_WAIT_L(n) asm volatile("s_waitcnt lgkmcnt(" #n ")" ::: "memory")
#define PG8_BAR __builtin_amdgcn_s_barrier()
#define PG8_SCHED __builtin_amdgcn_sched_barrier(0)
    Unit cur, nxt; int ui = 0;
    if (!S.next(0, cur)) return;
    f32x4 acc[2][2][4][2];
#pragma unroll
    for (int a = 0; a < 2; ++a)
#pragma unroll
        for (int b = 0; b < 2; ++b)
#pragma unroll
            for (int m = 0; m < 4; ++m)
#pragma unroll
                for (int n = 0; n < 2; ++n) acc[a][b][m][n] = (f32x4){0.f, 0.f, 0.f, 0.f};
    bf16x8 At[4][2], B0[2][2], B1[2][2];
    const char* cA = (const char*)g.A + (size_t)cur.pm * tstep; const char* cB = (const char*)g.Bt + (size_t)cur.pn * tstep;
    S.a_ready(cur);
    if constexpr (SP2) {
        PG8_STAGE(PG8_SB(0, 0), cB, voffB); PG8_STAGE(PG8_SB(0, 1), cB + hstep, voffB); PG8_STAGE(PG8_SA(0, 0), cA, voffA); PG8_STAGE(PG8_SA(0, 1), cA + hstep, voffA);
        if (wr == 1) PG8_BAR;
        PG8_WAIT_V(2); PG8_BAR;
        PG8_STAGE(PG8_SB(1, 0), cB + kstep, voffB); PG8_STAGE(PG8_SA(1, 0), cA + kstep, voffA); PG8_STAGE(PG8_SB(1, 1), cB + hstep + kstep, voffB);
        PG8_WAIT_V(6); PG8_BAR;
    } else {
        PG8_STAGE(PG8_SB(0, 0), cB, voffB); PG8_STAGE(PG8_SA(0, 0), cA, voffA); PG8_STAGE(PG8_SB(0, 1), cB + hstep, voffB); PG8_STAGE(PG8_SA(0, 1), cA + hstep, voffA);
        if (wr == 1) PG8_BAR;
        PG8_WAIT_V(4); PG8_BAR;
        PG8_STAGE(PG8_SB(1, 0), cB + kstep, voffB); PG8_STAGE(PG8_SA(1, 0), cA + kstep, voffA); PG8_STAGE(PG8_SB(1, 1), cB + hstep + kstep, voffB);
        PG8_WAIT_V(6); PG8_BAR;
    }
    for (;;) {
        const bool has_next = S.next(ui + 1, nxt);
        const char* nA = has_next ? (const char*)g.A + (size_t)nxt.pm * tstep : cA; const char* nB = has_next ? (const char*)g.Bt + (size_t)nxt.pn * tstep : cB;
        for (int t = 0; t < nt; t += 2) {
            if constexpr (Epi::HOOK) { if ((t & 7) == 0) E.khook(acc, cur, t, wr, wc, fr, fq); }
            const bool last = (t == nt - 2);
            const char* a1 = cA + (size_t)(t + 1) * kstep;
            const char* a2 = last ? nA : cA + (size_t)(t + 2) * kstep; const char* b2 = last ? nB : cB + (size_t)(t + 2) * kstep;
            const char* a3 = a2 + kstep; const char* b3 = b2 + kstep;
            if (last && has_next) S.a_ready(nxt);
            if constexpr (SP2) {
            PG8_LDB(B0, 0, 0); PG8_LDB(B1, 0, 1); PG8_SCHED; PG8_LDA(At, 0, 0); PG8_STAGE(PG8_SA(1, 1), a1 + hstep, voffA);
            PG8_WAIT_V(8); PG8_WAIT_L(0); PG8_BAR; PG8_MMA(0, 0, At, B0); PG8_MMA(0, 1, At, B1); PG8_BAR; PG8_SCHED;
            PG8_LDA(At, 0, 1); PG8_STAGE(PG8_SB(0, 0), b2, voffB); PG8_STAGE(PG8_SB(0, 1), b2 + hstep, voffB); PG8_STAGE(PG8_SA(0, 0), a2, voffA);
            PG8_WAIT_V(8); PG8_WAIT_L(0); PG8_BAR; PG8_MMA(1, 0, At, B0); PG8_MMA(1, 1, At, B1); PG8_BAR; PG8_SCHED;
            PG8_LDB(B0, 1, 0); PG8_LDB(B1, 1, 1); PG8_SCHED; PG8_LDA(At, 1, 0); PG8_STAGE(PG8_SA(0, 1), a2 + hstep, voffA);
            PG8_WAIT_V(8); PG8_WAIT_L(0); PG8_BAR; PG8_MMA(0, 0, At, B0); PG8_MMA(0, 1, At, B1); PG8_BAR; PG8_SCHED;
            PG8_LDA(At, 1, 1); PG8_STAGE(PG8_SB(1, 0), b3, voffB); PG8_STAGE(PG8_SB(1, 1), b3 + hstep, voffB); PG8_STAGE(PG8_SA(1, 0), a3, voffA);
            PG8_WAIT_V(8); PG8_WAIT_L(0); PG8_BAR; PG8_MMA(1, 0, At, B0); PG8_MMA(1, 1, At, B1); PG8_BAR; PG8_SCHED;
            } else {
            PG8_LDB(B0, 0, 0); PG8_SCHED; PG8_LDA(At, 0, 0); PG8_STAGE(PG8_SA(1, 1), a1 + hstep, voffA);
            PG8_WAIT_L(8); PG8_BAR; PG8_WAIT_L(0); PG8_MMA(0, 0, At, B0); PG8_BAR; PG8_SCHED;
            PG8_LDB(B1, 0, 1); PG8_STAGE(PG8_SB(0, 0), b2, voffB);
            PG8_BAR; PG8_WAIT_L(0); PG8_MMA(0, 1, At, B1); PG8_BAR;
            PG8_LDA(At, 0, 1); PG8_STAGE(PG8_SA(0, 0), a2, voffA);
            PG8_BAR; PG8_WAIT_L(0); PG8_MMA(1, 0, At, B0); PG8_BAR; PG8_SCHED;
            PG8_STAGE(PG8_SB(0, 1), b2 + hstep, voffB);
            PG8_WAIT_V(6); PG8_BAR; PG8_MMA(1, 1, At, B1); PG8_BAR;
            PG8_LDB(B0, 1, 0); PG8_SCHED; PG8_LDA(At, 1, 0); PG8_STAGE(PG8_SA(0, 1), a2 + hstep, voffA);
            PG8_WAIT_L(8); PG8_BAR; PG8_WAIT_L(0); PG8_MMA(0, 0, At, B0); PG8_BAR; PG8_SCHED;
            PG8_LDB(B1, 1, 1); PG8_STAGE(PG8_SB(1, 0), b3, voffB);
            PG8_BAR; PG8_WAIT_L(0); PG8_MMA(0, 1, At, B1); PG8_BAR;
            PG8_LDA(At, 1, 1); PG8_STAGE(PG8_SA(1, 0), a3, voffA);
            PG8_BAR; PG8_WAIT_L(0); PG8_MMA(1, 0, At, B0); PG8_BAR; PG8_SCHED;
            PG8_STAGE(PG8_SB(1, 1), b3 + hstep, voffB);
            PG8_WAIT_V(6); PG8_BAR; PG8_MMA(1, 1, At, B1); PG8_BAR;
            }
        }
        if constexpr (ALIGN_EPI) { if (wr == 0) PG8_BAR; }
        if constexpr (!Epi::AFTER_DRAIN) { E(acc, cur, wr, wc, fr, fq); S.done(cur); }
        if (!has_next) break;
#pragma unroll
        for (int a = 0; a < 2; ++a)
#pragma unroll
            for (int b = 0; b < 2; ++b)
#pragma unroll
                for (int m = 0; m < 4; ++m)
#pragma unroll
                    for (int n = 0; n < 2; ++n) acc[a][b][m][n] = (f32x4){0.f, 0.f, 0.f, 0.f};
        cur = nxt; cA = nA; cB = nB; ++ui;
        if constexpr (ALIGN_EPI) { if (wr == 1) PG8_BAR; }
    }
    PG8_WAIT_V(0);
    if constexpr (!ALIGN_EPI) { if (wr == 0) PG8_BAR; }
    PG8_BAR;
    if constexpr (Epi::AFTER_DRAIN) { E.fused(acc, cur, wr, wc, fr, fq, lds, wid, lane); S.done(cur); }
#undef PG8_SA
#undef PG8_SB
#undef PG8_STAGE
#undef PG8_LDA
#undef PG8_LDB
#undef PG8_MMA
#undef PG8_WAIT_V
#undef PG8_WAIT_L
#undef PG8_BAR
#undef PG8_SCHED
}
}

namespace mk {
using pg8::bf16_t; using pg8::f32x4; using pg8::f32x2; using pg8::Unit; using pg8::cvt_pk_bf16; using pg8::gelu_pk;
typedef unsigned u32x2 __attribute__((ext_vector_type(2)));
typedef unsigned u32x4 __attribute__((ext_vector_type(4)));
#define LAS __attribute__((address_space(3)))

constexpr int MP = 16384, MS = 512, MT = MP + MS, DM = 1024, INW = 10240, FF = 4096, PLE = 256;
constexpr int ZLD = INW + 128;
constexpr int CQ = 0, CK = 1024, CV = 2048, CG = 4096, CU = 6144, CGV = 7168, CGA = 8192, CGB = 9216;
constexpr int NTAB = 2048 + 4;
constexpr float EPS = 1e-6f;
constexpr int NWAVES = 8, NTHR = 512;

constexpr size_t O_Y = 0;
constexpr size_t O_SRP = (size_t)MT * DM;
constexpr size_t O_SRS = O_SRP + (size_t)8 * 4 * 256 * 512;
constexpr size_t O_GMV = O_SRS + (size_t)128 * 4 * 256 * 512;
constexpr size_t O_END = O_GMV + (size_t)128 * 4 * 1024;

constexpr size_t al256(size_t x) { return (x + 255) & ~(size_t)255; }
constexpr size_t WS_CTL = 0, CTL_BYTES = 1u << 20;
constexpr size_t WS_LNS = WS_CTL + CTL_BYTES;
constexpr size_t WS_SSQO = WS_LNS + al256((size_t)MT * 2 * 4);
constexpr size_t WS_SSQ2 = WS_SSQO + al256((size_t)MT * 4 * 4);
constexpr size_t WS_SSQ3 = WS_SSQ2 + al256((size_t)MT * 4);
constexpr size_t WS_SSQ4 = WS_SSQ3 + al256((size_t)MT * 4);
constexpr size_t WS_ZERO_END = WS_SSQ4 + al256((size_t)MT * 4);
constexpr size_t WS_COS = al256(WS_ZERO_END);
constexpr size_t WS_SIN = WS_COS + al256((size_t)NTAB * 128 * 4);
constexpr size_t WS_WIN = WS_SIN + al256((size_t)NTAB * 128 * 4);
constexpr size_t WS_WBRA = WS_WIN + (size_t)INW * DM * 2;
constexpr size_t WS_WBRB = WS_WBRA + (size_t)DM * 2048 * 2;
constexpr size_t WS_WO = WS_WBRB + (size_t)DM * DM * 2;
constexpr size_t WS_WUP = WS_WO + (size_t)DM * DM * 2;
constexpr size_t WS_WDN = WS_WUP + (size_t)FF * DM * 2;
constexpr size_t WS_WPG = WS_WDN + (size_t)DM * FF * 2;
constexpr size_t WS_WPP = WS_WPG + (size_t)DM * DM * 2;
constexpr size_t WS_WSB = WS_WPP + (size_t)DM * PLE * 2;
constexpr size_t WS_XN = WS_WSB + (size_t)8 * 128 * 128 * 2;
constexpr size_t WS_PB = WS_XN + (size_t)MT * DM * 2;
constexpr size_t WS_A = WS_PB + (size_t)MT * PLE * 2;
constexpr size_t WS_Z = WS_A;
constexpr size_t WS_U = WS_A;
constexpr size_t WS_H2 = WS_U + (size_t)MT * FF * 2;
constexpr size_t WS_H2B = WS_H2 + (size_t)MT * DM * 4;
constexpr size_t WS_PE = WS_H2B + (size_t)MT * DM * 2;
constexpr size_t WS_A_END = WS_A + (size_t)MT * ZLD * 2;
static_assert(WS_PE + (size_t)MT * DM * 4 <= WS_A_END, "region A overlay");
constexpr size_t WS_ORAW = WS_A_END;
constexpr size_t WS_H3 = WS_ORAW;
constexpr size_t WS_YA = WS_ORAW + (size_t)MT * 2048 * 2;
constexpr size_t WS_YB = WS_YA + (size_t)MT * 2048 * 2;
constexpr size_t WS_T = WS_YB + (size_t)MT * DM * 2;
constexpr size_t WS_MG = WS_T + (size_t)MT * DM * 4;
constexpr size_t WS_H1 = WS_MG + (size_t)MT * DM * 2;
constexpr size_t WS_H1B = WS_H1 + (size_t)MT * DM * 4;
constexpr size_t WS_END = WS_H1B + (size_t)MT * DM * 2;

constexpr int LDS_RING = 131072, LDS_BYTES = 163840, LDS_MISC = LDS_BYTES - 256;

struct Args {
    const float* in[21]; float* out; unsigned char* ws; int ph_lo, ph_hi;
};

__device__ __forceinline__ float bf2f(unsigned short u) { return __uint_as_float((unsigned)u << 16); }
__device__ __forceinline__ unsigned f2bf(float f) { unsigned u = __float_as_uint(f); return (u + 0x7fffu + ((u >> 16) & 1u)) >> 16; }
__device__ __forceinline__ unsigned pk2(float lo, float hi) { return f2bf(lo) | (f2bf(hi) << 16); }
__device__ __forceinline__ f32x4 ld_bf4(const bf16_t* p) { const u32x2 w = *(const u32x2*)p; return (f32x4){__uint_as_float(w.x << 16), __uint_as_float(w.x & 0xffff0000u), __uint_as_float(w.y << 16), __uint_as_float(w.y & 0xffff0000u)}; }
typedef float f32x2_t __attribute__((ext_vector_type(2))); typedef __bf16 bf16x2_t __attribute__((ext_vector_type(2)));
__device__ __forceinline__ unsigned cvtpk(float lo, float hi) { const f32x2_t v = {lo, hi}; const bf16x2_t b = __builtin_convertvector(v, bf16x2_t); return __builtin_bit_cast(unsigned, b); }
__device__ __forceinline__ void st_bf4(bf16_t* p, f32x4 v) { u32x2 w; w.x = cvtpk(v[0], v[1]); w.y = cvtpk(v[2], v[3]); *(u32x2*)p = w; }
__device__ __forceinline__ void ld_bf8(const bf16_t* p, f32x4& a, f32x4& b) { const u32x4 w = *(const u32x4*)p;
    a = (f32x4){__uint_as_float(w.x << 16), __uint_as_float(w.x & 0xffff0000u), __uint_as_float(w.y << 16), __uint_as_float(w.y & 0xffff0000u)};
    b = (f32x4){__uint_as_float(w.z << 16), __uint_as_float(w.z & 0xffff0000u), __uint_as_float(w.w << 16), __uint_as_float(w.w & 0xffff0000u)}; }
__device__ __forceinline__ void st_bf8(bf16_t* p, f32x4 a, f32x4 b) { u32x4 w; w.x = cvtpk(a[0], a[1]); w.y = cvtpk(a[2], a[3]); w.z = cvtpk(b[0], b[1]); w.w = cvtpk(b[2], b[3]); *(u32x4*)p = w; }
__device__ __forceinline__ float sigmoidf_(float x) { return __builtin_amdgcn_rcpf(1.0f + __builtin_amdgcn_exp2f(-1.4426950408889634f * x)); }
__device__ __forceinline__ f32x4 sigmoid4(f32x4 v) { return (f32x4){sigmoidf_(v[0]), sigmoidf_(v[1]), sigmoidf_(v[2]), sigmoidf_(v[3])}; }
__device__ __forceinline__ f32x4 silu4(f32x4 v) { return v * sigmoid4(v); }
__device__ __forceinline__ f32x4 gelu4(f32x4 v) { const f32x2 a = gelu_pk((f32x2){v[0], v[1]}), b = gelu_pk((f32x2){v[2], v[3]}); return (f32x4){a.x, a.y, b.x, b.y}; }
__device__ __forceinline__ float sum4(f32x4 v) { return (v[0] + v[1]) + (v[2] + v[3]); }
__device__ __forceinline__ float wave_sum(float v) {
#pragma unroll
    for (int o = 1; o < 64; o <<= 1) v += __shfl_xor(v, o);
    return v;
}
__device__ __forceinline__ int tab_index(int row) { return row < MP ? (row & 2047) : 2048 + (row & 3); }

template <class F> struct EpiGen {
    static constexpr bool PERM = true, AFTER_DRAIN = false, HOOK = F::HOOK;
    F f;
    __device__ __forceinline__ void khook(f32x4 (&acc)[2][2][4][2], const Unit& u, int t, int wr, int wc, int fr, int fq) const { f.khook(acc, u.pm * 256 + wr * 64 + fr, t); }
    template <int KIND> __device__ __forceinline__ void run(const f32x4 (&acc)[2][2][4][2], int row0, int col0, int fq) const {
#pragma unroll
        for (int ai = 0; ai < 2; ++ai)
#pragma unroll
            for (int m = 0; m < 4; ++m) {
                const int row = row0 + ai * 128 + m * 16;
                float red[2] = {0.f, 0.f};
                const typename F::RowCtx rc = f.template row_begin<KIND>(row);
                f.template oct<KIND>(rc, row, col0, acc[ai][0][m][0], acc[ai][0][m][1], col0 + 128, acc[ai][1][m][0], acc[ai][1][m][1], red);
                if (F::template nred<KIND>() > 0) {
                    red[0] += __shfl_xor(red[0], 16); red[0] += __shfl_xor(red[0], 32);
                    if (F::template nred<KIND>() > 1) { red[1] += __shfl_xor(red[1], 16); red[1] += __shfl_xor(red[1], 32); }
                    if (fq == 0) f.template row_add<KIND>(row, red);
                }
                asm volatile("" ::: "memory");
            }
    }
    __device__ __forceinline__ void operator()(const f32x4 (&acc)[2][2][4][2], const Unit& u, int wr, int wc, int fr, int fq) const {
        const int row0 = u.pm * 256 + wr * 64 + fr, col0 = u.pn * 256 + wc * 32 + 8 * fq;
        const int kind = f.kind(u.pn * 256);
        if (F::NK == 1) { run<0>(acc, row0, col0, fq); return; }
        switch (kind) {
            case 0: run<0>(acc, row0, col0, fq); break;
            case 1: run<(F::NK > 1 ? 1 : 0)>(acc, row0, col0, fq); break;
            case 2: run<(F::NK > 2 ? 2 : 0)>(acc, row0, col0, fq); break;
            case 3: run<(F::NK > 3 ? 3 : 0)>(acc, row0, col0, fq); break;
            case 4: run<(F::NK > 4 ? 4 : 0)>(acc, row0, col0, fq); break;
            default: run<(F::NK > 5 ? 5 : 0)>(acc, row0, col0, fq); break;
        }
    }
};
#define F_NOHOOK static constexpr bool HOOK = false; __device__ __forceinline__ void khook(f32x4 (&)[2][2][4][2], int, int) const {}
#define F_COMMON1 static constexpr int NK = 1; __device__ __forceinline__ int kind(int) const { return 0; }

struct F1 {
    F_NOHOOK static constexpr int NK = 6; typedef int RowCtx;
    bf16_t* Z; const float* cosT; const float* sinT; float* LNS;
    __device__ __forceinline__ int kind(int cb) const { return cb < CV ? 0 : cb < CG ? 1 : cb < CU ? 2 : cb < CGV ? 3 : cb < CGA ? 4 : 5; }
    template <int K> static __device__ __forceinline__ constexpr int nred() { return K == 4 ? 2 : 0; }
    template <int K> __device__ __forceinline__ RowCtx row_begin(int row) const { return K == 0 ? tab_index(row) * 128 : 0; }
    template <int K> __device__ __forceinline__ void oct(RowCtx rc, int row, int c0, f32x4 a0, f32x4 a1, int c1, f32x4 b0, f32x4 b1, float (&red)[2]) const {
        bf16_t* zr = Z + (size_t)row * ZLD;
        if (K == 0) { const int i0 = c0 & 255; const f32x4 cs0 = *(const f32x4*)(cosT + rc + i0), cs1 = *(const f32x4*)(cosT + rc + i0 + 4), sn0 = *(const f32x4*)(sinT + rc + i0), sn1 = *(const f32x4*)(sinT + rc + i0 + 4);
            st_bf8(zr + c0, a0 * cs0 - b0 * sn0, a1 * cs1 - b1 * sn1); st_bf8(zr + c1, b0 * cs0 + a0 * sn0, b1 * cs1 + a1 * sn1); }
        else if (K == 1) { st_bf8(zr + c0, a0, a1); st_bf8(zr + c1, b0, b1); }
        else if (K == 2 || K == 3) { st_bf8(zr + c0, a0, a1); st_bf8(zr + c1, b0, b1); }
        else if (K == 4) { const f32x4 g0 = gelu4(a0), g1 = gelu4(a1), g2 = gelu4(b0), g3 = gelu4(b1); st_bf8(zr + c0, g0, g1); st_bf8(zr + c1, g2, g3);
            red[0] += (sum4(g0) + sum4(g1)) + (sum4(g2) + sum4(g3)); red[1] += (sum4(g0 * g0) + sum4(g1 * g1)) + (sum4(g2 * g2) + sum4(g3 * g3)); }
        else { st_bf8(zr + c0, sigmoid4(a0), sigmoid4(a1)); st_bf8(zr + c1, sigmoid4(b0), sigmoid4(b1)); }
    }
    template <int K> __device__ __forceinline__ void row_add(int row, const float (&red)[2]) const { atomicAdd(LNS + 2 * row, red[0]); atomicAdd(LNS + 2 * row + 1, red[1]); }
};
struct F2a {
    static constexpr bool HOOK = true; F_COMMON1 typedef float RowCtx;
    const bf16_t* Z; bf16_t* T; const float* SSQO;
    __device__ __forceinline__ void khook(f32x4 (&acc)[2][2][4][2], int row0, int t) const {
        int h = t >> 3; asm volatile("" : "+s"(h));
        if (h == 0) return;
        const float* p = SSQO + (size_t)row0 * 4 + (h - 1);
        float s0[8], s1[8];
#pragma unroll
        for (int g = 0; g < 8; ++g) { s0[g] = p[((g >> 2) * 128 + (g & 3) * 16) * 4]; s1[g] = p[((g >> 2) * 128 + (g & 3) * 16) * 4 + 1]; }
#pragma unroll
        for (int g = 0; g < 8; ++g) { const float ratio = sqrtf((s1[g] * (1.f / 512.f) + EPS) / (s0[g] * (1.f / 512.f) + EPS));
#pragma unroll
            for (int bj = 0; bj < 2; ++bj)
#pragma unroll
                for (int n = 0; n < 2; ++n) acc[g >> 2][bj][g & 3][n] = acc[g >> 2][bj][g & 3][n] * ratio; }
    }
    template <int K> static __device__ __forceinline__ constexpr int nred() { return 0; }
    template <int K> __device__ __forceinline__ RowCtx row_begin(int row) const { return row < MP ? rsqrtf(SSQO[row * 4 + 3] * (1.f / 512.f) + EPS) : 1.0f; }
    template <int K> __device__ __forceinline__ void oct(RowCtx rs, int row, int c0, f32x4 a0, f32x4 a1, int c1, f32x4 b0, f32x4 b1, float (&)[2]) const {
        const bf16_t* g = Z + (size_t)row * ZLD + CGA; bf16_t* t = T + (size_t)row * DM; f32x4 g0, g1;
        ld_bf8(g + c0, g0, g1); st_bf8(t + c0, g0 * a0 * rs, g1 * a1 * rs); ld_bf8(g + c1, g0, g1); st_bf8(t + c1, g0 * b0 * rs, g1 * b1 * rs);
    }
    template <int K> __device__ __forceinline__ void row_add(int, const float (&)[2]) const {}
};
struct F2b {
    F_NOHOOK F_COMMON1 typedef int RowCtx;
    const bf16_t* Z; const bf16_t* T; bf16_t* MG;
    template <int K> static __device__ __forceinline__ constexpr int nred() { return 0; }
    template <int K> __device__ __forceinline__ RowCtx row_begin(int) const { return 0; }
    template <int K> __device__ __forceinline__ void oct(RowCtx, int row, int c0, f32x4 a0, f32x4 a1, int c1, f32x4 b0, f32x4 b1, float (&)[2]) const {
        const bf16_t* g = Z + (size_t)row * ZLD + CGB; const bf16_t* t = T + (size_t)row * DM; bf16_t* o = MG + (size_t)row * DM; f32x4 g0, g1, t0, t1;
        ld_bf8(g + c0, g0, g1); ld_bf8(t + c0, t0, t1); st_bf8(o + c0, t0 + g0 * a0, t1 + g1 * a1);
        ld_bf8(g + c1, g0, g1); ld_bf8(t + c1, t0, t1); st_bf8(o + c1, t0 + g0 * b0, t1 + g1 * b1);
    }
    template <int K> __device__ __forceinline__ void row_add(int, const float (&)[2]) const {}
};
template <bool BF> struct FRes {
    F_NOHOOK F_COMMON1 typedef size_t RowCtx;
    const float* baseP; const float* baseS; const bf16_t* baseB; bf16_t* HB; float* SSQ;
    template <int K> static __device__ __forceinline__ constexpr int nred() { return 1; }
    template <int K> __device__ __forceinline__ RowCtx row_begin(int row) const { return (size_t)row * DM; }
    template <int K> __device__ __forceinline__ void oct(RowCtx ro, int row, int c0, f32x4 a0, f32x4 a1, int c1, f32x4 b0, f32x4 b1, float (&red)[2]) const {
        f32x4 x0, x1, x2, x3;
        if (BF) { ld_bf8(baseB + ro + c0, x0, x1); ld_bf8(baseB + ro + c1, x2, x3); }
        else { const float* xr = row < MP ? baseP + ro : baseS + (ro - (size_t)MP * DM); x0 = *(const f32x4*)(xr + c0); x1 = *(const f32x4*)(xr + c0 + 4); x2 = *(const f32x4*)(xr + c1); x3 = *(const f32x4*)(xr + c1 + 4); }
        const f32x4 h0 = x0 + a0, h1 = x1 + a1, h2 = x2 + b0, h3 = x3 + b1;
        st_bf8(HB + ro + c0, h0, h1); st_bf8(HB + ro + c1, h2, h3);
        red[0] += (sum4(h0 * h0) + sum4(h1 * h1)) + (sum4(h2 * h2) + sum4(h3 * h3));
    }
    template <int K> __device__ __forceinline__ void row_add(int row, const float (&red)[2]) const { atomicAdd(SSQ + row, red[0]); }
};
struct F4 {
    F_NOHOOK F_COMMON1 typedef float RowCtx;
    const float* SSQ; bf16_t* U;
    template <int K> static __device__ __forceinline__ constexpr int nred() { return 0; }
    template <int K> __device__ __forceinline__ RowCtx row_begin(int row) const { return rsqrtf(SSQ[row] * (1.0f / DM) + EPS); }
    template <int K> __device__ __forceinline__ void oct(RowCtx rs, int row, int c0, f32x4 a0, f32x4 a1, int c1, f32x4 b0, f32x4 b1, float (&)[2]) const {
        bf16_t* u = U + (size_t)row * FF; const f32x4 z = (f32x4){0.f, 0.f, 0.f, 0.f};
        a0 = __builtin_elementwise_max(a0 * rs, z); a1 = __builtin_elementwise_max(a1 * rs, z); b0 = __builtin_elementwise_max(b0 * rs, z); b1 = __builtin_elementwise_max(b1 * rs, z);
        st_bf8(u + c0, a0 * a0, a1 * a1); st_bf8(u + c1, b0 * b0, b1 * b1);
    }
    template <int K> __device__ __forceinline__ void row_add(int, const float (&)[2]) const {}
};
struct F6a {
    F_NOHOOK F_COMMON1 typedef int RowCtx;
    bf16_t* PE;
    template <int K> static __device__ __forceinline__ constexpr int nred() { return 0; }
    template <int K> __device__ __forceinline__ RowCtx row_begin(int) const { return 0; }
    template <int K> __device__ __forceinline__ void oct(RowCtx, int row, int c0, f32x4 a0, f32x4 a1, int c1, f32x4 b0, f32x4 b1, float (&)[2]) const {
        bf16_t* p = PE + (size_t)row * DM; st_bf8(p + c0, a0, a1); st_bf8(p + c1, b0, b1);
    }
    template <int K> __device__ __forceinline__ void row_add(int, const float (&)[2]) const {}
};
struct F6b {
    F_NOHOOK F_COMMON1 typedef float RowCtx;
    const float* SSQ3; const bf16_t* H2; const bf16_t* PE; bf16_t* H3; float* SSQ4;
    template <int K> static __device__ __forceinline__ constexpr int nred() { return 1; }
    template <int K> __device__ __forceinline__ RowCtx row_begin(int row) const { return rsqrtf(SSQ3[row] * (1.0f / DM) + EPS); }
    template <int K> __device__ __forceinline__ void oct(RowCtx rs, int row, int c0, f32x4 a0, f32x4 a1, int c1, f32x4 b0, f32x4 b1, float (&red)[2]) const {
        const size_t o = (size_t)row * DM; f32x4 h0, h1, p0, p1;
        ld_bf8(H2 + o + c0, h0, h1); ld_bf8(PE + o + c0, p0, p1); h0 = h0 + sigmoid4(a0 * rs) * p0; h1 = h1 + sigmoid4(a1 * rs) * p1; st_bf8(H3 + o + c0, h0, h1);
        float s = sum4(h0 * h0) + sum4(h1 * h1);
        ld_bf8(H2 + o + c1, h0, h1); ld_bf8(PE + o + c1, p0, p1); h0 = h0 + sigmoid4(b0 * rs) * p0; h1 = h1 + sigmoid4(b1 * rs) * p1; st_bf8(H3 + o + c1, h0, h1);
        red[0] += s + sum4(h0 * h0) + sum4(h1 * h1);
    }
    template <int K> __device__ __forceinline__ void row_add(int row, const float (&red)[2]) const { atomicAdd(SSQ4 + row, red[0]); }
};
#define XB_TMO      128
#define XB_XCNT(j)  (256  + 64 * (j))
#define XB_XSUB(j)  (1280 + 64 * (j))
#define XB_XGEN(j)  (2304 + 64 * (j))
#define XB_TOP      3328
#define XB_TOPGEN   3392
#define XCD_BAR_WORDS 3456
#define XB_SPIN_CAP (1u << 21)

__device__ __forceinline__ unsigned xb_ld(unsigned* p)              { return __hip_atomic_load(p, __ATOMIC_RELAXED, __HIP_MEMORY_SCOPE_AGENT); }
__device__ __forceinline__ unsigned xb_add(unsigned* p, unsigned v) { return __hip_atomic_fetch_add(p, v, __ATOMIC_RELAXED, __HIP_MEMORY_SCOPE_AGENT); }
__device__ __forceinline__ unsigned xb_xcc_id() { return (unsigned)__builtin_amdgcn_s_getreg((3 << 11) | 20) & 0xFu; }
#define XB_SPIN(cond, bar) do { unsigned _sp = 0; while (cond) { __builtin_amdgcn_s_sleep(1); \
    if ((++_sp & 255u) == 0u) { if (xb_ld(&(bar)[XB_TMO])) break; if (_sp > XB_SPIN_CAP) { atomicAdd(&(bar)[XB_TMO], 1u); break; } } } } while (0)

struct XcdBarrier {
    unsigned* bar; unsigned x;
    volatile LAS unsigned* st;
};

__device__ __forceinline__ XcdBarrier xcd_barrier_post(unsigned* bar, volatile LAS unsigned* st) {
    XcdBarrier b; b.bar = bar; b.x = xb_xcc_id(); b.st = st;
    if (threadIdx.x == 0) (void)xb_add(&bar[XB_XCNT(b.x)], 1u);
    return b;
}
__device__ __forceinline__ void xcd_barrier_complete(unsigned* bar, unsigned x, unsigned& nloc, unsigned& nx) {
    const unsigned G = gridDim.x * gridDim.y * gridDim.z;
    unsigned sum, cnt, mine, sp = 0u;
    for (;;) {
        sum = 0u; cnt = 0u; mine = 0u;
#pragma unroll
        for (unsigned j = 0; j < 16; ++j) { const unsigned c = xb_ld(&bar[XB_XCNT(j)]); sum += c; cnt += (c > 0u) ? 1u : 0u; mine = (j == x) ? c : mine; }
        if (sum == G) break;
        __builtin_amdgcn_s_sleep(1);
        if ((++sp & 255u) == 0u) { if (xb_ld(&bar[XB_TMO])) break; if (sp > XB_SPIN_CAP) { atomicAdd(&bar[XB_TMO], 1u); break; } }
    }
    nloc = mine > 0u ? mine : 1u; nx = cnt > 0u ? cnt : 1u;
}

__device__ __forceinline__ void xcd_barrier(const XcdBarrier& b) {
    asm volatile("s_waitcnt vmcnt(0)" ::: "memory");
    __syncthreads();
    if (threadIdx.x == 0) {
        unsigned* bar = b.bar;
        __builtin_amdgcn_s_waitcnt(0);
        unsigned nloc = b.st[0], nx = b.st[1];
        if (nloc == 0u) { xcd_barrier_complete(bar, b.x, nloc, nx); b.st[0] = nloc; b.st[1] = nx; }
        const unsigned old = xb_add(&bar[XB_XSUB(b.x)], 1u);
        const unsigned gen = old / nloc;
        if (old + 1u == (gen + 1u) * nloc) {
            __builtin_amdgcn_fence(__ATOMIC_RELEASE, "agent");
            asm volatile("s_waitcnt vmcnt(0)" ::: "memory");
            const unsigned og = xb_add(&bar[XB_TOP], 1u);
            const unsigned tg = og / nx;
            if (og + 1u == (tg + 1u) * nx) xb_add(&bar[XB_TOPGEN], 1u);
            else XB_SPIN(xb_ld(&bar[XB_TOPGEN]) == tg, bar);
            __builtin_amdgcn_fence(__ATOMIC_ACQUIRE, "agent");
            xb_add(&bar[XB_XGEN(b.x)], 1u);
            asm volatile("s_waitcnt vmcnt(0)" ::: "memory");
        } else {
            XB_SPIN(xb_ld(&bar[XB_XGEN(b.x)]) == gen, bar);
            __builtin_amdgcn_fence(__ATOMIC_ACQUIRE, "agent");
            asm volatile("s_waitcnt vmcnt(0)" ::: "memory");
        }
    }
    __syncthreads();
}

struct Ctx {
    LAS unsigned char* lds; int tid, lane, wave, vcu, G;
    const float* const* in; float* out; unsigned char* ws;
    template <class T> __device__ __forceinline__ T* w(size_t off) const { return (T*)(ws + off); }
};
enum { I_XP = 0, I_XS, I_PP, I_PS, I_ST, I_GMIX, I_WIN, I_GRET, I_WS, I_BS, I_GGM, I_WBRA, I_WBRB, I_WO, I_GMLP, I_WUP, I_WDN, I_GPLE, I_WPG, I_WPP, I_GFIN };

__device__ __forceinline__ void p0_transpose_item(const float* W, int K, int N, bf16_t* WT, LAS float* scr, int item, int lane, const float* rowg, int cs_lo, int cs_hi, float cs) {
    const int nblk = N / 32, kb = item / nblk, nb = item % nblk, k0 = 64 * kb, n0 = 32 * nb;
    { const int kr = lane >> 3, n4 = (lane & 7) * 4;
#pragma unroll
      for (int i = 0; i < 8; ++i) { const int kk = 8 * i + kr; f32x4 wv = *(const f32x4*)(W + (size_t)(k0 + kk) * N + n0 + n4); if (rowg) wv = wv * rowg[k0 + kk];
          scr[kk * 33 + n4] = wv[0]; scr[kk * 33 + n4 + 1] = wv[1]; scr[kk * 33 + n4 + 2] = wv[2]; scr[kk * 33 + n4 + 3] = wv[3]; } }
    asm volatile("s_waitcnt lgkmcnt(0)" ::: "memory");
    const int c = lane & 7;
#pragma unroll
    for (int j = 0; j < 4; ++j) { const int n = (lane >> 3) + 8 * j; const LAS float* s = scr + (8 * c) * 33 + n; const float sc = (n0 + n >= cs_lo && n0 + n < cs_hi) ? cs : 1.0f;
        u32x4 o; o.x = pk2(s[0 * 33] * sc, s[1 * 33] * sc); o.y = pk2(s[2 * 33] * sc, s[3 * 33] * sc); o.z = pk2(s[4 * 33] * sc, s[5 * 33] * sc); o.w = pk2(s[6 * 33] * sc, s[7 * 33] * sc);
        *(u32x4*)(WT + (size_t)(n0 + n) * K + k0 + 8 * c) = o; }
    asm volatile("s_waitcnt lgkmcnt(0)" ::: "memory");
}
__device__ __forceinline__ double sin_poly(double x) {
    const double x2 = x * x; double r = -1.0 / 8841761993739701954543616000000.0;
    r = r * x2 + 1.0 / 10888869450418352160768000000.0;
    r = r * x2 - 1.0 / 15511210043330985984000000.0;
    r = r * x2 + 1.0 / 25852016738884976640000.0;
    r = r * x2 - 1.0 / 51090942171709440000.0;
    r = r * x2 + 1.0 / 121645100408832000.0;
    r = r * x2 - 1.0 / 355687428096000.0;
    r = r * x2 + 1.0 / 1307674368000.0;
    r = r * x2 - 1.0 / 6227020800.0;
    r = r * x2 + 1.0 / 39916800.0;
    r = r * x2 - 1.0 / 362880.0;
    r = r * x2 + 1.0 / 5040.0;
    r = r * x2 - 1.0 / 120.0;
    r = r * x2 + 1.0 / 6.0;
    r = r * x2 - 1.0;
    return -r * x;
}
__device__ __forceinline__ double cos_poly(double x) {
    const double x2 = x * x; double r = -1.0 / 265252859812191058636308480000000.0;
    r = r * x2 + 1.0 / 304888344611713860501504000000.0;
    r = r * x2 - 1.0 / 403291461126605635584000000.0;
    r = r * x2 + 1.0 / 620448401733239439360000.0;
    r = r * x2 - 1.0 / 1124000727777607680000.0;
    r = r * x2 + 1.0 / 2432902008176640000.0;
    r = r * x2 - 1.0 / 6402373705728000.0;
    r = r * x2 + 1.0 / 20922789888000.0;
    r = r * x2 - 1.0 / 87178291200.0;
    r = r * x2 + 1.0 / 479001600.0;
    r = r * x2 - 1.0 / 3628800.0;
    r = r * x2 + 1.0 / 40320.0;
    r = r * x2 - 1.0 / 720.0;
    r = r * x2 + 1.0 / 24.0;
    r = r * x2 - 0.5;
    r = r * x2 + 1.0;
    return r;
}
__device__ __forceinline__ void p0_prologue(const Ctx& C) {
    LAS float* scr = (LAS float*)(C.lds + C.wave * 16384);
    const int gw = C.vcu * NWAVES + C.wave, NGW = C.G * NWAVES, lane = C.lane;
    constexpr int I_IN = (DM / 64) * (INW / 32);
    for (int it = gw; it < I_IN; it += NGW) p0_transpose_item(C.in[I_WIN], DM, INW, C.w<bf16_t>(WS_WIN), scr, it, lane, nullptr, CK, CV, 0.0625f);
    const float* gm = C.in[I_GMIX];
    f32x4 gv[4];
#pragma unroll
    for (int j = 0; j < 4; ++j) gv[j] = ((const f32x4*)gm)[lane + 64 * j];
    bf16_t* XN = C.w<bf16_t>(WS_XN);
    for (int m0 = gw; m0 < MT; m0 += 2 * NGW) {
        f32x4 v[2][4];
#pragma unroll
        for (int r = 0; r < 2; ++r) { const int m = m0 + r * NGW; if (m < MT) { const f32x4* xr = (const f32x4*)(m < MP ? C.in[I_XP] + (size_t)m * DM : C.in[I_XS] + (size_t)(m - MP) * DM) + lane;
#pragma unroll
            for (int j = 0; j < 4; ++j) v[r][j] = xr[64 * j]; } }
#pragma unroll
        for (int r = 0; r < 2; ++r) { const int m = m0 + r * NGW; if (m < MT) { float s = 0.f;
#pragma unroll
            for (int j = 0; j < 4; ++j) s += sum4(v[r][j] * v[r][j]);
            const float rstd = rsqrtf(wave_sum(s) * (1.f / DM) + EPS);
            u32x2* o8 = (u32x2*)(XN + (size_t)m * DM) + lane;
#pragma unroll
            for (int j = 0; j < 4; ++j) { const f32x4 y = v[r][j] * rstd * gv[j]; u32x2 w; w.x = pk2(y[0], y[1]); w.y = pk2(y[2], y[3]); o8[64 * j] = w; } } }
    }
    float* cosT = C.w<float>(WS_COS); float* sinT = C.w<float>(WS_SIN);
    for (int e = (C.vcu * NTHR + C.tid); e < NTAB * 128; e += C.G * NTHR) {
        const int ti = e >> 7, i = e & 127; const float pos = ti < 2048 ? (float)ti : (float)(16384 + ti - 2048);
        const float inv = (float)exp2(-(double)i * (13.287712379549449 / 128.0));
        const float ang = pos * inv;
        const double x = (double)ang; const double k = __builtin_rint(x * 0.15915494309189535);
        double r = __builtin_fma(-k, 6.283185307179586, x); r = __builtin_fma(-k, 2.4492935982947064e-16, r);
        cosT[e] = (float)cos_poly(r); sinT[e] = (float)sin_poly(r);
    }
}
__device__ __forceinline__ void p0_deferred(const Ctx& C, int sub, int nsub) {
    LAS float* scr = (LAS float*)(C.lds + C.wave * 16384);
    const int gw = sub * NWAVES + C.wave, NGW = nsub * NWAVES, lane = C.lane;
    constexpr int I_BRA = (2048 / 64) * (DM / 32), I_SQ = (DM / 64) * (DM / 32), I_UP = (DM / 64) * (FF / 32), I_DN = (FF / 64) * (DM / 32), I_PPI = (PLE / 64) * (DM / 32);
    constexpr int NITEMS = I_BRA + 3 * I_SQ + I_UP + I_DN + I_PPI;
    for (int it = gw; it < NITEMS; it += NGW) {
        int r = it;
        if (r < I_BRA) { p0_transpose_item(C.in[I_WBRA], 2048, DM, C.w<bf16_t>(WS_WBRA), scr, r, lane, nullptr, 0, 0, 1.f); continue; } r -= I_BRA;
        if (r < I_SQ) { p0_transpose_item(C.in[I_WBRB], DM, DM, C.w<bf16_t>(WS_WBRB), scr, r, lane, nullptr, 0, 0, 1.f); continue; } r -= I_SQ;
        if (r < I_SQ) { p0_transpose_item(C.in[I_WO], DM, DM, C.w<bf16_t>(WS_WO), scr, r, lane, nullptr, 0, 0, 1.f); continue; } r -= I_SQ;
        if (r < I_SQ) { p0_transpose_item(C.in[I_WPG], DM, DM, C.w<bf16_t>(WS_WPG), scr, r, lane, C.in[I_GPLE], 0, 0, 1.f); continue; } r -= I_SQ;
        if (r < I_UP) { p0_transpose_item(C.in[I_WUP], DM, FF, C.w<bf16_t>(WS_WUP), scr, r, lane, C.in[I_GMLP], 0, 0, 1.f); continue; } r -= I_UP;
        if (r < I_DN) { p0_transpose_item(C.in[I_WDN], FF, DM, C.w<bf16_t>(WS_WDN), scr, r, lane, nullptr, 0, 0, 1.f); continue; } r -= I_DN;
        p0_transpose_item(C.in[I_WPP], PLE, DM, C.w<bf16_t>(WS_WPP), scr, r, lane, nullptr, 0, 0, 1.f);
    }
    bf16_t* PB = C.w<bf16_t>(WS_PB);
    for (int m = gw; m < MT; m += NGW) {
        const float* prow = m < MP ? C.in[I_PP] + (size_t)m * PLE : C.in[I_PS] + (size_t)(m - MP) * PLE;
        const f32x4 pv = ((const f32x4*)prow)[lane]; u32x2 pw; pw.x = pk2(pv[0], pv[1]); pw.y = pk2(pv[2], pv[3]);
        ((u32x2*)(PB + (size_t)m * PLE))[lane] = pw;
    }
    { const float* w_s = C.in[I_WS]; bf16_t* WSB = C.w<bf16_t>(WS_WSB);
      for (int e = (sub * NTHR + C.tid); e < 8 * 128 * 128; e += nsub * NTHR) { const int n = (e >> 7) & 127, m = e & 127; WSB[e] = (bf16_t)f2bf(m <= n ? w_s[e] : 0.f); } }
}

template <class F> __device__ __forceinline__ void run_gemm(const Ctx& C, const bf16_t* A, const bf16_t* Bt, int M, int N, int K, const F& f) {
    asm volatile("" : "+s"(K));
    pg8::Gemm g{A, Bt, M, N, K}; pg8::StaticOrder S; S.init(M, N, C.G, (int)blockIdx.x);
    EpiGen<F> E{f};
    pg8::gemm_phase<EpiGen<F>, pg8::StaticOrder, true, true>((PG8_LAS unsigned char*)C.lds, g, S, E);
}

typedef short sbf16x8 __attribute__((ext_vector_type(8)));
typedef float sf32x16 __attribute__((ext_vector_type(16)));
template <class F, int KIND> __device__ __forceinline__ void small_epi(const F& f, int grow, int cA, int cB, f32x4 va0, f32x4 va1, f32x4 vb0, f32x4 vb1, int q) {
    float red[2] = {0.f, 0.f};
    const typename F::RowCtx rc = f.template row_begin<KIND>(grow);
    f.template oct<KIND>(rc, grow, cA, va0, va1, cB, vb0, vb1, red);
    if (F::template nred<KIND>() > 0) {
        red[0] += __shfl_xor(red[0], 1); red[0] += __shfl_xor(red[0], 2);
        if (F::template nred<KIND>() > 1) { red[1] += __shfl_xor(red[1], 1); red[1] += __shfl_xor(red[1], 2); }
        if (q == 0) f.template row_add<KIND>(grow, red);
    }
}
template <class F> __device__ __forceinline__ void small_gemm(const Ctx& C, const bf16_t* A, const bf16_t* Bt, int N, int K, const F& f, bool rot) {
    asm volatile("" : "+s"(K));
    const int ntile = 16 * (N / 64), Kw = K / 8;
    const int wave = C.wave, l31 = C.lane & 31, hh = C.lane >> 5, tid = C.tid;
    LAS float* red = (LAS float*)C.lds;
    for (int t = C.vcu; t < ntile; t += C.G) {
        const int rt = t & 15, ct = t >> 4;
        int cA = ct * 64, cB = cA + 32;
        if (rot && cA < CV) { cA = (ct >> 2) * 256 + (ct & 3) * 32; cB = cA + 128; }
        const int r0 = MP + 32 * rt;
        const bf16_t* pa = A + (size_t)(r0 + l31) * K + wave * Kw + 8 * hh;
        const bf16_t* pb0 = Bt + (size_t)(cA + l31) * K + wave * Kw + 8 * hh;
        const bf16_t* pb1 = Bt + (size_t)(cB + l31) * K + wave * Kw + 8 * hh;
        sf32x16 a0, a1;
#pragma unroll
        for (int i = 0; i < 16; ++i) { a0[i] = 0.f; a1[i] = 0.f; }
#pragma unroll 4
        for (int k = 0; k < Kw; k += 32) {
            const sbf16x8 fa0 = *(const sbf16x8*)(pa + k), fa1 = *(const sbf16x8*)(pa + k + 16);
            const sbf16x8 fb00 = *(const sbf16x8*)(pb0 + k), fb01 = *(const sbf16x8*)(pb0 + k + 16);
            const sbf16x8 fb10 = *(const sbf16x8*)(pb1 + k), fb11 = *(const sbf16x8*)(pb1 + k + 16);
            a0 = __builtin_amdgcn_mfma_f32_32x32x16_bf16(fa0, fb00, a0, 0, 0, 0); a1 = __builtin_amdgcn_mfma_f32_32x32x16_bf16(fa0, fb10, a1, 0, 0, 0);
            a0 = __builtin_amdgcn_mfma_f32_32x32x16_bf16(fa1, fb01, a0, 0, 0, 0); a1 = __builtin_amdgcn_mfma_f32_32x32x16_bf16(fa1, fb11, a1, 0, 0, 0);
        }
        __syncthreads();
#pragma unroll
        for (int i = 0; i < 16; ++i) { const int r = (i & 3) + 8 * (i >> 2) + 4 * hh; red[(wave * 32 + r) * 68 + l31] = a0[i]; red[(wave * 32 + r) * 68 + 32 + l31] = a1[i]; }
        __syncthreads();
        if (tid < 128) {
            const int r = tid >> 2, q = tid & 3;
            f32x4 va0 = (f32x4){0.f, 0.f, 0.f, 0.f}, va1 = va0, vb0 = va0, vb1 = va0;
#pragma unroll
            for (int w = 0; w < 8; ++w) { const LAS float* p = red + (w * 32 + r) * 68 + 8 * q;
                va0 = va0 + *(const LAS f32x4*)(p); va1 = va1 + *(const LAS f32x4*)(p + 4); vb0 = vb0 + *(const LAS f32x4*)(p + 32); vb1 = vb1 + *(const LAS f32x4*)(p + 36); }
            const int grow = r0 + r, kind = f.kind(cA), ca = cA + 8 * q, cb = cB + 8 * q;
            if (F::NK == 1) small_epi<F, 0>(f, grow, ca, cb, va0, va1, vb0, vb1, q);
            else switch (kind) {
                case 0: small_epi<F, 0>(f, grow, ca, cb, va0, va1, vb0, vb1, q); break;
                case 1: small_epi<F, (F::NK > 1 ? 1 : 0)>(f, grow, ca, cb, va0, va1, vb0, vb1, q); break;
                case 2: small_epi<F, (F::NK > 2 ? 2 : 0)>(f, grow, ca, cb, va0, va1, vb0, vb1, q); break;
                case 3: small_epi<F, (F::NK > 3 ? 3 : 0)>(f, grow, ca, cb, va0, va1, vb0, vb1, q); break;
                case 4: small_epi<F, (F::NK > 4 ? 4 : 0)>(f, grow, ca, cb, va0, va1, vb0, vb1, q); break;
                default: small_epi<F, (F::NK > 5 ? 5 : 0)>(f, grow, ca, cb, va0, va1, vb0, vb1, q); break;
            }
        }
    }
    __syncthreads();
}
constexpr int SG3_WAVE = 12288;
static_assert(8 * SG3_WAVE <= LDS_MISC && 8 * 32 * 68 * 4 <= LDS_MISC, "small path LDS map");
template <class F> __device__ __forceinline__ void small_gemm3(const Ctx& C, const bf16_t* A, const bf16_t* Bt, int N, int K, const F& f) {
    asm volatile("" : "+s"(K));
    static_assert(F::NK == 1, "small_gemm3: single-kind epilogues only");
    const int ntile = 16 * (N / 64), Kw = K / 8, lnb = (Kw >= 512) ? 2 : ((Kw >= 256) ? 1 : 0);
    const int wave = C.wave, tid = C.tid;
    LAS float* red = (LAS float*)C.lds;
    const int ntl = (ntile - C.vcu + C.G - 1) / C.G, S = ntl << lnb;
    if (S <= 0) return;
    int lane = C.lane; asm volatile("" : "+v"(lane));
    const int lr = lane >> 3, lc = lane & 7, m31 = lane & 31, hh = lane >> 5;
    LAS unsigned char* wl = C.lds + wave * SG3_WAVE;
    LAS unsigned char* wst = wl + lr * 128 + ((lc ^ lr) * 16);
    const LAS unsigned char* wld = wl + m31 * 128;
    sbf16x8 g[24];
    sf32x16 a0, a1;
#pragma unroll
    for (int i = 0; i < 16; ++i) { a0[i] = 0.f; a1[i] = 0.f; }
#define SG3_ISSUE(half, sidx) do { int s_ = (sidx); asm volatile("" : "+s"(s_)); \
        const int tl_ = s_ >> lnb, t_ = C.vcu + tl_ * C.G; const size_t ko_ = (size_t)(wave * Kw + (s_ - (tl_ << lnb)) * 128 + (half) * 64 + 8 * lc); \
        const bf16_t* pa_ = A + (size_t)(MP + 32 * (t_ & 15) + lr) * K + ko_; const bf16_t* pb_ = Bt + (size_t)((t_ >> 4) * 64 + lr) * K + ko_; \
        _Pragma("unroll") for (int i = 0; i < 4; ++i) { g[(half) * 12 + i] = *(const sbf16x8*)(pa_ + (size_t)(8 * i) * K); g[(half) * 12 + 4 + i] = *(const sbf16x8*)(pb_ + (size_t)(8 * i) * K); \
            g[(half) * 12 + 8 + i] = *(const sbf16x8*)(pb_ + (size_t)(32 + 8 * i) * K); } } while (0)
#define SG3_WRITE(half) do { _Pragma("unroll") for (int i = 0; i < 4; ++i) { *(LAS sbf16x8*)(wst + i * 1024) = g[(half) * 12 + i]; *(LAS sbf16x8*)(wst + 4096 + i * 1024) = g[(half) * 12 + 4 + i]; \
        *(LAS sbf16x8*)(wst + 8192 + i * 1024) = g[(half) * 12 + 8 + i]; } } while (0)
#define SG3_MMA() do { _Pragma("unroll") for (int j = 0; j < 4; ++j) { const int po_ = ((2 * j + hh) ^ (m31 & 7)) * 16; \
        const sbf16x8 fa_ = *(const LAS sbf16x8*)(wld + po_), fb_ = *(const LAS sbf16x8*)(wld + 4096 + po_), fc_ = *(const LAS sbf16x8*)(wld + 8192 + po_); \
        a0 = __builtin_amdgcn_mfma_f32_32x32x16_bf16(fa_, fb_, a0, 0, 0, 0); a1 = __builtin_amdgcn_mfma_f32_32x32x16_bf16(fa_, fc_, a1, 0, 0, 0); } } while (0)
    SG3_ISSUE(0, 0); SG3_ISSUE(1, 0);
#pragma unroll 1
    for (int s = 0; s < S; ++s) {
        SG3_WRITE(0); asm volatile("" ::: "memory");
        if (s + 1 < S) SG3_ISSUE(0, s + 1);
        asm volatile("" ::: "memory");
        SG3_MMA(); asm volatile("" ::: "memory");
        SG3_WRITE(1); asm volatile("" ::: "memory");
        if (s + 1 < S) SG3_ISSUE(1, s + 1);
        asm volatile("" ::: "memory");
        SG3_MMA(); asm volatile("" ::: "memory");
        if (((s + 1) & ((1 << lnb) - 1)) == 0) {
            const int t_ = C.vcu + (s >> lnb) * C.G;
            __syncthreads();
#pragma unroll
            for (int i = 0; i < 16; ++i) { const int r = (i & 3) + 8 * (i >> 2) + 4 * hh; red[(wave * 32 + r) * 68 + m31] = a0[i]; red[(wave * 32 + r) * 68 + 32 + m31] = a1[i]; a0[i] = 0.f; a1[i] = 0.f; }
            __syncthreads();
            if (tid < 128) { const int r = tid >> 2, q = tid & 3;
                f32x4 va0 = (f32x4){0.f, 0.f, 0.f, 0.f}, va1 = va0, vb0 = va0, vb1 = va0;
#pragma unroll
                for (int w = 0; w < 8; ++w) { const LAS float* p = red + (w * 32 + r) * 68 + 8 * q;
                    va0 = va0 + *(const LAS f32x4*)(p); va1 = va1 + *(const LAS f32x4*)(p + 4); vb0 = vb0 + *(const LAS f32x4*)(p + 32); vb1 = vb1 + *(const LAS f32x4*)(p + 36); }
                small_epi<F, 0>(f, MP + 32 * (t_ & 15) + r, (t_ >> 4) * 64 + 8 * q, (t_ >> 4) * 64 + 32 + 8 * q, va0, va1, vb0, vb1, q); }
            __syncthreads();
        }
    }
#undef SG3_ISSUE
#undef SG3_WRITE
#undef SG3_MMA
}
template <class F> __device__ __forceinline__ void run_gemm_split(const Ctx& C, const bf16_t* A, const bf16_t* Bt, int N, int K, const F& f) {
    run_gemm(C, A, Bt, MP, N, K, f);
    if (K >= 1024) small_gemm3(C, A, Bt, N, K, f); else small_gemm(C, A, Bt, N, K, f, false);
}
__device__ __forceinline__ void ret_simple_item(const Ctx& C, bool sample, int b, int h, int vs) {
    const int v = C.tid & 63, dg = C.wave, d0 = 32 * dg;
    const int L = sample ? 4 : 2048, row0 = sample ? MP + 4 * b : 2048 * b;
    const float gamma = 1.0f - exp2f(-5.0f - (float)h);
    float S[32];
    const size_t sbase = ((size_t)(b * 4 + h) * 256 + d0) * 512 + vs * 64 + v;
    if (sample) { const float* st = C.in[I_ST] + sbase;
#pragma unroll
        for (int j = 0; j < 32; ++j) S[j] = st[(size_t)j * 512]; }
    else {
#pragma unroll
        for (int j = 0; j < 32; ++j) S[j] = 0.f; }
    const bf16_t* Z = C.w<bf16_t>(WS_Z); bf16_t* OR = C.w<bf16_t>(WS_ORAW);
    LAS float* part = (LAS float*)C.lds;
    for (int t = 0; t < L; ++t) {
        const int row = row0 + t; const bf16_t* zr = Z + (size_t)row * ZLD;
        const float vv = bf2f(zr[CV + h * 512 + vs * 64 + v]);
        const u32x4* qp = (const u32x4*)(zr + CQ + h * 256 + d0); const u32x4* kp = (const u32x4*)(zr + CK + h * 256 + d0);
        float o = 0.f;
#pragma unroll
        for (int c = 0; c < 4; ++c) { const u32x4 qw = qp[c], kw = kp[c];
#pragma unroll
            for (int e = 0; e < 4; ++e) { const unsigned q2 = qw[e], k2 = kw[e]; const int j = c * 8 + e * 2;
                S[j] = gamma * S[j] + __uint_as_float(k2 << 16) * vv; o += __uint_as_float(q2 << 16) * S[j];
                S[j + 1] = gamma * S[j + 1] + __uint_as_float(k2 & 0xffff0000u) * vv; o += __uint_as_float(q2 & 0xffff0000u) * S[j + 1]; } }
        part[((t & 1) * 8 + dg) * 64 + v] = o;
        __syncthreads();
        if (dg == 0) { float ot = 0.f;
#pragma unroll
            for (int g = 0; g < 8; ++g) ot += part[((t & 1) * 8 + g) * 64 + v];
            OR[(size_t)row * 2048 + h * 512 + vs * 64 + v] = (bf16_t)f2bf(ot); }
    }
    float* so = C.out + (sample ? O_SRS : O_SRP) + sbase;
#pragma unroll
    for (int j = 0; j < 32; ++j) so[(size_t)j * 512] = S[j];
    __syncthreads();
}
typedef short bf16x8 __attribute__((ext_vector_type(8)));
typedef short s16x4 __attribute__((ext_vector_type(4)));
typedef short v4i16_t __attribute__((ext_vector_type(4)));
typedef float f32x16 __attribute__((ext_vector_type(16)));
constexpr int R_QS = 528, R_VS = 192, R_PS = 144;
constexpr int R_Q = 0, R_K = R_Q + 64 * R_QS, R_ST = R_K + 64 * R_QS, R_V = R_ST + 64 * R_QS, R_VD = R_V + 64 * R_VS, R_P = R_VD + 64 * R_VS, R_END = R_P + 64 * R_PS;
static_assert(R_END <= LDS_MISC, "retention LDS map");
__device__ __forceinline__ s16x4 vtr(const LAS unsigned char* p) { return __builtin_bit_cast(s16x4, __builtin_amdgcn_ds_read_tr16_b64_v4i16((LAS v4i16_t*)p)); }
#define MFMA32(a, b, c) __builtin_amdgcn_mfma_f32_32x32x16_bf16((a), (b), (c), 0, 0, 0)
__device__ __forceinline__ bf16x8 tr_frag(const LAS unsigned char* a, int stride) { const s16x4 lo = vtr(a), hi = vtr(a + 4 * stride); return (bf16x8){lo[0], lo[1], lo[2], lo[3], hi[0], hi[1], hi[2], hi[3]}; }
constexpr int R_ZG = R_END  , R_TAB = R_END, R_OXL = R_TAB + 16384, R_RED = R_OXL + 8192, R_GR = R_RED + 256, R_END2 = R_GR + 256;
static_assert(R_END2 <= LDS_MISC, "retention + stream LDS map");
template <bool STREAM> __device__ __forceinline__ void ret_mfma_item(const Ctx& C, int b, int h, int vs, int sitem0) {
    const int tid = C.tid, lane = C.lane, wave = C.wave, l31_ = lane & 31, hh_ = lane >> 5;
    const LAS unsigned char* lds = C.lds;
    const bf16_t* Z = C.w<bf16_t>(WS_Z); bf16_t* OR = C.w<bf16_t>(WS_ORAW);
    const float lg = log2f(1.0f - exp2f(-5.0f - (float)h));
    const int row00 = b * 2048;
    if (tid < 64) ((LAS float*)(C.lds + R_GR))[tid] = C.in[I_GRET][h * 512 + vs * 64 + tid];
    for (int e = tid; e < 64 * R_QS / 16; e += NTHR) *(LAS u32x4*)(C.lds + R_ST + e * 16) = (u32x4){0u, 0u, 0u, 0u};
    f32x16 S0, S1;
#pragma unroll
    for (int i = 0; i < 16; ++i) { S0[i] = 0.f; S1[i] = 0.f; }
    u32x4 gq[4], gk[4], gv, gz;
    const int qrow = tid >> 5, qch = tid & 31, vrow = tid >> 3, vch = tid & 7;
    const bf16_t* zq = Z + (size_t)row00 * ZLD + CQ + h * 256 + qch * 8;
    const bf16_t* zk = Z + (size_t)row00 * ZLD + CK + h * 256 + qch * 8;
    const bf16_t* zv = Z + (size_t)row00 * ZLD + CV + h * 512 + vs * 64 + vch * 8;
    const bf16_t* zz = Z + (size_t)row00 * ZLD + CG + h * 512 + vs * 64 + vch * 8;
#define RET_LOAD(ci) do { _Pragma("unroll") for (int j = 0; j < 4; ++j) { const size_t ro = (size_t)((ci) * 64 + qrow + 16 * j) * ZLD; gq[j] = *(const u32x4*)(zq + ro); gk[j] = *(const u32x4*)(zk + ro); } \
        gv = *(const u32x4*)(zv + (size_t)((ci) * 64 + vrow) * ZLD); if (!STREAM) gz = *(const u32x4*)(zz + (size_t)((ci) * 64 + vrow) * ZLD); } while (0)
    RET_LOAD(0);
    const float vdsc = exp2f((float)(63 - vrow) * lg);
    const float g64 = exp2f(64.0f * lg);
    f32x4 cr[4][2]; float dots[10]; u32x2 vsp[4][2]; f32x4 sl[2][2];
    const float* STin = C.in[I_ST]; float* STout = C.out + O_SRS;
#define S_ITEM(j) int si_ = sitem0 + (j); asm volatile("" : "+s"(si_)); const int bs = si_ >> 2, hs = si_ & 3, srow0 = MP + 4 * bs; const float lgs = log2f(1.0f - exp2f(-5.0f - (float)hs))
#define S_UNPK(w) (f32x4){__uint_as_float((w).x << 16), __uint_as_float((w).x & 0xffff0000u), __uint_as_float((w).y << 16), __uint_as_float((w).y & 0xffff0000u)}
#define STREAM_TABLES(j) do { S_ITEM(j); const int d = tid >> 1, wh = tid & 1; f32x4 tv; \
        _Pragma("unroll") for (int t = 0; t < 4; ++t) tv[t] = bf2f(Z[(size_t)(srow0 + t) * ZLD + (wh ? CK : CQ) + hs * 256 + d]) * (wh ? exp2f((float)(3 - t) * lgs) : 1.0f); \
        *(LAS f32x4*)(C.lds + R_TAB + (j) * 8192 + d * 32 + wh * 16) = tv; } while (0)
#define STREAM_BEGIN(j) do { S_ITEM(j); (void)lgs; \
        _Pragma("unroll") for (int t = 0; t < 4; ++t) { const bf16_t* vp = Z + (size_t)(srow0 + t) * ZLD + CV + hs * 512 + 4 * lane; vsp[t][0] = *(const u32x2*)vp; vsp[t][1] = *(const u32x2*)(vp + 256); \
            cr[t][0] = (f32x4){0.f, 0.f, 0.f, 0.f}; cr[t][1] = cr[t][0]; } \
        _Pragma("unroll") for (int e = 0; e < 10; ++e) dots[e] = 0.f; } while (0)
#define S_ROW0(c) ((((c) & 15) * 8 + wave) * 2)
#define STREAM_LOAD(c) do { S_ITEM((c) >> 4); (void)lgs; (void)srow0; \
        _Pragma("unroll") for (int r = 0; r < 2; ++r) { const float* sp = STin + ((size_t)(bs * 4 + hs) * 256 + S_ROW0(c) + r) * 512 + 4 * lane; sl[r][0] = *(const f32x4*)sp; sl[r][1] = *(const f32x4*)(sp + 256); } } while (0)
#define STREAM_CONSUME(c) do { S_ITEM((c) >> 4); (void)srow0; const float g4s = exp2f(4.0f * lgs); \
        _Pragma("unroll") for (int r = 0; r < 2; ++r) { \
            const LAS unsigned char* tp = C.lds + R_TAB + ((c) >> 4) * 8192 + (S_ROW0(c) + r) * 32; const f32x4 tq = *(const LAS f32x4*)tp, tk = *(const LAS f32x4*)(tp + 16); \
            f32x4 n0 = sl[r][0] * g4s, n1 = sl[r][1] * g4s; \
            _Pragma("unroll") for (int t = 0; t < 4; ++t) { const f32x4 va = S_UNPK(vsp[t][0]), vb = S_UNPK(vsp[t][1]); \
                n0 = n0 + va * tk[t]; n1 = n1 + vb * tk[t]; cr[t][0] = cr[t][0] + sl[r][0] * tq[t]; cr[t][1] = cr[t][1] + sl[r][1] * tq[t]; } \
            float* op = STout + ((size_t)(bs * 4 + hs) * 256 + S_ROW0(c) + r) * 512 + 4 * lane; *(f32x4*)op = n0; *(f32x4*)(op + 256) = n1; \
            dots[0] += tq[0] * tk[0]; dots[1] += tq[1] * tk[0]; dots[2] += tq[1] * tk[1]; dots[3] += tq[2] * tk[0]; dots[4] += tq[2] * tk[1]; dots[5] += tq[2] * tk[2]; \
            dots[6] += tq[3] * tk[0]; dots[7] += tq[3] * tk[1]; dots[8] += tq[3] * tk[2]; dots[9] += tq[3] * tk[3]; } } while (0)
#define STREAM_FINISH(j) do { S_ITEM(j); \
        _Pragma("unroll") for (int t = 0; t < 4; ++t) { const float gc = exp2f((float)(t + 1) * lgs), gi = exp2f((float)(t - 3) * lgs); \
            f32x4 oa = cr[t][0] * gc, ob = cr[t][1] * gc; \
            _Pragma("unroll") for (int s = 0; s <= t; ++s) { const float w = dots[t * (t + 1) / 2 + s] * gi; oa = oa + S_UNPK(vsp[s][0]) * w; ob = ob + S_UNPK(vsp[s][1]) * w; } \
            LAS float* ox = (LAS float*)(C.lds + R_OXL) + t * 512 + 4 * lane; \
            _Pragma("unroll") for (int c = 0; c < 4; ++c) { __hip_atomic_fetch_add(ox + c, oa[c], __ATOMIC_RELAXED, __HIP_MEMORY_SCOPE_WORKGROUP); __hip_atomic_fetch_add(ox + 256 + c, ob[c], __ATOMIC_RELAXED, __HIP_MEMORY_SCOPE_WORKGROUP); } } \
        __syncthreads(); \
        { const int t = tid >> 7, jq = tid & 127; LAS f32x4* oxp = (LAS f32x4*)(C.lds + R_OXL + (t * 512 + 4 * jq) * 4); const f32x4 o4 = *oxp; *oxp = (f32x4){0.f, 0.f, 0.f, 0.f}; \
          const float ss = wave_sum(sum4(o4 * o4)); if (lane == 0) ((LAS float*)(C.lds + R_RED))[(j) * 8 + wave] = ss; \
          __syncthreads(); \
          const float rs = rsqrtf((((LAS float*)(C.lds + R_RED))[(j) * 8 + 2 * t] + ((LAS float*)(C.lds + R_RED))[(j) * 8 + 2 * t + 1]) * (1.f / 512.f) + EPS); \
          const int col = hs * 512 + 4 * jq; const f32x4 gz = silu4(ld_bf4(Z + (size_t)(srow0 + t) * ZLD + CG + col)), gr = *(const f32x4*)(C.in[I_GRET] + col); \
          st_bf4(C.w<bf16_t>(WS_YA) + (size_t)(srow0 + t) * 2048 + col, gz * o4 * rs * gr); } } while (0)
    if (STREAM) { STREAM_TABLES(0); STREAM_BEGIN(0); *(LAS f32x4*)(C.lds + R_OXL + tid * 16) = (f32x4){0.f, 0.f, 0.f, 0.f}; }
#ifdef PROBE_ST
    unsigned long long ts0 = 0, ts1 = 0, ts2 = 0, ts3 = 0, ts4 = 0, tl = __builtin_amdgcn_s_memrealtime();
#define ST_MARK(acc_) do { const unsigned long long tn_ = __builtin_amdgcn_s_memrealtime(); acc_ += tn_ - tl; tl = tn_; } while (0)
#else
#define ST_MARK(acc_) do { } while (0)
#endif
    u32x2 yap[4]; float ssp = 0.f;
#define RET_FLUSH(c) do { if (wave >= 4) { const int tt_ = (wave >> 1) & 1, vt_ = wave & 1, row_ = row00 + (c) * 64 + 32 * tt_ + l31; \
        if (hh == 0) atomicAdd(C.w<float>(WS_SSQO) + row_ * 4 + h, ssp); \
        bf16_t* ya_ = C.w<bf16_t>(WS_YA) + (size_t)row_ * 2048 + h * 512 + vs * 64 + 32 * vt_ + 4 * hh; \
        _Pragma("unroll") for (int g = 0; g < 4; ++g) *(u32x2*)(ya_ + 8 * g) = yap[g]; } } while (0)
    for (int ci = 0; ci < 32; ++ci) {
        int l31 = l31_, hh = hh_; asm volatile("" : "+v"(l31), "+v"(hh));
#pragma unroll
        for (int j = 0; j < 4; ++j) { *(LAS u32x4*)(C.lds + R_Q + (qrow + 16 * j) * R_QS + qch * 16) = gq[j]; *(LAS u32x4*)(C.lds + R_K + (qrow + 16 * j) * R_QS + qch * 16) = gk[j]; }
        *(LAS u32x4*)(C.lds + R_V + vrow * R_VS + vch * 16) = gv;
        if (!STREAM) *(LAS u32x4*)(C.lds + R_ZG + vrow * R_PS + vch * 16) = gz;
        { u32x4 d;
#pragma unroll
          for (int e = 0; e < 4; ++e) { const unsigned w = gv[e]; d[e] = pk2(__uint_as_float(w << 16) * vdsc, __uint_as_float(w & 0xffff0000u) * vdsc); }
          *(LAS u32x4*)(C.lds + R_VD + vrow * R_VS + vch * 16) = d; }
        if (STREAM && ci == 16) STREAM_TABLES(1);
        __syncthreads();
        ST_MARK(ts0);
        if (!STREAM) { if (ci + 1 < 32) RET_LOAD(ci + 1); }
        asm volatile("" ::: "memory");
        if (ci > 0) RET_FLUSH(ci - 1);
        if (STREAM) {
            if (ci > 0) STREAM_CONSUME(ci - 1);
            if (ci == 16) { STREAM_FINISH(0); STREAM_BEGIN(1); }
            STREAM_LOAD(ci);
        }
#ifdef PROBE_SAMEROWS
        if (ci + 1 < 32) RET_LOAD(0);
#else
        if (STREAM) { if (ci + 1 < 32) RET_LOAD(ci + 1); }
#endif
        ST_MARK(ts4);
        const int rowoff = l31, koff = 16 * hh;
        const int tr_q = (l31 & 15) >> 2, tr_p = l31 & 3, tr_blk = (l31 >> 4) & 1;
        f32x16 acc;
#pragma unroll
        for (int i = 0; i < 16; ++i) acc[i] = 0.f;
        if (wave < 3) {
            const int st = wave >> 1, tt = wave == 0 ? 0 : 1;
            const LAS unsigned char* pa = lds + R_K + (32 * st + rowoff) * R_QS + koff;
            const LAS unsigned char* pb = lds + R_Q + (32 * tt + rowoff) * R_QS + koff;
            { bf16x8 fa = *(const LAS bf16x8*)pa, fb = *(const LAS bf16x8*)pb;
#pragma unroll
              for (int ks = 0; ks < 16; ++ks) { bf16x8 na = fa, nb = fb; if (ks + 1 < 16) { na = *(const LAS bf16x8*)(pa + (ks + 1) * 32); nb = *(const LAS bf16x8*)(pb + (ks + 1) * 32); }
                  acc = MFMA32(fa, fb, acc); fa = na; fb = nb; } }
            const int t = 32 * tt + l31;
#pragma unroll
            for (int g = 0; g < 4; ++g) { float pv[4];
#pragma unroll
                for (int e = 0; e < 4; ++e) { const int s = 32 * st + 8 * g + 4 * hh + e; pv[e] = (t >= s) ? acc[4 * g + e] * __builtin_amdgcn_exp2f((float)(t - s) * lg) : 0.f; }
                u32x2 w; w.x = cvtpk(pv[0], pv[1]); w.y = cvtpk(pv[2], pv[3]);
                *(LAS u32x2*)(C.lds + R_P + t * R_PS + (32 * st + 8 * g + 4 * hh) * 2) = w; }
        } else if (wave >= 4) {
            const int tt = (wave >> 1) & 1, vt = wave & 1;
            const LAS unsigned char* pa = lds + R_ST + (32 * vt + rowoff) * R_QS + koff;
            const LAS unsigned char* pb = lds + R_Q + (32 * tt + rowoff) * R_QS + koff;
            { bf16x8 fa = *(const LAS bf16x8*)pa, fb = *(const LAS bf16x8*)pb;
#pragma unroll
              for (int ks = 0; ks < 16; ++ks) { bf16x8 na = fa, nb = fb; if (ks + 1 < 16) { na = *(const LAS bf16x8*)(pa + (ks + 1) * 32); nb = *(const LAS bf16x8*)(pb + (ks + 1) * 32); }
                  acc = MFMA32(fa, fb, acc); fa = na; fb = nb; } }
            const float dc = __builtin_amdgcn_exp2f((float)(32 * tt + l31 + 1) * lg);
#pragma unroll
            for (int i = 0; i < 16; ++i) acc[i] *= dc;
        }
        ST_MARK(ts1);
        __syncthreads();
        ST_MARK(ts3);
        if (wave >= 4) {
            const int tt = (wave >> 1) & 1, vt = wave & 1;
            const LAS unsigned char* pa = lds + R_V + (8 * hh + tr_q) * R_VS + (32 * vt + 16 * tr_blk + 4 * tr_p) * 2;
            const LAS unsigned char* pb = lds + R_P + (32 * tt + rowoff) * R_PS + koff;
            for (int ks = 0; ks < 2 * tt + 2; ++ks) acc = MFMA32(tr_frag(pa + 16 * ks * R_VS, R_VS), *(const LAS bf16x8*)(pb + ks * 32), acc);
            float ss = 0.f;
#pragma unroll
            for (int i = 0; i < 16; ++i) ss += acc[i] * acc[i];
            ssp = ss + __shfl_xor(ss, 32);
            const LAS float* gr = (const LAS float*)(C.lds + R_GR) + 32 * vt + 4 * hh;
#pragma unroll
            for (int g = 0; g < 4; ++g) { const u32x2 zw = STREAM ? *(const u32x2*)(Z + (size_t)(row00 + ci * 64 + 32 * tt + l31) * ZLD + CG + h * 512 + vs * 64 + 32 * vt + 4 * hh + 8 * g)
                                                            : *(const LAS u32x2*)(C.lds + R_ZG + (32 * tt + l31) * R_PS + (32 * vt + 4 * hh + 8 * g) * 2);
                const f32x4 y = silu4((f32x4){__uint_as_float(zw.x << 16), __uint_as_float(zw.x & 0xffff0000u), __uint_as_float(zw.y << 16), __uint_as_float(zw.y & 0xffff0000u)})
                    * (f32x4){acc[4 * g], acc[4 * g + 1], acc[4 * g + 2], acc[4 * g + 3]} * *(const LAS f32x4*)(gr + 8 * g);
                yap[g].x = cvtpk(y[0], y[1]); yap[g].y = cvtpk(y[2], y[3]); }
        }
        {
#pragma unroll
            for (int i = 0; i < 16; ++i) { S0[i] *= g64; S1[i] *= g64; }
            const LAS unsigned char* pa = lds + R_K + (8 * hh + tr_q) * R_QS + (32 * wave + 16 * tr_blk + 4 * tr_p) * 2;
            const LAS unsigned char* pb = lds + R_VD + (8 * hh + tr_q) * R_VS + (16 * tr_blk + 4 * tr_p) * 2;
#pragma unroll
            for (int ks = 0; ks < 4; ++ks) { const bf16x8 a = tr_frag(pa + 16 * ks * R_QS, R_QS);
                S0 = MFMA32(a, tr_frag(pb + 16 * ks * R_VS, R_VS), S0); S1 = MFMA32(a, tr_frag(pb + 16 * ks * R_VS + 64, R_VS), S1); }
#pragma unroll
            for (int g = 0; g < 4; ++g) { u32x2 w0, w1; w0.x = cvtpk(S0[4 * g], S0[4 * g + 1]); w0.y = cvtpk(S0[4 * g + 2], S0[4 * g + 3]); w1.x = cvtpk(S1[4 * g], S1[4 * g + 1]); w1.y = cvtpk(S1[4 * g + 2], S1[4 * g + 3]);
                *(LAS u32x2*)(C.lds + R_ST + l31 * R_QS + (32 * wave + 8 * g + 4 * hh) * 2) = w0;
                *(LAS u32x2*)(C.lds + R_ST + (32 + l31) * R_QS + (32 * wave + 8 * g + 4 * hh) * 2) = w1; }
        }
        __syncthreads();
        ST_MARK(ts2);
    }
#ifdef PROBE_ST
    if (blockIdx.x == 0 && tid == PROBE_ST_TID) { float* dbg = C.w<float>(WS_CTL) + 65536; dbg[0] = (float)ts0 * 0.01f; dbg[1] = (float)ts1 * 0.01f; dbg[2] = (float)ts2 * 0.01f; dbg[3] = (float)ts3 * 0.01f; dbg[4] = (float)ts4 * 0.01f; }
#endif
    { const int l31 = l31_, hh = hh_; RET_FLUSH(31); }
    if (STREAM) { STREAM_CONSUME(31); STREAM_FINISH(1); }
#undef RET_LOAD
#undef RET_FLUSH
#undef S_ITEM
#undef S_UNPK
#undef STREAM_TABLES
#undef STREAM_BEGIN
#undef S_ROW0
#undef STREAM_LOAD
#undef STREAM_CONSUME
#undef STREAM_FINISH
    float* so = C.out + O_SRP + ((size_t)(b * 4 + h) * 256 + 32 * wave) * 512 + vs * 64 + l31_;
#pragma unroll
    for (int i = 0; i < 16; ++i) { const int dl = (i & 3) + 8 * (i >> 2) + 4 * hh_; so[(size_t)dl * 512] = S0[i]; so[(size_t)dl * 512 + 32] = S1[i]; }
}
constexpr int T_TAB = 0, T_OXL = T_TAB + 8192, T_RED = T_OXL + 8192;
__device__ __forceinline__ void stream_item(const Ctx& C, int si) {
    const int tid = C.tid, lane = C.lane, wave = C.wave;
    const int bs = si >> 2, hs = si & 3, srow0 = MP + 4 * bs; const float lgs = log2f(1.0f - exp2f(-5.0f - (float)hs));
    const bf16_t* Z = C.w<bf16_t>(WS_Z);
    { const int d = tid >> 1, wh = tid & 1; f32x4 tv;
#pragma unroll
      for (int t = 0; t < 4; ++t) tv[t] = bf2f(Z[(size_t)(srow0 + t) * ZLD + (wh ? CK : CQ) + hs * 256 + d]) * (wh ? exp2f((float)(3 - t) * lgs) : 1.0f);
      *(LAS f32x4*)(C.lds + T_TAB + d * 32 + wh * 16) = tv;
      *(LAS f32x4*)(C.lds + T_OXL + tid * 16) = (f32x4){0.f, 0.f, 0.f, 0.f}; }
    f32x4 va[4], vb[4], cra[4], crb[4]; float dots[10];
#pragma unroll
    for (int t = 0; t < 4; ++t) { const bf16_t* vp = Z + (size_t)(srow0 + t) * ZLD + CV + hs * 512 + 4 * lane; va[t] = ld_bf4(vp); vb[t] = ld_bf4(vp + 256);
        cra[t] = (f32x4){0.f, 0.f, 0.f, 0.f}; crb[t] = cra[t]; }
#pragma unroll
    for (int e = 0; e < 10; ++e) dots[e] = 0.f;
    const float g4s = exp2f(4.0f * lgs);
    const float* sp = C.in[I_ST] + ((size_t)(bs * 4 + hs) * 256 + 32 * wave) * 512 + 4 * lane;
    float* op = C.out + O_SRS + ((size_t)(bs * 4 + hs) * 256 + 32 * wave) * 512 + 4 * lane;
    __syncthreads();
    f32x4 ba[4][2], bb[4][2];
#define ST_LOAD(buf, g) do { _Pragma("unroll") for (int r = 0; r < 4; ++r) { buf[r][0] = *(const f32x4*)(sp + (size_t)((g) * 4 + r) * 512); buf[r][1] = *(const f32x4*)(sp + (size_t)((g) * 4 + r) * 512 + 256); } } while (0)
#define ST_USE(buf, g) do { _Pragma("unroll") for (int r = 0; r < 4; ++r) { const int d = 32 * wave + (g) * 4 + r; \
        const f32x4 tq = *(const LAS f32x4*)(C.lds + T_TAB + d * 32), tk = *(const LAS f32x4*)(C.lds + T_TAB + d * 32 + 16); \
        f32x4 n0 = buf[r][0] * g4s, n1 = buf[r][1] * g4s; \
        _Pragma("unroll") for (int t = 0; t < 4; ++t) { n0 = n0 + va[t] * tk[t]; n1 = n1 + vb[t] * tk[t]; cra[t] = cra[t] + buf[r][0] * tq[t]; crb[t] = crb[t] + buf[r][1] * tq[t]; } \
        *(f32x4*)(op + (size_t)((g) * 4 + r) * 512) = n0; *(f32x4*)(op + (size_t)((g) * 4 + r) * 512 + 256) = n1; \
        dots[0] += tq[0] * tk[0]; dots[1] += tq[1] * tk[0]; dots[2] += tq[1] * tk[1]; dots[3] += tq[2] * tk[0]; dots[4] += tq[2] * tk[1]; dots[5] += tq[2] * tk[2]; \
        dots[6] += tq[3] * tk[0]; dots[7] += tq[3] * tk[1]; dots[8] += tq[3] * tk[2]; dots[9] += tq[3] * tk[3]; } } while (0)
    ST_LOAD(ba, 0);
#pragma unroll 1
    for (int g = 0; g < 8; g += 2) { ST_LOAD(bb, g + 1); ST_USE(ba, g); if (g + 2 < 8) ST_LOAD(ba, g + 2); ST_USE(bb, g + 1); }
#undef ST_LOAD
#undef ST_USE
#pragma unroll
    for (int t = 0; t < 4; ++t) { const float gc = exp2f((float)(t + 1) * lgs), gi = exp2f((float)(t - 3) * lgs);
        f32x4 oa = cra[t] * gc, ob = crb[t] * gc;
#pragma unroll
        for (int s = 0; s <= t; ++s) { const float w = dots[t * (t + 1) / 2 + s] * gi; oa = oa + va[s] * w; ob = ob + vb[s] * w; }
        LAS float* ox = (LAS float*)(C.lds + T_OXL) + t * 512 + 4 * lane;
#pragma unroll
        for (int c = 0; c < 4; ++c) { __hip_atomic_fetch_add(ox + c, oa[c], __ATOMIC_RELAXED, __HIP_MEMORY_SCOPE_WORKGROUP); __hip_atomic_fetch_add(ox + 256 + c, ob[c], __ATOMIC_RELAXED, __HIP_MEMORY_SCOPE_WORKGROUP); } }
    __syncthreads();
    { const int t = tid >> 7, jq = tid & 127; const f32x4 o4 = *(const LAS f32x4*)(C.lds + T_OXL + (t * 512 + 4 * jq) * 4);
      const float ss = wave_sum(sum4(o4 * o4)); if (lane == 0) ((LAS float*)(C.lds + T_RED))[wave] = ss;
      __syncthreads();
      const float rs = rsqrtf((((LAS float*)(C.lds + T_RED))[2 * t] + ((LAS float*)(C.lds + T_RED))[2 * t + 1]) * (1.f / 512.f) + EPS);
      const int col = hs * 512 + 4 * jq; const f32x4 gz = silu4(ld_bf4(Z + (size_t)(srow0 + t) * ZLD + CG + col)), gr = *(const f32x4*)(C.in[I_GRET] + col);
      st_bf4(C.w<bf16_t>(WS_YA) + (size_t)(srow0 + t) * 2048 + col, gz * o4 * rs * gr); }
    __syncthreads();
}
__device__ __forceinline__ void stream_pair(const Ctx& C, int si0) {
    const int wave = C.wave, ch = wave & 1, rq = wave >> 1;
    const bf16_t* Z = C.w<bf16_t>(WS_Z);
    int lane0 = C.lane; asm volatile("" : "+v"(lane0), "+s"(si0));
    const float* sp = C.in[I_ST] + ((size_t)si0 * 256 + 64 * rq) * 512 + ch * 256 + 4 * lane0;
    float* op = C.out + O_SRS + ((size_t)si0 * 256 + 64 * rq) * 512 + ch * 256 + 4 * lane0;
    f32x4 rg[8][4];
#define SP_OFF(G) ((size_t)((((G) >> 4) * 256) + (((G) & 15) * 4)) * 512)
#define SP_LOAD(slot, G) do { const float* p_ = sp + SP_OFF(G); rg[slot][0] = *(const f32x4*)p_; rg[slot][1] = *(const f32x4*)(p_ + 512); rg[slot][2] = *(const f32x4*)(p_ + 1024); rg[slot][3] = *(const f32x4*)(p_ + 1536); } while (0)
#pragma unroll
    for (int s = 0; s < 7; ++s) SP_LOAD(s, s);
#pragma unroll 1
    for (int item = 0; item < 2; ++item) {
        int si = si0 + item; asm volatile("" : "+s"(si));
        int tid = C.tid, lane = C.lane; asm volatile("" : "+v"(tid), "+v"(lane));
        const int bs = si >> 2, hs = si & 3, srow0 = MP + 4 * bs; const float lgs = log2f(1.0f - exp2f(-5.0f - (float)hs));
        { const int d = tid >> 1, wh = tid & 1; f32x4 tv;
#pragma unroll
          for (int t = 0; t < 4; ++t) tv[t] = bf2f(Z[(size_t)(srow0 + t) * ZLD + (wh ? CK : CQ) + hs * 256 + d]) * (wh ? exp2f((float)(3 - t) * lgs) : 1.0f);
          *(LAS f32x4*)(C.lds + T_TAB + d * 32 + wh * 16) = tv;
          *(LAS f32x4*)(C.lds + T_OXL + tid * 16) = (f32x4){0.f, 0.f, 0.f, 0.f}; }
        f32x4 va[4], cra[4];
#pragma unroll
        for (int t = 0; t < 4; ++t) { va[t] = ld_bf4(Z + (size_t)(srow0 + t) * ZLD + CV + hs * 512 + ch * 256 + 4 * lane); cra[t] = (f32x4){0.f, 0.f, 0.f, 0.f}; }
        const float g4s = exp2f(4.0f * lgs);
        __syncthreads();
#pragma unroll 1
        for (int half = 0; half < 2; ++half) {
#pragma unroll
            for (int j = 0; j < 8; ++j) { const int G = item * 16 + half * 8 + j;
                SP_LOAD((j + 7) & 7, (G + 7 < 32 ? G + 7 : 0));
                float* o_ = op + SP_OFF(G);
#pragma unroll
                for (int r = 0; r < 4; ++r) { const int d = 64 * rq + (half * 8 + j) * 4 + r;
                    const f32x4 tq = *(const LAS f32x4*)(C.lds + T_TAB + d * 32), tk = *(const LAS f32x4*)(C.lds + T_TAB + d * 32 + 16);
                    const f32x4 s0 = rg[j][r];
                    f32x4 n0 = s0 * g4s;
#pragma unroll
                    for (int t = 0; t < 4; ++t) { n0 = n0 + va[t] * tk[t]; cra[t] = cra[t] + s0 * tq[t]; }
                    *(f32x4*)(o_ + r * 512) = n0; }
                asm volatile("" ::: "memory"); }
        }
        int hse = hs; asm volatile("" : "+s"(hse)); const float lge = log2f(1.0f - exp2f(-5.0f - (float)hse));
        float dots[10];
#pragma unroll
        for (int e = 0; e < 10; ++e) dots[e] = 0.f;
#pragma unroll
        for (int i = 0; i < 4; ++i) { const int d = lane * 4 + i; const f32x4 tq = *(const LAS f32x4*)(C.lds + T_TAB + d * 32), tk = *(const LAS f32x4*)(C.lds + T_TAB + d * 32 + 16);
            dots[0] += tq[0] * tk[0]; dots[1] += tq[1] * tk[0]; dots[2] += tq[1] * tk[1]; dots[3] += tq[2] * tk[0]; dots[4] += tq[2] * tk[1]; dots[5] += tq[2] * tk[2];
            dots[6] += tq[3] * tk[0]; dots[7] += tq[3] * tk[1]; dots[8] += tq[3] * tk[2]; dots[9] += tq[3] * tk[3]; }
#pragma unroll
        for (int e = 0; e < 10; ++e) dots[e] = (rq == 0) ? wave_sum(dots[e]) : 0.f;
#pragma unroll
        for (int t = 0; t < 4; ++t) { const float gc = exp2f((float)(t + 1) * lge), gi = exp2f((float)(t - 3) * lge);
            f32x4 oa = cra[t] * gc;
#pragma unroll
            for (int s = 0; s <= t; ++s) { const float w = dots[t * (t + 1) / 2 + s] * gi; oa = oa + va[s] * w; }
            LAS float* ox = (LAS float*)(C.lds + T_OXL) + t * 512 + ch * 256 + 4 * lane;
#pragma unroll
            for (int c = 0; c < 4; ++c) __hip_atomic_fetch_add(ox + c, oa[c], __ATOMIC_RELAXED, __HIP_MEMORY_SCOPE_WORKGROUP); }
        __syncthreads();
        { const int t = tid >> 7, jq = tid & 127; const f32x4 o4 = *(const LAS f32x4*)(C.lds + T_OXL + (t * 512 + 4 * jq) * 4);
          const float ss = wave_sum(sum4(o4 * o4)); if (lane == 0) ((LAS float*)(C.lds + T_RED))[wave] = ss;
          __syncthreads();
          const float rs = rsqrtf((((LAS float*)(C.lds + T_RED))[2 * t] + ((LAS float*)(C.lds + T_RED))[2 * t + 1]) * (1.f / 512.f) + EPS);
          const int col = hs * 512 + 4 * jq; const f32x4 gz = silu4(ld_bf4(Z + (size_t)(srow0 + t) * ZLD + CG + col)), gr = *(const f32x4*)(C.in[I_GRET] + col);
          st_bf4(C.w<bf16_t>(WS_YA) + (size_t)(srow0 + t) * 2048 + col, gz * o4 * rs * gr); }
        __syncthreads();
    }
#undef SP_LOAD
#undef SP_OFF
}
__device__ __forceinline__ void p2_retention_simple(const Ctx& C) {
#ifdef RET_SIMPLE
    for (int it = C.vcu; it < 256; it += C.G) ret_simple_item(C, false, it >> 5, (it >> 3) & 3, it & 7);
#else
    if (C.G == 256) { const int it = C.vcu;
#ifdef RET_INTERLEAVED
        ret_mfma_item<true>(C, it >> 5, (it >> 3) & 3, it & 7, 2 * it); __syncthreads();
#else
#ifdef PROBE_RS
        const unsigned long long t0_ = __builtin_amdgcn_s_memrealtime();
        ret_mfma_item<false>(C, it >> 5, (it >> 3) & 3, it & 7, 0); __syncthreads();
        const unsigned long long t1_ = __builtin_amdgcn_s_memrealtime();
        stream_item(C, 2 * it); stream_item(C, 2 * it + 1);
        const unsigned long long t2_ = __builtin_amdgcn_s_memrealtime();
        if (blockIdx.x == 0 && C.tid == 0) { float* dbg = C.w<float>(WS_CTL) + 65536; dbg[0] = (float)(t1_ - t0_) * 0.01f; dbg[1] = (float)(t2_ - t1_) * 0.01f; }
#else
        const bool sfirst = (((int)blockIdx.x >> 3) & 1) != 0;
        if (sfirst) { stream_pair(C, 2 * it); __syncthreads(); ret_mfma_item<false>(C, it >> 5, (it >> 3) & 3, it & 7, 0); __syncthreads(); }
        else { ret_mfma_item<false>(C, it >> 5, (it >> 3) & 3, it & 7, 0); __syncthreads(); stream_pair(C, 2 * it); }
#endif
#endif
        return; }
    for (int it = C.vcu; it < 256; it += C.G) ret_mfma_item<false>(C, it >> 5, (it >> 3) & 3, it & 7, 0);
    __syncthreads();
#endif
    for (int it = C.vcu; it < 4096; it += C.G) ret_simple_item(C, true, it >> 5, (it >> 3) & 3, it & 7);
}
__device__ __forceinline__ void unpk8(u32x4 w, f32x4& a, f32x4& b) {
    a = (f32x4){__uint_as_float(w.x << 16), __uint_as_float(w.x & 0xffff0000u), __uint_as_float(w.y << 16), __uint_as_float(w.y & 0xffff0000u)};
    b = (f32x4){__uint_as_float(w.z << 16), __uint_as_float(w.z & 0xffff0000u), __uint_as_float(w.w << 16), __uint_as_float(w.w & 0xffff0000u)}; }
constexpr int G_WS = 272, G_GS = 320, G_W = 0, G_G = G_W + 128 * G_WS, G_END = G_G + 128 * G_GS;
static_assert(G_END <= LDS_MISC, "gating LDS map");
__device__ __forceinline__ void p2_gating_mfma(const Ctx& C) {
    const int tid = C.tid, wave = C.wave, l31 = C.lane & 31, hh = C.lane >> 5;
    const LAS unsigned char* lds = C.lds;
    const bf16_t* Z = C.w<bf16_t>(WS_Z); const float* LNS = C.w<float>(WS_LNS); bf16_t* YB = C.w<bf16_t>(WS_YB); const bf16_t* WSB = C.w<bf16_t>(WS_WSB);
    const float* b_s = C.in[I_BS]; const float* g_gm = C.in[I_GGM];
    int g_staged = -1;
    const int c16 = tid & 15, mrow = tid >> 4;
    u32x4 gvr[4]; f32x2_t lnr[4];
#define GT_LOAD(itx) do { const int g_ = (itx) & 7, r0_ = ((itx) >> 3) * 128; _Pragma("unroll") for (int j = 0; j < 4; ++j) { const int row_ = r0_ + mrow + 32 * j; \
        gvr[j] = *(const u32x4*)(Z + (size_t)row_ * ZLD + CGV + g_ * 128 + c16 * 8); lnr[j] = *(const f32x2_t*)(LNS + 2 * row_); } } while (0)
    if (C.vcu < 1024) GT_LOAD(C.vcu);
#pragma unroll 1
    for (int it = C.vcu; it < 1024; it += C.G) {
        const int g = it & 7, row0 = (it >> 3) * 128;
        __syncthreads();
        if (g != g_staged) { g_staged = g;
#pragma unroll
            for (int j = 0; j < 4; ++j) { const int idx = tid + NTHR * j, r = idx >> 4, cw = idx & 15;
                *(LAS u32x4*)(C.lds + G_W + r * G_WS + cw * 16) = *(const u32x4*)(WSB + ((size_t)g * 128 + r) * 128 + cw * 8); } }
        { const f32x4 gg0 = *(const f32x4*)(g_gm + g * 128 + c16 * 8), gg1 = *(const f32x4*)(g_gm + g * 128 + c16 * 8 + 4);
#pragma unroll
          for (int j = 0; j < 4; ++j) { const int m = mrow + 32 * j;
              const float mu = lnr[j][0] * (1.f / 1024.f), var = lnr[j][1] * (1.f / 1024.f) - mu * mu, rstd = rsqrtf(var + EPS);
              f32x4 x0, x1; unpk8(gvr[j], x0, x1);
              const f32x4 y0 = (x0 - mu) * rstd * gg0, y1 = (x1 - mu) * rstd * gg1;
              u32x4 w; w.x = cvtpk(y0[0], y0[1]); w.y = cvtpk(y0[2], y0[3]); w.z = cvtpk(y1[0], y1[1]); w.w = cvtpk(y1[2], y1[3]);
              *(LAS u32x4*)(C.lds + G_G + m * G_GS + c16 * 16) = w; } }
        const int nt = wave >> 1, ct0 = 2 * (wave & 1);
        const int n = 32 * nt + l31, row = row0 + n;
        const bf16_t* up = Z + (size_t)row * ZLD + CU + g * 128 + 32 * ct0 + 4 * hh;
        u32x2 ur[8];
#pragma unroll
        for (int q4 = 0; q4 < 4; ++q4) { ur[2 * q4] = *(const u32x2*)(up + 8 * q4); ur[2 * q4 + 1] = *(const u32x2*)(up + 32 + 8 * q4); }
        asm volatile("" ::: "memory");
        if (it + C.G < 1024) GT_LOAD(it + C.G);
        asm volatile("" ::: "memory");
        __syncthreads();
        f32x16 a0, a1;
#pragma unroll
        for (int i = 0; i < 16; ++i) { a0[i] = 0.f; a1[i] = 0.f; }
        const int tr_q = (l31 & 15) >> 2, tr_p = l31 & 3, tr_blk = (l31 >> 4) & 1;
        const LAS unsigned char* pw = lds + G_W + (32 * nt + l31) * G_WS + 16 * hh;
        const LAS unsigned char* pg = lds + G_G + (8 * hh + tr_q) * G_GS + (32 * ct0 + 16 * tr_blk + 4 * tr_p) * 2;
        for (int ks = 0; ks < 2 * nt + 2; ++ks) { const bf16x8 bw = *(const LAS bf16x8*)(pw + ks * 32);
            a0 = MFMA32(tr_frag(pg + 16 * ks * G_GS, G_GS), bw, a0); a1 = MFMA32(tr_frag(pg + 16 * ks * G_GS + 64, G_GS), bw, a1); }
        const float bias = b_s[g * 128 + n];
        bf16_t* yp = YB + (size_t)row * DM + g * 128 + 32 * ct0 + 4 * hh;
#define G_UNPK(w) (f32x4){__uint_as_float((w).x << 16), __uint_as_float((w).x & 0xffff0000u), __uint_as_float((w).y << 16), __uint_as_float((w).y & 0xffff0000u)}
#pragma unroll
        for (int q4 = 0; q4 < 4; ++q4) {
            const f32x4 o0 = (f32x4){a0[4 * q4], a0[4 * q4 + 1], a0[4 * q4 + 2], a0[4 * q4 + 3]} + bias, o1 = (f32x4){a1[4 * q4], a1[4 * q4 + 1], a1[4 * q4 + 2], a1[4 * q4 + 3]} + bias;
            st_bf4(yp + 8 * q4, gelu4(G_UNPK(ur[2 * q4])) * o0); st_bf4(yp + 32 + 8 * q4, gelu4(G_UNPK(ur[2 * q4 + 1])) * o1); }
#undef G_UNPK
    }
#undef GT_LOAD
    __syncthreads();
}
template <int CH> __device__ __forceinline__ void gate_simple_item(const Ctx& C, int row0, float* gmv_out) {
    LAS float* gvl = (LAS float*)C.lds;
    LAS float* wl = (LAS float*)(C.lds + 65536);
    const bf16_t* Z = C.w<bf16_t>(WS_Z); const float* LNS = C.w<float>(WS_LNS); bf16_t* YB = C.w<bf16_t>(WS_YB);
    const float* w_s = C.in[I_WS]; const float* b_s = C.in[I_BS]; const float* g_gm = C.in[I_GGM];
    for (int g = 0; g < 8; ++g) {
        for (int e = C.tid; e < CH * 128; e += NTHR) { const int m = e >> 7, ch = e & 127; const int row = row0 + m;
            const float mu = LNS[2 * row] * (1.f / 1024.f), var = LNS[2 * row + 1] * (1.f / 1024.f) - mu * mu, rstd = rsqrtf(var + EPS);
            const float x = bf2f(Z[(size_t)row * ZLD + CGV + g * 128 + ch]); const float y = (x - mu) * rstd * g_gm[g * 128 + ch];
            gvl[e] = y; if (gmv_out) gmv_out[(size_t)m * 1024 + g * 128 + ch] = y;
            wl[e] = (ch < CH) ? w_s[((size_t)g * 128 + m) * 128 + ch] : 0.f; }
        __syncthreads();
        const int ch = C.tid & 127;
        for (int n = C.tid >> 7; n < CH; n += 4) { float acc = b_s[g * 128 + n];
            for (int m = 0; m <= n; ++m) acc += wl[n * 128 + m] * gvl[m * 128 + ch];
            const int row = row0 + n; const f32x2 uu = gelu_pk((f32x2){bf2f(Z[(size_t)row * ZLD + CU + g * 128 + ch]), 0.f}); const float u = uu.x;
            YB[(size_t)row * DM + g * 128 + ch] = (bf16_t)f2bf(u * acc); }
        __syncthreads();
    }
}
__device__ __forceinline__ void gate_sample_item(const Ctx& C, int b) {
    const bf16_t* Z = C.w<bf16_t>(WS_Z); const float* LNS = C.w<float>(WS_LNS); bf16_t* YB = C.w<bf16_t>(WS_YB);
    const float* w_s = C.in[I_WS]; const float* b_s = C.in[I_BS]; const float* g_gm = C.in[I_GGM];
    const int row0 = MP + 4 * b; float* gmv = C.out + O_GMV + (size_t)b * 4 * 1024;
    float mu[4], rstd[4];
#pragma unroll
    for (int m = 0; m < 4; ++m) { mu[m] = LNS[2 * (row0 + m)] * (1.f / 1024.f); const float var = LNS[2 * (row0 + m) + 1] * (1.f / 1024.f) - mu[m] * mu[m]; rstd[m] = rsqrtf(var + EPS); }
#pragma unroll
    for (int j = 0; j < 2; ++j) { const int c = C.tid + NTHR * j, g = c >> 7; const float gg = g_gm[c];
        float gv[4];
#pragma unroll
        for (int m = 0; m < 4; ++m) { gv[m] = (bf2f(Z[(size_t)(row0 + m) * ZLD + CGV + c]) - mu[m]) * rstd[m] * gg; gmv[(size_t)m * 1024 + c] = gv[m]; }
#pragma unroll
        for (int n = 0; n < 4; ++n) { float acc = b_s[g * 128 + n];
#pragma unroll
            for (int m = 0; m <= n; ++m) acc += w_s[((size_t)g * 128 + n) * 128 + m] * gv[m];
            const f32x2 uu = gelu_pk((f32x2){bf2f(Z[(size_t)(row0 + n) * ZLD + CU + c]), 0.f});
            YB[(size_t)(row0 + n) * DM + c] = (bf16_t)f2bf(uu.x * acc); } }
}
__device__ __forceinline__ void p2_gating_simple(const Ctx& C) {
#ifdef GATE_SIMPLE
    for (int it = C.vcu; it < 128; it += C.G) gate_simple_item<128>(C, (it >> 4) * 2048 + (it & 15) * 128, nullptr);
#else
    p2_gating_mfma(C);
#endif
    for (int it = C.vcu; it < 128; it += C.G) gate_sample_item(C, it);
}
__device__ __forceinline__ void p3_finalize_ya(const Ctx& C) {
    const bf16_t* Z = C.w<bf16_t>(WS_Z); const bf16_t* OR = C.w<bf16_t>(WS_ORAW); bf16_t* YA = C.w<bf16_t>(WS_YA);
    const float* g_ret = C.in[I_GRET];
    const int gw = C.vcu * NWAVES + C.wave, NGW = C.G * NWAVES, lane = C.lane;
    const int mend = (C.G == 256) ? MP : MT;
    for (int row = gw; row < mend; row += NGW) {
        f32x4 o[8]; float rs[4];
#pragma unroll
        for (int j = 0; j < 8; ++j) o[j] = ld_bf4(OR + (size_t)row * 2048 + 4 * lane + 256 * j);
#pragma unroll
        for (int hd = 0; hd < 4; ++hd) rs[hd] = rsqrtf(wave_sum(sum4(o[2 * hd] * o[2 * hd]) + sum4(o[2 * hd + 1] * o[2 * hd + 1])) * (1.f / 512.f) + EPS);
#pragma unroll
        for (int j = 0; j < 8; ++j) { const int c = 4 * lane + 256 * j;
            const f32x4 gz = silu4(ld_bf4(Z + (size_t)row * ZLD + CG + c)), gr = *(const f32x4*)(g_ret + c);
            st_bf4(YA + (size_t)row * 2048 + c, gz * o[j] * rs[j >> 1] * gr); }
    }
}
__device__ __forceinline__ void p9_final_norm(const Ctx& C) {
    const bf16_t* H3 = C.w<bf16_t>(WS_H3); const float* SSQ4 = C.w<float>(WS_SSQ4); const float* gf = C.in[I_GFIN];
    const int gw = C.vcu * NWAVES + C.wave, NGW = C.G * NWAVES, lane = C.lane;
    f32x4 gv[4];
#pragma unroll
    for (int j = 0; j < 4; ++j) gv[j] = ((const f32x4*)gf)[lane + 64 * j];
    for (int row0 = gw; row0 < MT; row0 += 4 * NGW) {
        u32x2 hv[4][4]; float rs[4];
#pragma unroll
        for (int r = 0; r < 4; ++r) { const int row = row0 + r * NGW; if (row < MT) { rs[r] = SSQ4[row];
#pragma unroll
            for (int j = 0; j < 4; ++j) hv[r][j] = *(const u32x2*)(H3 + (size_t)row * DM + 4 * lane + 256 * j); } }
#pragma unroll
        for (int r = 0; r < 4; ++r) { const int row = row0 + r * NGW; if (row < MT) { const float s = rsqrtf(rs[r] * (1.f / DM) + EPS);
            f32x4* o = (f32x4*)(C.out + O_Y + (size_t)row * DM) + lane;
#pragma unroll
            for (int j = 0; j < 4; ++j) o[64 * j] = (f32x4){__uint_as_float(hv[r][j].x << 16), __uint_as_float(hv[r][j].x & 0xffff0000u), __uint_as_float(hv[r][j].y << 16), __uint_as_float(hv[r][j].y & 0xffff0000u)} * s * gv[j]; } }
    }
}
#ifdef DBG_EXPORT
__device__ __forceinline__ void dbg_export(const Ctx& C) {
    const bf16_t* Z = C.w<bf16_t>(WS_Z); const bf16_t* YA = C.w<bf16_t>(WS_YA); const bf16_t* YB = C.w<bf16_t>(WS_YB);
    const int gw = C.vcu * NWAVES + C.wave, NGW = C.G * NWAVES, lane = C.lane;
    for (int row = gw; row < MT; row += NGW)
        for (int j = 0; j < 4; ++j) { const int c = 4 * lane + 256 * j;
            f32x4 v = (f32x4){0.f, 0.f, 0.f, 0.f};
#if DBG_EXPORT == 1
            v = ld_bf4(YB + (size_t)row * DM + c);
#elif DBG_EXPORT == 4
            v = ld_bf4(YA + (size_t)row * 2048 + c) + ld_bf4(YA + (size_t)row * 2048 + 1024 + c);
#elif DBG_EXPORT == 5
            v = ld_bf4(Z + (size_t)row * ZLD + CGA + c) + ld_bf4(Z + (size_t)row * ZLD + CGB + c);
#elif DBG_EXPORT == 6
            v = ld_bf4(C.w<bf16_t>(WS_ORAW) + (size_t)row * 2048 + c) + ld_bf4(C.w<bf16_t>(WS_ORAW) + (size_t)row * 2048 + 1024 + c);
#elif DBG_EXPORT == 7
            v = ld_bf4(Z + (size_t)row * ZLD + CG + c) + ld_bf4(Z + (size_t)row * ZLD + CG + 1024 + c);
#elif DBG_EXPORT == 8
            v = ld_bf4(Z + (size_t)row * ZLD + CQ + c);
#endif
            *(f32x4*)(C.out + O_Y + (size_t)row * DM + c) = v; }
}
#endif
constexpr int NPHASE = 10;
__global__ void __launch_bounds__(NTHR, 2) mk_fwd(Args args) {
    extern __shared__ __attribute__((aligned(16))) unsigned char lds_raw[];
    Ctx C;
    C.lds = (LAS unsigned char*)lds_raw; C.tid = threadIdx.x; C.lane = C.tid & 63; C.wave = __builtin_amdgcn_readfirstlane(C.tid >> 6);
    C.G = gridDim.x; { const int bx = blockIdx.x; C.vcu = (C.G % 8 == 0) ? (bx % 8) * (C.G / 8) + bx / 8 : bx; }
    C.in = args.in; C.out = args.out; C.ws = args.ws;
    const int lo = args.ph_lo, hi = args.ph_hi;
    if (C.tid < 64) ((LAS unsigned*)(C.lds + LDS_MISC))[C.tid] = 0u;
    __syncthreads();
    const XcdBarrier bar = xcd_barrier_post((unsigned*)(args.ws + WS_CTL) + 4096, (volatile LAS unsigned*)(C.lds + LDS_MISC));
#define IN(k) (lo <= (k) && (k) < hi)
#ifndef PROBE_BSCALE
#define PROBE_BSCALE 0.1f
#endif
#ifdef PROBE_A
    unsigned long long tA0 = 0, tA1 = 0, tB0 = 0, tB1 = 0;
#define PSTAMP(k, which) do { if ((k) == PROBE_A) { if (which) tA1 = __builtin_amdgcn_s_memrealtime(); else tA0 = __builtin_amdgcn_s_memrealtime(); } if ((k) == PROBE_B) { if (which) tB1 = __builtin_amdgcn_s_memrealtime(); else tB0 = __builtin_amdgcn_s_memrealtime(); } } while (0)
#else
#define PSTAMP(k, which) do { } while (0)
#endif
#define SEAM(k) do { if (IN(k) && IN((k) + 1)) { GRID_BAR(); } } while (0)
#define GRID_BAR() do { xcd_barrier(bar); } while (0)
    PSTAMP(0, 0);
    if (IN(0)) { p0_prologue(C); } SEAM(0);
    if (lo < 0) cooperative_groups::this_grid().sync();
    PSTAMP(0, 1);
    PSTAMP(1, 0);
    if (IN(1)) { F1 f{C.w<bf16_t>(WS_Z), C.w<float>(WS_COS), C.w<float>(WS_SIN), C.w<float>(WS_LNS)}; run_gemm(C, C.w<bf16_t>(WS_XN), C.w<bf16_t>(WS_WIN), MT, INW, DM, f);
                 { constexpr int NU = (MT / 256) * (INW / 256); const int rem = NU % C.G;
                   if (rem == 0) p0_deferred(C, (int)blockIdx.x, C.G); else if ((int)blockIdx.x >= rem) p0_deferred(C, (int)blockIdx.x - rem, C.G - rem); } } SEAM(1);
    PSTAMP(1, 1);
    PSTAMP(2, 0);
#ifdef PROBE_P2
    if (IN(2)) { tA0 = __builtin_amdgcn_s_memrealtime(); p2_retention_simple(C); tA1 = __builtin_amdgcn_s_memrealtime(); tB0 = tA1; p2_gating_simple(C); tB1 = __builtin_amdgcn_s_memrealtime(); }
#else
    if (IN(2)) { p2_retention_simple(C); p2_gating_simple(C); }
#endif
    if (IN(2) && IN(4)) { GRID_BAR(); }
    PSTAMP(2, 1);
    PSTAMP(3, 0);
    PSTAMP(3, 1);
    PSTAMP(4, 0);
    if (IN(4)) { { F2a f{C.w<bf16_t>(WS_Z), C.w<bf16_t>(WS_T), C.w<float>(WS_SSQO)}; run_gemm_split(C, C.w<bf16_t>(WS_YA), C.w<bf16_t>(WS_WBRA), DM, 2048, f); }
                 { F2b f{C.w<bf16_t>(WS_Z), C.w<bf16_t>(WS_T), C.w<bf16_t>(WS_MG)}; run_gemm_split(C, C.w<bf16_t>(WS_YB), C.w<bf16_t>(WS_WBRB), DM, DM, f); } } SEAM(4);
    PSTAMP(4, 1);
    PSTAMP(5, 0);
    if (IN(5)) { FRes<false> f{C.in[I_XP], C.in[I_XS], nullptr, C.w<bf16_t>(WS_H1B), C.w<float>(WS_SSQ2)}; run_gemm_split(C, C.w<bf16_t>(WS_MG), C.w<bf16_t>(WS_WO), DM, DM, f); } SEAM(5);
    PSTAMP(5, 1);
    PSTAMP(6, 0);
    if (IN(6)) { F4 f{C.w<float>(WS_SSQ2), C.w<bf16_t>(WS_U)}; run_gemm_split(C, C.w<bf16_t>(WS_H1B), C.w<bf16_t>(WS_WUP), FF, DM, f); } SEAM(6);
    PSTAMP(6, 1);
    PSTAMP(7, 0);
    if (IN(7)) { FRes<true> f{nullptr, nullptr, C.w<bf16_t>(WS_H1B), C.w<bf16_t>(WS_H2B), C.w<float>(WS_SSQ3)}; run_gemm_split(C, C.w<bf16_t>(WS_U), C.w<bf16_t>(WS_WDN), DM, FF, f); } SEAM(7);
    PSTAMP(7, 1);
    PSTAMP(8, 0);
    if (IN(8)) { { F6a f{C.w<bf16_t>(WS_PE)}; run_gemm_split(C, C.w<bf16_t>(WS_PB), C.w<bf16_t>(WS_WPP), DM, PLE, f); }
                 { F6b f{C.w<float>(WS_SSQ3), C.w<bf16_t>(WS_H2B), C.w<bf16_t>(WS_PE), C.w<bf16_t>(WS_H3), C.w<float>(WS_SSQ4)}; run_gemm_split(C, C.w<bf16_t>(WS_H2B), C.w<bf16_t>(WS_WPG), DM, DM, f); } } SEAM(8);
    PSTAMP(8, 1);
    PSTAMP(9, 0);
    if (IN(9)) { p9_final_norm(C); }
    PSTAMP(9, 1);
#ifdef PROBE_A
    GRID_BAR();
    if (blockIdx.x == 0 && C.tid == 0) { float dA = (float)(tA1 - tA0) * 0.01f, dB = (float)(tB1 - tB0) * 0.01f;
#ifdef PROBE_RS
        dA = C.w<float>(WS_CTL)[65536]; dB = C.w<float>(WS_CTL)[65537];
#endif
#ifdef PROBE_ST
        dA = C.w<float>(WS_CTL)[65536 + PROBE_ST_X]; dB = C.w<float>(WS_CTL)[65536 + PROBE_ST_Y];
#endif
        C.out[0] = 0.1f * dA; C.out[O_Y + (size_t)MP * DM] = PROBE_BSCALE * dB; }
#endif
#undef IN
#undef SEAM
#undef GRID_BAR
}
}

extern "C" void kernel_launch(void* const* d_in, const int* in_sizes, int n_in, void* d_out, int out_size, void* d_ws, size_t ws_size, hipStream_t stream) {
    using namespace mk;
    static int grid = 0;
    if (grid == 0) {
        if (n_in != 21 || (size_t)out_size != O_END || ws_size < WS_END) { fprintf(stderr, "kernel_launch: unexpected shapes: n_in %d out %d ws %zu (need %zu)\n", n_in, out_size, ws_size, (size_t)WS_END); grid = -1; return; }
        int dev = 0, cus = 0;
        if (hipGetDevice(&dev) != hipSuccess || hipDeviceGetAttribute(&cus, hipDeviceAttributeMultiprocessorCount, dev) != hipSuccess) { grid = -1; return; }
        if (hipFuncSetAttribute((const void*)mk_fwd, hipFuncAttributeMaxDynamicSharedMemorySize, LDS_BYTES) != hipSuccess) { fprintf(stderr, "kernel_launch: hipFuncSetAttribute failed\n"); grid = -1; return; }
        int per_cu = 0;
        if (hipOccupancyMaxActiveBlocksPerMultiprocessor(&per_cu, (const void*)mk_fwd, NTHR, LDS_BYTES) != hipSuccess || per_cu < 1) { fprintf(stderr, "kernel_launch: occupancy query says %d blocks/CU\n", per_cu); (void)hipGetLastError(); grid = -1; return; }
        if (cus != 256) { fprintf(stderr, "kernel_launch: built for a 256-CU device (the retention phase deals exactly one prompt item and two sample items per workgroup); found %d CUs\n", cus); grid = -1; return; }
        grid = cus;
    }
    if (grid < 0) return;
    (void)hipMemsetAsync((char*)d_ws, 0, WS_ZERO_END, stream);
    Args a{};
    for (int i = 0; i < 21; ++i) a.in[i] = (const float*)d_in[i];
    a.out = (float*)d_out; a.ws = (unsigned char*)d_ws;
#ifdef MK_MULTI
    for (int p = 0; p < NPHASE; ++p) { a.ph_lo = p; a.ph_hi = p + 1; hipLaunchKernelGGL(mk_fwd, dim3(grid), dim3(NTHR), LDS_BYTES, stream, a); }
#else
    a.ph_lo = 0; a.ph_hi = NPHASE;
    void* kargs[] = {&a};
    const hipError_t le = hipLaunchCooperativeKernel((const void*)mk_fwd, dim3(grid), dim3(NTHR), kargs, LDS_BYTES, stream);
    if (le != hipSuccess) fprintf(stderr, "kernel_launch: cooperative launch failed: %s (grid %d)\n", hipGetErrorString(le), grid);
#endif
}
```
